# Optimizing an MI355X kernel written in HIP

```python
import math
import jax, jax.numpy as jnp
from jax import lax
import numpy as np

D_MODEL = 1024
BATCH = 16
SEQ = 2048
DEPTH = 4
DEC_BATCH = 8
DEC_SEQ = 32
PAST_LEN = 1024

CHUNK = 64
N_A = DEPTH // 2
N_B = DEPTH - N_A
HG_HEADS = 8
HG_DK = D_MODEL // HG_HEADS
HG_DV = D_MODEL // HG_HEADS
GLA_BLOCK = 16
DA_HEADS = 8
DA_HEAD_DIM = D_MODEL // (2 * DA_HEADS)
Q_BLOCK = 128
NUM_BUCKETS = 32
MAX_DISTANCE = 256
D_FF = 2816
CONV_W = 3
PLE_DIM = 256
EPS = 1e-6

kernel_name = 'yoco_hgrn2_diffattn_streaming_step'


def rmsnorm(x, g):
    xf = x.astype(jnp.float32)
    y = xf * lax.rsqrt(jnp.mean(xf * xf, axis=-1, keepdims=True) + EPS)
    return (y * g.astype(jnp.float32)).astype(x.dtype)


def head_rmsnorm(x, g):
    return rmsnorm(x, g.reshape(x.shape[-2], x.shape[-1]))


def t5_bucket(rel):
    half = NUM_BUCKETS // 2
    ret = jnp.where(rel > 0, half, 0)
    n = jnp.abs(rel)
    max_exact = half // 2
    nf = jnp.maximum(n, 1).astype(jnp.float32)
    large = max_exact + (jnp.log(nf / max_exact) / math.log(MAX_DISTANCE / max_exact)
                         * (half - max_exact)).astype(jnp.int32)
    large = jnp.minimum(large, half - 1)
    return ret + jnp.where(n < max_exact, n, large)


def gla_blocked(q, k, v, logf, s0):
    B, T, H, dk = q.shape
    dv = v.shape[-1]
    pad = (-T) % GLA_BLOCK
    if pad:
        pw = ((0, 0), (0, pad), (0, 0), (0, 0))
        q, k, v, logf = [jnp.pad(a, pw) for a in (q, k, v, logf)]
    n = (T + pad) // GLA_BLOCK

    def blocks(a):
        return a.astype(jnp.float32).reshape(B, n, GLA_BLOCK, H, a.shape[-1]).transpose(1, 0, 2, 3, 4)

    qs, ks, vs, ls = blocks(q), blocks(k), blocks(v), blocks(logf)
    causal = jnp.tril(jnp.ones((GLA_BLOCK, GLA_BLOCK), dtype=bool))

    def step(S, inp):
        qb, kb, vb, lb = inp
        b = jnp.cumsum(lb, axis=1)
        b_last = b[:, -1:]
        qt = qb * jnp.exp(b)
        kt = kb * jnp.exp(-b)
        a = jnp.where(causal, jnp.einsum('blhk,bmhk->bhlm', qt, kt), 0.0)
        o = jnp.einsum('blhk,bhkv->blhv', qt, S) + jnp.einsum('bhlm,bmhv->blhv', a, vb)
        kd = kb * jnp.exp(b_last - b)
        S = jnp.exp(b_last[:, 0])[..., None] * S + jnp.einsum('bmhk,bmhv->bhkv', kd, vb)
        return S, o

    S, o = lax.scan(step, s0.astype(jnp.float32), (qs, ks, vs, ls))
    o = o.transpose(1, 0, 2, 3, 4).reshape(B, n * GLA_BLOCK, H, dv)[:, :T]
    return o, S


def hgrn2(h, s0, w_in, lower, g_out_norm, w_out):
    B, T, _ = h.shape
    qh, fh, ih, gh = jnp.split(h @ w_in, 4, axis=-1)
    fp = fh.astype(jnp.float32)
    logf = jnp.logaddexp(jnp.log(lower), jnp.log1p(-lower) + jax.nn.log_sigmoid(fp))
    kk = (1.0 - lower) * jax.nn.sigmoid(-fp)
    shp = (B, T, HG_HEADS, HG_DK)
    o, s = gla_blocked(jax.nn.silu(qh).reshape(shp), kk.reshape(shp),
                       ih.reshape(B, T, HG_HEADS, HG_DV), logf.reshape(shp), s0)
    o = head_rmsnorm(o, g_out_norm).astype(h.dtype) * jax.nn.silu(gh).reshape(B, T, HG_HEADS, HG_DV)
    return o.reshape(B, T, D_MODEL) @ w_out, s.astype(s0.dtype)


def diff_attn_core(q, k, v, q_pos, k_pos, rel_bias, lam):
    B, K = k.shape[0], k.shape[1]
    k = k.reshape(B, K, DA_HEADS, 2, DA_HEAD_DIM)
    s = jnp.einsum('bqhcd,bkhcd->bchqk', q, k).astype(jnp.float32) * (DA_HEAD_DIM ** -0.5)
    rel = k_pos[None, :] - q_pos[:, None]
    bias = jnp.transpose(rel_bias[t5_bucket(rel)], (2, 0, 1)).astype(jnp.float32)
    mask = (k_pos[None, :] // CHUNK) <= (q_pos[:, None] // CHUNK)
    p = jax.nn.softmax(jnp.where(mask, s + bias, -jnp.inf), axis=-1)
    w = p[:, 0] - lam * p[:, 1]
    return jnp.einsum('bhqk,bkhe->bqhe', w.astype(v.dtype), v)


def diff_attention(h, k_all, v_all, q_pos, k_pos, w_q, lam_p, g_subln, w_out, rel_bias, layer_idx, blocked):
    B, T, _ = h.shape
    q = (h @ w_q).reshape(B, T, DA_HEADS, 2, DA_HEAD_DIM)
    lam_init = 0.8 - 0.6 * math.exp(-0.3 * layer_idx)
    lp = lam_p.astype(jnp.float32)
    lam = jnp.exp(jnp.sum(lp[0] * lp[1])) - jnp.exp(jnp.sum(lp[2] * lp[3])) + lam_init
    if blocked:
        nb = T // Q_BLOCK
        qb = q.reshape(B, nb, Q_BLOCK, DA_HEADS, 2, DA_HEAD_DIM).transpose(1, 0, 2, 3, 4, 5)
        qpb = q_pos.reshape(nb, Q_BLOCK)
        o = lax.map(lambda a: diff_attn_core(a[0], k_all, v_all, a[1], k_pos, rel_bias, lam), (qb, qpb))
        o = o.transpose(1, 0, 2, 3, 4).reshape(B, T, DA_HEADS, 2 * DA_HEAD_DIM)
    else:
        o = diff_attn_core(q, k_all, v_all, q_pos, k_pos, rel_bias, lam)
    o = head_rmsnorm(o, g_subln) * (1.0 - lam_init)
    return o.reshape(B, T, D_MODEL) @ w_out


def conv_ffn(h, buf, w_in, cw, cb, w_out):
    g, u = jnp.split(h @ w_in, 2, axis=-1)
    T = g.shape[1]
    gp = jnp.concatenate([buf.astype(g.dtype), g], axis=1)
    c = cb
    for j in range(CONV_W):
        c = c + cw[j] * gp[:, j:j + T]
    return (jax.nn.silu(c) * u) @ w_out, gp[:, -(CONV_W - 1):]


def trunk(x, ple, pos, past_k, past_v, hg_s0, conv_s0, blocked,
          g_norms, w_in_a, lb_raw, g_hg, w_out_a, g_kv, w_kv, rel_bias,
          w_q_b, lam_b, g_subln, w_out_b, w_ffn_in, conv_w, conv_b, w_ffn_out,
          w_ple, w_ple_gate):
    B, T, _ = x.shape
    sm = jax.nn.softmax(lb_raw.astype(jnp.float32), axis=0)
    cs = jnp.cumsum(sm, axis=0)
    lower = cs - cs[0:1]
    hg_out, conv_out = [], []
    k_all = v_all = k_new = v_new = k_pos = None
    for i in range(DEPTH):
        h = rmsnorm(x, g_norms[i, 0])
        if i < N_A:
            m, s = hgrn2(h, hg_s0[i], w_in_a[i], lower[i], g_hg[i], w_out_a[i])
            hg_out.append(s)
        else:
            j = i - N_A
            m = diff_attention(h, k_all, v_all, pos, k_pos, w_q_b[j], lam_b[j], g_subln[j],
                               w_out_b[j], rel_bias, i, blocked)
        x = x + rmsnorm(m, g_norms[i, 1])
        h = rmsnorm(x, g_norms[i, 2])
        f, cbuf = conv_ffn(h, conv_s0[i], w_ffn_in[i], conv_w[i], conv_b[i], w_ffn_out[i])
        conv_out.append(cbuf)
        x = x + rmsnorm(f, g_norms[i, 3])
        x = x + jax.nn.sigmoid(x @ w_ple_gate[i]) * (ple[i] @ w_ple[i])
        if i == N_A - 1:
            kn, vn = jnp.split(rmsnorm(x, g_kv) @ w_kv, 2, axis=-1)
            k_new = kn.reshape(B, T, DA_HEADS, 2 * DA_HEAD_DIM)
            v_new = vn.reshape(B, T, DA_HEADS, 2 * DA_HEAD_DIM)
            if past_k is None:
                k_all, v_all, k_pos = k_new, v_new, pos
            else:
                k_all = jnp.concatenate([past_k.astype(k_new.dtype), k_new], axis=1)
                v_all = jnp.concatenate([past_v.astype(v_new.dtype), v_new], axis=1)
                k_pos = jnp.arange(past_k.shape[1] + T, dtype=jnp.int32)
    return x, k_new, v_new, jnp.stack(hg_out), jnp.stack(conv_out)


def setup_inputs(seed: int = 0) -> dict:
    key = jax.random.key(seed)
    ks = jax.random.split(key, 32)
    nrm = jax.random.normal
    f32 = jnp.float32
    d = {}
    d['x_prompt'] = nrm(ks[0], (BATCH, SEQ, D_MODEL), f32)
    d['x_sample'] = nrm(ks[1], (DEC_BATCH, DEC_SEQ, D_MODEL), f32)
    d['cache_k'] = nrm(ks[2], (DEC_BATCH, PAST_LEN, DA_HEADS, 2 * DA_HEAD_DIM), f32)
    d['cache_v'] = nrm(ks[3], (DEC_BATCH, PAST_LEN, DA_HEADS, 2 * DA_HEAD_DIM), f32)
    d['state_hgrn'] = 0.5 * nrm(ks[4], (N_A, DEC_BATCH, HG_HEADS, HG_DK, HG_DV), f32)
    d['state_conv'] = nrm(ks[5], (DEPTH, DEC_BATCH, CONV_W - 1, D_FF), f32)
    d['p_prompt'] = nrm(ks[6], (DEPTH, BATCH, SEQ, PLE_DIM), f32)
    d['p_sample'] = nrm(ks[7], (DEPTH, DEC_BATCH, DEC_SEQ, PLE_DIM), f32)
    sd = D_MODEL ** -0.5
    d['g_norms'] = 1.0 + 0.02 * nrm(ks[8], (DEPTH, 4, D_MODEL), f32)
    d['w_in_a'] = sd * nrm(ks[9], (N_A, D_MODEL, 4 * D_MODEL), f32)
    d['lb_raw'] = 0.5 * nrm(ks[10], (N_A, D_MODEL), f32)
    d['g_hg'] = 1.0 + 0.02 * nrm(ks[11], (N_A, D_MODEL), f32)
    d['w_out_a'] = sd * nrm(ks[12], (N_A, D_MODEL, D_MODEL), f32)
    d['g_kv'] = 1.0 + 0.02 * nrm(ks[13], (D_MODEL,), f32)
    d['w_kv'] = sd * nrm(ks[14], (D_MODEL, 2 * D_MODEL), f32)
    d['rel_bias'] = 0.2 * nrm(ks[15], (NUM_BUCKETS, DA_HEADS), f32)
    d['w_q_b'] = sd * nrm(ks[16], (N_B, D_MODEL, D_MODEL), f32)
    d['lam_b'] = 0.1 * nrm(ks[17], (N_B, 4, DA_HEAD_DIM), f32)
    d['g_subln'] = 1.0 + 0.02 * nrm(ks[18], (N_B, D_MODEL), f32)
    d['w_out_b'] = sd * nrm(ks[19], (N_B, D_MODEL, D_MODEL), f32)
    d['w_ffn_in'] = sd * nrm(ks[20], (DEPTH, D_MODEL, 2 * D_FF), f32)
    d['conv_w'] = (CONV_W ** -0.5) * nrm(ks[21], (DEPTH, CONV_W, D_FF), f32)
    d['conv_b'] = 0.01 * nrm(ks[22], (DEPTH, D_FF), f32)
    d['w_ffn_out'] = (D_FF ** -0.5) * nrm(ks[23], (DEPTH, D_FF, D_MODEL), f32)
    d['w_ple'] = (PLE_DIM ** -0.5) * nrm(ks[24], (DEPTH, PLE_DIM, D_MODEL), f32)
    d['w_ple_gate'] = sd * nrm(ks[25], (DEPTH, D_MODEL, D_MODEL), f32)
    return d


def reference(x_prompt, x_sample, cache_k, cache_v, state_hgrn, state_conv, p_prompt, p_sample,
              g_norms, w_in_a, lb_raw, g_hg, w_out_a, g_kv, w_kv, rel_bias,
              w_q_b, lam_b, g_subln, w_out_b, w_ffn_in, conv_w, conv_b, w_ffn_out,
              w_ple, w_ple_gate):
    weights = (g_norms, w_in_a, lb_raw, g_hg, w_out_a, g_kv, w_kv, rel_bias,
               w_q_b, lam_b, g_subln, w_out_b, w_ffn_in, conv_w, conv_b, w_ffn_out,
               w_ple, w_ple_gate)
    Bp, Tp, _ = x_prompt.shape
    Bs, Ts, _ = x_sample.shape
    pos_p = jnp.arange(Tp, dtype=jnp.int32)
    hg0 = jnp.zeros((N_A, Bp, HG_HEADS, HG_DK, HG_DV), x_prompt.dtype)
    cv0 = jnp.zeros((DEPTH, Bp, CONV_W - 1, D_FF), x_prompt.dtype)
    y_prompt, k_prompt, v_prompt, hgrn_prompt, conv_prompt = trunk(
        x_prompt, p_prompt, pos_p, None, None, hg0, cv0, True, *weights)
    pos_s = cache_k.shape[1] + jnp.arange(Ts, dtype=jnp.int32)
    y_sample, k_sample, v_sample, hgrn_sample, conv_sample = trunk(
        x_sample, p_sample, pos_s, cache_k, cache_v, state_hgrn, state_conv, False, *weights)
    return (y_prompt, y_sample, k_prompt, v_prompt, k_sample, v_sample,
            hgrn_prompt, hgrn_sample, conv_prompt, conv_sample)
```

```cpp
#include <hip/hip_runtime.h>
#include <hip/hip_cooperative_groups.h>
#include <cstdio>
namespace cg = cooperative_groups;

#define DI __device__ __forceinline__
typedef unsigned short u16;
typedef short bf16x8 __attribute__((ext_vector_type(8)));
typedef float f32x16 __attribute__((ext_vector_type(16)));
typedef float f32x4 __attribute__((ext_vector_type(4)));
typedef __bf16 bf2_t __attribute__((ext_vector_type(2)));
typedef float f2_t __attribute__((ext_vector_type(2)));
typedef unsigned u32x2 __attribute__((ext_vector_type(2)));
typedef unsigned u32x4 __attribute__((ext_vector_type(4)));

constexpr int D = 1024, ROWS_P = 32768, ROWS = 33024, DFF = 2816;
constexpr float EPS = 1e-6f;
constexpr float LOG2E = 1.4426950408889634f;
constexpr int NW = 25;

struct WD { const float* src; u16* dst; int K, N, mode, pad; };

struct P {
  const float *x_prompt, *x_sample, *cache_k, *cache_v, *state_hgrn, *state_conv, *p_prompt, *p_sample;
  const float *g_norms, *lb_raw, *g_hg, *g_kv, *rel_bias, *lam_b, *g_subln, *conv_w, *conv_b;
  float *y, *k_prompt, *v_prompt, *k_sample, *v_sample, *hgrn_prompt, *hgrn_sample, *conv_prompt, *conv_sample;
  u16 *wt_in_a, *wt_out_a, *wt_kv, *wt_q, *wt_out_b, *wt_ffn_in, *wt_ffn_out, *wt_ple, *wt_gate;
  u16 *XB, *OG; char* BIG;
  WD wd[NW];
};

DI unsigned pk2(float a, float b) { f2_t v = {a, b}; bf2_t r = __builtin_convertvector(v, bf2_t); return __builtin_bit_cast(unsigned, r); }
DI int ltid() { int t = threadIdx.x; asm volatile("" : "+v"(t)); return t; }
DI float bf2f(u16 x) { return __uint_as_float(((unsigned)x) << 16); }
DI float bflo(unsigned x) { return __uint_as_float(x << 16); }
DI float bfhi(unsigned x) { return __uint_as_float(x & 0xffff0000u); }
DI float sigm(float x) { return 1.f / (1.f + __expf(-x)); }
DI float wave_sum(float v) {
#pragma unroll
  for (int o = 32; o; o >>= 1) v += __shfl_xor(v, o);
  return v;
}
DI bf16x8 mk8(u32x2 lo, u32x2 hi) { u32x4 t = {lo[0], lo[1], hi[0], hi[1]}; return __builtin_bit_cast(bf16x8, t); }
DI bf16x8 mk8u(unsigned a, unsigned b, unsigned c, unsigned d) { u32x4 t = {a, b, c, d}; return __builtin_bit_cast(bf16x8, t); }

DI void prep_phase(const P& p, char* smem) {
  float* T = (float*)smem;
  const int tid = ltid();
  int total = 0;
  for (int i = 0; i < NW; ++i) total += (p.wd[i].K >> 6) * (p.wd[i].N >> 6);
  for (int flat = blockIdx.x; flat < total; flat += gridDim.x) {
    int wi = 0, base = 0;
    for (;;) { int nt = (p.wd[wi].K >> 6) * (p.wd[wi].N >> 6); if (flat < base + nt) break; base += nt; ++wi; }
    const WD& d = p.wd[wi];
    const int tix = flat - base, ntn = d.N >> 6;
    const int k0 = (tix / ntn) << 6, n0 = (tix % ntn) << 6;
    {
      const int n = tid & 63, kb = tid >> 6;
#pragma unroll
      for (int j = 0; j < 16; ++j) { int k = kb + 4 * j; T[k * 65 + n] = d.src[(size_t)(k0 + k) * d.N + n0 + n]; }
    }
    __syncthreads();
    {
      const int nn = tid >> 2, ks = tid & 3;
      int n = n0 + nn, drow = n;
      if (d.mode == 1) { int isu = n >= DFF; int ch = n - DFF * isu; drow = 128 * (ch >> 6) + 64 * ((ch >> 5) & 1) + 32 * isu + (ch & 31); }
      unsigned o[8];
#pragma unroll
      for (int j = 0; j < 8; ++j) o[j] = pk2(T[(16 * ks + 2 * j) * 65 + nn], T[(16 * ks + 2 * j + 1) * 65 + nn]);
      u32x4* dp = (u32x4*)(d.dst + (size_t)drow * d.K + k0 + 16 * ks);
      dp[0] = (u32x4){o[0], o[1], o[2], o[3]};
      dp[1] = (u32x4){o[4], o[5], o[6], o[7]};
    }
    __syncthreads();
  }
}

DI void rowop_phase(const P& p, bool x_from_in, const float* __restrict__ Madd, const float* __restrict__ gpost,
                    const float* __restrict__ gnext, u16* __restrict__ outH, const float* ple_p, const float* ple_s, u16* outP) {
  const int tidr = ltid();
  const int lane = tidr & 63;
  const int wave = (blockIdx.x * blockDim.x + tidr) >> 6;
  const int nwave = (gridDim.x * blockDim.x) >> 6;
  for (int r = wave; r < ROWS; r += nwave) {
    const float* xs = x_from_in ? (r < ROWS_P ? p.x_prompt + (size_t)r * D : p.x_sample + (size_t)(r - ROWS_P) * D) : p.y + (size_t)r * D;
    f32x4 x[4];
#pragma unroll
    for (int j = 0; j < 4; ++j) x[j] = *(const f32x4*)(xs + 4 * lane + 256 * j);
    if (Madd) {
      f32x4 m[4]; float ss = 0.f;
#pragma unroll
      for (int j = 0; j < 4; ++j) { m[j] = *(const f32x4*)(Madd + (size_t)r * D + 4 * lane + 256 * j); ss += m[j][0] * m[j][0] + m[j][1] * m[j][1] + m[j][2] * m[j][2] + m[j][3] * m[j][3]; }
      ss = wave_sum(ss);
      const float rs = rsqrtf(ss * (1.f / D) + EPS);
#pragma unroll
      for (int j = 0; j < 4; ++j) { f32x4 g = *(const f32x4*)(gpost + 4 * lane + 256 * j); x[j] += m[j] * rs * g; }
#pragma unroll
      for (int j = 0; j < 4; ++j) *(f32x4*)(p.y + (size_t)r * D + 4 * lane + 256 * j) = x[j];
    }
    float rx = 1.f;
    if (gnext) {
      float ss = 0.f;
#pragma unroll
      for (int j = 0; j < 4; ++j) ss += x[j][0] * x[j][0] + x[j][1] * x[j][1] + x[j][2] * x[j][2] + x[j][3] * x[j][3];
      ss = wave_sum(ss);
      rx = rsqrtf(ss * (1.f / D) + EPS);
    }
#pragma unroll
    for (int j = 0; j < 4; ++j) {
      f32x4 h = x[j] * rx;
      if (gnext) h *= *(const f32x4*)(gnext + 4 * lane + 256 * j);
      *(u32x2*)(outH + (size_t)r * D + 4 * lane + 256 * j) = (u32x2){pk2(h[0], h[1]), pk2(h[2], h[3])};
    }
    if (outP) {
      const float* ps = r < ROWS_P ? ple_p + (size_t)r * 256 : ple_s + (size_t)(r - ROWS_P) * 256;
      f32x4 v = *(const f32x4*)(ps + 4 * lane);
      *(u32x2*)(outP + (size_t)r * 256 + 4 * lane) = (u32x2){pk2(v[0], v[1]), pk2(v[2], v[3])};
    }
  }
}

template <class RowMap>
DI void gemm_core(const u16* __restrict__ A, int lda, RowMap rm, const u16* __restrict__ Bt, int ldb, int n0, int K,
                  f32x16 (&acc)[2][2], char* smem, const int tid) {
  const int l = tid & 63, w = tid >> 6, wm = w >> 1, wn = w & 1, l32 = l & 31, hh = l >> 5;
  const int lr = tid >> 3, lc = tid & 7;
  const u16* ap[4]; const u16* bp[4];
#pragma unroll
  for (int q = 0; q < 4; ++q) {
    ap[q] = A + (size_t)rm(q * 32 + lr) * lda + lc * 8;
    bp[q] = Bt + (size_t)(n0 + q * 32 + lr) * ldb + lc * 8;
  }
  const unsigned woff = lr * 128 + ((lc ^ ((lr >> 1) & 7)) << 4);
  const int swz = (l32 >> 1) & 7;
  const unsigned aoff = (wm * 64 + l32) * 128, boff = 16384 + (wn * 64 + l32) * 128;
  u32x4 ra[4], rb[4];
  const int nk = K >> 6;
#pragma unroll
  for (int q = 0; q < 4; ++q) { ra[q] = *(const u32x4*)(ap[q]); rb[q] = *(const u32x4*)(bp[q]); }
#pragma unroll
  for (int q = 0; q < 4; ++q) { *(u32x4*)(smem + woff + q * 4096) = ra[q]; *(u32x4*)(smem + 16384 + woff + q * 4096) = rb[q]; }
  __syncthreads();
  for (int kt = 0; kt < nk; ++kt) {
    const bool more = kt + 1 < nk;
    if (more) {
#pragma unroll
      for (int q = 0; q < 4; ++q) { ra[q] = *(const u32x4*)(ap[q] + (kt + 1) * 64); rb[q] = *(const u32x4*)(bp[q] + (kt + 1) * 64); }
    }
    const char* sb = smem + (kt & 1) * 32768;
#pragma unroll
    for (int ks = 0; ks < 4; ++ks) {
      const unsigned co = ((2 * ks + hh) ^ swz) << 4;
      bf16x8 a0 = *(const bf16x8*)(sb + aoff + co);
      bf16x8 a1 = *(const bf16x8*)(sb + aoff + 32 * 128 + co);
      bf16x8 b0 = *(const bf16x8*)(sb + boff + co);
      bf16x8 b1 = *(const bf16x8*)(sb + boff + 32 * 128 + co);
      acc[0][0] = __builtin_amdgcn_mfma_f32_32x32x16_bf16(b0, a0, acc[0][0], 0, 0, 0);
      acc[0][1] = __builtin_amdgcn_mfma_f32_32x32x16_bf16(b1, a0, acc[0][1], 0, 0, 0);
      acc[1][0] = __builtin_amdgcn_mfma_f32_32x32x16_bf16(b0, a1, acc[1][0], 0, 0, 0);
      acc[1][1] = __builtin_amdgcn_mfma_f32_32x32x16_bf16(b1, a1, acc[1][1], 0, 0, 0);
    }
    if (more) {
      char* db = smem + ((kt + 1) & 1) * 32768;
#pragma unroll
      for (int q = 0; q < 4; ++q) { *(u32x4*)(db + woff + q * 4096) = ra[q]; *(u32x4*)(db + 16384 + woff + q * 4096) = rb[q]; }
    }
    __syncthreads();
  }
}

DI bool next_tile(int it, int ntm, int ntn, int& tm, int& tn) {
  const int b = blockIdx.x, x = b & 7, slot = b >> 3, S = gridDim.x >> 3;
  const int nq = (ntm - x + 7) >> 3;
  const int L = slot + it * S;
  if (L >= nq * ntn) return false;
  const int gsize = 8 * ntn;
  const int grp = L / gsize, r = L - grp * gsize;
  const int gsz = min(8, nq - 8 * grp);
  tn = r / gsz;
  tm = x + 8 * (8 * grp + r % gsz);
  return true;
}

struct IdMap { int base; DI int operator()(int r) const { return base + r; } };
struct ClampMap { int rowbase, t0, T; DI int operator()(int r) const { int t = t0 + r; t = t < 0 ? 0 : (t > T - 1 ? T - 1 : t); return rowbase + t; } };

#define ZERO_ACC(a) _Pragma("unroll") for (int _i = 0; _i < 2; ++_i) _Pragma("unroll") for (int _j = 0; _j < 2; ++_j) _Pragma("unroll") for (int _e = 0; _e < 16; ++_e) a[_i][_j][_e] = 0.f;

template <int EPI>
DI void gemm_phase(const P& p, const u16* A, int K, const u16* Bt, int N, void* outp, char* smem) {
  const int tid = ltid(), l = tid & 63, w = tid >> 6, wm = w >> 1, wn = w & 1, l32 = l & 31, hh = l >> 5;
  const int ntm = ROWS / 128, ntn = N / 128;
  int tm, tn;
  for (int it = 0; next_tile(it, ntm, ntn, tm, tn); ++it) {
    f32x16 acc[2][2];
    ZERO_ACC(acc);
    gemm_core(A, K, IdMap{tm * 128}, Bt, K, tn * 128, K, acc, smem, tid);
    const int n0 = tn * 128;
#pragma unroll
    for (int mi = 0; mi < 2; ++mi) {
      const int m = tm * 128 + wm * 64 + mi * 32 + l32;
#pragma unroll
      for (int ni = 0; ni < 2; ++ni)
#pragma unroll
        for (int q = 0; q < 4; ++q) {
          const int n = n0 + wn * 64 + ni * 32 + 8 * q + 4 * hh;
          float v0 = acc[mi][ni][4 * q], v1 = acc[mi][ni][4 * q + 1], v2 = acc[mi][ni][4 * q + 2], v3 = acc[mi][ni][4 * q + 3];
          if (EPI == 0) {
            const int sec = n0 >> 10;
            if (sec == 0 || sec == 3) { v0 *= sigm(v0); v1 *= sigm(v1); v2 *= sigm(v2); v3 *= sigm(v3); }
            *(u32x2*)((u16*)outp + (size_t)m * 4096 + n) = (u32x2){pk2(v0, v1), pk2(v2, v3)};
          } else if (EPI == 1) {
            const float sc = 0.125f * LOG2E;
            *(u32x2*)((u16*)outp + (size_t)m * 1024 + n) = (u32x2){pk2(v0 * sc, v1 * sc), pk2(v2 * sc, v3 * sc)};
          } else if (EPI == 2) {
            *(f32x4*)((float*)outp + (size_t)m * 1024 + n) = (f32x4){v0, v1, v2, v3};
          } else {
            float* dst;
            if (n < 1024) dst = (m < ROWS_P ? p.k_prompt + (size_t)m * 1024 : p.k_sample + (size_t)(m - ROWS_P) * 1024) + n;
            else dst = (m < ROWS_P ? p.v_prompt + (size_t)m * 1024 : p.v_sample + (size_t)(m - ROWS_P) * 1024) + (n - 1024);
            *(f32x4*)dst = (f32x4){v0, v1, v2, v3};
          }
        }
    }
  }
}

DI void ple_phase(const P& p, int layer, char* smem) {
  const int tid = ltid(), l = tid & 63, w = tid >> 6, wm = w >> 1, wn = w & 1, l32 = l & 31, hh = l >> 5;
  const u16* XB2 = (const u16*)p.BIG;
  const u16* PB = (const u16*)(p.BIG + (size_t)ROWS * 1024 * 2);
  const u16* Wg = p.wt_gate + (size_t)layer * 1024 * 1024;
  const u16* Wp = p.wt_ple + (size_t)layer * 1024 * 256;
  int tm, tn;
  for (int it = 0; next_tile(it, ROWS / 128, 8, tm, tn); ++it) {
    unsigned pl[2][2][8];
    {
      f32x16 acc2[2][2];
      ZERO_ACC(acc2);
      gemm_core(PB, 256, IdMap{tm * 128}, Wp, 256, tn * 128, 256, acc2, smem, tid);
#pragma unroll
      for (int a = 0; a < 2; ++a)
#pragma unroll
        for (int b2 = 0; b2 < 2; ++b2)
#pragma unroll
          for (int e = 0; e < 8; ++e) pl[a][b2][e] = pk2(acc2[a][b2][2 * e], acc2[a][b2][2 * e + 1]);
    }
    f32x16 acc[2][2];
    ZERO_ACC(acc);
    gemm_core(XB2, 1024, IdMap{tm * 128}, Wg, 1024, tn * 128, 1024, acc, smem, tid);
#pragma unroll
    for (int mi = 0; mi < 2; ++mi) {
      const int m = tm * 128 + wm * 64 + mi * 32 + l32;
#pragma unroll
      for (int ni = 0; ni < 2; ++ni)
#pragma unroll
        for (int q = 0; q < 4; ++q) {
          const int n = tn * 128 + wn * 64 + ni * 32 + 8 * q + 4 * hh;
          f32x4* xp = (f32x4*)(p.y + (size_t)m * D + n);
          f32x4 x = *xp;
#pragma unroll
          for (int c = 0; c < 4; ++c) {
            const unsigned pv = pl[mi][ni][2 * q + (c >> 1)];
            x[c] += sigm(acc[mi][ni][4 * q + c]) * ((c & 1) ? bfhi(pv) : bflo(pv));
          }
          *xp = x;
        }
    }
  }
}

DI void ffn_in_phase(const P& p, int layer, char* smem) {
  const int tid = ltid(), l = tid & 63, w = tid >> 6, wm = w >> 1, wn = w & 1, l32 = l & 31, hh = l >> 5;
  const u16* Wt = p.wt_ffn_in + (size_t)layer * 5632 * 1024;
  u16* HID = (u16*)p.BIG;
  float* GS = (float*)smem;
  const float* cw = p.conv_w + (size_t)layer * 3 * DFF;
  const float* cb = p.conv_b + (size_t)layer * DFF;
  int tm, tn;
  for (int it = 0; next_tile(it, 280, 44, tm, tn); ++it) {
    int seq, T, rowbase, t0; bool last;
    if (tm < 272) { seq = tm / 17; int j = tm - seq * 17; T = 2048; rowbase = seq * 2048; t0 = 126 * j - 2; last = (j == 16); }
    else { seq = 16 + (tm - 272); T = 32; rowbase = ROWS_P + (tm - 272) * 32; t0 = -2; last = true; }
    f32x16 acc[2][2];
    ZERO_ACC(acc);
    gemm_core(p.XB, 1024, ClampMap{rowbase, t0, T}, Wt, 1024, tn * 128, 1024, acc, smem, tid);
    const int chw = tn * 64 + wn * 32;
    if (t0 < 0 && wm == 0 && l32 < 2) {
#pragma unroll
      for (int q = 0; q < 4; ++q) {
        f32x4 sv = {0.f, 0.f, 0.f, 0.f};
        if (seq >= 16) sv = *(const f32x4*)(p.state_conv + ((size_t)(layer * 8 + (seq - 16)) * 2 + l32) * DFF + chw + 8 * q + 4 * hh);
#pragma unroll
        for (int c = 0; c < 4; ++c) acc[0][0][4 * q + c] = sv[c];
      }
    }
#pragma unroll
    for (int mi = 0; mi < 2; ++mi)
#pragma unroll
      for (int i = 0; i < 16; ++i) {
        const int chl = wn * 32 + 8 * (i >> 2) + 4 * hh + (i & 3);
        GS[chl * 132 + wm * 64 + mi * 32 + l32] = acc[mi][0][i];
      }
    __syncthreads();
#pragma unroll
    for (int q = 0; q < 4; ++q) {
      const int chq = chw + 8 * q + 4 * hh;
      const f32x4 b4 = *(const f32x4*)(cb + chq);
      const f32x4 w0 = *(const f32x4*)(cw + chq), w1 = *(const f32x4*)(cw + DFF + chq), w2 = *(const f32x4*)(cw + 2 * DFF + chq);
#pragma unroll
      for (int mi = 0; mi < 2; ++mi) {
        const int m = wm * 64 + mi * 32 + l32;
        const int t = t0 + m;
        if (m >= 2 && t < T) {
          float hv[4];
#pragma unroll
          for (int c = 0; c < 4; ++c) {
            const int chl = wn * 32 + 8 * q + 4 * hh + c;
            const float g0 = acc[mi][0][4 * q + c], g1 = GS[chl * 132 + m - 1], g2 = GS[chl * 132 + m - 2];
            const float cv = b4[c] + w0[c] * g2 + w1[c] * g1 + w2[c] * g0;
            hv[c] = cv * sigm(cv) * acc[mi][1][4 * q + c];
          }
          *(u32x2*)(HID + (size_t)(rowbase + t) * DFF + chq) = (u32x2){pk2(hv[0], hv[1]), pk2(hv[2], hv[3])};
          if (last && t >= T - 2) {
            float* co = seq < 16 ? p.conv_prompt + ((size_t)(layer * 16 + seq) * 2 + (t - (T - 2))) * DFF
                                 : p.conv_sample + ((size_t)(layer * 8 + (seq - 16)) * 2 + (t - (T - 2))) * DFF;
            *(f32x4*)(co + chq) = (f32x4){acc[mi][0][4 * q], acc[mi][0][4 * q + 1], acc[mi][0][4 * q + 2], acc[mi][0][4 * q + 3]};
          }
        }
      }
    }
    __syncthreads();
  }
}

DI void gla_phase(const P& p, int layer, char* smem) {
  const u16* PROJ = (const u16*)p.BIG;
  const int tid = ltid(), l = tid & 63, w = tid >> 6, l32 = l & 31, hh = l >> 5, m16 = l & 15;
  u16* QT = (u16*)smem;
  u16* KT = QT + 16 * 136;
  u16* KDT = KT + 16 * 136;
  float* DD = (float*)(KDT + 128 * 20);
  float* RED = DD + 128;
  const int k = tid & 127, th = tid >> 7;
  for (int item = blockIdx.x; item < 192; item += gridDim.x) {
    const int s = item >> 3, h = item & 7;
    const bool smp = s >= 16;
    const int T = smp ? 32 : 2048;
    const int rowbase = smp ? ROWS_P + (s - 16) * 32 : s * 2048;
    float lower = 0.f;
    if (layer == 1) lower = sigm(p.lb_raw[1024 + h * 128 + k] - p.lb_raw[h * 128 + k]);
    const float oml = 1.f - lower;
    f32x16 S[4];
    if (smp) {
      const float* sp = p.state_hgrn + ((size_t)(layer * 8 + (s - 16)) * 8 + h) * 16384 + 32 * w + l32;
#pragma unroll
      for (int kt = 0; kt < 4; ++kt)
#pragma unroll
        for (int i = 0; i < 16; ++i) S[kt][i] = sp[(size_t)(32 * kt + (i & 3) + 8 * (i >> 2) + 4 * hh) * 128];
    } else {
#pragma unroll
      for (int kt = 0; kt < 4; ++kt)
#pragma unroll
        for (int i = 0; i < 16; ++i) S[kt][i] = 0.f;
    }
    const int nblk = T >> 4;
    for (int blk = 0; blk < nblk; ++blk) {
      const size_t r0 = (size_t)rowbase + blk * 16;
      {
        const u16* pf = PROJ + r0 * 4096 + 1024 + h * 128 + k;
        const u16* pq = PROJ + (r0 + 8 * th) * 4096 + h * 128 + k;
        float bown[8], kown[8];
        float bsum = 0.f;
#pragma unroll
        for (int t = 0; t < 16; ++t) {
          const float f = bf2f(pf[(size_t)t * 4096]);
          const float g = lower + oml * sigm(f);
          bsum += __logf(g);
          if ((t >> 3) == 0) { if (th == 0) { bown[t & 7] = bsum; kown[t & 7] = 1.f - g; } }
          else { if (th == 1) { bown[t & 7] = bsum; kown[t & 7] = 1.f - g; } }
        }
        unsigned kdp[4];
        float kdprev = 0.f;
#pragma unroll
        for (int j = 0; j < 8; ++j) {
          const int t = 8 * th + j;
          const float q = bf2f(pq[(size_t)j * 4096]);
          const float qt = q * __expf(bown[j]);
          const float ktv = kown[j] * __expf(-bown[j]);
          const float kd = kown[j] * __expf(bsum - bown[j]);
          QT[t * 136 + k] = (u16)(pk2(qt, 0.f) & 0xffffu);
          KT[t * 136 + k] = (u16)(pk2(ktv, 0.f) & 0xffffu);
          if (j & 1) kdp[j >> 1] = pk2(kdprev, kd); else kdprev = kd;
        }
        *(u32x2*)(KDT + k * 20 + 8 * th) = (u32x2){kdp[0], kdp[1]};
        *(u32x2*)(KDT + k * 20 + 8 * th + 4) = (u32x2){kdp[2], kdp[3]};
        if (th == 0) DD[k] = __expf(bsum);
      }
      bf16x8 vfrag;
      {
        const u16* pv = PROJ + r0 * 4096 + 2048 + h * 128 + 32 * w + l32;
#pragma unroll
        for (int jj = 0; jj < 8; ++jj) vfrag[jj] = (short)pv[(size_t)(8 * (jj >> 2) + 4 * hh + (jj & 3)) * 4096];
      }
      __syncthreads();
      f32x16 aacc;
#pragma unroll
      for (int i = 0; i < 16; ++i) aacc[i] = 0.f;
#pragma unroll
      for (int ks = 0; ks < 8; ++ks) {
        bf16x8 ka = *(const bf16x8*)(KT + m16 * 136 + 16 * ks + 8 * hh);
        bf16x8 qb = *(const bf16x8*)(QT + m16 * 136 + 16 * ks + 8 * hh);
        aacc = __builtin_amdgcn_mfma_f32_32x32x16_bf16(ka, qb, aacc, 0, 0, 0);
      }
      float am[8];
#pragma unroll
      for (int i = 0; i < 8; ++i) { const int m = (i & 3) + 8 * (i >> 2) + 4 * hh; am[i] = (m <= m16) ? aacc[i] : 0.f; }
      const bf16x8 afrag = mk8u(pk2(am[0], am[1]), pk2(am[2], am[3]), pk2(am[4], am[5]), pk2(am[6], am[7]));
      f32x16 oacc;
#pragma unroll
      for (int i = 0; i < 16; ++i) oacc[i] = 0.f;
#pragma unroll
      for (int kt = 0; kt < 4; ++kt)
#pragma unroll
        for (int s2 = 0; s2 < 2; ++s2) {
          const bf16x8 sa = mk8u(pk2(S[kt][8 * s2], S[kt][8 * s2 + 1]), pk2(S[kt][8 * s2 + 2], S[kt][8 * s2 + 3]),
                                 pk2(S[kt][8 * s2 + 4], S[kt][8 * s2 + 5]), pk2(S[kt][8 * s2 + 6], S[kt][8 * s2 + 7]));
          const u32x2 lo = *(const u32x2*)(QT + m16 * 136 + 32 * kt + 16 * s2 + 4 * hh);
          const u32x2 hi = *(const u32x2*)(QT + m16 * 136 + 32 * kt + 16 * s2 + 8 + 4 * hh);
          oacc = __builtin_amdgcn_mfma_f32_32x32x16_bf16(sa, mk8(lo, hi), oacc, 0, 0, 0);
        }
      oacc = __builtin_amdgcn_mfma_f32_32x32x16_bf16(vfrag, afrag, oacc, 0, 0, 0);
#pragma unroll
      for (int kt = 0; kt < 4; ++kt) {
#pragma unroll
        for (int q = 0; q < 4; ++q) {
          const f32x4 d4 = *(const f32x4*)(DD + 32 * kt + 8 * q + 4 * hh);
#pragma unroll
          for (int c = 0; c < 4; ++c) S[kt][4 * q + c] *= d4[c];
        }
        const u32x2 lo = *(const u32x2*)(KDT + (32 * kt + l32) * 20 + 4 * hh);
        const u32x2 hi = *(const u32x2*)(KDT + (32 * kt + l32) * 20 + 8 + 4 * hh);
        S[kt] = __builtin_amdgcn_mfma_f32_32x32x16_bf16(mk8(lo, hi), vfrag, S[kt], 0, 0, 0);
      }
      float ss = 0.f;
#pragma unroll
      for (int i = 0; i < 16; ++i) ss += oacc[i] * oacc[i];
      ss += __shfl_xor(ss, 32);
      if (l < 16) RED[w * 16 + l] = ss;
      __syncthreads();
      if (l32 < 16) {
        const float tot = RED[l32] + RED[16 + l32] + RED[32 + l32] + RED[48 + l32];
        const float rn = rsqrtf(tot * (1.f / 128.f) + EPS);
        const size_t row = r0 + l32;
#pragma unroll
        for (int q = 0; q < 4; ++q) {
          const int v = h * 128 + 32 * w + 8 * q + 4 * hh;
          const u32x2 gs = *(const u32x2*)(PROJ + row * 4096 + 3072 + v);
          const f32x4 gh = *(const f32x4*)(p.g_hg + layer * 1024 + v);
          const float o0 = oacc[4 * q] * rn * gh[0] * bflo(gs[0]);
          const float o1 = oacc[4 * q + 1] * rn * gh[1] * bfhi(gs[0]);
          const float o2 = oacc[4 * q + 2] * rn * gh[2] * bflo(gs[1]);
          const float o3 = oacc[4 * q + 3] * rn * gh[3] * bfhi(gs[1]);
          *(u32x2*)(p.OG + row * 1024 + v) = (u32x2){pk2(o0, o1), pk2(o2, o3)};
        }
      }
    }
    {
      float* op = (smp ? p.hgrn_sample + ((size_t)(layer * 8 + (s - 16)) * 8 + h) * 16384
                       : p.hgrn_prompt + ((size_t)(layer * 16 + s) * 8 + h) * 16384) + 32 * w + l32;
#pragma unroll
      for (int kt = 0; kt < 4; ++kt)
#pragma unroll
        for (int i = 0; i < 16; ++i) op[(size_t)(32 * kt + (i & 3) + 8 * (i >> 2) + 4 * hh) * 128] = S[kt][i];
    }
  }
}

DI void attn_phase(const P& p, int layer, char* smem) {
  const int jl = layer - 2;
  const u16* Q = (const u16*)p.BIG;
  const int tid = ltid(), l = tid & 63, w = tid >> 6, l16 = l & 15, g = l >> 4;
  u16* KS = (u16*)smem;
  u16* VT = KS + 64 * 136;
  float* BT = (float*)(VT + 128 * 68);
  const float lam_init = 0.8f - 0.6f * __expf(-0.3f * (float)layer);
  float lam;
  {
    const float* lp = p.lam_b + jl * 256;
    float a = 0.f, b = 0.f;
    for (int d = 0; d < 64; ++d) { a += lp[d] * lp[64 + d]; b += lp[128 + d] * lp[192 + d]; }
    lam = __expf(a) - __expf(b) + lam_init;
  }
  for (int item = blockIdx.x; item < 4096 + 64; item += gridDim.x) {
    int b, h, nq, qrow0, qpos0, ntiles; bool smp;
    if (item < 4096) { const int jq = 31 - (item >> 7); const int bh = item & 127; b = bh >> 3; h = bh & 7; smp = false; nq = 64; qrow0 = b * 2048 + 64 * jq; qpos0 = 64 * jq; ntiles = jq + 1; }
    else { const int si = item - 4096; b = si >> 3; h = si & 7; smp = true; nq = 32; qrow0 = ROWS_P + b * 32; qpos0 = 1024; ntiles = 17; }
    if (tid < 230) {
      const int rel = tid - 166;
      const int n = rel < 0 ? -rel : rel;
      int bk = n < 8 ? n : 8 + (n >= 13) + (n >= 20) + (n >= 30) + (n >= 46) + (n >= 70) + (n >= 108) + (n >= 166);
      if (rel > 0) bk += 16;
      BT[tid] = p.rel_bias[bk * 8 + h] * LOG2E;
    }
    bf16x8 qf[2][2];
    {
      const int qr = min(16 * w + l16, nq - 1);
      const u16* qp = Q + (size_t)(qrow0 + qr) * 1024 + h * 128;
#pragma unroll
      for (int c = 0; c < 2; ++c)
#pragma unroll
        for (int ks = 0; ks < 2; ++ks) qf[c][ks] = *(const bf16x8*)(qp + c * 64 + 32 * ks + 8 * g);
    }
    f32x4 oacc[2][8];
#pragma unroll
    for (int c = 0; c < 2; ++c)
#pragma unroll
      for (int vs = 0; vs < 8; ++vs) oacc[c][vs] = (f32x4){0.f, 0.f, 0.f, 0.f};
    float mrun[2] = {-1e30f, -1e30f}, lsum[2] = {0.f, 0.f};
    const int qpos = qpos0 + min(16 * w + l16, nq - 1);
    for (int kt = 0; kt < ntiles; ++kt) {
      const float *kb, *vb; int nvalid = 64;
      if (!smp) { kb = p.k_prompt + ((size_t)(b * 2048 + 64 * kt)) * 1024 + h * 128; vb = p.v_prompt + ((size_t)(b * 2048 + 64 * kt)) * 1024 + h * 128; }
      else if (kt < 16) { kb = p.cache_k + ((size_t)(b * 1024 + 64 * kt)) * 1024 + h * 128; vb = p.cache_v + ((size_t)(b * 1024 + 64 * kt)) * 1024 + h * 128; }
      else { kb = p.k_sample + ((size_t)(b * 32)) * 1024 + h * 128; vb = p.v_sample + ((size_t)(b * 32)) * 1024 + h * 128; nvalid = 32; }
      __syncthreads();
#pragma unroll 4
      for (int pp = 0; pp < 8; ++pp) {
        const int key = 8 * pp + (tid >> 5), d4 = (tid & 31) * 4;
        f32x4 v = {0.f, 0.f, 0.f, 0.f};
        if (key < nvalid) v = *(const f32x4*)(kb + (size_t)key * 1024 + d4);
        *(u32x2*)(KS + key * 136 + d4) = (u32x2){pk2(v[0], v[1]), pk2(v[2], v[3])};
      }
#pragma unroll 2
      for (int pp = 0; pp < 8; ++pp) {
        const int v = tid & 127, kq = 2 * pp + (tid >> 7);
        float e[4];
#pragma unroll
        for (int j = 0; j < 4; ++j) { const int key = 4 * kq + j; e[j] = key < nvalid ? vb[(size_t)key * 1024 + v] : 0.f; }
        *(u32x2*)(VT + v * 68 + 4 * kq) = (u32x2){pk2(e[0], e[1]), pk2(e[2], e[3])};
      }
      __syncthreads();
      f32x4 sacc[2][4];
#pragma unroll
      for (int c = 0; c < 2; ++c)
#pragma unroll
        for (int sub = 0; sub < 4; ++sub) {
          sacc[c][sub] = (f32x4){0.f, 0.f, 0.f, 0.f};
#pragma unroll
          for (int ks = 0; ks < 2; ++ks) {
            const bf16x8 kf = *(const bf16x8*)(KS + (16 * sub + l16) * 136 + c * 64 + 32 * ks + 8 * g);
            sacc[c][sub] = __builtin_amdgcn_mfma_f32_16x16x32_bf16(kf, qf[c][ks], sacc[c][sub], 0, 0, 0);
          }
        }
#pragma unroll
      for (int sub = 0; sub < 4; ++sub)
#pragma unroll
        for (int i = 0; i < 4; ++i) {
          const int kl = 16 * sub + 4 * g + i;
          int rel = 64 * kt + kl - qpos;
          rel = rel < -166 ? -166 : rel;
          const float bt = BT[rel + 166];
          const bool ok = kl < nvalid;
          sacc[0][sub][i] = ok ? sacc[0][sub][i] + bt : -30000.f;
          sacc[1][sub][i] = ok ? sacc[1][sub][i] + bt : -30000.f;
        }
      bf16x8 pf[2][2];
#pragma unroll
      for (int c = 0; c < 2; ++c) {
        float mx = -1e30f;
#pragma unroll
        for (int sub = 0; sub < 4; ++sub)
#pragma unroll
          for (int i = 0; i < 4; ++i) mx = fmaxf(mx, sacc[c][sub][i]);
        mx = fmaxf(mx, __shfl_xor(mx, 16));
        mx = fmaxf(mx, __shfl_xor(mx, 32));
        const float mnew = fmaxf(mrun[c], mx);
        const float alpha = __builtin_amdgcn_exp2f(mrun[c] - mnew);
        mrun[c] = mnew;
        float rs = 0.f;
#pragma unroll
        for (int sub = 0; sub < 4; ++sub)
#pragma unroll
          for (int i = 0; i < 4; ++i) { const float e = __builtin_amdgcn_exp2f(sacc[c][sub][i] - mnew); sacc[c][sub][i] = e; rs += e; }
        lsum[c] = lsum[c] * alpha + rs;
#pragma unroll
        for (int vs = 0; vs < 8; ++vs) oacc[c][vs] *= alpha;
#pragma unroll
        for (int j = 0; j < 2; ++j)
          pf[c][j] = mk8u(pk2(sacc[c][2 * j][0], sacc[c][2 * j][1]), pk2(sacc[c][2 * j][2], sacc[c][2 * j][3]),
                          pk2(sacc[c][2 * j + 1][0], sacc[c][2 * j + 1][1]), pk2(sacc[c][2 * j + 1][2], sacc[c][2 * j + 1][3]));
      }
#pragma unroll
      for (int j = 0; j < 2; ++j)
#pragma unroll
        for (int vs = 0; vs < 8; ++vs) {
          const u32x2 lo = *(const u32x2*)(VT + (16 * vs + l16) * 68 + 32 * j + 4 * g);
          const u32x2 hi = *(const u32x2*)(VT + (16 * vs + l16) * 68 + 32 * j + 16 + 4 * g);
          const bf16x8 vf = mk8(lo, hi);
          oacc[0][vs] = __builtin_amdgcn_mfma_f32_16x16x32_bf16(vf, pf[0][j], oacc[0][vs], 0, 0, 0);
          oacc[1][vs] = __builtin_amdgcn_mfma_f32_16x16x32_bf16(vf, pf[1][j], oacc[1][vs], 0, 0, 0);
        }
    }
#pragma unroll
    for (int c = 0; c < 2; ++c) { lsum[c] += __shfl_xor(lsum[c], 16); lsum[c] += __shfl_xor(lsum[c], 32); }
    const float inv0 = 1.f / lsum[0], inv1 = lam / lsum[1];
    float ss = 0.f;
#pragma unroll
    for (int vs = 0; vs < 8; ++vs)
#pragma unroll
      for (int i = 0; i < 4; ++i) { const float o = oacc[0][vs][i] * inv0 - oacc[1][vs][i] * inv1; oacc[0][vs][i] = o; ss += o * o; }
    ss += __shfl_xor(ss, 16);
    ss += __shfl_xor(ss, 32);
    const float rn = rsqrtf(ss * (1.f / 128.f) + EPS) * (1.f - lam_init);
    if (16 * w + l16 < nq) {
      const size_t row = (size_t)qrow0 + 16 * w + l16;
#pragma unroll
      for (int vs = 0; vs < 8; ++vs) {
        const int v = h * 128 + 16 * vs + 4 * g;
        const f32x4 gl = *(const f32x4*)(p.g_subln + jl * 1024 + v);
        *(u32x2*)(p.OG + row * 1024 + v) = (u32x2){pk2(oacc[0][vs][0] * rn * gl[0], oacc[0][vs][1] * rn * gl[1]),
                                                   pk2(oacc[0][vs][2] * rn * gl[2], oacc[0][vs][3] * rn * gl[3])};
      }
    }
  }
}

__global__ void __launch_bounds__(256, 2) yoco_megakernel(P p) {
  __shared__ __attribute__((aligned(16))) char smem[65536];
  cg::grid_group grid = cg::this_grid();
  prep_phase(p, smem);
  grid.sync();
  float* Mbuf = (float*)p.BIG;
  float* Fbuf = (float*)p.XB;
  u16* XB2 = (u16*)p.BIG;
  u16* PB = (u16*)(p.BIG + (size_t)ROWS * 1024 * 2);
  for (int i = 0; i < 4; ++i) {
    const float* gn = p.g_norms + i * 4 * D;
    rowop_phase(p, i == 0, nullptr, nullptr, gn, p.XB, nullptr, nullptr, nullptr);
    grid.sync();
    if (i < 2) {
      gemm_phase<0>(p, p.XB, 1024, p.wt_in_a + (size_t)i * 4096 * 1024, 4096, p.BIG, smem);
      grid.sync();
      gla_phase(p, i, smem);
      grid.sync();
      gemm_phase<2>(p, p.OG, 1024, p.wt_out_a + (size_t)i * 1024 * 1024, 1024, Mbuf, smem);
      grid.sync();
    } else {
      gemm_phase<1>(p, p.XB, 1024, p.wt_q + (size_t)(i - 2) * 1024 * 1024, 1024, p.BIG, smem);
      grid.sync();
      attn_phase(p, i, smem);
      grid.sync();
      gemm_phase<2>(p, p.OG, 1024, p.wt_out_b + (size_t)(i - 2) * 1024 * 1024, 1024, Mbuf, smem);
      grid.sync();
    }
    rowop_phase(p, i == 0, Mbuf, gn + D, gn + 2 * D, p.XB, nullptr, nullptr, nullptr);
    grid.sync();
    ffn_in_phase(p, i, smem);
    grid.sync();
    gemm_phase<2>(p, (const u16*)p.BIG, DFF, p.wt_ffn_out + (size_t)i * 1024 * DFF, 1024, Fbuf, smem);
    grid.sync();
    rowop_phase(p, false, Fbuf, gn + 3 * D, nullptr, XB2, p.p_prompt + (size_t)i * ROWS_P * 256, p.p_sample + (size_t)i * 256 * 256, PB);
    grid.sync();
    ple_phase(p, i, smem);
    grid.sync();
    if (i == 1) {
      rowop_phase(p, false, nullptr, nullptr, p.g_kv, p.XB, nullptr, nullptr, nullptr);
      grid.sync();
      gemm_phase<3>(p, p.XB, 1024, p.wt_kv, 2048, nullptr, smem);
      grid.sync();
    }
  }
}

extern "C" void kernel_launch(void* const* d_in, const int* in_sizes, int n_in, void* d_out, int out_size, void* d_ws,
                              size_t ws_size, hipStream_t stream) {
  static int grid_blocks = 0;
  if (!grid_blocks) {
    int dev = 0, cus = 0, per_cu = 0;
    hipGetDevice(&dev);
    hipDeviceGetAttribute(&cus, hipDeviceAttributeMultiprocessorCount, dev);
    hipOccupancyMaxActiveBlocksPerMultiprocessor(&per_cu, yoco_megakernel, 256, 0);
    if (per_cu > 2) per_cu = 2;
    grid_blocks = cus * per_cu;
    grid_blocks &= ~7;
  }
  P p{};
  const float* const* in = (const float* const*)d_in;
  p.x_prompt = in[0]; p.x_sample = in[1]; p.cache_k = in[2]; p.cache_v = in[3]; p.state_hgrn = in[4]; p.state_conv = in[5];
  p.p_prompt = in[6]; p.p_sample = in[7];
  p.g_norms = in[8]; const float* w_in_a = in[9]; p.lb_raw = in[10]; p.g_hg = in[11]; const float* w_out_a = in[12]; p.g_kv = in[13];
  const float* w_kv = in[14]; p.rel_bias = in[15]; const float* w_q_b = in[16]; p.lam_b = in[17]; p.g_subln = in[18];
  const float* w_out_b = in[19]; const float* w_ffn_in = in[20]; p.conv_w = in[21]; p.conv_b = in[22]; const float* w_ffn_out = in[23];
  const float* w_ple = in[24]; const float* w_ple_gate = in[25];
  float* o = (float*)d_out;
  p.y = o; o += (size_t)ROWS * D;
  p.k_prompt = o; o += (size_t)ROWS_P * D;
  p.v_prompt = o; o += (size_t)ROWS_P * D;
  p.k_sample = o; o += (size_t)256 * D;
  p.v_sample = o; o += (size_t)256 * D;
  p.hgrn_prompt = o; o += (size_t)2 * 16 * 8 * 16384;
  p.hgrn_sample = o; o += (size_t)2 * 8 * 8 * 16384;
  p.conv_prompt = o; o += (size_t)4 * 16 * 2 * DFF;
  p.conv_sample = o;
  u16* ws = (u16*)d_ws;
  p.wt_in_a = ws; ws += (size_t)2 * 4096 * 1024;
  p.wt_out_a = ws; ws += (size_t)2 * 1024 * 1024;
  p.wt_kv = ws; ws += (size_t)2048 * 1024;
  p.wt_q = ws; ws += (size_t)2 * 1024 * 1024;
  p.wt_out_b = ws; ws += (size_t)2 * 1024 * 1024;
  p.wt_ffn_in = ws; ws += (size_t)4 * 5632 * 1024;
  p.wt_ffn_out = ws; ws += (size_t)4 * 1024 * DFF;
  p.wt_ple = ws; ws += (size_t)4 * 1024 * 256;
  p.wt_gate = ws; ws += (size_t)4 * 1024 * 1024;
  p.XB = ws; ws += (size_t)ROWS * 1024;
  p.OG = ws; ws += (size_t)ROWS * 1024;
  p.BIG = (char*)ws;
  int n = 0;
  for (int i = 0; i < 2; ++i) p.wd[n++] = WD{w_in_a + (size_t)i * 1024 * 4096, p.wt_in_a + (size_t)i * 4096 * 1024, 1024, 4096, 0, 0};
  for (int i = 0; i < 2; ++i) p.wd[n++] = WD{w_out_a + (size_t)i * 1024 * 1024, p.wt_out_a + (size_t)i * 1024 * 1024, 1024, 1024, 0, 0};
  p.wd[n++] = WD{w_kv, p.wt_kv, 1024, 2048, 0, 0};
  for (int i = 0; i < 2; ++i) p.wd[n++] = WD{w_q_b + (size_t)i * 1024 * 1024, p.wt_q + (size_t)i * 1024 * 1024, 1024, 1024, 0, 0};
  for (int i = 0; i < 2; ++i) p.wd[n++] = WD{w_out_b + (size_t)i * 1024 * 1024, p.wt_out_b + (size_t)i * 1024 * 1024, 1024, 1024, 0, 0};
  for (int i = 0; i < 4; ++i) p.wd[n++] = WD{w_ffn_in + (size_t)i * 1024 * 5632, p.wt_ffn_in + (size_t)i * 5632 * 1024, 1024, 5632, 1, 0};
  for (int i = 0; i < 4; ++i) p.wd[n++] = WD{w_ffn_out + (size_t)i * DFF * 1024, p.wt_ffn_out + (size_t)i * 1024 * DFF, DFF, 1024, 0, 0};
  for (int i = 0; i < 4; ++i) p.wd[n++] = WD{w_ple + (size_t)i * 256 * 1024, p.wt_ple + (size_t)i * 1024 * 256, 256, 1024, 0, 0};
  for (int i = 0; i < 4; ++i) p.wd[n++] = WD{w_ple_gate + (size_t)i * 1024 * 1024, p.wt_gate + (size_t)i * 1024 * 1024, 1024, 1024, 0, 0};
  void* args[] = {&p};
  hipError_t e = hipLaunchCooperativeKernel((void*)yoco_megakernel, dim3(grid_blocks), dim3(256), args, 0, stream);
  if (e != hipSuccess) fprintf(stderr, "cooperative launch failed: %s (grid %d)\n", hipGetErrorString(e), grid_blocks);
}
```

```cpp
#include <hip/hip_runtime.h>
#include <hip/hip_cooperative_groups.h>
#include <cstdio>
namespace cg = cooperative_groups;

#define DI __device__ __forceinline__
typedef unsigned short u16;
typedef short bf16x8 __attribute__((ext_vector_type(8)));
typedef float f32x16 __attribute__((ext_vector_type(16)));
typedef float f32x4 __attribute__((ext_vector_type(4)));
typedef __bf16 bf2_t __attribute__((ext_vector_type(2)));
typedef float f2_t __attribute__((ext_vector_type(2)));
typedef unsigned u32x2 __attribute__((ext_vector_type(2)));
typedef unsigned u32x4 __attribute__((ext_vector_type(4)));

constexpr int D = 1024, ROWS_P = 32768, ROWS = 33024, DFF = 2816;
constexpr float EPS = 1e-6f;
constexpr float LOG2E = 1.4426950408889634f;
constexpr int NW = 25;
#ifndef REP_GEMM
#define REP_GEMM 1
#endif
#ifndef REP_GLA
#define REP_GLA 1
#endif
#ifndef REP_ATTN
#define REP_ATTN 1
#endif
#define REPG for (int _r = 0; _r < REP_GEMM; ++_r)

struct WD { const float* src; u16* dst; int K, N, mode, pad; };

struct P {
  const float *x_prompt, *x_sample, *cache_k, *cache_v, *state_hgrn, *state_conv, *p_prompt, *p_sample;
  const float *g_norms, *lb_raw, *g_hg, *g_kv, *rel_bias, *lam_b, *g_subln, *conv_w, *conv_b;
  float *y, *k_prompt, *v_prompt, *k_sample, *v_sample, *hgrn_prompt, *hgrn_sample, *conv_prompt, *conv_sample;
  u16 *wt_in_a, *wt_out_a, *wt_kv, *wt_q, *wt_out_b, *wt_ffn_in, *wt_ffn_out, *wt_ple, *wt_gate;
  u16 *XB, *OG; char* BIG; unsigned* bar;
  WD wd[NW];
};

DI unsigned pk2(float a, float b) { f2_t v = {a, b}; bf2_t r = __builtin_convertvector(v, bf2_t); return __builtin_bit_cast(unsigned, r); }
DI int ltid() { int t = threadIdx.x; asm volatile("" : "+v"(t)); return t; }
DI float bf2f(u16 x) { return __uint_as_float(((unsigned)x) << 16); }
DI float bflo(unsigned x) { return __uint_as_float(x << 16); }
DI float bfhi(unsigned x) { return __uint_as_float(x & 0xffff0000u); }
DI float sigm(float x) { return 1.f / (1.f + __expf(-x)); }
DI float wave_sum(float v) {
#pragma unroll
  for (int o = 32; o; o >>= 1) v += __shfl_xor(v, o);
  return v;
}
DI bf16x8 mk8(u32x2 lo, u32x2 hi) { u32x4 t = {lo[0], lo[1], hi[0], hi[1]}; return __builtin_bit_cast(bf16x8, t); }
DI bf16x8 mk8u(unsigned a, unsigned b, unsigned c, unsigned d) { u32x4 t = {a, b, c, d}; return __builtin_bit_cast(bf16x8, t); }

DI void prep_phase(const P& p, char* smem) {
  float* T = (float*)smem;
  const int tid = ltid();
  int total = 0;
  for (int i = 0; i < NW; ++i) total += (p.wd[i].K >> 6) * (p.wd[i].N >> 6);
  for (int flat = blockIdx.x; flat < total; flat += gridDim.x) {
    int wi = 0, base = 0;
    for (;;) { int nt = (p.wd[wi].K >> 6) * (p.wd[wi].N >> 6); if (flat < base + nt) break; base += nt; ++wi; }
    const WD& d = p.wd[wi];
    const int tix = flat - base, ntn = d.N >> 6;
    const int k0 = (tix / ntn) << 6, n0 = (tix % ntn) << 6;
    {
      const int n = tid & 63, kb = tid >> 6;
#pragma unroll
      for (int j = 0; j < 16; ++j) { int k = kb + 4 * j; T[k * 65 + n] = d.src[(size_t)(k0 + k) * d.N + n0 + n]; }
    }
    __syncthreads();
    {
      const int nn = tid >> 2, ks = tid & 3;
      int n = n0 + nn, drow = n;
      if (d.mode == 1) { int isu = n >= DFF; int ch = n - DFF * isu; drow = 128 * (ch >> 6) + 64 * ((ch >> 5) & 1) + 32 * isu + (ch & 31); }
      unsigned o[8];
#pragma unroll
      for (int j = 0; j < 8; ++j) o[j] = pk2(T[(16 * ks + 2 * j) * 65 + nn], T[(16 * ks + 2 * j + 1) * 65 + nn]);
      u32x4* dp = (u32x4*)(d.dst + (size_t)drow * d.K + k0 + 16 * ks);
      dp[0] = (u32x4){o[0], o[1], o[2], o[3]};
      dp[1] = (u32x4){o[4], o[5], o[6], o[7]};
    }
    __syncthreads();
  }
}

DI void rowop_phase(const P& p, bool x_from_in, const float* __restrict__ Madd, const float* __restrict__ gpost,
                    const float* __restrict__ gnext, u16* __restrict__ outH, const float* ple_p, const float* ple_s, u16* outP) {
  const int tidr = ltid();
  const int lane = tidr & 63;
  const int wave = (blockIdx.x * blockDim.x + tidr) >> 6;
  const int nwave = (gridDim.x * blockDim.x) >> 6;
  for (int r = wave; r < ROWS; r += nwave) {
    const float* xs = x_from_in ? (r < ROWS_P ? p.x_prompt + (size_t)r * D : p.x_sample + (size_t)(r - ROWS_P) * D) : p.y + (size_t)r * D;
    f32x4 x[4];
#pragma unroll
    for (int j = 0; j < 4; ++j) x[j] = *(const f32x4*)(xs + 4 * lane + 256 * j);
    if (Madd) {
      f32x4 m[4]; float ss = 0.f;
#pragma unroll
      for (int j = 0; j < 4; ++j) { m[j] = *(const f32x4*)(Madd + (size_t)r * D + 4 * lane + 256 * j); ss += m[j][0] * m[j][0] + m[j][1] * m[j][1] + m[j][2] * m[j][2] + m[j][3] * m[j][3]; }
      ss = wave_sum(ss);
      const float rs = rsqrtf(ss * (1.f / D) + EPS);
#pragma unroll
      for (int j = 0; j < 4; ++j) { f32x4 g = *(const f32x4*)(gpost + 4 * lane + 256 * j); x[j] += m[j] * rs * g; }
#pragma unroll
      for (int j = 0; j < 4; ++j) *(f32x4*)(p.y + (size_t)r * D + 4 * lane + 256 * j) = x[j];
    }
    float rx = 1.f;
    if (gnext) {
      float ss = 0.f;
#pragma unroll
      for (int j = 0; j < 4; ++j) ss += x[j][0] * x[j][0] + x[j][1] * x[j][1] + x[j][2] * x[j][2] + x[j][3] * x[j][3];
      ss = wave_sum(ss);
      rx = rsqrtf(ss * (1.f / D) + EPS);
    }
#pragma unroll
    for (int j = 0; j < 4; ++j) {
      f32x4 h = x[j] * rx;
      if (gnext) h *= *(const f32x4*)(gnext + 4 * lane + 256 * j);
      *(u32x2*)(outH + (size_t)r * D + 4 * lane + 256 * j) = (u32x2){pk2(h[0], h[1]), pk2(h[2], h[3])};
    }
    if (outP) {
      const float* ps = r < ROWS_P ? ple_p + (size_t)r * 256 : ple_s + (size_t)(r - ROWS_P) * 256;
      f32x4 v = *(const f32x4*)(ps + 4 * lane);
      *(u32x2*)(outP + (size_t)r * 256 + 4 * lane) = (u32x2){pk2(v[0], v[1]), pk2(v[2], v[3])};
    }
  }
}

template <class RowMap>
DI void gemm_core(const u16* __restrict__ A, int lda, RowMap rm, const u16* __restrict__ Bt, int ldb, int n0, int K,
                  f32x16 (&acc)[2][2], char* smem, const int tid) {
  const int l = tid & 63, w = tid >> 6, wm = w >> 1, wn = w & 1, l32 = l & 31, hh = l >> 5;
  const int lr = tid >> 3, lc = tid & 7;
  const u16* ap[4]; const u16* bp[4];
#pragma unroll
  for (int q = 0; q < 4; ++q) {
    ap[q] = A + (size_t)rm(q * 32 + lr) * lda + lc * 8;
    bp[q] = Bt + (size_t)(n0 + q * 32 + lr) * ldb + lc * 8;
  }
  const unsigned woff = lr * 128 + ((lc ^ ((lr >> 1) & 7)) << 4);
  const int swz = (l32 >> 1) & 7;
  const unsigned aoff = (wm * 64 + l32) * 128, boff = 16384 + (wn * 64 + l32) * 128;
  u32x4 ra0[4], rb0[4], ra1[4], rb1[4];
  const int nk = K >> 6;
#define GLOAD(RA, RB, T) _Pragma("unroll") for (int q = 0; q < 4; ++q) { RA[q] = *(const u32x4*)(ap[q] + (T) * 64); RB[q] = *(const u32x4*)(bp[q] + (T) * 64); }
#define SWRITE(RA, RB, BUF) { char* db_ = smem + (BUF) * 32768; _Pragma("unroll") for (int q = 0; q < 4; ++q) { *(u32x4*)(db_ + woff + q * 4096) = RA[q]; *(u32x4*)(db_ + 16384 + woff + q * 4096) = RB[q]; } }
#define COMPUTE(BUF) { const char* sb = smem + (BUF) * 32768; _Pragma("unroll") for (int ks = 0; ks < 4; ++ks) { \
      const unsigned co = ((2 * ks + hh) ^ swz) << 4; \
      bf16x8 a0 = *(const bf16x8*)(sb + aoff + co); \
      bf16x8 a1 = *(const bf16x8*)(sb + aoff + 32 * 128 + co); \
      bf16x8 b0 = *(const bf16x8*)(sb + boff + co); \
      bf16x8 b1 = *(const bf16x8*)(sb + boff + 32 * 128 + co); \
      acc[0][0] = __builtin_amdgcn_mfma_f32_32x32x16_bf16(b0, a0, acc[0][0], 0, 0, 0); \
      acc[0][1] = __builtin_amdgcn_mfma_f32_32x32x16_bf16(b1, a0, acc[0][1], 0, 0, 0); \
      acc[1][0] = __builtin_amdgcn_mfma_f32_32x32x16_bf16(b0, a1, acc[1][0], 0, 0, 0); \
      acc[1][1] = __builtin_amdgcn_mfma_f32_32x32x16_bf16(b1, a1, acc[1][1], 0, 0, 0); } }
  GLOAD(ra0, rb0, 0);
  GLOAD(ra1, rb1, 1);
  SWRITE(ra0, rb0, 0);
  __syncthreads();
  for (int kt = 0; kt < nk; kt += 2) {
    if (kt + 2 < nk) GLOAD(ra0, rb0, kt + 2);
    COMPUTE(0);
    SWRITE(ra1, rb1, 1);
    __syncthreads();
    if (kt + 3 < nk) GLOAD(ra1, rb1, kt + 3);
    COMPUTE(1);
    if (kt + 2 < nk) SWRITE(ra0, rb0, 0);
    __syncthreads();
  }
#undef GLOAD
#undef SWRITE
#undef COMPUTE
}

DI bool next_tile(int it, int ntm, int ntn, int& tm, int& tn) {
  const int b = blockIdx.x, x = b & 7, slot = b >> 3, S = gridDim.x >> 3;
  const int nq = (ntm - x + 7) >> 3;
  const int L = slot + it * S;
  if (L >= nq * ntn) return false;
  const int gsize = 8 * ntn;
  const int grp = L / gsize, r = L - grp * gsize;
  const int gsz = min(8, nq - 8 * grp);
  tn = r / gsz;
  tm = x + 8 * (8 * grp + r % gsz);
  return true;
}

struct IdMap { int base; DI int operator()(int r) const { return base + r; } };
struct ClampMap { int rowbase, t0, T; DI int operator()(int r) const { int t = t0 + r; t = t < 0 ? 0 : (t > T - 1 ? T - 1 : t); return rowbase + t; } };

#define ZERO_ACC(a) _Pragma("unroll") for (int _i = 0; _i < 2; ++_i) _Pragma("unroll") for (int _j = 0; _j < 2; ++_j) _Pragma("unroll") for (int _e = 0; _e < 16; ++_e) a[_i][_j][_e] = 0.f;

template <int EPI>
DI void gemm_phase(const P& p, const u16* A, int K, const u16* Bt, int N, void* outp, char* smem) {
  const int tid = ltid(), l = tid & 63, w = tid >> 6, wm = w >> 1, wn = w & 1, l32 = l & 31, hh = l >> 5;
  const int ntm = ROWS / 128, ntn = N / 128;
  int tm, tn;
  for (int it = 0; next_tile(it, ntm, ntn, tm, tn); ++it) {
    f32x16 acc[2][2];
    ZERO_ACC(acc);
    gemm_core(A, K, IdMap{tm * 128}, Bt, K, tn * 128, K, acc, smem, tid);
    const int n0 = tn * 128;
#pragma unroll
    for (int mi = 0; mi < 2; ++mi) {
      const int m = tm * 128 + wm * 64 + mi * 32 + l32;
#pragma unroll
      for (int ni = 0; ni < 2; ++ni)
#pragma unroll
        for (int q = 0; q < 4; ++q) {
          const int n = n0 + wn * 64 + ni * 32 + 8 * q + 4 * hh;
          float v0 = acc[mi][ni][4 * q], v1 = acc[mi][ni][4 * q + 1], v2 = acc[mi][ni][4 * q + 2], v3 = acc[mi][ni][4 * q + 3];
          if (EPI == 0) {
            const int sec = n0 >> 10;
            if (sec == 0 || sec == 3) { v0 *= sigm(v0); v1 *= sigm(v1); v2 *= sigm(v2); v3 *= sigm(v3); }
            *(u32x2*)((u16*)outp + (size_t)m * 4096 + n) = (u32x2){pk2(v0, v1), pk2(v2, v3)};
          } else if (EPI == 1) {
            const float sc = 0.125f * LOG2E;
            *(u32x2*)((u16*)outp + (size_t)m * 1024 + n) = (u32x2){pk2(v0 * sc, v1 * sc), pk2(v2 * sc, v3 * sc)};
          } else if (EPI == 2) {
            *(f32x4*)((float*)outp + (size_t)m * 1024 + n) = (f32x4){v0, v1, v2, v3};
          } else {
            float* dst;
            if (n < 1024) dst = (m < ROWS_P ? p.k_prompt + (size_t)m * 1024 : p.k_sample + (size_t)(m - ROWS_P) * 1024) + n;
            else dst = (m < ROWS_P ? p.v_prompt + (size_t)m * 1024 : p.v_sample + (size_t)(m - ROWS_P) * 1024) + (n - 1024);
            *(f32x4*)dst = (f32x4){v0, v1, v2, v3};
          }
        }
    }
  }
}

DI void ple_phase(const P& p, int layer, char* smem) {
  const int tid = ltid(), l = tid & 63, w = tid >> 6, wm = w >> 1, wn = w & 1, l32 = l & 31, hh = l >> 5;
  const u16* XB2 = (const u16*)p.BIG;
  const u16* PB = (const u16*)(p.BIG + (size_t)ROWS * 1024 * 2);
  const u16* Wg = p.wt_gate + (size_t)layer * 1024 * 1024;
  const u16* Wp = p.wt_ple + (size_t)layer * 1024 * 256;
  int tm, tn;
  for (int it = 0; next_tile(it, ROWS / 128, 8, tm, tn); ++it) {
    unsigned pl[2][2][8];
    {
      f32x16 acc2[2][2];
      ZERO_ACC(acc2);
      gemm_core(PB, 256, IdMap{tm * 128}, Wp, 256, tn * 128, 256, acc2, smem, tid);
#pragma unroll
      for (int a = 0; a < 2; ++a)
#pragma unroll
        for (int b2 = 0; b2 < 2; ++b2)
#pragma unroll
          for (int e = 0; e < 8; ++e) pl[a][b2][e] = pk2(acc2[a][b2][2 * e], acc2[a][b2][2 * e + 1]);
    }
    f32x16 acc[2][2];
    ZERO_ACC(acc);
    gemm_core(XB2, 1024, IdMap{tm * 128}, Wg, 1024, tn * 128, 1024, acc, smem, tid);
#pragma unroll
    for (int mi = 0; mi < 2; ++mi) {
      const int m = tm * 128 + wm * 64 + mi * 32 + l32;
#pragma unroll
      for (int ni = 0; ni < 2; ++ni)
#pragma unroll
        for (int q = 0; q < 4; ++q) {
          const int n = tn * 128 + wn * 64 + ni * 32 + 8 * q + 4 * hh;
          f32x4* xp = (f32x4*)(p.y + (size_t)m * D + n);
          f32x4 x = *xp;
#pragma unroll
          for (int c = 0; c < 4; ++c) {
            const unsigned pv = pl[mi][ni][2 * q + (c >> 1)];
            x[c] += sigm(acc[mi][ni][4 * q + c]) * ((c & 1) ? bfhi(pv) : bflo(pv));
          }
          *xp = x;
        }
    }
  }
}

DI void ffn_in_phase(const P& p, int layer, char* smem) {
  const int tid = ltid(), l = tid & 63, w = tid >> 6, wm = w >> 1, wn = w & 1, l32 = l & 31, hh = l >> 5;
  const u16* Wt = p.wt_ffn_in + (size_t)layer * 5632 * 1024;
  u16* HID = (u16*)p.BIG;
  float* GS = (float*)smem;
  const float* cw = p.conv_w + (size_t)layer * 3 * DFF;
  const float* cb = p.conv_b + (size_t)layer * DFF;
  int tm, tn;
  for (int it = 0; next_tile(it, 280, 44, tm, tn); ++it) {
    int seq, T, rowbase, t0; bool last;
    if (tm < 272) { seq = tm / 17; int j = tm - seq * 17; T = 2048; rowbase = seq * 2048; t0 = 126 * j - 2; last = (j == 16); }
    else { seq = 16 + (tm - 272); T = 32; rowbase = ROWS_P + (tm - 272) * 32; t0 = -2; last = true; }
    f32x16 acc[2][2];
    ZERO_ACC(acc);
    gemm_core(p.XB, 1024, ClampMap{rowbase, t0, T}, Wt, 1024, tn * 128, 1024, acc, smem, tid);
    const int chw = tn * 64 + wn * 32;
    if (t0 < 0 && wm == 0 && l32 < 2) {
#pragma unroll
      for (int q = 0; q < 4; ++q) {
        f32x4 sv = {0.f, 0.f, 0.f, 0.f};
        if (seq >= 16) sv = *(const f32x4*)(p.state_conv + ((size_t)(layer * 8 + (seq - 16)) * 2 + l32) * DFF + chw + 8 * q + 4 * hh);
#pragma unroll
        for (int c = 0; c < 4; ++c) acc[0][0][4 * q + c] = sv[c];
      }
    }
#pragma unroll
    for (int mi = 0; mi < 2; ++mi)
#pragma unroll
      for (int i = 0; i < 16; ++i) {
        const int chl = wn * 32 + 8 * (i >> 2) + 4 * hh + (i & 3);
        GS[chl * 132 + wm * 64 + mi * 32 + l32] = acc[mi][0][i];
      }
    __syncthreads();
#pragma unroll
    for (int q = 0; q < 4; ++q) {
      const int chq = chw + 8 * q + 4 * hh;
      const f32x4 b4 = *(const f32x4*)(cb + chq);
      const f32x4 w0 = *(const f32x4*)(cw + chq), w1 = *(const f32x4*)(cw + DFF + chq), w2 = *(const f32x4*)(cw + 2 * DFF + chq);
#pragma unroll
      for (int mi = 0; mi < 2; ++mi) {
        const int m = wm * 64 + mi * 32 + l32;
        const int t = t0 + m;
        if (m >= 2 && t < T) {
          float hv[4];
#pragma unroll
          for (int c = 0; c < 4; ++c) {
            const int chl = wn * 32 + 8 * q + 4 * hh + c;
            const float g0 = acc[mi][0][4 * q + c], g1 = GS[chl * 132 + m - 1], g2 = GS[chl * 132 + m - 2];
            const float cv = b4[c] + w0[c] * g2 + w1[c] * g1 + w2[c] * g0;
            hv[c] = cv * sigm(cv) * acc[mi][1][4 * q + c];
          }
          *(u32x2*)(HID + (size_t)(rowbase + t) * DFF + chq) = (u32x2){pk2(hv[0], hv[1]), pk2(hv[2], hv[3])};
          if (last && t >= T - 2) {
            float* co = seq < 16 ? p.conv_prompt + ((size_t)(layer * 16 + seq) * 2 + (t - (T - 2))) * DFF
                                 : p.conv_sample + ((size_t)(layer * 8 + (seq - 16)) * 2 + (t - (T - 2))) * DFF;
            *(f32x4*)(co + chq) = (f32x4){acc[mi][0][4 * q], acc[mi][0][4 * q + 1], acc[mi][0][4 * q + 2], acc[mi][0][4 * q + 3]};
          }
        }
      }
    }
    __syncthreads();
  }
}

DI void gla_phase(const P& p, int layer, char* smem) {
  const u16* PROJ = (const u16*)p.BIG;
  const int tid = ltid(), l = tid & 63, w = tid >> 6, l32 = l & 31, hh = l >> 5, m16 = l & 15;
  u16* QT = (u16*)smem;
  u16* KT = QT + 16 * 136;
  u16* KDT = KT + 16 * 136;
  float* DD = (float*)(KDT + 128 * 20);
  float* RED = DD + 128;
  const int k = tid & 127, th = tid >> 7;
  for (int item = blockIdx.x; item < 192; item += gridDim.x) {
    const int s = item >> 3, h = item & 7;
    const bool smp = s >= 16;
    const int T = smp ? 32 : 2048;
    const int rowbase = smp ? ROWS_P + (s - 16) * 32 : s * 2048;
    float lower = 0.f;
    if (layer == 1) lower = sigm(p.lb_raw[1024 + h * 128 + k] - p.lb_raw[h * 128 + k]);
    const float oml = 1.f - lower;
    f32x16 S[4];
    if (smp) {
      const float* sp = p.state_hgrn + ((size_t)(layer * 8 + (s - 16)) * 8 + h) * 16384 + 32 * w + l32;
#pragma unroll
      for (int kt = 0; kt < 4; ++kt)
#pragma unroll
        for (int i = 0; i < 16; ++i) S[kt][i] = sp[(size_t)(32 * kt + (i & 3) + 8 * (i >> 2) + 4 * hh) * 128];
    } else {
#pragma unroll
      for (int kt = 0; kt < 4; ++kt)
#pragma unroll
        for (int i = 0; i < 16; ++i) S[kt][i] = 0.f;
    }
    const int nblk = T >> 4;
    for (int blk = 0; blk < nblk; ++blk) {
      const size_t r0 = (size_t)rowbase + blk * 16;
      {
        const u16* pf = PROJ + r0 * 4096 + 1024 + h * 128 + k;
        const u16* pq = PROJ + (r0 + 8 * th) * 4096 + h * 128 + k;
        float bown[8], kown[8];
        float bsum = 0.f;
#pragma unroll
        for (int t = 0; t < 16; ++t) {
          const float f = bf2f(pf[(size_t)t * 4096]);
          const float g = lower + oml * sigm(f);
          bsum += __logf(g);
          if ((t >> 3) == 0) { if (th == 0) { bown[t & 7] = bsum; kown[t & 7] = 1.f - g; } }
          else { if (th == 1) { bown[t & 7] = bsum; kown[t & 7] = 1.f - g; } }
        }
        unsigned kdp[4];
        float kdprev = 0.f;
#pragma unroll
        for (int j = 0; j < 8; ++j) {
          const int t = 8 * th + j;
          const float q = bf2f(pq[(size_t)j * 4096]);
          const float qt = q * __expf(bown[j]);
          const float ktv = kown[j] * __expf(-bown[j]);
          const float kd = kown[j] * __expf(bsum - bown[j]);
          QT[t * 136 + k] = (u16)(pk2(qt, 0.f) & 0xffffu);
          KT[t * 136 + k] = (u16)(pk2(ktv, 0.f) & 0xffffu);
          if (j & 1) kdp[j >> 1] = pk2(kdprev, kd); else kdprev = kd;
        }
        *(u32x2*)(KDT + k * 20 + 8 * th) = (u32x2){kdp[0], kdp[1]};
        *(u32x2*)(KDT + k * 20 + 8 * th + 4) = (u32x2){kdp[2], kdp[3]};
        if (th == 0) DD[k] = __expf(bsum);
      }
      bf16x8 vfrag;
      {
        const u16* pv = PROJ + r0 * 4096 + 2048 + h * 128 + 32 * w + l32;
#pragma unroll
        for (int jj = 0; jj < 8; ++jj) vfrag[jj] = (short)pv[(size_t)(8 * (jj >> 2) + 4 * hh + (jj & 3)) * 4096];
      }
      __syncthreads();
      f32x16 aacc;
#pragma unroll
      for (int i = 0; i < 16; ++i) aacc[i] = 0.f;
#pragma unroll
      for (int ks = 0; ks < 8; ++ks) {
        bf16x8 ka = *(const bf16x8*)(KT + m16 * 136 + 16 * ks + 8 * hh);
        bf16x8 qb = *(const bf16x8*)(QT + m16 * 136 + 16 * ks + 8 * hh);
        aacc = __builtin_amdgcn_mfma_f32_32x32x16_bf16(ka, qb, aacc, 0, 0, 0);
      }
      float am[8];
#pragma unroll
      for (int i = 0; i < 8; ++i) { const int m = (i & 3) + 8 * (i >> 2) + 4 * hh; am[i] = (m <= m16) ? aacc[i] : 0.f; }
      const bf16x8 afrag = mk8u(pk2(am[0], am[1]), pk2(am[2], am[3]), pk2(am[4], am[5]), pk2(am[6], am[7]));
      f32x16 oacc;
#pragma unroll
      for (int i = 0; i < 16; ++i) oacc[i] = 0.f;
#pragma unroll
      for (int kt = 0; kt < 4; ++kt)
#pragma unroll
        for (int s2 = 0; s2 < 2; ++s2) {
          const bf16x8 sa = mk8u(pk2(S[kt][8 * s2], S[kt][8 * s2 + 1]), pk2(S[kt][8 * s2 + 2], S[kt][8 * s2 + 3]),
                                 pk2(S[kt][8 * s2 + 4], S[kt][8 * s2 + 5]), pk2(S[kt][8 * s2 + 6], S[kt][8 * s2 + 7]));
          const u32x2 lo = *(const u32x2*)(QT + m16 * 136 + 32 * kt + 16 * s2 + 4 * hh);
          const u32x2 hi = *(const u32x2*)(QT + m16 * 136 + 32 * kt + 16 * s2 + 8 + 4 * hh);
          oacc = __builtin_amdgcn_mfma_f32_32x32x16_bf16(sa, mk8(lo, hi), oacc, 0, 0, 0);
        }
      oacc = __builtin_amdgcn_mfma_f32_32x32x16_bf16(vfrag, afrag, oacc, 0, 0, 0);
#pragma unroll
      for (int kt = 0; kt < 4; ++kt) {
#pragma unroll
        for (int q = 0; q < 4; ++q) {
          const f32x4 d4 = *(const f32x4*)(DD + 32 * kt + 8 * q + 4 * hh);
#pragma unroll
          for (int c = 0; c < 4; ++c) S[kt][4 * q + c] *= d4[c];
        }
        const u32x2 lo = *(const u32x2*)(KDT + (32 * kt + l32) * 20 + 4 * hh);
        const u32x2 hi = *(const u32x2*)(KDT + (32 * kt + l32) * 20 + 8 + 4 * hh);
        S[kt] = __builtin_amdgcn_mfma_f32_32x32x16_bf16(mk8(lo, hi), vfrag, S[kt], 0, 0, 0);
      }
      float ss = 0.f;
#pragma unroll
      for (int i = 0; i < 16; ++i) ss += oacc[i] * oacc[i];
      ss += __shfl_xor(ss, 32);
      if (l < 16) RED[w * 16 + l] = ss;
      __syncthreads();
      if (l32 < 16) {
        const float tot = RED[l32] + RED[16 + l32] + RED[32 + l32] + RED[48 + l32];
        const float rn = rsqrtf(tot * (1.f / 128.f) + EPS);
        const size_t row = r0 + l32;
#pragma unroll
        for (int q = 0; q < 4; ++q) {
          const int v = h * 128 + 32 * w + 8 * q + 4 * hh;
          const u32x2 gs = *(const u32x2*)(PROJ + row * 4096 + 3072 + v);
          const f32x4 gh = *(const f32x4*)(p.g_hg + layer * 1024 + v);
          const float o0 = oacc[4 * q] * rn * gh[0] * bflo(gs[0]);
          const float o1 = oacc[4 * q + 1] * rn * gh[1] * bfhi(gs[0]);
          const float o2 = oacc[4 * q + 2] * rn * gh[2] * bflo(gs[1]);
          const float o3 = oacc[4 * q + 3] * rn * gh[3] * bfhi(gs[1]);
          *(u32x2*)(p.OG + row * 1024 + v) = (u32x2){pk2(o0, o1), pk2(o2, o3)};
        }
      }
    }
    {
      float* op = (smp ? p.hgrn_sample + ((size_t)(layer * 8 + (s - 16)) * 8 + h) * 16384
                       : p.hgrn_prompt + ((size_t)(layer * 16 + s) * 8 + h) * 16384) + 32 * w + l32;
#pragma unroll
      for (int kt = 0; kt < 4; ++kt)
#pragma unroll
        for (int i = 0; i < 16; ++i) op[(size_t)(32 * kt + (i & 3) + 8 * (i >> 2) + 4 * hh) * 128] = S[kt][i];
    }
  }
}

DI void attn_phase(const P& p, int layer, char* smem) {
  const int jl = layer - 2;
  const u16* Q = (const u16*)p.BIG;
  const int tid = ltid(), l = tid & 63, w = tid >> 6, l16 = l & 15, g = l >> 4;
  u16* KS = (u16*)smem;
  u16* VT = KS + 64 * 136;
  float* BT = (float*)(VT + 128 * 68);
  const float lam_init = 0.8f - 0.6f * __expf(-0.3f * (float)layer);
  float lam;
  {
    const float* lp = p.lam_b + jl * 256;
    float a = 0.f, b = 0.f;
    for (int d = 0; d < 64; ++d) { a += lp[d] * lp[64 + d]; b += lp[128 + d] * lp[192 + d]; }
    lam = __expf(a) - __expf(b) + lam_init;
  }
  for (int item = blockIdx.x; item < 4096 + 64; item += gridDim.x) {
    int b, h, nq, qrow0, qpos0, ntiles; bool smp;
    if (item < 4096) { const int jq = 31 - (item >> 7); const int bh = item & 127; b = bh >> 3; h = bh & 7; smp = false; nq = 64; qrow0 = b * 2048 + 64 * jq; qpos0 = 64 * jq; ntiles = jq + 1; }
    else { const int si = item - 4096; b = si >> 3; h = si & 7; smp = true; nq = 32; qrow0 = ROWS_P + b * 32; qpos0 = 1024; ntiles = 17; }
    if (tid < 230) {
      const int rel = tid - 166;
      const int n = rel < 0 ? -rel : rel;
      int bk = n < 8 ? n : 8 + (n >= 13) + (n >= 20) + (n >= 30) + (n >= 46) + (n >= 70) + (n >= 108) + (n >= 166);
      if (rel > 0) bk += 16;
      BT[tid] = p.rel_bias[bk * 8 + h] * LOG2E;
    }
    bf16x8 qf[2][2];
    {
      const int qr = min(16 * w + l16, nq - 1);
      const u16* qp = Q + (size_t)(qrow0 + qr) * 1024 + h * 128;
#pragma unroll
      for (int c = 0; c < 2; ++c)
#pragma unroll
        for (int ks = 0; ks < 2; ++ks) qf[c][ks] = *(const bf16x8*)(qp + c * 64 + 32 * ks + 8 * g);
    }
    f32x4 oacc[2][8];
#pragma unroll
    for (int c = 0; c < 2; ++c)
#pragma unroll
      for (int vs = 0; vs < 8; ++vs) oacc[c][vs] = (f32x4){0.f, 0.f, 0.f, 0.f};
    float mrun[2] = {-1e30f, -1e30f}, lsum[2] = {0.f, 0.f};
    const int qpos = qpos0 + min(16 * w + l16, nq - 1);
    for (int kt = 0; kt < ntiles; ++kt) {
      const float *kb, *vb; int nvalid = 64;
      if (!smp) { kb = p.k_prompt + ((size_t)(b * 2048 + 64 * kt)) * 1024 + h * 128; vb = p.v_prompt + ((size_t)(b * 2048 + 64 * kt)) * 1024 + h * 128; }
      else if (kt < 16) { kb = p.cache_k + ((size_t)(b * 1024 + 64 * kt)) * 1024 + h * 128; vb = p.cache_v + ((size_t)(b * 1024 + 64 * kt)) * 1024 + h * 128; }
      else { kb = p.k_sample + ((size_t)(b * 32)) * 1024 + h * 128; vb = p.v_sample + ((size_t)(b * 32)) * 1024 + h * 128; nvalid = 32; }
      __syncthreads();
#pragma unroll 4
      for (int pp = 0; pp < 8; ++pp) {
        const int key = 8 * pp + (tid >> 5), d4 = (tid & 31) * 4;
        f32x4 v = {0.f, 0.f, 0.f, 0.f};
        if (key < nvalid) v = *(const f32x4*)(kb + (size_t)key * 1024 + d4);
        *(u32x2*)(KS + key * 136 + d4) = (u32x2){pk2(v[0], v[1]), pk2(v[2], v[3])};
      }
#pragma unroll 2
      for (int pp = 0; pp < 8; ++pp) {
        const int v = tid & 127, kq = 2 * pp + (tid >> 7);
        float e[4];
#pragma unroll
        for (int j = 0; j < 4; ++j) { const int key = 4 * kq + j; e[j] = key < nvalid ? vb[(size_t)key * 1024 + v] : 0.f; }
        *(u32x2*)(VT + v * 68 + 4 * kq) = (u32x2){pk2(e[0], e[1]), pk2(e[2], e[3])};
      }
      __syncthreads();
      f32x4 sacc[2][4];
#pragma unroll
      for (int c = 0; c < 2; ++c)
#pragma unroll
        for (int sub = 0; sub < 4; ++sub) {
          sacc[c][sub] = (f32x4){0.f, 0.f, 0.f, 0.f};
#pragma unroll
          for (int ks = 0; ks < 2; ++ks) {
            const bf16x8 kf = *(const bf16x8*)(KS + (16 * sub + l16) * 136 + c * 64 + 32 * ks + 8 * g);
            sacc[c][sub] = __builtin_amdgcn_mfma_f32_16x16x32_bf16(kf, qf[c][ks], sacc[c][sub], 0, 0, 0);
          }
        }
#pragma unroll
      for (int sub = 0; sub < 4; ++sub)
#pragma unroll
        for (int i = 0; i < 4; ++i) {
          const int kl = 16 * sub + 4 * g + i;
          int rel = 64 * kt + kl - qpos;
          rel = rel < -166 ? -166 : rel;
          const float bt = BT[rel + 166];
          const bool ok = kl < nvalid;
          sacc[0][sub][i] = ok ? sacc[0][sub][i] + bt : -30000.f;
          sacc[1][sub][i] = ok ? sacc[1][sub][i] + bt : -30000.f;
        }
      bf16x8 pf[2][2];
#pragma unroll
      for (int c = 0; c < 2; ++c) {
        float mx = -1e30f;
#pragma unroll
        for (int sub = 0; sub < 4; ++sub)
#pragma unroll
          for (int i = 0; i < 4; ++i) mx = fmaxf(mx, sacc[c][sub][i]);
        mx = fmaxf(mx, __shfl_xor(mx, 16));
        mx = fmaxf(mx, __shfl_xor(mx, 32));
        const float mnew = fmaxf(mrun[c], mx);
        const float alpha = __builtin_amdgcn_exp2f(mrun[c] - mnew);
        mrun[c] = mnew;
        float rs = 0.f;
#pragma unroll
        for (int sub = 0; sub < 4; ++sub)
#pragma unroll
          for (int i = 0; i < 4; ++i) { const float e = __builtin_amdgcn_exp2f(sacc[c][sub][i] - mnew); sacc[c][sub][i] = e; rs += e; }
        lsum[c] = lsum[c] * alpha + rs;
#pragma unroll
        for (int vs = 0; vs < 8; ++vs) oacc[c][vs] *= alpha;
#pragma unroll
        for (int j = 0; j < 2; ++j)
          pf[c][j] = mk8u(pk2(sacc[c][2 * j][0], sacc[c][2 * j][1]), pk2(sacc[c][2 * j][2], sacc[c][2 * j][3]),
                          pk2(sacc[c][2 * j + 1][0], sacc[c][2 * j + 1][1]), pk2(sacc[c][2 * j + 1][2], sacc[c][2 * j + 1][3]));
      }
#pragma unroll
      for (int j = 0; j < 2; ++j)
#pragma unroll
        for (int vs = 0; vs < 8; ++vs) {
          const u32x2 lo = *(const u32x2*)(VT + (16 * vs + l16) * 68 + 32 * j + 4 * g);
          const u32x2 hi = *(const u32x2*)(VT + (16 * vs + l16) * 68 + 32 * j + 16 + 4 * g);
          const bf16x8 vf = mk8(lo, hi);
          oacc[0][vs] = __builtin_amdgcn_mfma_f32_16x16x32_bf16(vf, pf[0][j], oacc[0][vs], 0, 0, 0);
          oacc[1][vs] = __builtin_amdgcn_mfma_f32_16x16x32_bf16(vf, pf[1][j], oacc[1][vs], 0, 0, 0);
        }
    }
#pragma unroll
    for (int c = 0; c < 2; ++c) { lsum[c] += __shfl_xor(lsum[c], 16); lsum[c] += __shfl_xor(lsum[c], 32); }
    const float inv0 = 1.f / lsum[0], inv1 = lam / lsum[1];
    float ss = 0.f;
#pragma unroll
    for (int vs = 0; vs < 8; ++vs)
#pragma unroll
      for (int i = 0; i < 4; ++i) { const float o = oacc[0][vs][i] * inv0 - oacc[1][vs][i] * inv1; oacc[0][vs][i] = o; ss += o * o; }
    ss += __shfl_xor(ss, 16);
    ss += __shfl_xor(ss, 32);
    const float rn = rsqrtf(ss * (1.f / 128.f) + EPS) * (1.f - lam_init);
    if (16 * w + l16 < nq) {
      const size_t row = (size_t)qrow0 + 16 * w + l16;
#pragma unroll
      for (int vs = 0; vs < 8; ++vs) {
        const int v = h * 128 + 16 * vs + 4 * g;
        const f32x4 gl = *(const f32x4*)(p.g_subln + jl * 1024 + v);
        *(u32x2*)(p.OG + row * 1024 + v) = (u32x2){pk2(oacc[0][vs][0] * rn * gl[0], oacc[0][vs][1] * rn * gl[1]),
                                                   pk2(oacc[0][vs][2] * rn * gl[2], oacc[0][vs][3] * rn * gl[3])};
      }
    }
  }
}


DI void gbar(unsigned* bar, unsigned& gen) {
  gen += 1;
  asm volatile("s_waitcnt vmcnt(0) lgkmcnt(0)" ::: "memory");
  __syncthreads();
  if (threadIdx.x < 64) {
    const unsigned g = blockIdx.x >> 4, ng = gridDim.x >> 4;
    bool last = false;
    if (threadIdx.x == 0) {
      __builtin_amdgcn_fence(__ATOMIC_RELEASE, "agent");
      asm volatile("s_waitcnt vmcnt(0)" ::: "memory");
      const unsigned o = __hip_atomic_fetch_add(bar + 64 * g, 1u, __ATOMIC_RELAXED, __HIP_MEMORY_SCOPE_AGENT);
      if (o + 1 == 16 * gen) {
        const unsigned o2 = __hip_atomic_fetch_add(bar + 64 * 64, 1u, __ATOMIC_RELAXED, __HIP_MEMORY_SCOPE_AGENT);
        last = (o2 + 1 == ng * gen);
      }
    }
    last = __shfl(last ? 1 : 0, 0) != 0;
    if (last && threadIdx.x < ng) __hip_atomic_store(bar + 64 * (65 + threadIdx.x), gen, __ATOMIC_RELAXED, __HIP_MEMORY_SCOPE_AGENT);
    if (threadIdx.x == 0) {
      while (__hip_atomic_load(bar + 64 * (65 + g), __ATOMIC_RELAXED, __HIP_MEMORY_SCOPE_AGENT) < gen) __builtin_amdgcn_s_sleep(2);
      __builtin_amdgcn_fence(__ATOMIC_ACQUIRE, "agent");
      asm volatile("s_waitcnt vmcnt(0)" ::: "memory");
    }
  }
  __syncthreads();
}

__global__ void __launch_bounds__(256, 2) yoco_megakernel(P p) {
  __shared__ __attribute__((aligned(16))) char smem[65536];
  cg::grid_group grid = cg::this_grid();
  if (blockIdx.x == 0 && threadIdx.x < 130) __hip_atomic_store(p.bar + 64 * threadIdx.x, 0u, __ATOMIC_RELAXED, __HIP_MEMORY_SCOPE_AGENT);
  prep_phase(p, smem);
  grid.sync();
  unsigned btarget = 0;
  float* Mbuf = (float*)p.BIG;
  float* Fbuf = (float*)p.XB;
  u16* XB2 = (u16*)p.BIG;
  u16* PB = (u16*)(p.BIG + (size_t)ROWS * 1024 * 2);
  for (int i = 0; i < 4; ++i) {
    const float* gn = p.g_norms + i * 4 * D;
    rowop_phase(p, i == 0, nullptr, nullptr, gn, p.XB, nullptr, nullptr, nullptr);
    gbar(p.bar, btarget);
    if (i < 2) {
      REPG gemm_phase<0>(p, p.XB, 1024, p.wt_in_a + (size_t)i * 4096 * 1024, 4096, p.BIG, smem);
      gbar(p.bar, btarget);
      for (int _r = 0; _r < REP_GLA; ++_r) gla_phase(p, i, smem);
      gbar(p.bar, btarget);
      REPG gemm_phase<2>(p, p.OG, 1024, p.wt_out_a + (size_t)i * 1024 * 1024, 1024, Mbuf, smem);
      gbar(p.bar, btarget);
    } else {
      REPG gemm_phase<1>(p, p.XB, 1024, p.wt_q + (size_t)(i - 2) * 1024 * 1024, 1024, p.BIG, smem);
      gbar(p.bar, btarget);
      for (int _r = 0; _r < REP_ATTN; ++_r) attn_phase(p, i, smem);
      gbar(p.bar, btarget);
      REPG gemm_phase<2>(p, p.OG, 1024, p.wt_out_b + (size_t)(i - 2) * 1024 * 1024, 1024, Mbuf, smem);
      gbar(p.bar, btarget);
    }
    rowop_phase(p, i == 0, Mbuf, gn + D, gn + 2 * D, p.XB, nullptr, nullptr, nullptr);
    gbar(p.bar, btarget);
    REPG ffn_in_phase(p, i, smem);
    gbar(p.bar, btarget);
    REPG gemm_phase<2>(p, (const u16*)p.BIG, DFF, p.wt_ffn_out + (size_t)i * 1024 * DFF, 1024, Fbuf, smem);
    gbar(p.bar, btarget);
    rowop_phase(p, false, Fbuf, gn + 3 * D, nullptr, XB2, p.p_prompt + (size_t)i * ROWS_P * 256, p.p_sample + (size_t)i * 256 * 256, PB);
    gbar(p.bar, btarget);
    ple_phase(p, i, smem);
    gbar(p.bar, btarget);
    if (i == 1) {
      rowop_phase(p, false, nullptr, nullptr, p.g_kv, p.XB, nullptr, nullptr, nullptr);
      gbar(p.bar, btarget);
      REPG gemm_phase<3>(p, p.XB, 1024, p.wt_kv, 2048, nullptr, smem);
      gbar(p.bar, btarget);
    }
  }
}

extern "C" void kernel_launch(void* const* d_in, const int* in_sizes, int n_in, void* d_out, int out_size, void* d_ws,
                              size_t ws_size, hipStream_t stream) {
  static int grid_blocks = 0;
  if (!grid_blocks) {
    int dev = 0, cus = 0, per_cu = 0;
    hipGetDevice(&dev);
    hipDeviceGetAttribute(&cus, hipDeviceAttributeMultiprocessorCount, dev);
    hipOccupancyMaxActiveBlocksPerMultiprocessor(&per_cu, yoco_megakernel, 256, 0);
    if (per_cu > 2) per_cu = 2;
    grid_blocks = cus * per_cu;
    grid_blocks &= ~7;
  }
  P p{};
  const float* const* in = (const float* const*)d_in;
  p.x_prompt = in[0]; p.x_sample = in[1]; p.cache_k = in[2]; p.cache_v = in[3]; p.state_hgrn = in[4]; p.state_conv = in[5];
  p.p_prompt = in[6]; p.p_sample = in[7];
  p.g_norms = in[8]; const float* w_in_a = in[9]; p.lb_raw = in[10]; p.g_hg = in[11]; const float* w_out_a = in[12]; p.g_kv = in[13];
  const float* w_kv = in[14]; p.rel_bias = in[15]; const float* w_q_b = in[16]; p.lam_b = in[17]; p.g_subln = in[18];
  const float* w_out_b = in[19]; const float* w_ffn_in = in[20]; p.conv_w = in[21]; p.conv_b = in[22]; const float* w_ffn_out = in[23];
  const float* w_ple = in[24]; const float* w_ple_gate = in[25];
  float* o = (float*)d_out;
  p.y = o; o += (size_t)ROWS * D;
  p.k_prompt = o; o += (size_t)ROWS_P * D;
  p.v_prompt = o; o += (size_t)ROWS_P * D;
  p.k_sample = o; o += (size_t)256 * D;
  p.v_sample = o; o += (size_t)256 * D;
  p.hgrn_prompt = o; o += (size_t)2 * 16 * 8 * 16384;
  p.hgrn_sample = o; o += (size_t)2 * 8 * 8 * 16384;
  p.conv_prompt = o; o += (size_t)4 * 16 * 2 * DFF;
  p.conv_sample = o;
  u16* ws = (u16*)d_ws;
  p.wt_in_a = ws; ws += (size_t)2 * 4096 * 1024;
  p.wt_out_a = ws; ws += (size_t)2 * 1024 * 1024;
  p.wt_kv = ws; ws += (size_t)2048 * 1024;
  p.wt_q = ws; ws += (size_t)2 * 1024 * 1024;
  p.wt_out_b = ws; ws += (size_t)2 * 1024 * 1024;
  p.wt_ffn_in = ws; ws += (size_t)4 * 5632 * 1024;
  p.wt_ffn_out = ws; ws += (size_t)4 * 1024 * DFF;
  p.wt_ple = ws; ws += (size_t)4 * 1024 * 256;
  p.wt_gate = ws; ws += (size_t)4 * 1024 * 1024;
  p.XB = ws; ws += (size_t)ROWS * 1024;
  p.OG = ws; ws += (size_t)ROWS * 1024;
  p.BIG = (char*)ws;
  p.bar = (unsigned*)((char*)d_ws + ((size_t)500 << 20));
  int n = 0;
  for (int i = 0; i < 2; ++i) p.wd[n++] = WD{w_in_a + (size_t)i * 1024 * 4096, p.wt_in_a + (size_t)i * 4096 * 1024, 1024, 4096, 0, 0};
  for (int i = 0; i < 2; ++i) p.wd[n++] = WD{w_out_a + (size_t)i * 1024 * 1024, p.wt_out_a + (size_t)i * 1024 * 1024, 1024, 1024, 0, 0};
  p.wd[n++] = WD{w_kv, p.wt_kv, 1024, 2048, 0, 0};
  for (int i = 0; i < 2; ++i) p.wd[n++] = WD{w_q_b + (size_t)i * 1024 * 1024, p.wt_q + (size_t)i * 1024 * 1024, 1024, 1024, 0, 0};
  for (int i = 0; i < 2; ++i) p.wd[n++] = WD{w_out_b + (size_t)i * 1024 * 1024, p.wt_out_b + (size_t)i * 1024 * 1024, 1024, 1024, 0, 0};
  for (int i = 0; i < 4; ++i) p.wd[n++] = WD{w_ffn_in + (size_t)i * 1024 * 5632, p.wt_ffn_in + (size_t)i * 5632 * 1024, 1024, 5632, 1, 0};
  for (int i = 0; i < 4; ++i) p.wd[n++] = WD{w_ffn_out + (size_t)i * DFF * 1024, p.wt_ffn_out + (size_t)i * 1024 * DFF, DFF, 1024, 0, 0};
  for (int i = 0; i < 4; ++i) p.wd[n++] = WD{w_ple + (size_t)i * 256 * 1024, p.wt_ple + (size_t)i * 1024 * 256, 256, 1024, 0, 0};
  for (int i = 0; i < 4; ++i) p.wd[n++] = WD{w_ple_gate + (size_t)i * 1024 * 1024, p.wt_gate + (size_t)i * 1024 * 1024, 1024, 1024, 0, 0};
  void* args[] = {&p};
  hipError_t e = hipLaunchCooperativeKernel((void*)yoco_megakernel, dim3(grid_blocks), dim3(256), args, 0, stream);
  if (e != hipSuccess) fprintf(stderr, "cooperative launch failed: %s (grid %d)\n", hipGetErrorString(e), grid_blocks);
}
```

```cpp
#include <hip/hip_runtime.h>
#include <hip/hip_cooperative_groups.h>
#include <cstdio>
namespace cg = cooperative_groups;

#define DI __device__ __forceinline__
typedef unsigned short u16;
typedef short bf16x8 __attribute__((ext_vector_type(8)));
typedef float f32x16 __attribute__((ext_vector_type(16)));
typedef float f32x4 __attribute__((ext_vector_type(4)));
typedef __bf16 bf2_t __attribute__((ext_vector_type(2)));
typedef float f2_t __attribute__((ext_vector_type(2)));
typedef unsigned u32x2 __attribute__((ext_vector_type(2)));
typedef unsigned u32x4 __attribute__((ext_vector_type(4)));

constexpr int D = 1024, ROWS_P = 32768, ROWS = 33024, DFF = 2816;
constexpr float EPS = 1e-6f;
constexpr float LOG2E = 1.4426950408889634f;
constexpr int NW = 25;
#ifndef REP_GEMM
#define REP_GEMM 1
#endif
#ifndef REP_GLA
#define REP_GLA 1
#endif
#ifndef REP_ATTN
#define REP_ATTN 1
#endif
#define REPG for (int _r = 0; _r < REP_GEMM; ++_r)

struct WD { const float* src; u16* dst; int K, N, mode, pad; };

struct P {
  const float *x_prompt, *x_sample, *cache_k, *cache_v, *state_hgrn, *state_conv, *p_prompt, *p_sample;
  const float *g_norms, *lb_raw, *g_hg, *g_kv, *rel_bias, *lam_b, *g_subln, *conv_w, *conv_b;
  float *y, *k_prompt, *v_prompt, *k_sample, *v_sample, *hgrn_prompt, *hgrn_sample, *conv_prompt, *conv_sample;
  u16 *wt_in_a, *wt_out_a, *wt_kv, *wt_q, *wt_out_b, *wt_ffn_in, *wt_ffn_out, *wt_ple, *wt_gate;
  u16 *XB, *OG; char* BIG; unsigned* bar;
  WD wd[NW];
};

DI unsigned pk2(float a, float b) { f2_t v = {a, b}; bf2_t r = __builtin_convertvector(v, bf2_t); return __builtin_bit_cast(unsigned, r); }
DI int ltid() { int t = threadIdx.x; asm volatile("" : "+v"(t)); return t; }
DI float bf2f(u16 x) { return __uint_as_float(((unsigned)x) << 16); }
DI float bflo(unsigned x) { return __uint_as_float(x << 16); }
DI float bfhi(unsigned x) { return __uint_as_float(x & 0xffff0000u); }
DI float sigm(float x) { return 1.f / (1.f + __expf(-x)); }
DI float wave_sum(float v) {
#pragma unroll
  for (int o = 32; o; o >>= 1) v += __shfl_xor(v, o);
  return v;
}
DI bf16x8 mk8(u32x2 lo, u32x2 hi) { u32x4 t = {lo[0], lo[1], hi[0], hi[1]}; return __builtin_bit_cast(bf16x8, t); }
DI bf16x8 mk8u(unsigned a, unsigned b, unsigned c, unsigned d) { u32x4 t = {a, b, c, d}; return __builtin_bit_cast(bf16x8, t); }

DI void prep_phase(const P& p, char* smem) {
  float* T = (float*)smem;
  const int tid = ltid();
  int total = 0;
  for (int i = 0; i < NW; ++i) total += (p.wd[i].K >> 6) * (p.wd[i].N >> 6);
  for (int flat = blockIdx.x; flat < total; flat += gridDim.x) {
    int wi = 0, base = 0;
    for (;;) { int nt = (p.wd[wi].K >> 6) * (p.wd[wi].N >> 6); if (flat < base + nt) break; base += nt; ++wi; }
    const WD& d = p.wd[wi];
    const int tix = flat - base, ntn = d.N >> 6;
    const int k0 = (tix / ntn) << 6, n0 = (tix % ntn) << 6;
    {
      const int n = tid & 63, kb = tid >> 6;
#pragma unroll
      for (int j = 0; j < 16; ++j) { int k = kb + 4 * j; T[k * 65 + n] = d.src[(size_t)(k0 + k) * d.N + n0 + n]; }
    }
    __syncthreads();
    {
      const int nn = tid >> 2, ks = tid & 3;
      int n = n0 + nn, drow = n;
      if (d.mode == 1) { int isu = n >= DFF; int ch = n - DFF * isu; drow = 128 * (ch >> 6) + 64 * ((ch >> 5) & 1) + 32 * isu + (ch & 31); }
      unsigned o[8];
#pragma unroll
      for (int j = 0; j < 8; ++j) o[j] = pk2(T[(16 * ks + 2 * j) * 65 + nn], T[(16 * ks + 2 * j + 1) * 65 + nn]);
      u32x4* dp = (u32x4*)(d.dst + (size_t)drow * d.K + k0 + 16 * ks);
      dp[0] = (u32x4){o[0], o[1], o[2], o[3]};
      dp[1] = (u32x4){o[4], o[5], o[6], o[7]};
    }
    __syncthreads();
  }
}

DI void rowop_phase(const P& p, bool x_from_in, const float* __restrict__ Madd, const float* __restrict__ gpost,
                    const float* __restrict__ gnext, u16* __restrict__ outH, const float* ple_p, const float* ple_s, u16* outP) {
  const int tidr = ltid();
  const int lane = tidr & 63;
  const int wave = (blockIdx.x * blockDim.x + tidr) >> 6;
  const int nwave = (gridDim.x * blockDim.x) >> 6;
  for (int r = wave; r < ROWS; r += nwave) {
    const float* xs = x_from_in ? (r < ROWS_P ? p.x_prompt + (size_t)r * D : p.x_sample + (size_t)(r - ROWS_P) * D) : p.y + (size_t)r * D;
    f32x4 x[4];
#pragma unroll
    for (int j = 0; j < 4; ++j) x[j] = *(const f32x4*)(xs + 4 * lane + 256 * j);
    if (Madd) {
      f32x4 m[4]; float ss = 0.f;
#pragma unroll
      for (int j = 0; j < 4; ++j) { m[j] = *(const f32x4*)(Madd + (size_t)r * D + 4 * lane + 256 * j); ss += m[j][0] * m[j][0] + m[j][1] * m[j][1] + m[j][2] * m[j][2] + m[j][3] * m[j][3]; }
      ss = wave_sum(ss);
      const float rs = rsqrtf(ss * (1.f / D) + EPS);
#pragma unroll
      for (int j = 0; j < 4; ++j) { f32x4 g = *(const f32x4*)(gpost + 4 * lane + 256 * j); x[j] += m[j] * rs * g; }
#pragma unroll
      for (int j = 0; j < 4; ++j) *(f32x4*)(p.y + (size_t)r * D + 4 * lane + 256 * j) = x[j];
    }
    float rx = 1.f;
    if (gnext) {
      float ss = 0.f;
#pragma unroll
      for (int j = 0; j < 4; ++j) ss += x[j][0] * x[j][0] + x[j][1] * x[j][1] + x[j][2] * x[j][2] + x[j][3] * x[j][3];
      ss = wave_sum(ss);
      rx = rsqrtf(ss * (1.f / D) + EPS);
    }
#pragma unroll
    for (int j = 0; j < 4; ++j) {
      f32x4 h = x[j] * rx;
      if (gnext) h *= *(const f32x4*)(gnext + 4 * lane + 256 * j);
      *(u32x2*)(outH + (size_t)r * D + 4 * lane + 256 * j) = (u32x2){pk2(h[0], h[1]), pk2(h[2], h[3])};
    }
    if (outP) {
      const float* ps = r < ROWS_P ? ple_p + (size_t)r * 256 : ple_s + (size_t)(r - ROWS_P) * 256;
      f32x4 v = *(const f32x4*)(ps + 4 * lane);
      *(u32x2*)(outP + (size_t)r * 256 + 4 * lane) = (u32x2){pk2(v[0], v[1]), pk2(v[2], v[3])};
    }
  }
}

template <class RowMap>
DI void gemm_core(const u16* __restrict__ A, int lda, RowMap rm, const u16* __restrict__ Bt, int ldb, int n0, int K,
                  f32x16 (&acc)[2][2], char* smem, const int tid) {
  const int l = tid & 63, w = tid >> 6, wm = w >> 1, wn = w & 1, l32 = l & 31, hh = l >> 5;
  const int lr = tid >> 3, lc = tid & 7;
  const u16* ap[4]; const u16* bp[4];
#pragma unroll
  for (int q = 0; q < 4; ++q) {
    ap[q] = A + (size_t)rm(q * 32 + lr) * lda + lc * 8;
    bp[q] = Bt + (size_t)(n0 + q * 32 + lr) * ldb + lc * 8;
  }
  const unsigned woff = lr * 128 + ((lc ^ ((lr >> 1) & 7)) << 4);
  const int swz = (l32 >> 1) & 7;
  const unsigned aoff = (wm * 64 + l32) * 128, boff = 16384 + (wn * 64 + l32) * 128;
  u32x4 ra0[4], rb0[4], ra1[4], rb1[4];
  const int nk = K >> 6;
#define GLOAD(RA, RB, T) _Pragma("unroll") for (int q = 0; q < 4; ++q) { RA[q] = *(const u32x4*)(ap[q] + (T) * 64); RB[q] = *(const u32x4*)(bp[q] + (T) * 64); }
#define SWRITE(RA, RB, BUF) { char* db_ = smem + (BUF) * 32768; _Pragma("unroll") for (int q = 0; q < 4; ++q) { *(u32x4*)(db_ + woff + q * 4096) = RA[q]; *(u32x4*)(db_ + 16384 + woff + q * 4096) = RB[q]; } }
#define COMPUTE(BUF) { const char* sb = smem + (BUF) * 32768; _Pragma("unroll") for (int ks = 0; ks < 4; ++ks) { \
      const unsigned co = ((2 * ks + hh) ^ swz) << 4; \
      bf16x8 a0 = *(const bf16x8*)(sb + aoff + co); \
      bf16x8 a1 = *(const bf16x8*)(sb + aoff + 32 * 128 + co); \
      bf16x8 b0 = *(const bf16x8*)(sb + boff + co); \
      bf16x8 b1 = *(const bf16x8*)(sb + boff + 32 * 128 + co); \
      acc[0][0] = __builtin_amdgcn_mfma_f32_32x32x16_bf16(b0, a0, acc[0][0], 0, 0, 0); \
      acc[0][1] = __builtin_amdgcn_mfma_f32_32x32x16_bf16(b1, a0, acc[0][1], 0, 0, 0); \
      acc[1][0] = __builtin_amdgcn_mfma_f32_32x32x16_bf16(b0, a1, acc[1][0], 0, 0, 0); \
      acc[1][1] = __builtin_amdgcn_mfma_f32_32x32x16_bf16(b1, a1, acc[1][1], 0, 0, 0); } }
  GLOAD(ra0, rb0, 0);
  GLOAD(ra1, rb1, 1);
  SWRITE(ra0, rb0, 0);
  __syncthreads();
  for (int kt = 0; kt < nk; kt += 2) {
    if (kt + 2 < nk) GLOAD(ra0, rb0, kt + 2);
    COMPUTE(0);
    SWRITE(ra1, rb1, 1);
    __syncthreads();
    if (kt + 3 < nk) GLOAD(ra1, rb1, kt + 3);
    COMPUTE(1);
    if (kt + 2 < nk) SWRITE(ra0, rb0, 0);
    __syncthreads();
  }
#undef GLOAD
#undef SWRITE
#undef COMPUTE
}

DI bool next_tile(int it, int ntm, int ntn, int& tm, int& tn) {
  const int b = blockIdx.x, x = b & 7, slot = b >> 3, S = gridDim.x >> 3;
  const int nq = (ntm - x + 7) >> 3;
  const int L = slot + it * S;
  if (L >= nq * ntn) return false;
  const int gsize = 8 * ntn;
  const int grp = L / gsize, r = L - grp * gsize;
  const int gsz = min(8, nq - 8 * grp);
  tn = r / gsz;
  tm = x + 8 * (8 * grp + r % gsz);
  return true;
}

struct IdMap { int base; DI int operator()(int r) const { return base + r; } };
struct ClampMap { int rowbase, t0, T; DI int operator()(int r) const { int t = t0 + r; t = t < 0 ? 0 : (t > T - 1 ? T - 1 : t); return rowbase + t; } };

#define ZERO_ACC(a) _Pragma("unroll") for (int _i = 0; _i < 2; ++_i) _Pragma("unroll") for (int _j = 0; _j < 2; ++_j) _Pragma("unroll") for (int _e = 0; _e < 16; ++_e) a[_i][_j][_e] = 0.f;

template <int EPI>
DI void gemm_phase(const P& p, const u16* A, int K, const u16* Bt, int N, void* outp, char* smem) {
  const int tid = ltid(), l = tid & 63, w = tid >> 6, wm = w >> 1, wn = w & 1, l32 = l & 31, hh = l >> 5;
  const int ntm = ROWS / 128, ntn = N / 128;
  int tm, tn;
  for (int it = 0; next_tile(it, ntm, ntn, tm, tn); ++it) {
    f32x16 acc[2][2];
    ZERO_ACC(acc);
    gemm_core(A, K, IdMap{tm * 128}, Bt, K, tn * 128, K, acc, smem, tid);
    const int n0 = tn * 128;
#pragma unroll
    for (int mi = 0; mi < 2; ++mi) {
      const int m = tm * 128 + wm * 64 + mi * 32 + l32;
#pragma unroll
      for (int ni = 0; ni < 2; ++ni)
#pragma unroll
        for (int q = 0; q < 4; ++q) {
          const int n = n0 + wn * 64 + ni * 32 + 8 * q + 4 * hh;
          float v0 = acc[mi][ni][4 * q], v1 = acc[mi][ni][4 * q + 1], v2 = acc[mi][ni][4 * q + 2], v3 = acc[mi][ni][4 * q + 3];
          if (EPI == 0) {
            const int sec = n0 >> 10;
            if (sec == 0 || sec == 3) { v0 *= sigm(v0); v1 *= sigm(v1); v2 *= sigm(v2); v3 *= sigm(v3); }
            *(u32x2*)((u16*)outp + (size_t)m * 4096 + n) = (u32x2){pk2(v0, v1), pk2(v2, v3)};
          } else if (EPI == 1) {
            const float sc = 0.125f * LOG2E;
            *(u32x2*)((u16*)outp + (size_t)m * 1024 + n) = (u32x2){pk2(v0 * sc, v1 * sc), pk2(v2 * sc, v3 * sc)};
          } else if (EPI == 2) {
            *(f32x4*)((float*)outp + (size_t)m * 1024 + n) = (f32x4){v0, v1, v2, v3};
          } else {
            float* dst;
            if (n < 1024) dst = (m < ROWS_P ? p.k_prompt + (size_t)m * 1024 : p.k_sample + (size_t)(m - ROWS_P) * 1024) + n;
            else dst = (m < ROWS_P ? p.v_prompt + (size_t)m * 1024 : p.v_sample + (size_t)(m - ROWS_P) * 1024) + (n - 1024);
            *(f32x4*)dst = (f32x4){v0, v1, v2, v3};
          }
        }
    }
  }
}

DI void ple_phase(const P& p, int layer, char* smem) {
  const int tid = ltid(), l = tid & 63, w = tid >> 6, wm = w >> 1, wn = w & 1, l32 = l & 31, hh = l >> 5;
  const u16* XB2 = (const u16*)p.BIG;
  const u16* PB = (const u16*)(p.BIG + (size_t)ROWS * 1024 * 2);
  const u16* Wg = p.wt_gate + (size_t)layer * 1024 * 1024;
  const u16* Wp = p.wt_ple + (size_t)layer * 1024 * 256;
  int tm, tn;
  for (int it = 0; next_tile(it, ROWS / 128, 8, tm, tn); ++it) {
    unsigned pl[2][2][8];
    {
      f32x16 acc2[2][2];
      ZERO_ACC(acc2);
      gemm_core(PB, 256, IdMap{tm * 128}, Wp, 256, tn * 128, 256, acc2, smem, tid);
#pragma unroll
      for (int a = 0; a < 2; ++a)
#pragma unroll
        for (int b2 = 0; b2 < 2; ++b2)
#pragma unroll
          for (int e = 0; e < 8; ++e) pl[a][b2][e] = pk2(acc2[a][b2][2 * e], acc2[a][b2][2 * e + 1]);
    }
    f32x16 acc[2][2];
    ZERO_ACC(acc);
    gemm_core(XB2, 1024, IdMap{tm * 128}, Wg, 1024, tn * 128, 1024, acc, smem, tid);
#pragma unroll
    for (int mi = 0; mi < 2; ++mi) {
      const int m = tm * 128 + wm * 64 + mi * 32 + l32;
#pragma unroll
      for (int ni = 0; ni < 2; ++ni)
#pragma unroll
        for (int q = 0; q < 4; ++q) {
          const int n = tn * 128 + wn * 64 + ni * 32 + 8 * q + 4 * hh;
          f32x4* xp = (f32x4*)(p.y + (size_t)m * D + n);
          f32x4 x = *xp;
#pragma unroll
          for (int c = 0; c < 4; ++c) {
            const unsigned pv = pl[mi][ni][2 * q + (c >> 1)];
            x[c] += sigm(acc[mi][ni][4 * q + c]) * ((c & 1) ? bfhi(pv) : bflo(pv));
          }
          *xp = x;
        }
    }
  }
}

DI void ffn_in_phase(const P& p, int layer, char* smem) {
  const int tid = ltid(), l = tid & 63, w = tid >> 6, wm = w >> 1, wn = w & 1, l32 = l & 31, hh = l >> 5;
  const u16* Wt = p.wt_ffn_in + (size_t)layer * 5632 * 1024;
  u16* HID = (u16*)p.BIG;
  float* GS = (float*)smem;
  const float* cw = p.conv_w + (size_t)layer * 3 * DFF;
  const float* cb = p.conv_b + (size_t)layer * DFF;
  int tm, tn;
  for (int it = 0; next_tile(it, 280, 44, tm, tn); ++it) {
    int seq, T, rowbase, t0; bool last;
    if (tm < 272) { seq = tm / 17; int j = tm - seq * 17; T = 2048; rowbase = seq * 2048; t0 = 126 * j - 2; last = (j == 16); }
    else { seq = 16 + (tm - 272); T = 32; rowbase = ROWS_P + (tm - 272) * 32; t0 = -2; last = true; }
    f32x16 acc[2][2];
    ZERO_ACC(acc);
    gemm_core(p.XB, 1024, ClampMap{rowbase, t0, T}, Wt, 1024, tn * 128, 1024, acc, smem, tid);
    const int chw = tn * 64 + wn * 32;
    if (t0 < 0 && wm == 0 && l32 < 2) {
#pragma unroll
      for (int q = 0; q < 4; ++q) {
        f32x4 sv = {0.f, 0.f, 0.f, 0.f};
        if (seq >= 16) sv = *(const f32x4*)(p.state_conv + ((size_t)(layer * 8 + (seq - 16)) * 2 + l32) * DFF + chw + 8 * q + 4 * hh);
#pragma unroll
        for (int c = 0; c < 4; ++c) acc[0][0][4 * q + c] = sv[c];
      }
    }
#pragma unroll
    for (int mi = 0; mi < 2; ++mi)
#pragma unroll
      for (int i = 0; i < 16; ++i) {
        const int chl = wn * 32 + 8 * (i >> 2) + 4 * hh + (i & 3);
        GS[chl * 132 + wm * 64 + mi * 32 + l32] = acc[mi][0][i];
      }
    __syncthreads();
#pragma unroll
    for (int q = 0; q < 4; ++q) {
      const int chq = chw + 8 * q + 4 * hh;
      const f32x4 b4 = *(const f32x4*)(cb + chq);
      const f32x4 w0 = *(const f32x4*)(cw + chq), w1 = *(const f32x4*)(cw + DFF + chq), w2 = *(const f32x4*)(cw + 2 * DFF + chq);
#pragma unroll
      for (int mi = 0; mi < 2; ++mi) {
        const int m = wm * 64 + mi * 32 + l32;
        const int t = t0 + m;
        if (m >= 2 && t < T) {
          float hv[4];
#pragma unroll
          for (int c = 0; c < 4; ++c) {
            const int chl = wn * 32 + 8 * q + 4 * hh + c;
            const float g0 = acc[mi][0][4 * q + c], g1 = GS[chl * 132 + m - 1], g2 = GS[chl * 132 + m - 2];
            const float cv = b4[c] + w0[c] * g2 + w1[c] * g1 + w2[c] * g0;
            hv[c] = cv * sigm(cv) * acc[mi][1][4 * q + c];
          }
          *(u32x2*)(HID + (size_t)(rowbase + t) * DFF + chq) = (u32x2){pk2(hv[0], hv[1]), pk2(hv[2], hv[3])};
          if (last && t >= T - 2) {
            float* co = seq < 16 ? p.conv_prompt + ((size_t)(layer * 16 + seq) * 2 + (t - (T - 2))) * DFF
                                 : p.conv_sample + ((size_t)(layer * 8 + (seq - 16)) * 2 + (t - (T - 2))) * DFF;
            *(f32x4*)(co + chq) = (f32x4){acc[mi][0][4 * q], acc[mi][0][4 * q + 1], acc[mi][0][4 * q + 2], acc[mi][0][4 * q + 3]};
          }
        }
      }
    }
    __syncthreads();
  }
}

DI void gla_phase(const P& p, int layer, char* smem) {
  const u16* PROJ = (const u16*)p.BIG;
  const int tid = ltid(), l = tid & 63, w = tid >> 6, l32 = l & 31, hh = l >> 5, m16 = l & 15;
  float* REDB = (float*)(smem + 2 * 14336);
  const int k = tid >> 1, th = tid & 1;
  for (int item = blockIdx.x; item < 192; item += gridDim.x) {
    const int s = item >> 3, h = item & 7;
    const bool smp = s >= 16;
    const int T = smp ? 32 : 2048;
    const int rowbase = smp ? ROWS_P + (s - 16) * 32 : s * 2048;
    float lower = 0.f;
    if (layer == 1) lower = sigm(p.lb_raw[1024 + h * 128 + k] - p.lb_raw[h * 128 + k]);
    const float oml = 1.f - lower;
    f32x16 S[4];
    if (smp) {
      const float* sp = p.state_hgrn + ((size_t)(layer * 8 + (s - 16)) * 8 + h) * 16384 + 32 * w + l32;
#pragma unroll
      for (int kt = 0; kt < 4; ++kt)
#pragma unroll
        for (int i = 0; i < 16; ++i) S[kt][i] = sp[(size_t)(32 * kt + (i & 3) + 8 * (i >> 2) + 4 * hh) * 128];
    } else {
#pragma unroll
      for (int kt = 0; kt < 4; ++kt)
#pragma unroll
        for (int i = 0; i < 16; ++i) S[kt][i] = 0.f;
    }
    const int nblk = T >> 4;
    u16 fr[8], qr[8], vr[8];
#define GLA_LOADRAW(BLK) { const size_t r0_ = (size_t)rowbase + (BLK) * 16; \
      const u16* pf_ = PROJ + (r0_ + 8 * th) * 4096 + 1024 + h * 128 + k; \
      const u16* pq_ = PROJ + (r0_ + 8 * th) * 4096 + h * 128 + k; \
      const u16* pv_ = PROJ + r0_ * 4096 + 2048 + h * 128 + 32 * w + l32; \
      _Pragma("unroll") for (int t = 0; t < 8; ++t) fr[t] = pf_[(size_t)t * 4096]; \
      _Pragma("unroll") for (int j = 0; j < 8; ++j) qr[j] = pq_[(size_t)j * 4096]; \
      _Pragma("unroll") for (int jj = 0; jj < 8; ++jj) vr[jj] = pv_[(size_t)(8 * (jj >> 2) + 4 * hh + (jj & 3)) * 4096]; }
#define GLA_LOADGS(BLK) { const u16* pg_ = PROJ + ((size_t)rowbase + (BLK) * 16 + m16) * 4096 + 3072 + h * 128 + 32 * w + 4 * hh; \
      _Pragma("unroll") for (int q = 0; q < 4; ++q) gsl[q] = *(const u32x2*)(pg_ + 8 * q); }
#define GLA_FINAL(BLK) { const float* RED_ = REDB + ((BLK) & 1) * 64; \
      if (l32 < 16) { \
        const float tot = RED_[l32] + RED_[16 + l32] + RED_[32 + l32] + RED_[48 + l32]; \
        const float rn = rsqrtf(tot * (1.f / 128.f) + EPS); \
        u16* op_ = p.OG + ((size_t)rowbase + (BLK) * 16 + l32) * 1024 + h * 128 + 32 * w + 4 * hh; \
        const float* gp_ = p.g_hg + layer * 1024 + h * 128 + 32 * w + 4 * hh; \
        _Pragma("unroll") for (int q = 0; q < 4; ++q) { const f32x4 gh = *(const f32x4*)(gp_ + 8 * q); \
          *(u32x2*)(op_ + 8 * q) = (u32x2){pk2(oacc[4 * q] * rn * gh[0] * bflo(gsl[q][0]), oacc[4 * q + 1] * rn * gh[1] * bfhi(gsl[q][0])), \
                                          pk2(oacc[4 * q + 2] * rn * gh[2] * bflo(gsl[q][1]), oacc[4 * q + 3] * rn * gh[3] * bfhi(gsl[q][1]))}; } \
      } }
    GLA_LOADRAW(0);
    u32x2 gsl[4];
    for (int blk = 0; blk < nblk; ++blk) {
      GLA_LOADGS(blk);
      char* sb = smem + (blk & 1) * 14336;
      u16* QT = (u16*)sb;
      u16* KT = QT + 16 * 136;
      u16* KDT = KT + 16 * 136;
      float* DD = (float*)(KDT + 128 * 20);
      {
        float bown[8], kown[8];
        float bs = 0.f;
#pragma unroll
        for (int t = 0; t < 8; ++t) {
          const float f = bf2f(fr[t]);
          const float g = lower + oml * sigm(f);
          bs += __logf(g);
          bown[t] = bs; kown[t] = 1.f - g;
        }
        const float other = __shfl_xor(bs, 1);
        const float boff = th ? other : 0.f;
        const float bsum = bs + other;
#pragma unroll
        for (int t = 0; t < 8; ++t) bown[t] += boff;
        unsigned kdp[4];
        float kdprev = 0.f;
#pragma unroll
        for (int j = 0; j < 8; ++j) {
          const int t = 8 * th + j;
          const float q = bf2f(qr[j]);
          const float eb = __expf(bown[j]);
          const float ei = __expf(-bown[j]);
          const float qt = q * eb;
          const float ktv = kown[j] * ei;
          const float kd = ktv * __expf(bsum);
          QT[t * 136 + k] = (u16)(pk2(qt, 0.f) & 0xffffu);
          KT[t * 136 + k] = (u16)(pk2(ktv, 0.f) & 0xffffu);
          if (j & 1) kdp[j >> 1] = pk2(kdprev, kd); else kdprev = kd;
        }
        *(u32x2*)(KDT + k * 20 + 8 * th) = (u32x2){kdp[0], kdp[1]};
        *(u32x2*)(KDT + k * 20 + 8 * th + 4) = (u32x2){kdp[2], kdp[3]};
        if (th == 0) DD[k] = __expf(bsum);
      }
      const bf16x8 vfrag = mk8u((unsigned)vr[0] | ((unsigned)vr[1] << 16), (unsigned)vr[2] | ((unsigned)vr[3] << 16),
                                (unsigned)vr[4] | ((unsigned)vr[5] << 16), (unsigned)vr[6] | ((unsigned)vr[7] << 16));
      if (blk + 1 < nblk) GLA_LOADRAW(blk + 1);
      __syncthreads();
      f32x16 aacc, oacc;
#pragma unroll
      for (int i = 0; i < 16; ++i) { aacc[i] = 0.f; oacc[i] = 0.f; }
#pragma unroll
      for (int ks = 0; ks < 8; ++ks) {
        const bf16x8 ka = *(const bf16x8*)(KT + m16 * 136 + 16 * ks + 8 * hh);
        const bf16x8 qb = *(const bf16x8*)(QT + m16 * 136 + 16 * ks + 8 * hh);
        aacc = __builtin_amdgcn_mfma_f32_32x32x16_bf16(ka, qb, aacc, 0, 0, 0);
        const int kt = ks >> 1, s2 = ks & 1;
        const bf16x8 sa = mk8u(pk2(S[kt][8 * s2], S[kt][8 * s2 + 1]), pk2(S[kt][8 * s2 + 2], S[kt][8 * s2 + 3]),
                               pk2(S[kt][8 * s2 + 4], S[kt][8 * s2 + 5]), pk2(S[kt][8 * s2 + 6], S[kt][8 * s2 + 7]));
        const u32x2 lo = *(const u32x2*)(QT + m16 * 136 + 32 * kt + 16 * s2 + 4 * hh);
        const u32x2 hi = *(const u32x2*)(QT + m16 * 136 + 32 * kt + 16 * s2 + 8 + 4 * hh);
        oacc = __builtin_amdgcn_mfma_f32_32x32x16_bf16(sa, mk8(lo, hi), oacc, 0, 0, 0);
      }
      float am[8];
#pragma unroll
      for (int i = 0; i < 8; ++i) { const int m = (i & 3) + 8 * (i >> 2) + 4 * hh; am[i] = (m <= m16) ? aacc[i] : 0.f; }
      const bf16x8 afrag = mk8u(pk2(am[0], am[1]), pk2(am[2], am[3]), pk2(am[4], am[5]), pk2(am[6], am[7]));
      oacc = __builtin_amdgcn_mfma_f32_32x32x16_bf16(vfrag, afrag, oacc, 0, 0, 0);
#pragma unroll
      for (int kt = 0; kt < 4; ++kt) {
#pragma unroll
        for (int q = 0; q < 4; ++q) {
          const f32x4 d4 = *(const f32x4*)(DD + 32 * kt + 8 * q + 4 * hh);
#pragma unroll
          for (int c = 0; c < 4; ++c) S[kt][4 * q + c] *= d4[c];
        }
        const u32x2 lo = *(const u32x2*)(KDT + (32 * kt + l32) * 20 + 4 * hh);
        const u32x2 hi = *(const u32x2*)(KDT + (32 * kt + l32) * 20 + 8 + 4 * hh);
        S[kt] = __builtin_amdgcn_mfma_f32_32x32x16_bf16(mk8(lo, hi), vfrag, S[kt], 0, 0, 0);
      }
      float ss = 0.f;
#pragma unroll
      for (int i = 0; i < 16; ++i) ss += oacc[i] * oacc[i];
      ss += __shfl_xor(ss, 32);
      if (l < 16) REDB[(blk & 1) * 64 + w * 16 + l] = ss;
      __syncthreads();
      GLA_FINAL(blk);
    }
#undef GLA_LOADGS
#undef GLA_LOADRAW
#undef GLA_FINAL
    {
      float* op = (smp ? p.hgrn_sample + ((size_t)(layer * 8 + (s - 16)) * 8 + h) * 16384
                       : p.hgrn_prompt + ((size_t)(layer * 16 + s) * 8 + h) * 16384) + 32 * w + l32;
#pragma unroll
      for (int kt = 0; kt < 4; ++kt)
#pragma unroll
        for (int i = 0; i < 16; ++i) op[(size_t)(32 * kt + (i & 3) + 8 * (i >> 2) + 4 * hh) * 128] = S[kt][i];
    }
  }
}

DI void kvconv_phase(const P& p) {
  const int tid = ltid();
  char* KVT = p.BIG + (size_t)ROWS * 1024 * 2;
  for (int t = blockIdx.x; t < 4096 + 1088; t += gridDim.x) {
    const float *kb, *vb; int nvalid = 64;
    if (t < 4096) { const int kt = t & 31, sh = t >> 5, s = sh >> 3, h = sh & 7; const size_t off = ((size_t)(s * 2048 + 64 * kt)) * 1024 + h * 128; kb = p.k_prompt + off; vb = p.v_prompt + off; }
    else { const int u = t - 4096; const int kt = u % 17, sh = u / 17, b = sh >> 3, h = sh & 7;
      if (kt < 16) { const size_t off = ((size_t)(b * 1024 + 64 * kt)) * 1024 + h * 128; kb = p.cache_k + off; vb = p.cache_v + off; }
      else { const size_t off = ((size_t)(b * 32)) * 1024 + h * 128; kb = p.k_sample + off; vb = p.v_sample + off; nvalid = 32; } }
    u16* kd = (u16*)(KVT + (size_t)t * 32768);
    u16* vd = kd + 8192;
#pragma unroll
    for (int pp = 0; pp < 4; ++pp) {
      const int key = 16 * pp + (tid >> 4), d8 = (tid & 15) * 8;
      f32x4 a = {0.f, 0.f, 0.f, 0.f}, b2 = {0.f, 0.f, 0.f, 0.f};
      if (key < nvalid) { a = *(const f32x4*)(kb + (size_t)key * 1024 + d8); b2 = *(const f32x4*)(kb + (size_t)key * 1024 + d8 + 4); }
      *(u32x4*)(kd + key * 128 + d8) = (u32x4){pk2(a[0], a[1]), pk2(a[2], a[3]), pk2(b2[0], b2[1]), pk2(b2[2], b2[3])};
    }
#pragma unroll
    for (int c = 0; c < 4; ++c) {
      const int v = tid & 127, cc = 4 * (tid >> 7) + c;
      float e[8];
#pragma unroll
      for (int j = 0; j < 8; ++j) { const int key = 8 * cc + j; e[j] = key < nvalid ? vb[(size_t)key * 1024 + v] : 0.f; }
      *(u32x4*)(vd + v * 64 + 8 * cc) = (u32x4){pk2(e[0], e[1]), pk2(e[2], e[3]), pk2(e[4], e[5]), pk2(e[6], e[7])};
    }
  }
}

DI void attn_phase(const P& p, int layer, char* smem) {
  const int jl = layer - 2;
  const u16* Q = (const u16*)p.BIG;
  const char* KVT = p.BIG + (size_t)ROWS * 1024 * 2;
  const int tid = ltid(), l = tid & 63, w = tid >> 6, l16 = l & 15, g = l >> 4;
  u16* KS = (u16*)smem;
  u16* VT = KS + 64 * 136;
  float* BT = (float*)(VT + 128 * 72);
  const float lam_init = 0.8f - 0.6f * __expf(-0.3f * (float)layer);
  float lam;
  {
    const float* lp = p.lam_b + jl * 256;
    float a = 0.f, b = 0.f;
    for (int d = 0; d < 64; ++d) { a += lp[d] * lp[64 + d]; b += lp[128 + d] * lp[192 + d]; }
    lam = __expf(a) - __expf(b) + lam_init;
  }
  for (int item = blockIdx.x; item < 4096 + 64; item += gridDim.x) {
    int b, h, nq, qrow0, qpos0, ntiles, tile0; bool smp;
    if (item < 4096) { const int jq = 31 - (item >> 7); const int bh = item & 127; b = bh >> 3; h = bh & 7; smp = false; nq = 64; qrow0 = b * 2048 + 64 * jq; qpos0 = 64 * jq; ntiles = jq + 1; tile0 = bh * 32; }
    else { const int si = item - 4096; b = si >> 3; h = si & 7; smp = true; nq = 32; qrow0 = ROWS_P + b * 32; qpos0 = 1024; ntiles = 17; tile0 = 4096 + si * 17; }
    __syncthreads();
    if (tid < 230) {
      const int rel = tid - 166;
      const int n = rel < 0 ? -rel : rel;
      int bk = n < 8 ? n : 8 + (n >= 13) + (n >= 20) + (n >= 30) + (n >= 46) + (n >= 70) + (n >= 108) + (n >= 166);
      if (rel > 0) bk += 16;
      BT[tid] = p.rel_bias[bk * 8 + h] * LOG2E;
    }
    bf16x8 qf[2][2];
    {
      const int qr = min(16 * w + l16, nq - 1);
      const u16* qp = Q + (size_t)(qrow0 + qr) * 1024 + h * 128;
#pragma unroll
      for (int c = 0; c < 2; ++c)
#pragma unroll
        for (int ks = 0; ks < 2; ++ks) qf[c][ks] = *(const bf16x8*)(qp + c * 64 + 32 * ks + 8 * g);
    }
    f32x4 oacc[2][8];
#pragma unroll
    for (int c = 0; c < 2; ++c)
#pragma unroll
      for (int vs = 0; vs < 8; ++vs) oacc[c][vs] = (f32x4){0.f, 0.f, 0.f, 0.f};
    float mrun[2] = {-1e30f, -1e30f}, lsum[2] = {0.f, 0.f};
    const int qpos = qpos0 + min(16 * w + l16, nq - 1);
    u32x4 rk[4], rv[4];
    {
      const u32x4* src = (const u32x4*)(KVT + (size_t)tile0 * 32768);
#pragma unroll
      for (int pp = 0; pp < 4; ++pp) { rk[pp] = src[pp * 256 + tid]; rv[pp] = src[1024 + pp * 256 + tid]; }
    }
    for (int kt = 0; kt < ntiles; ++kt) {
      const int nvalid = (smp && kt == 16) ? 32 : 64;
      if (kt > 0) __syncthreads();
#pragma unroll
      for (int pp = 0; pp < 4; ++pp) {
        const int idx = pp * 256 + tid;
        *(u32x4*)(KS + (idx >> 4) * 136 + (idx & 15) * 8) = rk[pp];
        *(u32x4*)(VT + (idx >> 3) * 72 + (idx & 7) * 8) = rv[pp];
      }
      if (kt + 1 < ntiles) {
        const u32x4* src = (const u32x4*)(KVT + (size_t)(tile0 + kt + 1) * 32768);
#pragma unroll
        for (int pp = 0; pp < 4; ++pp) { rk[pp] = src[pp * 256 + tid]; rv[pp] = src[1024 + pp * 256 + tid]; }
      }
      __syncthreads();
      f32x4 sacc[2][4];
#pragma unroll
      for (int c = 0; c < 2; ++c)
#pragma unroll
        for (int sub = 0; sub < 4; ++sub) {
          sacc[c][sub] = (f32x4){0.f, 0.f, 0.f, 0.f};
#pragma unroll
          for (int ks = 0; ks < 2; ++ks) {
            const bf16x8 kf = *(const bf16x8*)(KS + (16 * sub + l16) * 136 + c * 64 + 32 * ks + 8 * g);
            sacc[c][sub] = __builtin_amdgcn_mfma_f32_16x16x32_bf16(kf, qf[c][ks], sacc[c][sub], 0, 0, 0);
          }
        }
#pragma unroll
      for (int sub = 0; sub < 4; ++sub)
#pragma unroll
        for (int i = 0; i < 4; ++i) {
          const int kl = 16 * sub + 4 * g + i;
          int rel = 64 * kt + kl - qpos;
          rel = rel < -166 ? -166 : rel;
          const float bt = BT[rel + 166];
          const bool ok = kl < nvalid;
          sacc[0][sub][i] = ok ? sacc[0][sub][i] + bt : -30000.f;
          sacc[1][sub][i] = ok ? sacc[1][sub][i] + bt : -30000.f;
        }
      bf16x8 pf[2][2];
#pragma unroll
      for (int c = 0; c < 2; ++c) {
        float mx = -1e30f;
#pragma unroll
        for (int sub = 0; sub < 4; ++sub)
#pragma unroll
          for (int i = 0; i < 4; ++i) mx = fmaxf(mx, sacc[c][sub][i]);
        mx = fmaxf(mx, __shfl_xor(mx, 16));
        mx = fmaxf(mx, __shfl_xor(mx, 32));
        const float mnew = fmaxf(mrun[c], mx);
        const float alpha = __builtin_amdgcn_exp2f(mrun[c] - mnew);
        mrun[c] = mnew;
        float rs = 0.f;
#pragma unroll
        for (int sub = 0; sub < 4; ++sub)
#pragma unroll
          for (int i = 0; i < 4; ++i) { const float e = __builtin_amdgcn_exp2f(sacc[c][sub][i] - mnew); sacc[c][sub][i] = e; rs += e; }
        lsum[c] = lsum[c] * alpha + rs;
#pragma unroll
        for (int vs = 0; vs < 8; ++vs) oacc[c][vs] *= alpha;
#pragma unroll
        for (int j = 0; j < 2; ++j)
          pf[c][j] = mk8u(pk2(sacc[c][2 * j][0], sacc[c][2 * j][1]), pk2(sacc[c][2 * j][2], sacc[c][2 * j][3]),
                          pk2(sacc[c][2 * j + 1][0], sacc[c][2 * j + 1][1]), pk2(sacc[c][2 * j + 1][2], sacc[c][2 * j + 1][3]));
      }
#pragma unroll
      for (int j = 0; j < 2; ++j)
#pragma unroll
        for (int vs = 0; vs < 8; ++vs) {
          const u32x2 lo = *(const u32x2*)(VT + (16 * vs + l16) * 72 + 32 * j + 4 * g);
          const u32x2 hi = *(const u32x2*)(VT + (16 * vs + l16) * 72 + 32 * j + 16 + 4 * g);
          const bf16x8 vf = mk8(lo, hi);
          oacc[0][vs] = __builtin_amdgcn_mfma_f32_16x16x32_bf16(vf, pf[0][j], oacc[0][vs], 0, 0, 0);
          oacc[1][vs] = __builtin_amdgcn_mfma_f32_16x16x32_bf16(vf, pf[1][j], oacc[1][vs], 0, 0, 0);
        }
    }
#pragma unroll
    for (int c = 0; c < 2; ++c) { lsum[c] += __shfl_xor(lsum[c], 16); lsum[c] += __shfl_xor(lsum[c], 32); }
    const float inv0 = 1.f / lsum[0], inv1 = lam / lsum[1];
    float ss = 0.f;
#pragma unroll
    for (int vs = 0; vs < 8; ++vs)
#pragma unroll
      for (int i = 0; i < 4; ++i) { const float o = oacc[0][vs][i] * inv0 - oacc[1][vs][i] * inv1; oacc[0][vs][i] = o; ss += o * o; }
    ss += __shfl_xor(ss, 16);
    ss += __shfl_xor(ss, 32);
    const float rn = rsqrtf(ss * (1.f / 128.f) + EPS) * (1.f - lam_init);
    if (16 * w + l16 < nq) {
      const size_t row = (size_t)qrow0 + 16 * w + l16;
#pragma unroll
      for (int vs = 0; vs < 8; ++vs) {
        const int v = h * 128 + 16 * vs + 4 * g;
        const f32x4 gl = *(const f32x4*)(p.g_subln + jl * 1024 + v);
        *(u32x2*)(p.OG + row * 1024 + v) = (u32x2){pk2(oacc[0][vs][0] * rn * gl[0], oacc[0][vs][1] * rn * gl[1]),
                                                   pk2(oacc[0][vs][2] * rn * gl[2], oacc[0][vs][3] * rn * gl[3])};
      }
    }
  }
}

DI void gbar(unsigned* bar, unsigned& gen) {
  gen += 1;
  asm volatile("s_waitcnt vmcnt(0) lgkmcnt(0)" ::: "memory");
  __syncthreads();
  if (threadIdx.x < 64) {
    const unsigned g = blockIdx.x >> 4, ng = gridDim.x >> 4;
    bool last = false;
    if (threadIdx.x == 0) {
      __builtin_amdgcn_fence(__ATOMIC_RELEASE, "agent");
      asm volatile("s_waitcnt vmcnt(0)" ::: "memory");
      const unsigned o = __hip_atomic_fetch_add(bar + 64 * g, 1u, __ATOMIC_RELAXED, __HIP_MEMORY_SCOPE_AGENT);
      if (o + 1 == 16 * gen) {
        const unsigned o2 = __hip_atomic_fetch_add(bar + 64 * 64, 1u, __ATOMIC_RELAXED, __HIP_MEMORY_SCOPE_AGENT);
        last = (o2 + 1 == ng * gen);
      }
    }
    last = __shfl(last ? 1 : 0, 0) != 0;
    if (last && threadIdx.x < ng) __hip_atomic_store(bar + 64 * (65 + threadIdx.x), gen, __ATOMIC_RELAXED, __HIP_MEMORY_SCOPE_AGENT);
    if (threadIdx.x == 0) {
      while (__hip_atomic_load(bar + 64 * (65 + g), __ATOMIC_RELAXED, __HIP_MEMORY_SCOPE_AGENT) < gen) __builtin_amdgcn_s_sleep(2);
      __builtin_amdgcn_fence(__ATOMIC_ACQUIRE, "agent");
      asm volatile("s_waitcnt vmcnt(0)" ::: "memory");
    }
  }
  __syncthreads();
}

__global__ void __launch_bounds__(256, 2) yoco_megakernel(P p) {
  __shared__ __attribute__((aligned(16))) char smem[65536];
  cg::grid_group grid = cg::this_grid();
  if (blockIdx.x == 0 && threadIdx.x < 130) __hip_atomic_store(p.bar + 64 * threadIdx.x, 0u, __ATOMIC_RELAXED, __HIP_MEMORY_SCOPE_AGENT);
  prep_phase(p, smem);
  grid.sync();
  unsigned btarget = 0;
  float* Mbuf = (float*)p.BIG;
  float* Fbuf = (float*)p.XB;
  u16* XB2 = (u16*)p.BIG;
  u16* PB = (u16*)(p.BIG + (size_t)ROWS * 1024 * 2);
  for (int i = 0; i < 4; ++i) {
    const float* gn = p.g_norms + i * 4 * D;
    rowop_phase(p, i == 0, nullptr, nullptr, gn, p.XB, nullptr, nullptr, nullptr);
    gbar(p.bar, btarget);
    if (i < 2) {
      REPG gemm_phase<0>(p, p.XB, 1024, p.wt_in_a + (size_t)i * 4096 * 1024, 4096, p.BIG, smem);
      gbar(p.bar, btarget);
      for (int _r = 0; _r < REP_GLA; ++_r) gla_phase(p, i, smem);
      gbar(p.bar, btarget);
      REPG gemm_phase<2>(p, p.OG, 1024, p.wt_out_a + (size_t)i * 1024 * 1024, 1024, Mbuf, smem);
      gbar(p.bar, btarget);
    } else {
      REPG gemm_phase<1>(p, p.XB, 1024, p.wt_q + (size_t)(i - 2) * 1024 * 1024, 1024, p.BIG, smem);
      kvconv_phase(p);
      gbar(p.bar, btarget);
      for (int _r = 0; _r < REP_ATTN; ++_r) attn_phase(p, i, smem);
      gbar(p.bar, btarget);
      REPG gemm_phase<2>(p, p.OG, 1024, p.wt_out_b + (size_t)(i - 2) * 1024 * 1024, 1024, Mbuf, smem);
      gbar(p.bar, btarget);
    }
    rowop_phase(p, i == 0, Mbuf, gn + D, gn + 2 * D, p.XB, nullptr, nullptr, nullptr);
    gbar(p.bar, btarget);
    REPG ffn_in_phase(p, i, smem);
    gbar(p.bar, btarget);
    REPG gemm_phase<2>(p, (const u16*)p.BIG, DFF, p.wt_ffn_out + (size_t)i * 1024 * DFF, 1024, Fbuf, smem);
    gbar(p.bar, btarget);
    rowop_phase(p, false, Fbuf, gn + 3 * D, nullptr, XB2, p.p_prompt + (size_t)i * ROWS_P * 256, p.p_sample + (size_t)i * 256 * 256, PB);
    gbar(p.bar, btarget);
    ple_phase(p, i, smem);
    gbar(p.bar, btarget);
    if (i == 1) {
      rowop_phase(p, false, nullptr, nullptr, p.g_kv, p.XB, nullptr, nullptr, nullptr);
      gbar(p.bar, btarget);
      REPG gemm_phase<3>(p, p.XB, 1024, p.wt_kv, 2048, nullptr, smem);
      gbar(p.bar, btarget);
    }
  }
}

extern "C" void kernel_launch(void* const* d_in, const int* in_sizes, int n_in, void* d_out, int out_size, void* d_ws,
                              size_t ws_size, hipStream_t stream) {
  static int grid_blocks = 0;
  if (!grid_blocks) {
    int dev = 0, cus = 0, per_cu = 0;
    hipGetDevice(&dev);
    hipDeviceGetAttribute(&cus, hipDeviceAttributeMultiprocessorCount, dev);
    hipOccupancyMaxActiveBlocksPerMultiprocessor(&per_cu, yoco_megakernel, 256, 0);
    if (per_cu > 2) per_cu = 2;
    grid_blocks = cus * per_cu;
    grid_blocks &= ~7;
  }
  P p{};
  const float* const* in = (const float* const*)d_in;
  p.x_prompt = in[0]; p.x_sample = in[1]; p.cache_k = in[2]; p.cache_v = in[3]; p.state_hgrn = in[4]; p.state_conv = in[5];
  p.p_prompt = in[6]; p.p_sample = in[7];
  p.g_norms = in[8]; const float* w_in_a = in[9]; p.lb_raw = in[10]; p.g_hg = in[11]; const float* w_out_a = in[12]; p.g_kv = in[13];
  const float* w_kv = in[14]; p.rel_bias = in[15]; const float* w_q_b = in[16]; p.lam_b = in[17]; p.g_subln = in[18];
  const float* w_out_b = in[19]; const float* w_ffn_in = in[20]; p.conv_w = in[21]; p.conv_b = in[22]; const float* w_ffn_out = in[23];
  const float* w_ple = in[24]; const float* w_ple_gate = in[25];
  float* o = (float*)d_out;
  p.y = o; o += (size_t)ROWS * D;
  p.k_prompt = o; o += (size_t)ROWS_P * D;
  p.v_prompt = o; o += (size_t)ROWS_P * D;
  p.k_sample = o; o += (size_t)256 * D;
  p.v_sample = o; o += (size_t)256 * D;
  p.hgrn_prompt = o; o += (size_t)2 * 16 * 8 * 16384;
  p.hgrn_sample = o; o += (size_t)2 * 8 * 8 * 16384;
  p.conv_prompt = o; o += (size_t)4 * 16 * 2 * DFF;
  p.conv_sample = o;
  u16* ws = (u16*)d_ws;
  p.wt_in_a = ws; ws += (size_t)2 * 4096 * 1024;
  p.wt_out_a = ws; ws += (size_t)2 * 1024 * 1024;
  p.wt_kv = ws; ws += (size_t)2048 * 1024;
  p.wt_q = ws; ws += (size_t)2 * 1024 * 1024;
  p.wt_out_b = ws; ws += (size_t)2 * 1024 * 1024;
  p.wt_ffn_in = ws; ws += (size_t)4 * 5632 * 1024;
  p.wt_ffn_out = ws; ws += (size_t)4 * 1024 * DFF;
  p.wt_ple = ws; ws += (size_t)4 * 1024 * 256;
  p.wt_gate = ws; ws += (size_t)4 * 1024 * 1024;
  p.XB = ws; ws += (size_t)ROWS * 1024;
  p.OG = ws; ws += (size_t)ROWS * 1024;
  p.BIG = (char*)ws;
  p.bar = (unsigned*)((char*)d_ws + ((size_t)500 << 20));
  int n = 0;
  for (int i = 0; i < 2; ++i) p.wd[n++] = WD{w_in_a + (size_t)i * 1024 * 4096, p.wt_in_a + (size_t)i * 4096 * 1024, 1024, 4096, 0, 0};
  for (int i = 0; i < 2; ++i) p.wd[n++] = WD{w_out_a + (size_t)i * 1024 * 1024, p.wt_out_a + (size_t)i * 1024 * 1024, 1024, 1024, 0, 0};
  p.wd[n++] = WD{w_kv, p.wt_kv, 1024, 2048, 0, 0};
  for (int i = 0; i < 2; ++i) p.wd[n++] = WD{w_q_b + (size_t)i * 1024 * 1024, p.wt_q + (size_t)i * 1024 * 1024, 1024, 1024, 0, 0};
  for (int i = 0; i < 2; ++i) p.wd[n++] = WD{w_out_b + (size_t)i * 1024 * 1024, p.wt_out_b + (size_t)i * 1024 * 1024, 1024, 1024, 0, 0};
  for (int i = 0; i < 4; ++i) p.wd[n++] = WD{w_ffn_in + (size_t)i * 1024 * 5632, p.wt_ffn_in + (size_t)i * 5632 * 1024, 1024, 5632, 1, 0};
  for (int i = 0; i < 4; ++i) p.wd[n++] = WD{w_ffn_out + (size_t)i * DFF * 1024, p.wt_ffn_out + (size_t)i * 1024 * DFF, DFF, 1024, 0, 0};
  for (int i = 0; i < 4; ++i) p.wd[n++] = WD{w_ple + (size_t)i * 256 * 1024, p.wt_ple + (size_t)i * 1024 * 256, 256, 1024, 0, 0};
  for (int i = 0; i < 4; ++i) p.wd[n++] = WD{w_ple_gate + (size_t)i * 1024 * 1024, p.wt_gate + (size_t)i * 1024 * 1024, 1024, 1024, 0, 0};
  void* args[] = {&p};
  hipError_t e = hipLaunchCooperativeKernel((void*)yoco_megakernel, dim3(grid_blocks), dim3(256), args, 0, stream);
  if (e != hipSuccess) fprintf(stderr, "cooperative launch failed: %s (grid %d)\n", hipGetErrorString(e), grid_blocks);
}
```

```cpp
#include <hip/hip_runtime.h>
#include <hip/hip_cooperative_groups.h>
#include <cstdio>
namespace cg = cooperative_groups;

#define DI __device__ __forceinline__
typedef unsigned short u16;
typedef short bf16x8 __attribute__((ext_vector_type(8)));
typedef float f32x16 __attribute__((ext_vector_type(16)));
typedef float f32x4 __attribute__((ext_vector_type(4)));
typedef __bf16 bf2_t __attribute__((ext_vector_type(2)));
typedef float f2_t __attribute__((ext_vector_type(2)));
typedef unsigned u32x2 __attribute__((ext_vector_type(2)));
typedef unsigned u32x4 __attribute__((ext_vector_type(4)));

constexpr int D = 1024, ROWS_P = 32768, ROWS = 33024, DFF = 2816;
constexpr float EPS = 1e-6f;
constexpr float LOG2E = 1.4426950408889634f;
constexpr int NW = 25;
#ifndef REP_GEMM
#define REP_GEMM 1
#endif
#ifndef REP_GLA
#define REP_GLA 1
#endif
#ifndef REP_ATTN
#define REP_ATTN 1
#endif
#define REPG for (int _r = 0; _r < REP_GEMM; ++_r)

struct WD { const float* src; u16* dst; const float* gain; int K, N, mode, pad; };

struct P {
  const float *x_prompt, *x_sample, *cache_k, *cache_v, *state_hgrn, *state_conv, *p_prompt, *p_sample;
  const float *g_norms, *lb_raw, *g_hg, *g_kv, *rel_bias, *lam_b, *g_subln, *conv_w, *conv_b;
  float *y, *k_prompt, *v_prompt, *k_sample, *v_sample, *hgrn_prompt, *hgrn_sample, *conv_prompt, *conv_sample;
  u16 *wt_in_a, *wt_out_a, *wt_kv, *wt_q, *wt_out_b, *wt_ffn_in, *wt_ffn_out, *wt_ple, *wt_gate;
  u16 *XB, *OG; char* BIG; unsigned* bar; float* ss;
  WD wd[NW];
};

DI unsigned pk2(float a, float b) { f2_t v = {a, b}; bf2_t r = __builtin_convertvector(v, bf2_t); return __builtin_bit_cast(unsigned, r); }
DI int ltid() { int t = threadIdx.x; asm volatile("" : "+v"(t)); return t; }
DI float bf2f(u16 x) { return __uint_as_float(((unsigned)x) << 16); }
DI float bflo(unsigned x) { return __uint_as_float(x << 16); }
DI float bfhi(unsigned x) { return __uint_as_float(x & 0xffff0000u); }
DI float sigm(float x) { return 1.f / (1.f + __expf(-x)); }
DI float wave_sum(float v) {
#pragma unroll
  for (int o = 32; o; o >>= 1) v += __shfl_xor(v, o);
  return v;
}
DI bf16x8 mk8(u32x2 lo, u32x2 hi) { u32x4 t = {lo[0], lo[1], hi[0], hi[1]}; return __builtin_bit_cast(bf16x8, t); }
DI bf16x8 mk8u(unsigned a, unsigned b, unsigned c, unsigned d) { u32x4 t = {a, b, c, d}; return __builtin_bit_cast(bf16x8, t); }

DI void prep_phase(const P& p, char* smem) {
  float* T = (float*)smem;
  const int tid = ltid();
  int total = 0;
  for (int i = 0; i < NW; ++i) total += (p.wd[i].K >> 6) * (p.wd[i].N >> 6);
  for (int flat = blockIdx.x; flat < total; flat += gridDim.x) {
    int wi = 0, base = 0;
    for (;;) { int nt = (p.wd[wi].K >> 6) * (p.wd[wi].N >> 6); if (flat < base + nt) break; base += nt; ++wi; }
    const WD& d = p.wd[wi];
    const int tix = flat - base, ntn = d.N >> 6;
    const int k0 = (tix / ntn) << 6, n0 = (tix % ntn) << 6;
    {
      const int n = tid & 63, kb = tid >> 6;
#pragma unroll
      for (int j = 0; j < 16; ++j) { int k = kb + 4 * j; float v = d.src[(size_t)(k0 + k) * d.N + n0 + n]; if (d.gain) v *= d.gain[k0 + k]; T[k * 65 + n] = v; }
    }
    __syncthreads();
    {
      const int nn = tid >> 2, ks = tid & 3;
      int n = n0 + nn, drow = n;
      if (d.mode == 1) { int isu = n >= DFF; int ch = n - DFF * isu; drow = 128 * (ch >> 6) + 64 * ((ch >> 5) & 1) + 32 * isu + (ch & 31); }
      unsigned o[8];
#pragma unroll
      for (int j = 0; j < 8; ++j) o[j] = pk2(T[(16 * ks + 2 * j) * 65 + nn], T[(16 * ks + 2 * j + 1) * 65 + nn]);
      u32x4* dp = (u32x4*)(d.dst + (size_t)drow * d.K + k0 + 16 * ks);
      dp[0] = (u32x4){o[0], o[1], o[2], o[3]};
      dp[1] = (u32x4){o[4], o[5], o[6], o[7]};
    }
    __syncthreads();
  }
}

DI void rowop_phase(const P& p, bool x_from_in, const u16* __restrict__ Madd, const float* __restrict__ gpost,
                    const float* __restrict__ gnext, u16* __restrict__ outH, const float* ple_p, const float* ple_s, u16* outP) {
  const int tidr = ltid();
  const int lane = tidr & 63;
  const int wave = (blockIdx.x * blockDim.x + tidr) >> 6;
  const int nwave = (gridDim.x * blockDim.x) >> 6;
  for (int rb = wave * 2; rb < ROWS; rb += nwave * 2) {
    f32x4 x[2][4];
    u32x2 m[2][4];
#pragma unroll
    for (int u = 0; u < 2; ++u) {
      const int r = rb + u;
      const float* xs = x_from_in ? (r < ROWS_P ? p.x_prompt + (size_t)r * D : p.x_sample + (size_t)(r - ROWS_P) * D) : p.y + (size_t)r * D;
#pragma unroll
      for (int j = 0; j < 4; ++j) x[u][j] = *(const f32x4*)(xs + 4 * lane + 256 * j);
      if (Madd) {
#pragma unroll
        for (int j = 0; j < 4; ++j) m[u][j] = *(const u32x2*)(Madd + (size_t)r * D + 4 * lane + 256 * j);
      }
    }
#pragma unroll
    for (int u = 0; u < 2; ++u) {
      const int r = rb + u;
      if (Madd) {
        f32x4 mf[4]; float ss = 0.f;
#pragma unroll
        for (int j = 0; j < 4; ++j) { mf[j] = (f32x4){bflo(m[u][j][0]), bfhi(m[u][j][0]), bflo(m[u][j][1]), bfhi(m[u][j][1])}; ss += mf[j][0] * mf[j][0] + mf[j][1] * mf[j][1] + mf[j][2] * mf[j][2] + mf[j][3] * mf[j][3]; }
        ss = wave_sum(ss);
        const float rs = rsqrtf(ss * (1.f / D) + EPS);
#pragma unroll
        for (int j = 0; j < 4; ++j) { f32x4 g = *(const f32x4*)(gpost + 4 * lane + 256 * j); x[u][j] += mf[j] * rs * g; }
#pragma unroll
        for (int j = 0; j < 4; ++j) *(f32x4*)(p.y + (size_t)r * D + 4 * lane + 256 * j) = x[u][j];
      }
      float rx = 1.f;
      if (gnext) {
        float ss = 0.f;
#pragma unroll
        for (int j = 0; j < 4; ++j) ss += x[u][j][0] * x[u][j][0] + x[u][j][1] * x[u][j][1] + x[u][j][2] * x[u][j][2] + x[u][j][3] * x[u][j][3];
        ss = wave_sum(ss);
        rx = rsqrtf(ss * (1.f / D) + EPS);
      }
#pragma unroll
      for (int j = 0; j < 4; ++j) {
        f32x4 h = x[u][j] * rx;
        if (gnext) h *= *(const f32x4*)(gnext + 4 * lane + 256 * j);
        *(u32x2*)(outH + (size_t)r * D + 4 * lane + 256 * j) = (u32x2){pk2(h[0], h[1]), pk2(h[2], h[3])};
      }
      if (outP) {
        const float* ps = r < ROWS_P ? ple_p + (size_t)r * 256 : ple_s + (size_t)(r - ROWS_P) * 256;
        f32x4 v = *(const f32x4*)(ps + 4 * lane);
        *(u32x2*)(outP + (size_t)r * 256 + 4 * lane) = (u32x2){pk2(v[0], v[1]), pk2(v[2], v[3])};
      }
    }
  }
}

template <class RowMap>
DI void gemm_core(const u16* __restrict__ A, int lda, RowMap rm, const u16* __restrict__ Bt, int ldb, int n0, int K,
                  f32x16 (&acc)[2][2], char* smem, const int tid) {
  const int l = tid & 63, w = tid >> 6, wm = w >> 1, wn = w & 1, l32 = l & 31, hh = l >> 5;
  const int lr = tid >> 3, lc = tid & 7;
  const u16* ap[4]; const u16* bp[4];
#pragma unroll
  for (int q = 0; q < 4; ++q) {
    ap[q] = A + (size_t)rm(q * 32 + lr) * lda + lc * 8;
    bp[q] = Bt + (size_t)(n0 + q * 32 + lr) * ldb + lc * 8;
  }
  const unsigned woff = lr * 128 + ((lc ^ ((lr >> 1) & 7)) << 4);
  const int swz = (l32 >> 1) & 7;
  const unsigned aoff = (wm * 64 + l32) * 128, boff = 16384 + (wn * 64 + l32) * 128;
  u32x4 ra0[4], rb0[4], ra1[4], rb1[4];
  const int nk = K >> 6;
#define GLOAD(RA, RB, T) _Pragma("unroll") for (int q = 0; q < 4; ++q) { RA[q] = *(const u32x4*)(ap[q] + (T) * 64); RB[q] = *(const u32x4*)(bp[q] + (T) * 64); }
#define SWRITE(RA, RB, BUF) { char* db_ = smem + (BUF) * 32768; _Pragma("unroll") for (int q = 0; q < 4; ++q) { *(u32x4*)(db_ + woff + q * 4096) = RA[q]; *(u32x4*)(db_ + 16384 + woff + q * 4096) = RB[q]; } }
#define COMPUTE(BUF) { const char* sb = smem + (BUF) * 32768; _Pragma("unroll") for (int ks = 0; ks < 4; ++ks) { \
      const unsigned co = ((2 * ks + hh) ^ swz) << 4; \
      bf16x8 a0 = *(const bf16x8*)(sb + aoff + co); \
      bf16x8 a1 = *(const bf16x8*)(sb + aoff + 32 * 128 + co); \
      bf16x8 b0 = *(const bf16x8*)(sb + boff + co); \
      bf16x8 b1 = *(const bf16x8*)(sb + boff + 32 * 128 + co); \
      acc[0][0] = __builtin_amdgcn_mfma_f32_32x32x16_bf16(b0, a0, acc[0][0], 0, 0, 0); \
      acc[0][1] = __builtin_amdgcn_mfma_f32_32x32x16_bf16(b1, a0, acc[0][1], 0, 0, 0); \
      acc[1][0] = __builtin_amdgcn_mfma_f32_32x32x16_bf16(b0, a1, acc[1][0], 0, 0, 0); \
      acc[1][1] = __builtin_amdgcn_mfma_f32_32x32x16_bf16(b1, a1, acc[1][1], 0, 0, 0); } }
  GLOAD(ra0, rb0, 0);
  GLOAD(ra1, rb1, 1);
  SWRITE(ra0, rb0, 0);
  __syncthreads();
  for (int kt = 0; kt < nk; kt += 2) {
    if (kt + 2 < nk) GLOAD(ra0, rb0, kt + 2);
    __builtin_amdgcn_sched_barrier(0);
    COMPUTE(0);
    SWRITE(ra1, rb1, 1);
    __syncthreads();
    if (kt + 3 < nk) GLOAD(ra1, rb1, kt + 3);
    __builtin_amdgcn_sched_barrier(0);
    COMPUTE(1);
    if (kt + 2 < nk) SWRITE(ra0, rb0, 0);
    __syncthreads();
  }
#undef GLOAD
#undef SWRITE
#undef COMPUTE
}

DI bool next_tile(int it, int ntm, int ntn, int& tm, int& tn) {
  const int b = blockIdx.x, x = b & 7, slot = b >> 3, S = gridDim.x >> 3;
  const int nq = (ntm - x + 7) >> 3;
  const int L = slot + it * S;
  if (L >= nq * ntn) return false;
  const int gsize = 8 * ntn;
  const int grp = L / gsize, r = L - grp * gsize;
  const int gsz = min(8, nq - 8 * grp);
  tn = r / gsz;
  tm = x + 8 * (8 * grp + r % gsz);
  return true;
}

struct IdMap { int base; DI int operator()(int r) const { return base + r; } };
struct ClampMap { int rowbase, t0, T; DI int operator()(int r) const { int t = t0 + r; t = t < 0 ? 0 : (t > T - 1 ? T - 1 : t); return rowbase + t; } };

#define ZERO_ACC(a) _Pragma("unroll") for (int _i = 0; _i < 2; ++_i) _Pragma("unroll") for (int _j = 0; _j < 2; ++_j) _Pragma("unroll") for (int _e = 0; _e < 16; ++_e) a[_i][_j][_e] = 0.f;

template <int EPI>
DI void gemm_phase(const P& p, const u16* A, int K, const u16* Bt, int N, void* outp, char* smem, const float* rowss = nullptr) {
  const int tid = ltid(), l = tid & 63, w = tid >> 6, wm = w >> 1, wn = w & 1, l32 = l & 31, hh = l >> 5;
  const int ntm = ROWS / 128, ntn = N / 128;
  int tm, tn;
  for (int it = 0; next_tile(it, ntm, ntn, tm, tn); ++it) {
    f32x16 acc[2][2];
    ZERO_ACC(acc);
    gemm_core(A, K, IdMap{tm * 128}, Bt, K, tn * 128, K, acc, smem, tid);
    const int n0 = tn * 128;
#pragma unroll
    for (int mi = 0; mi < 2; ++mi) {
      const int m = tm * 128 + wm * 64 + mi * 32 + l32;
      float rsc = 1.f;
      if (rowss) { const f32x4* sp = (const f32x4*)(rowss + (size_t)m * 16); const f32x4 s0 = sp[0], s1 = sp[1], s2 = sp[2], s3 = sp[3];
        const float tot = ((s0[0] + s0[1]) + (s0[2] + s0[3])) + ((s1[0] + s1[1]) + (s1[2] + s1[3])) + ((s2[0] + s2[1]) + (s2[2] + s2[3])) + ((s3[0] + s3[1]) + (s3[2] + s3[3]));
        rsc = rsqrtf(tot * (1.f / D) + EPS); }
#pragma unroll
      for (int ni = 0; ni < 2; ++ni)
#pragma unroll
        for (int q = 0; q < 4; ++q) {
          const int n = n0 + wn * 64 + ni * 32 + 8 * q + 4 * hh;
          float v0 = acc[mi][ni][4 * q] * rsc, v1 = acc[mi][ni][4 * q + 1] * rsc, v2 = acc[mi][ni][4 * q + 2] * rsc, v3 = acc[mi][ni][4 * q + 3] * rsc;
          if (EPI == 0) {
            const int sec = n0 >> 10;
            if (sec == 0 || sec == 3) { v0 *= sigm(v0); v1 *= sigm(v1); v2 *= sigm(v2); v3 *= sigm(v3); }
            *(u32x2*)((u16*)outp + (size_t)m * 4096 + n) = (u32x2){pk2(v0, v1), pk2(v2, v3)};
          } else if (EPI == 1) {
            const float sc = 0.125f * LOG2E;
            *(u32x2*)((u16*)outp + (size_t)m * 1024 + n) = (u32x2){pk2(v0 * sc, v1 * sc), pk2(v2 * sc, v3 * sc)};
          } else if (EPI == 2) {
            *(u32x2*)((u16*)outp + (size_t)m * 1024 + n) = (u32x2){pk2(v0, v1), pk2(v2, v3)};
          } else {
            float* dst;
            if (n < 1024) dst = (m < ROWS_P ? p.k_prompt + (size_t)m * 1024 : p.k_sample + (size_t)(m - ROWS_P) * 1024) + n;
            else dst = (m < ROWS_P ? p.v_prompt + (size_t)m * 1024 : p.v_sample + (size_t)(m - ROWS_P) * 1024) + (n - 1024);
            *(f32x4*)dst = (f32x4){v0, v1, v2, v3};
          }
        }
    }
  }
}

DI void ple_phase(const P& p, int layer, char* smem) {
  const int tid = ltid(), l = tid & 63, w = tid >> 6, wm = w >> 1, wn = w & 1, l32 = l & 31, hh = l >> 5;
  const u16* XB2 = (const u16*)p.BIG;
  const u16* PB = (const u16*)(p.BIG + (size_t)ROWS * 1024 * 2);
  const u16* Wg = p.wt_gate + (size_t)layer * 1024 * 1024;
  const u16* Wp = p.wt_ple + (size_t)layer * 1024 * 256;
  int tm, tn;
  for (int it = 0; next_tile(it, ROWS / 128, 8, tm, tn); ++it) {
    u16* PL = (u16*)(p.BIG + (size_t)ROWS * 1024 * 2 + (size_t)ROWS * 256 * 2);
    {
      f32x16 acc2[2][2];
      ZERO_ACC(acc2);
      gemm_core(PB, 256, IdMap{tm * 128}, Wp, 256, tn * 128, 256, acc2, smem, tid);
#pragma unroll
      for (int mi = 0; mi < 2; ++mi)
#pragma unroll
        for (int ni = 0; ni < 2; ++ni)
#pragma unroll
          for (int q = 0; q < 4; ++q)
            *(u32x2*)(PL + (size_t)(tm * 128 + wm * 64 + mi * 32 + l32) * D + tn * 128 + wn * 64 + ni * 32 + 8 * q + 4 * hh) =
                (u32x2){pk2(acc2[mi][ni][4 * q], acc2[mi][ni][4 * q + 1]), pk2(acc2[mi][ni][4 * q + 2], acc2[mi][ni][4 * q + 3])};
    }
    f32x16 acc[2][2];
    ZERO_ACC(acc);
    gemm_core(XB2, 1024, IdMap{tm * 128}, Wg, 1024, tn * 128, 1024, acc, smem, tid);
#pragma unroll
    for (int mi = 0; mi < 2; ++mi) {
      const int m = tm * 128 + wm * 64 + mi * 32 + l32;
      float ssq = 0.f;
#pragma unroll
      for (int ni = 0; ni < 2; ++ni)
#pragma unroll
        for (int q = 0; q < 4; ++q) {
          const int n = tn * 128 + wn * 64 + ni * 32 + 8 * q + 4 * hh;
          f32x4* xp = (f32x4*)(p.y + (size_t)m * D + n);
          f32x4 x = *xp;
          const u32x2 pv = *(const u32x2*)(PL + (size_t)m * D + n);
          x[0] += sigm(acc[mi][ni][4 * q]) * bflo(pv[0]);
          x[1] += sigm(acc[mi][ni][4 * q + 1]) * bfhi(pv[0]);
          x[2] += sigm(acc[mi][ni][4 * q + 2]) * bflo(pv[1]);
          x[3] += sigm(acc[mi][ni][4 * q + 3]) * bfhi(pv[1]);
          *xp = x;
          *(u32x2*)(p.XB + (size_t)m * D + n) = (u32x2){pk2(x[0], x[1]), pk2(x[2], x[3])};
          ssq += x[0] * x[0] + x[1] * x[1] + x[2] * x[2] + x[3] * x[3];
        }
      ssq += __shfl_xor(ssq, 32);
      if (hh == 0) p.ss[(size_t)m * 16 + tn * 2 + wn] = ssq;
    }
  }
}

DI void ffn_in_phase(const P& p, int layer, char* smem) {
  const int tid = ltid(), l = tid & 63, w = tid >> 6, wm = w >> 1, wn = w & 1, l32 = l & 31, hh = l >> 5;
  const u16* Wt = p.wt_ffn_in + (size_t)layer * 5632 * 1024;
  u16* HID = (u16*)p.BIG;
  float* GS = (float*)smem;
  const float* cw = p.conv_w + (size_t)layer * 3 * DFF;
  const float* cb = p.conv_b + (size_t)layer * DFF;
  int tm, tn;
  for (int it = 0; next_tile(it, 280, 44, tm, tn); ++it) {
    int seq, T, rowbase, t0; bool last;
    if (tm < 272) { seq = tm / 17; int j = tm - seq * 17; T = 2048; rowbase = seq * 2048; t0 = 126 * j - 2; last = (j == 16); }
    else { seq = 16 + (tm - 272); T = 32; rowbase = ROWS_P + (tm - 272) * 32; t0 = -2; last = true; }
    f32x16 acc[2][2];
    ZERO_ACC(acc);
    gemm_core(p.XB, 1024, ClampMap{rowbase, t0, T}, Wt, 1024, tn * 128, 1024, acc, smem, tid);
    const int chw = tn * 64 + wn * 32;
    if (t0 < 0 && wm == 0 && l32 < 2) {
#pragma unroll
      for (int q = 0; q < 4; ++q) {
        f32x4 sv = {0.f, 0.f, 0.f, 0.f};
        if (seq >= 16) sv = *(const f32x4*)(p.state_conv + ((size_t)(layer * 8 + (seq - 16)) * 2 + l32) * DFF + chw + 8 * q + 4 * hh);
#pragma unroll
        for (int c = 0; c < 4; ++c) acc[0][0][4 * q + c] = sv[c];
      }
    }
#pragma unroll
    for (int mi = 0; mi < 2; ++mi)
#pragma unroll
      for (int i = 0; i < 16; ++i) {
        const int chl = wn * 32 + 8 * (i >> 2) + 4 * hh + (i & 3);
        GS[chl * 132 + wm * 64 + mi * 32 + l32] = acc[mi][0][i];
      }
    __syncthreads();
#pragma unroll
    for (int q = 0; q < 4; ++q) {
      const int chq = chw + 8 * q + 4 * hh;
      const f32x4 b4 = *(const f32x4*)(cb + chq);
      const f32x4 w0 = *(const f32x4*)(cw + chq), w1 = *(const f32x4*)(cw + DFF + chq), w2 = *(const f32x4*)(cw + 2 * DFF + chq);
#pragma unroll
      for (int mi = 0; mi < 2; ++mi) {
        const int m = wm * 64 + mi * 32 + l32;
        const int t = t0 + m;
        if (m >= 2 && t < T) {
          float hv[4];
#pragma unroll
          for (int c = 0; c < 4; ++c) {
            const int chl = wn * 32 + 8 * q + 4 * hh + c;
            const float g0 = acc[mi][0][4 * q + c], g1 = GS[chl * 132 + m - 1], g2 = GS[chl * 132 + m - 2];
            const float cv = b4[c] + w0[c] * g2 + w1[c] * g1 + w2[c] * g0;
            hv[c] = cv * sigm(cv) * acc[mi][1][4 * q + c];
          }
          *(u32x2*)(HID + (size_t)(rowbase + t) * DFF + chq) = (u32x2){pk2(hv[0], hv[1]), pk2(hv[2], hv[3])};
          if (last && t >= T - 2) {
            float* co = seq < 16 ? p.conv_prompt + ((size_t)(layer * 16 + seq) * 2 + (t - (T - 2))) * DFF
                                 : p.conv_sample + ((size_t)(layer * 8 + (seq - 16)) * 2 + (t - (T - 2))) * DFF;
            *(f32x4*)(co + chq) = (f32x4){acc[mi][0][4 * q], acc[mi][0][4 * q + 1], acc[mi][0][4 * q + 2], acc[mi][0][4 * q + 3]};
          }
        }
      }
    }
    __syncthreads();
  }
}

DI void gla_phase(const P& p, int layer, char* smem) {
  const u16* PROJ = (const u16*)p.BIG;
  const int tid = ltid(), l = tid & 63, w = tid >> 6, l32 = l & 31, hh = l >> 5, m16 = l & 15;
  float* REDB = (float*)(smem + 2 * 14336);
  const int k = tid >> 1, th = tid & 1;
  for (int item = blockIdx.x; item < 192; item += gridDim.x) {
    const int s = item >> 3, h = item & 7;
    const bool smp = s >= 16;
    const int T = smp ? 32 : 2048;
    const int rowbase = smp ? ROWS_P + (s - 16) * 32 : s * 2048;
    float lower = 0.f;
    if (layer == 1) lower = sigm(p.lb_raw[1024 + h * 128 + k] - p.lb_raw[h * 128 + k]);
    const float oml = 1.f - lower;
    f32x16 S[4];
    if (smp) {
      const float* sp = p.state_hgrn + ((size_t)(layer * 8 + (s - 16)) * 8 + h) * 16384 + 32 * w + l32;
#pragma unroll
      for (int kt = 0; kt < 4; ++kt)
#pragma unroll
        for (int i = 0; i < 16; ++i) S[kt][i] = sp[(size_t)(32 * kt + (i & 3) + 8 * (i >> 2) + 4 * hh) * 128];
    } else {
#pragma unroll
      for (int kt = 0; kt < 4; ++kt)
#pragma unroll
        for (int i = 0; i < 16; ++i) S[kt][i] = 0.f;
    }
    const int nblk = T >> 4;
    u16 fr[8], qr[8], vr[8];
#define GLA_LOADRAW(BLK) { const size_t r0_ = (size_t)rowbase + (BLK) * 16; \
      const u16* pf_ = PROJ + (r0_ + 8 * th) * 4096 + 1024 + h * 128 + k; \
      const u16* pq_ = PROJ + (r0_ + 8 * th) * 4096 + h * 128 + k; \
      _Pragma("unroll") for (int t = 0; t < 8; ++t) fr[t] = pf_[(size_t)t * 4096]; \
      _Pragma("unroll") for (int j = 0; j < 8; ++j) qr[j] = pq_[(size_t)j * 4096]; \
 }
#define GLA_LOADV(BLK) { const u16* pv_ = PROJ + ((size_t)rowbase + (BLK) * 16) * 4096 + 2048 + h * 128 + 32 * w + l32; \
      _Pragma("unroll") for (int jj = 0; jj < 8; ++jj) vr[jj] = pv_[(size_t)(8 * (jj >> 2) + 4 * hh + (jj & 3)) * 4096]; }
#define GLA_LOADGS(BLK) { const u16* pg_ = PROJ + ((size_t)rowbase + (BLK) * 16 + m16) * 4096 + 3072 + h * 128 + 32 * w + 4 * hh; \
      _Pragma("unroll") for (int q = 0; q < 4; ++q) gsl[q] = *(const u32x2*)(pg_ + 8 * q); }
#define GLA_FINAL(BLK) { const float* RED_ = REDB + ((BLK) & 1) * 64; \
      if (l32 < 16) { \
        const float tot = RED_[l32] + RED_[16 + l32] + RED_[32 + l32] + RED_[48 + l32]; \
        const float rn = rsqrtf(tot * (1.f / 128.f) + EPS); \
        u16* op_ = p.OG + ((size_t)rowbase + (BLK) * 16 + l32) * 1024 + h * 128 + 32 * w + 4 * hh; \
        const float* gp_ = p.g_hg + layer * 1024 + h * 128 + 32 * w + 4 * hh; \
        _Pragma("unroll") for (int q = 0; q < 4; ++q) { const f32x4 gh = *(const f32x4*)(gp_ + 8 * q); \
          *(u32x2*)(op_ + 8 * q) = (u32x2){pk2(oacc[4 * q] * rn * gh[0] * bflo(gsl[q][0]), oacc[4 * q + 1] * rn * gh[1] * bfhi(gsl[q][0])), \
                                          pk2(oacc[4 * q + 2] * rn * gh[2] * bflo(gsl[q][1]), oacc[4 * q + 3] * rn * gh[3] * bfhi(gsl[q][1]))}; } \
      } }
    GLA_LOADRAW(0);
    GLA_LOADV(0);
    u32x2 gsl[4];
    for (int blk = 0; blk < nblk; ++blk) {
      GLA_LOADGS(blk);
      char* sb = smem + (blk & 1) * 14336;
      u16* QT = (u16*)sb;
      u16* KT = QT + 16 * 136;
      u16* KDT = KT + 16 * 136;
      float* DD = (float*)(KDT + 128 * 20);
      {
        float qtm[8], ktm[8];
        float bs = 0.f;
#pragma unroll
        for (int t = 0; t < 8; ++t) {
          const float f = bf2f(fr[t]);
          const float g = lower + oml * sigm(f);
          bs += __logf(g);
          const float eb = __expf(bs);
          qtm[t] = bf2f(qr[t]) * eb;
          ktm[t] = (1.f - g) * __builtin_amdgcn_rcpf(eb);
        }
        const float other = __shfl_xor(bs, 1);
        const float boff = th ? other : 0.f;
        const float bsum = bs + other;
        const float E1 = __expf(boff), E1i = __expf(-boff), EL = __expf(bsum);
        unsigned kdp[4];
        float kdprev = 0.f;
#pragma unroll
        for (int j = 0; j < 8; ++j) {
          const int t = 8 * th + j;
          const float qt = qtm[j] * E1;
          const float ktv = ktm[j] * E1i;
          const float kd = ktv * EL;
          QT[t * 136 + k] = (u16)(pk2(qt, 0.f) & 0xffffu);
          KT[t * 136 + k] = (u16)(pk2(ktv, 0.f) & 0xffffu);
          if (j & 1) kdp[j >> 1] = pk2(kdprev, kd); else kdprev = kd;
        }
        *(u32x2*)(KDT + k * 20 + 8 * th) = (u32x2){kdp[0], kdp[1]};
        *(u32x2*)(KDT + k * 20 + 8 * th + 4) = (u32x2){kdp[2], kdp[3]};
        if (th == 0) DD[k] = __expf(bsum);
      }
      if (blk + 1 < nblk) GLA_LOADRAW(blk + 1);
      __syncthreads();
      const bf16x8 vfrag = mk8u((unsigned)vr[0] | ((unsigned)vr[1] << 16), (unsigned)vr[2] | ((unsigned)vr[3] << 16),
                                (unsigned)vr[4] | ((unsigned)vr[5] << 16), (unsigned)vr[6] | ((unsigned)vr[7] << 16));
      if (blk + 1 < nblk) GLA_LOADV(blk + 1);
      f32x16 aacc, oacc;
#pragma unroll
      for (int i = 0; i < 16; ++i) { aacc[i] = 0.f; oacc[i] = 0.f; }
#pragma unroll
      for (int ks = 0; ks < 8; ++ks) {
        const bf16x8 ka = *(const bf16x8*)(KT + m16 * 136 + 16 * ks + 8 * hh);
        const bf16x8 qb = *(const bf16x8*)(QT + m16 * 136 + 16 * ks + 8 * hh);
        aacc = __builtin_amdgcn_mfma_f32_32x32x16_bf16(ka, qb, aacc, 0, 0, 0);
        const int kt = ks >> 1, s2 = ks & 1;
        const bf16x8 sa = mk8u(pk2(S[kt][8 * s2], S[kt][8 * s2 + 1]), pk2(S[kt][8 * s2 + 2], S[kt][8 * s2 + 3]),
                               pk2(S[kt][8 * s2 + 4], S[kt][8 * s2 + 5]), pk2(S[kt][8 * s2 + 6], S[kt][8 * s2 + 7]));
        const u32x2 lo = *(const u32x2*)(QT + m16 * 136 + 32 * kt + 16 * s2 + 4 * hh);
        const u32x2 hi = *(const u32x2*)(QT + m16 * 136 + 32 * kt + 16 * s2 + 8 + 4 * hh);
        oacc = __builtin_amdgcn_mfma_f32_32x32x16_bf16(sa, mk8(lo, hi), oacc, 0, 0, 0);
      }
      float am[8];
#pragma unroll
      for (int i = 0; i < 8; ++i) { const int m = (i & 3) + 8 * (i >> 2) + 4 * hh; am[i] = (m <= m16) ? aacc[i] : 0.f; }
      const bf16x8 afrag = mk8u(pk2(am[0], am[1]), pk2(am[2], am[3]), pk2(am[4], am[5]), pk2(am[6], am[7]));
      oacc = __builtin_amdgcn_mfma_f32_32x32x16_bf16(vfrag, afrag, oacc, 0, 0, 0);
#pragma unroll
      for (int kt = 0; kt < 4; ++kt) {
#pragma unroll
        for (int q = 0; q < 4; ++q) {
          const f32x4 d4 = *(const f32x4*)(DD + 32 * kt + 8 * q + 4 * hh);
#pragma unroll
          for (int c = 0; c < 4; ++c) S[kt][4 * q + c] *= d4[c];
        }
        const u32x2 lo = *(const u32x2*)(KDT + (32 * kt + l32) * 20 + 4 * hh);
        const u32x2 hi = *(const u32x2*)(KDT + (32 * kt + l32) * 20 + 8 + 4 * hh);
        S[kt] = __builtin_amdgcn_mfma_f32_32x32x16_bf16(mk8(lo, hi), vfrag, S[kt], 0, 0, 0);
      }
      float ss = 0.f;
#pragma unroll
      for (int i = 0; i < 16; ++i) ss += oacc[i] * oacc[i];
      ss += __shfl_xor(ss, 32);
      if (l < 16) REDB[(blk & 1) * 64 + w * 16 + l] = ss;
      __syncthreads();
      GLA_FINAL(blk);
    }
#undef GLA_LOADGS
#undef GLA_LOADV
#undef GLA_LOADRAW
#undef GLA_FINAL
    {
      float* op = (smp ? p.hgrn_sample + ((size_t)(layer * 8 + (s - 16)) * 8 + h) * 16384
                       : p.hgrn_prompt + ((size_t)(layer * 16 + s) * 8 + h) * 16384) + 32 * w + l32;
#pragma unroll
      for (int kt = 0; kt < 4; ++kt)
#pragma unroll
        for (int i = 0; i < 16; ++i) op[(size_t)(32 * kt + (i & 3) + 8 * (i >> 2) + 4 * hh) * 128] = S[kt][i];
    }
  }
}

DI void kvconv_phase(const P& p) {
  const int tid = ltid();
  char* KVT = p.BIG + (size_t)ROWS * 1024 * 2;
  for (int t = blockIdx.x; t < 4096 + 1088; t += gridDim.x) {
    const float *kb, *vb; int nvalid = 64;
    if (t < 4096) { const int kt = t & 31, sh = t >> 5, s = sh >> 3, h = sh & 7; const size_t off = ((size_t)(s * 2048 + 64 * kt)) * 1024 + h * 128; kb = p.k_prompt + off; vb = p.v_prompt + off; }
    else { const int u = t - 4096; const int kt = u % 17, sh = u / 17, b = sh >> 3, h = sh & 7;
      if (kt < 16) { const size_t off = ((size_t)(b * 1024 + 64 * kt)) * 1024 + h * 128; kb = p.cache_k + off; vb = p.cache_v + off; }
      else { const size_t off = ((size_t)(b * 32)) * 1024 + h * 128; kb = p.k_sample + off; vb = p.v_sample + off; nvalid = 32; } }
    u16* kd = (u16*)(KVT + (size_t)t * 32768);
    u16* vd = kd + 8192;
#pragma unroll
    for (int pp = 0; pp < 4; ++pp) {
      const int key = 16 * pp + (tid >> 4), d8 = (tid & 15) * 8;
      f32x4 a = {0.f, 0.f, 0.f, 0.f}, b2 = {0.f, 0.f, 0.f, 0.f};
      if (key < nvalid) { a = *(const f32x4*)(kb + (size_t)key * 1024 + d8); b2 = *(const f32x4*)(kb + (size_t)key * 1024 + d8 + 4); }
      *(u32x4*)(kd + key * 128 + d8) = (u32x4){pk2(a[0], a[1]), pk2(a[2], a[3]), pk2(b2[0], b2[1]), pk2(b2[2], b2[3])};
    }
#pragma unroll
    for (int c = 0; c < 4; ++c) {
      const int v = tid & 127, cc = 4 * (tid >> 7) + c;
      float e[8];
#pragma unroll
      for (int j = 0; j < 8; ++j) { const int key = 8 * cc + j; e[j] = key < nvalid ? vb[(size_t)key * 1024 + v] : 0.f; }
      *(u32x4*)(vd + v * 64 + 8 * cc) = (u32x4){pk2(e[0], e[1]), pk2(e[2], e[3]), pk2(e[4], e[5]), pk2(e[6], e[7])};
    }
  }
}

DI void attn_phase(const P& p, int layer, char* smem) {
  const int jl = layer - 2;
  const u16* Q = (const u16*)p.BIG;
  const char* KVT = p.BIG + (size_t)ROWS * 1024 * 2;
  const int tid = ltid(), l = tid & 63, w = tid >> 6, l16 = l & 15, g = l >> 4;
  u16* KS = (u16*)smem;
  u16* VT = KS + 64 * 136;
  float* BT = (float*)(VT + 128 * 72);
  u16* QS = (u16*)(BT + 256);
  const float lam_init = 0.8f - 0.6f * __expf(-0.3f * (float)layer);
  float lam;
  {
    const float* lp = p.lam_b + jl * 256;
    float a = 0.f, b = 0.f;
    for (int d = 0; d < 64; ++d) { a += lp[d] * lp[64 + d]; b += lp[128 + d] * lp[192 + d]; }
    lam = __expf(a) - __expf(b) + lam_init;
  }
  for (int item = blockIdx.x; item < 4096 + 64; item += gridDim.x) {
    int b, h, nq, qrow0, qpos0, ntiles, tile0; bool smp;
    if (item < 4096) { const int jq = 31 - (item >> 7); const int bh = item & 127; b = bh >> 3; h = bh & 7; smp = false; nq = 64; qrow0 = b * 2048 + 64 * jq; qpos0 = 64 * jq; ntiles = jq + 1; tile0 = bh * 32; }
    else { const int si = item - 4096; b = si >> 3; h = si & 7; smp = true; nq = 32; qrow0 = ROWS_P + b * 32; qpos0 = 1024; ntiles = 17; tile0 = 4096 + si * 17; }
    __syncthreads();
    if (tid < 230) {
      const int rel = tid - 166;
      const int n = rel < 0 ? -rel : rel;
      int bk = n < 8 ? n : 8 + (n >= 13) + (n >= 20) + (n >= 30) + (n >= 46) + (n >= 70) + (n >= 108) + (n >= 166);
      if (rel > 0) bk += 16;
      BT[tid] = p.rel_bias[bk * 8 + h] * LOG2E;
    }
#pragma unroll
    for (int pp = 0; pp < 4; ++pp) {
      const int idx = pp * 256 + tid, r = idx >> 4, c16 = idx & 15;
      *(u32x4*)(QS + r * 136 + c16 * 8) = *(const u32x4*)(Q + (size_t)(qrow0 + min(r, nq - 1)) * 1024 + h * 128 + c16 * 8);
    }
    f32x4 oacc[2][8];
#pragma unroll
    for (int c = 0; c < 2; ++c)
#pragma unroll
      for (int vs = 0; vs < 8; ++vs) oacc[c][vs] = (f32x4){0.f, 0.f, 0.f, 0.f};
    float mrun[2] = {-1e30f, -1e30f}, lsum[2] = {0.f, 0.f};
    const int qpos = qpos0 + min(16 * w + l16, nq - 1);
    u32x4 rk[4], rv[4];
    {
      const u32x4* src = (const u32x4*)(KVT + (size_t)tile0 * 32768);
#pragma unroll
      for (int pp = 0; pp < 4; ++pp) { rk[pp] = src[pp * 256 + tid]; rv[pp] = src[1024 + pp * 256 + tid]; }
    }
    for (int kt = 0; kt < ntiles; ++kt) {
      const int nvalid = (smp && kt == 16) ? 32 : 64;
      if (kt > 0) __syncthreads();
#pragma unroll
      for (int pp = 0; pp < 4; ++pp) {
        const int idx = pp * 256 + tid;
        *(u32x4*)(KS + (idx >> 4) * 136 + (idx & 15) * 8) = rk[pp];
        *(u32x4*)(VT + (idx >> 3) * 72 + (idx & 7) * 8) = rv[pp];
      }
      if (kt + 1 < ntiles) {
        const u32x4* src = (const u32x4*)(KVT + (size_t)(tile0 + kt + 1) * 32768);
#pragma unroll
        for (int pp = 0; pp < 4; ++pp) { rk[pp] = src[pp * 256 + tid]; rv[pp] = src[1024 + pp * 256 + tid]; }
      }
      __syncthreads();
      f32x4 sacc[2][4];
#pragma unroll
      for (int c = 0; c < 2; ++c)
#pragma unroll
        for (int sub = 0; sub < 4; ++sub) {
          sacc[c][sub] = (f32x4){0.f, 0.f, 0.f, 0.f};
#pragma unroll
          for (int ks = 0; ks < 2; ++ks) {
            const bf16x8 kf = *(const bf16x8*)(KS + (16 * sub + l16) * 136 + c * 64 + 32 * ks + 8 * g);
            const bf16x8 qfr = *(const bf16x8*)(QS + (16 * w + l16) * 136 + c * 64 + 32 * ks + 8 * g);
            sacc[c][sub] = __builtin_amdgcn_mfma_f32_16x16x32_bf16(kf, qfr, sacc[c][sub], 0, 0, 0);
          }
        }
#pragma unroll
      for (int sub = 0; sub < 4; ++sub)
#pragma unroll
        for (int i = 0; i < 4; ++i) {
          const int kl = 16 * sub + 4 * g + i;
          int rel = 64 * kt + kl - qpos;
          rel = rel < -166 ? -166 : rel;
          const float bt = BT[rel + 166];
          const bool ok = kl < nvalid;
          sacc[0][sub][i] = ok ? sacc[0][sub][i] + bt : -30000.f;
          sacc[1][sub][i] = ok ? sacc[1][sub][i] + bt : -30000.f;
        }
      bf16x8 pf[2][2];
#pragma unroll
      for (int c = 0; c < 2; ++c) {
        float mx = -1e30f;
#pragma unroll
        for (int sub = 0; sub < 4; ++sub)
#pragma unroll
          for (int i = 0; i < 4; ++i) mx = fmaxf(mx, sacc[c][sub][i]);
        mx = fmaxf(mx, __shfl_xor(mx, 16));
        mx = fmaxf(mx, __shfl_xor(mx, 32));
        const float mnew = fmaxf(mrun[c], mx);
        const float alpha = __builtin_amdgcn_exp2f(mrun[c] - mnew);
        mrun[c] = mnew;
        float rs = 0.f;
#pragma unroll
        for (int sub = 0; sub < 4; ++sub)
#pragma unroll
          for (int i = 0; i < 4; ++i) { const float e = __builtin_amdgcn_exp2f(sacc[c][sub][i] - mnew); sacc[c][sub][i] = e; rs += e; }
        lsum[c] = lsum[c] * alpha + rs;
#pragma unroll
        for (int vs = 0; vs < 8; ++vs) oacc[c][vs] *= alpha;
#pragma unroll
        for (int j = 0; j < 2; ++j)
          pf[c][j] = mk8u(pk2(sacc[c][2 * j][0], sacc[c][2 * j][1]), pk2(sacc[c][2 * j][2], sacc[c][2 * j][3]),
                          pk2(sacc[c][2 * j + 1][0], sacc[c][2 * j + 1][1]), pk2(sacc[c][2 * j + 1][2], sacc[c][2 * j + 1][3]));
      }
#pragma unroll
      for (int j = 0; j < 2; ++j)
#pragma unroll
        for (int vs = 0; vs < 8; ++vs) {
          const u32x2 lo = *(const u32x2*)(VT + (16 * vs + l16) * 72 + 32 * j + 4 * g);
          const u32x2 hi = *(const u32x2*)(VT + (16 * vs + l16) * 72 + 32 * j + 16 + 4 * g);
          const bf16x8 vf = mk8(lo, hi);
          oacc[0][vs] = __builtin_amdgcn_mfma_f32_16x16x32_bf16(vf, pf[0][j], oacc[0][vs], 0, 0, 0);
          oacc[1][vs] = __builtin_amdgcn_mfma_f32_16x16x32_bf16(vf, pf[1][j], oacc[1][vs], 0, 0, 0);
        }
    }
#pragma unroll
    for (int c = 0; c < 2; ++c) { lsum[c] += __shfl_xor(lsum[c], 16); lsum[c] += __shfl_xor(lsum[c], 32); }
    const float inv0 = 1.f / lsum[0], inv1 = lam / lsum[1];
    float ss = 0.f;
#pragma unroll
    for (int vs = 0; vs < 8; ++vs)
#pragma unroll
      for (int i = 0; i < 4; ++i) { const float o = oacc[0][vs][i] * inv0 - oacc[1][vs][i] * inv1; oacc[0][vs][i] = o; ss += o * o; }
    ss += __shfl_xor(ss, 16);
    ss += __shfl_xor(ss, 32);
    const float rn = rsqrtf(ss * (1.f / 128.f) + EPS) * (1.f - lam_init);
    if (16 * w + l16 < nq) {
      const size_t row = (size_t)qrow0 + 16 * w + l16;
#pragma unroll
      for (int vs = 0; vs < 8; ++vs) {
        const int v = h * 128 + 16 * vs + 4 * g;
        const f32x4 gl = *(const f32x4*)(p.g_subln + jl * 1024 + v);
        *(u32x2*)(p.OG + row * 1024 + v) = (u32x2){pk2(oacc[0][vs][0] * rn * gl[0], oacc[0][vs][1] * rn * gl[1]),
                                                   pk2(oacc[0][vs][2] * rn * gl[2], oacc[0][vs][3] * rn * gl[3])};
      }
    }
  }
}

DI void gbar(unsigned* bar, unsigned& gen) {
  gen += 1;
  asm volatile("s_waitcnt vmcnt(0) lgkmcnt(0)" ::: "memory");
  __syncthreads();
  if (threadIdx.x < 64) {
    const unsigned g = blockIdx.x >> 4, ng = gridDim.x >> 4;
    bool last = false;
    if (threadIdx.x == 0) {
      __builtin_amdgcn_fence(__ATOMIC_RELEASE, "agent");
      asm volatile("s_waitcnt vmcnt(0)" ::: "memory");
      const unsigned o = __hip_atomic_fetch_add(bar + 64 * g, 1u, __ATOMIC_RELAXED, __HIP_MEMORY_SCOPE_AGENT);
      if (o + 1 == 16 * gen) {
        const unsigned o2 = __hip_atomic_fetch_add(bar + 64 * 64, 1u, __ATOMIC_RELAXED, __HIP_MEMORY_SCOPE_AGENT);
        last = (o2 + 1 == ng * gen);
      }
    }
    last = __shfl(last ? 1 : 0, 0) != 0;
    if (last && threadIdx.x < ng) __hip_atomic_store(bar + 64 * (65 + threadIdx.x), gen, __ATOMIC_RELAXED, __HIP_MEMORY_SCOPE_AGENT);
    if (threadIdx.x == 0) {
      while (__hip_atomic_load(bar + 64 * (65 + g), __ATOMIC_RELAXED, __HIP_MEMORY_SCOPE_AGENT) < gen) __builtin_amdgcn_s_sleep(2);
      __builtin_amdgcn_fence(__ATOMIC_ACQUIRE, "agent");
      asm volatile("s_waitcnt vmcnt(0)" ::: "memory");
    }
  }
  __syncthreads();
}

__global__ void __launch_bounds__(256, 2) yoco_megakernel(P p) {
  __shared__ __attribute__((aligned(16))) char smem[65536];
  cg::grid_group grid = cg::this_grid();
  if (blockIdx.x == 0 && threadIdx.x < 130) __hip_atomic_store(p.bar + 64 * threadIdx.x, 0u, __ATOMIC_RELAXED, __HIP_MEMORY_SCOPE_AGENT);
  prep_phase(p, smem);
  grid.sync();
  unsigned btarget = 0;
  u16* Mbuf = (u16*)p.BIG;
  u16* Fbuf = p.XB;
  u16* XB2 = (u16*)p.BIG;
  u16* PB = (u16*)(p.BIG + (size_t)ROWS * 1024 * 2);
  for (int i = 0; i < 4; ++i) {
    const float* gn = p.g_norms + i * 4 * D;
    if (i == 0) {
      rowop_phase(p, true, nullptr, nullptr, gn, p.XB, nullptr, nullptr, nullptr);
      gbar(p.bar, btarget);
    }
    if (i < 2) {
      REPG gemm_phase<0>(p, p.XB, 1024, p.wt_in_a + (size_t)i * 4096 * 1024, 4096, p.BIG, smem, i ? p.ss : nullptr);
      gbar(p.bar, btarget);
      for (int _r = 0; _r < REP_GLA; ++_r) gla_phase(p, i, smem);
      gbar(p.bar, btarget);
      REPG gemm_phase<2>(p, p.OG, 1024, p.wt_out_a + (size_t)i * 1024 * 1024, 1024, Mbuf, smem);
      gbar(p.bar, btarget);
    } else {
      if (i == 2) gemm_phase<3>(p, p.XB, 1024, p.wt_kv, 2048, nullptr, smem, p.ss);
      REPG gemm_phase<1>(p, p.XB, 1024, p.wt_q + (size_t)(i - 2) * 1024 * 1024, 1024, p.BIG, smem, p.ss);
      if (i == 2) gbar(p.bar, btarget);
      kvconv_phase(p);
      gbar(p.bar, btarget);
      for (int _r = 0; _r < REP_ATTN; ++_r) attn_phase(p, i, smem);
      gbar(p.bar, btarget);
      REPG gemm_phase<2>(p, p.OG, 1024, p.wt_out_b + (size_t)(i - 2) * 1024 * 1024, 1024, Mbuf, smem);
      gbar(p.bar, btarget);
    }
    rowop_phase(p, i == 0, Mbuf, gn + D, gn + 2 * D, p.XB, nullptr, nullptr, nullptr);
    gbar(p.bar, btarget);
    REPG ffn_in_phase(p, i, smem);
    gbar(p.bar, btarget);
    REPG gemm_phase<2>(p, (const u16*)p.BIG, DFF, p.wt_ffn_out + (size_t)i * 1024 * DFF, 1024, Fbuf, smem);
    gbar(p.bar, btarget);
    rowop_phase(p, false, Fbuf, gn + 3 * D, nullptr, XB2, p.p_prompt + (size_t)i * ROWS_P * 256, p.p_sample + (size_t)i * 256 * 256, PB);
    gbar(p.bar, btarget);
    ple_phase(p, i, smem);
    gbar(p.bar, btarget);
  }
}

extern "C" void kernel_launch(void* const* d_in, const int* in_sizes, int n_in, void* d_out, int out_size, void* d_ws,
                              size_t ws_size, hipStream_t stream) {
  static int grid_blocks = 0;
  if (!grid_blocks) {
    int dev = 0, cus = 0, per_cu = 0;
    hipGetDevice(&dev);
    hipDeviceGetAttribute(&cus, hipDeviceAttributeMultiprocessorCount, dev);
    hipOccupancyMaxActiveBlocksPerMultiprocessor(&per_cu, yoco_megakernel, 256, 0);
    if (per_cu > 2) per_cu = 2;
    grid_blocks = cus * per_cu;
    grid_blocks &= ~7;
  }
  P p{};
  const float* const* in = (const float* const*)d_in;
  p.x_prompt = in[0]; p.x_sample = in[1]; p.cache_k = in[2]; p.cache_v = in[3]; p.state_hgrn = in[4]; p.state_conv = in[5];
  p.p_prompt = in[6]; p.p_sample = in[7];
  p.g_norms = in[8]; const float* w_in_a = in[9]; p.lb_raw = in[10]; p.g_hg = in[11]; const float* w_out_a = in[12]; p.g_kv = in[13];
  const float* w_kv = in[14]; p.rel_bias = in[15]; const float* w_q_b = in[16]; p.lam_b = in[17]; p.g_subln = in[18];
  const float* w_out_b = in[19]; const float* w_ffn_in = in[20]; p.conv_w = in[21]; p.conv_b = in[22]; const float* w_ffn_out = in[23];
  const float* w_ple = in[24]; const float* w_ple_gate = in[25];
  float* o = (float*)d_out;
  p.y = o; o += (size_t)ROWS * D;
  p.k_prompt = o; o += (size_t)ROWS_P * D;
  p.v_prompt = o; o += (size_t)ROWS_P * D;
  p.k_sample = o; o += (size_t)256 * D;
  p.v_sample = o; o += (size_t)256 * D;
  p.hgrn_prompt = o; o += (size_t)2 * 16 * 8 * 16384;
  p.hgrn_sample = o; o += (size_t)2 * 8 * 8 * 16384;
  p.conv_prompt = o; o += (size_t)4 * 16 * 2 * DFF;
  p.conv_sample = o;
  u16* ws = (u16*)d_ws;
  p.wt_in_a = ws; ws += (size_t)2 * 4096 * 1024;
  p.wt_out_a = ws; ws += (size_t)2 * 1024 * 1024;
  p.wt_kv = ws; ws += (size_t)2048 * 1024;
  p.wt_q = ws; ws += (size_t)2 * 1024 * 1024;
  p.wt_out_b = ws; ws += (size_t)2 * 1024 * 1024;
  p.wt_ffn_in = ws; ws += (size_t)4 * 5632 * 1024;
  p.wt_ffn_out = ws; ws += (size_t)4 * 1024 * DFF;
  p.wt_ple = ws; ws += (size_t)4 * 1024 * 256;
  p.wt_gate = ws; ws += (size_t)4 * 1024 * 1024;
  p.XB = ws; ws += (size_t)ROWS * 1024;
  p.OG = ws; ws += (size_t)ROWS * 1024;
  p.BIG = (char*)ws;
  p.bar = (unsigned*)((char*)d_ws + ((size_t)500 << 20));
  p.ss = (float*)((char*)d_ws + ((size_t)501 << 20));
  int n = 0;
  for (int i = 0; i < 2; ++i) p.wd[n++] = WD{w_in_a + (size_t)i * 1024 * 4096, p.wt_in_a + (size_t)i * 4096 * 1024, i ? p.g_norms + 4 * D : nullptr, 1024, 4096, 0, 0};
  for (int i = 0; i < 2; ++i) p.wd[n++] = WD{w_out_a + (size_t)i * 1024 * 1024, p.wt_out_a + (size_t)i * 1024 * 1024, nullptr, 1024, 1024, 0, 0};
  p.wd[n++] = WD{w_kv, p.wt_kv, p.g_kv, 1024, 2048, 0, 0};
  for (int i = 0; i < 2; ++i) p.wd[n++] = WD{w_q_b + (size_t)i * 1024 * 1024, p.wt_q + (size_t)i * 1024 * 1024, p.g_norms + (size_t)(i + 2) * 4 * D, 1024, 1024, 0, 0};
  for (int i = 0; i < 2; ++i) p.wd[n++] = WD{w_out_b + (size_t)i * 1024 * 1024, p.wt_out_b + (size_t)i * 1024 * 1024, nullptr, 1024, 1024, 0, 0};
  for (int i = 0; i < 4; ++i) p.wd[n++] = WD{w_ffn_in + (size_t)i * 1024 * 5632, p.wt_ffn_in + (size_t)i * 5632 * 1024, nullptr, 1024, 5632, 1, 0};
  for (int i = 0; i < 4; ++i) p.wd[n++] = WD{w_ffn_out + (size_t)i * DFF * 1024, p.wt_ffn_out + (size_t)i * 1024 * DFF, nullptr, DFF, 1024, 0, 0};
  for (int i = 0; i < 4; ++i) p.wd[n++] = WD{w_ple + (size_t)i * 256 * 1024, p.wt_ple + (size_t)i * 1024 * 256, nullptr, 256, 1024, 0, 0};
  for (int i = 0; i < 4; ++i) p.wd[n++] = WD{w_ple_gate + (size_t)i * 1024 * 1024, p.wt_gate + (size_t)i * 1024 * 1024, nullptr, 1024, 1024, 0, 0};
  void* args[] = {&p};
  hipError_t e = hipLaunchCooperativeKernel((void*)yoco_megakernel, dim3(grid_blocks), dim3(256), args, 0, stream);
  if (e != hipSuccess) fprintf(stderr, "cooperative launch failed: %s (grid %d)\n", hipGetErrorString(e), grid_blocks);
}
```

```cpp
#include <hip/hip_runtime.h>
#include <hip/hip_cooperative_groups.h>
#include <cstdio>
namespace cg = cooperative_groups;

#define DI __device__ __forceinline__
typedef unsigned short u16;
typedef short bf16x8 __attribute__((ext_vector_type(8)));
typedef float f32x16 __attribute__((ext_vector_type(16)));
typedef float f32x4 __attribute__((ext_vector_type(4)));
typedef __bf16 bf2_t __attribute__((ext_vector_type(2)));
typedef float f2_t __attribute__((ext_vector_type(2)));
typedef unsigned u32x2 __attribute__((ext_vector_type(2)));
typedef unsigned u32x4 __attribute__((ext_vector_type(4)));

constexpr int D = 1024, ROWS_P = 32768, ROWS = 33024, DFF = 2816;
constexpr float EPS = 1e-6f;
constexpr float LOG2E = 1.4426950408889634f;
constexpr int NW = 25;
#ifndef REP_GEMM
#define REP_GEMM 1
#endif
#ifndef REP_GLA
#define REP_GLA 1
#endif
#ifndef REP_ATTN
#define REP_ATTN 1
#endif
#define REPG for (int _r = 0; _r < REP_GEMM; ++_r)

struct WD { const float* src; u16* dst; const float* gain; int K, N, mode, pad; };

struct P {
  const float *x_prompt, *x_sample, *cache_k, *cache_v, *state_hgrn, *state_conv, *p_prompt, *p_sample;
  const float *g_norms, *lb_raw, *g_hg, *g_kv, *rel_bias, *lam_b, *g_subln, *conv_w, *conv_b;
  float *y, *k_prompt, *v_prompt, *k_sample, *v_sample, *hgrn_prompt, *hgrn_sample, *conv_prompt, *conv_sample;
  u16 *wt_in_a, *wt_out_a, *wt_kv, *wt_q, *wt_out_b, *wt_ffn_in, *wt_ffn_out, *wt_ple, *wt_gate;
  u16 *XB, *OG; char* BIG; unsigned* bar; float* ss;
  WD wd[NW];
};

DI unsigned pk2(float a, float b) { f2_t v = {a, b}; bf2_t r = __builtin_convertvector(v, bf2_t); return __builtin_bit_cast(unsigned, r); }
DI int ltid() { int t = threadIdx.x; asm volatile("" : "+v"(t)); return t; }
DI float bf2f(u16 x) { return __uint_as_float(((unsigned)x) << 16); }
DI float bflo(unsigned x) { return __uint_as_float(x << 16); }
DI float bfhi(unsigned x) { return __uint_as_float(x & 0xffff0000u); }
DI float sigm(float x) { return 1.f / (1.f + __expf(-x)); }
DI float wave_sum(float v) {
#pragma unroll
  for (int o = 32; o; o >>= 1) v += __shfl_xor(v, o);
  return v;
}
DI bf16x8 mk8(u32x2 lo, u32x2 hi) { u32x4 t = {lo[0], lo[1], hi[0], hi[1]}; return __builtin_bit_cast(bf16x8, t); }
DI bf16x8 mk8u(unsigned a, unsigned b, unsigned c, unsigned d) { u32x4 t = {a, b, c, d}; return __builtin_bit_cast(bf16x8, t); }

DI void prep_phase(const P& p, char* smem) {
  float* T = (float*)smem;
  const int tid = ltid();
  int total = 0;
  for (int i = 0; i < NW; ++i) total += (p.wd[i].K >> 6) * (p.wd[i].N >> 6);
  for (int flat = blockIdx.x; flat < total; flat += gridDim.x) {
    int wi = 0, base = 0;
    for (;;) { int nt = (p.wd[wi].K >> 6) * (p.wd[wi].N >> 6); if (flat < base + nt) break; base += nt; ++wi; }
    const WD& d = p.wd[wi];
    const int tix = flat - base, ntn = d.N >> 6;
    const int k0 = (tix / ntn) << 6, n0 = (tix % ntn) << 6;
    {
      const int n = tid & 63, kb = tid >> 6;
#pragma unroll
      for (int j = 0; j < 16; ++j) { int k = kb + 4 * j; float v = d.src[(size_t)(k0 + k) * d.N + n0 + n]; if (d.gain) v *= d.gain[k0 + k]; T[k * 65 + n] = v; }
    }
    __syncthreads();
    {
      const int nn = tid >> 2, ks = tid & 3;
      int n = n0 + nn, drow = n;
      if (d.mode == 1) { int isu = n >= DFF; int ch = n - DFF * isu; drow = 128 * (ch >> 6) + 64 * ((ch >> 5) & 1) + 32 * isu + (ch & 31); }
      unsigned o[8];
#pragma unroll
      for (int j = 0; j < 8; ++j) o[j] = pk2(T[(16 * ks + 2 * j) * 65 + nn], T[(16 * ks + 2 * j + 1) * 65 + nn]);
      u16* fb = d.dst + (((size_t)(drow >> 5) * (d.K >> 4) + ((k0 >> 4) + ks)) * 64 + (drow & 31)) * 8;
      *(u32x4*)(fb) = (u32x4){o[0], o[1], o[2], o[3]};
      *(u32x4*)(fb + 256) = (u32x4){o[4], o[5], o[6], o[7]};
    }
    __syncthreads();
  }
}

DI void rowop_phase(const P& p, bool x_from_in, const u16* __restrict__ Madd, const float* __restrict__ gpost,
                    const float* __restrict__ gnext, u16* __restrict__ outH, const float* ple_p, const float* ple_s, u16* outP) {
  const int tidr = ltid();
  const int lane = tidr & 63;
  const int wave = (blockIdx.x * blockDim.x + tidr) >> 6;
  const int nwave = (gridDim.x * blockDim.x) >> 6;
  for (int rb = wave * 2; rb < ROWS; rb += nwave * 2) {
    f32x4 x[2][4];
    u32x2 m[2][4];
#pragma unroll
    for (int u = 0; u < 2; ++u) {
      const int r = rb + u;
      const float* xs = x_from_in ? (r < ROWS_P ? p.x_prompt + (size_t)r * D : p.x_sample + (size_t)(r - ROWS_P) * D) : p.y + (size_t)r * D;
#pragma unroll
      for (int j = 0; j < 4; ++j) x[u][j] = *(const f32x4*)(xs + 4 * lane + 256 * j);
      if (Madd) {
#pragma unroll
        for (int j = 0; j < 4; ++j) m[u][j] = *(const u32x2*)(Madd + (size_t)r * D + 4 * lane + 256 * j);
      }
    }
#pragma unroll
    for (int u = 0; u < 2; ++u) {
      const int r = rb + u;
      if (Madd) {
        f32x4 mf[4]; float ss = 0.f;
#pragma unroll
        for (int j = 0; j < 4; ++j) { mf[j] = (f32x4){bflo(m[u][j][0]), bfhi(m[u][j][0]), bflo(m[u][j][1]), bfhi(m[u][j][1])}; ss += mf[j][0] * mf[j][0] + mf[j][1] * mf[j][1] + mf[j][2] * mf[j][2] + mf[j][3] * mf[j][3]; }
        ss = wave_sum(ss);
        const float rs = rsqrtf(ss * (1.f / D) + EPS);
#pragma unroll
        for (int j = 0; j < 4; ++j) { f32x4 g = *(const f32x4*)(gpost + 4 * lane + 256 * j); x[u][j] += mf[j] * rs * g; }
#pragma unroll
        for (int j = 0; j < 4; ++j) *(f32x4*)(p.y + (size_t)r * D + 4 * lane + 256 * j) = x[u][j];
      }
      float rx = 1.f;
      if (gnext) {
        float ss = 0.f;
#pragma unroll
        for (int j = 0; j < 4; ++j) ss += x[u][j][0] * x[u][j][0] + x[u][j][1] * x[u][j][1] + x[u][j][2] * x[u][j][2] + x[u][j][3] * x[u][j][3];
        ss = wave_sum(ss);
        rx = rsqrtf(ss * (1.f / D) + EPS);
      }
#pragma unroll
      for (int j = 0; j < 4; ++j) {
        f32x4 h = x[u][j] * rx;
        if (gnext) h *= *(const f32x4*)(gnext + 4 * lane + 256 * j);
        *(u32x2*)(outH + (size_t)r * D + 4 * lane + 256 * j) = (u32x2){pk2(h[0], h[1]), pk2(h[2], h[3])};
      }
      if (outP) {
        const float* ps = r < ROWS_P ? ple_p + (size_t)r * 256 : ple_s + (size_t)(r - ROWS_P) * 256;
        f32x4 v = *(const f32x4*)(ps + 4 * lane);
        *(u32x2*)(outP + (size_t)r * 256 + 4 * lane) = (u32x2){pk2(v[0], v[1]), pk2(v[2], v[3])};
      }
    }
  }
}

template <class RowMap>
DI void gemm_core(const u16* __restrict__ A, int lda, RowMap rm, const u16* __restrict__ Bt, int ldb, int n0, int K,
                  f32x16 (&acc)[2][2], char* smem, const int tid) {
  const int l = tid & 63, w = tid >> 6, wm = w >> 1, wn = w & 1, l32 = l & 31, hh = l >> 5;
  const int lr = tid >> 3, lc = tid & 7;
  const u16* ap[4];
#pragma unroll
  for (int q = 0; q < 4; ++q) ap[q] = A + (size_t)rm(q * 32 + lr) * lda + lc * 8;
  const u16* bq0 = Bt + ((size_t)((n0 + wn * 64) >> 5) * (K >> 4) * 64 + l) * 8;
  const u16* bq1 = bq0 + (size_t)(K >> 4) * 512;
  const unsigned woff = lr * 128 + ((lc ^ ((lr >> 1) & 7)) << 4);
  const int swz = (l32 >> 1) & 7;
  const unsigned aoff = (wm * 64 + l32) * 128;
  u32x4 ra0[4], ra1[4];
  bf16x8 bf0[4], bf1[4];
  const int nk = K >> 6;
#define GLOADA(RA, T) _Pragma("unroll") for (int q = 0; q < 4; ++q) { RA[q] = *(const u32x4*)(ap[q] + (T) * 64); }
#define SWRITEA(RA, BUF) { char* db_ = smem + (BUF) * 16384; _Pragma("unroll") for (int q = 0; q < 4; ++q) { *(u32x4*)(db_ + woff + q * 4096) = RA[q]; } }
#define COMPUTE(BUF, TN, MORE) { const char* sb = smem + (BUF) * 16384; _Pragma("unroll") for (int ks = 0; ks < 4; ++ks) { \
      const unsigned co = ((2 * ks + hh) ^ swz) << 4; \
      bf16x8 a0 = *(const bf16x8*)(sb + aoff + co); \
      bf16x8 a1 = *(const bf16x8*)(sb + aoff + 32 * 128 + co); \
      acc[0][0] = __builtin_amdgcn_mfma_f32_32x32x16_bf16(bf0[ks], a0, acc[0][0], 0, 0, 0); \
      acc[0][1] = __builtin_amdgcn_mfma_f32_32x32x16_bf16(bf1[ks], a0, acc[0][1], 0, 0, 0); \
      acc[1][0] = __builtin_amdgcn_mfma_f32_32x32x16_bf16(bf0[ks], a1, acc[1][0], 0, 0, 0); \
      acc[1][1] = __builtin_amdgcn_mfma_f32_32x32x16_bf16(bf1[ks], a1, acc[1][1], 0, 0, 0); \
      if (MORE) { bf0[ks] = *(const bf16x8*)(bq0 + ((TN) * 4 + ks) * 512); bf1[ks] = *(const bf16x8*)(bq1 + ((TN) * 4 + ks) * 512); } \
      __builtin_amdgcn_sched_barrier(0); } }
  GLOADA(ra0, 0);
  GLOADA(ra1, 1);
#pragma unroll
  for (int ks = 0; ks < 4; ++ks) { bf0[ks] = *(const bf16x8*)(bq0 + ks * 512); bf1[ks] = *(const bf16x8*)(bq1 + ks * 512); }
  SWRITEA(ra0, 0);
  __syncthreads();
  for (int kt = 0; kt < nk; kt += 2) {
    if (kt + 2 < nk) GLOADA(ra0, kt + 2);
    __builtin_amdgcn_sched_barrier(0);
    COMPUTE(0, kt + 1, true);
    SWRITEA(ra1, 1);
    __syncthreads();
    if (kt + 3 < nk) GLOADA(ra1, kt + 3);
    __builtin_amdgcn_sched_barrier(0);
    COMPUTE(1, kt + 2, kt + 2 < nk);
    if (kt + 2 < nk) SWRITEA(ra0, 0);
    __syncthreads();
  }
#undef GLOADA
#undef SWRITEA
#undef COMPUTE
}

DI bool next_tile(int it, int ntm, int ntn, int& tm, int& tn) {
  const int b = blockIdx.x, x = b & 7, slot = b >> 3, S = gridDim.x >> 3;
  const int nq = (ntm - x + 7) >> 3;
  const int L = slot + it * S;
  if (L >= nq * ntn) return false;
  const int gsize = 8 * ntn;
  const int grp = L / gsize, r = L - grp * gsize;
  const int gsz = min(8, nq - 8 * grp);
  tn = r / gsz;
  tm = x + 8 * (8 * grp + r % gsz);
  return true;
}

struct IdMap { int base; DI int operator()(int r) const { return base + r; } };
struct ClampMap { int rowbase, t0, T; DI int operator()(int r) const { int t = t0 + r; t = t < 0 ? 0 : (t > T - 1 ? T - 1 : t); return rowbase + t; } };

#define ZERO_ACC(a) _Pragma("unroll") for (int _i = 0; _i < 2; ++_i) _Pragma("unroll") for (int _j = 0; _j < 2; ++_j) _Pragma("unroll") for (int _e = 0; _e < 16; ++_e) a[_i][_j][_e] = 0.f;

template <int EPI>
DI void gemm_phase(const P& p, const u16* A, int K, const u16* Bt, int N, void* outp, char* smem, const float* rowss = nullptr) {
  const int tid = ltid(), l = tid & 63, w = tid >> 6, wm = w >> 1, wn = w & 1, l32 = l & 31, hh = l >> 5;
  const int ntm = ROWS / 128, ntn = N / 128;
  int tm, tn;
  for (int it = 0; next_tile(it, ntm, ntn, tm, tn); ++it) {
    f32x16 acc[2][2];
    ZERO_ACC(acc);
    gemm_core(A, K, IdMap{tm * 128}, Bt, K, tn * 128, K, acc, smem, tid);
    const int n0 = tn * 128;
#pragma unroll
    for (int mi = 0; mi < 2; ++mi) {
      const int m = tm * 128 + wm * 64 + mi * 32 + l32;
      float rsc = 1.f;
      if (rowss) { const f32x4* sp = (const f32x4*)(rowss + (size_t)m * 16); const f32x4 s0 = sp[0], s1 = sp[1], s2 = sp[2], s3 = sp[3];
        const float tot = ((s0[0] + s0[1]) + (s0[2] + s0[3])) + ((s1[0] + s1[1]) + (s1[2] + s1[3])) + ((s2[0] + s2[1]) + (s2[2] + s2[3])) + ((s3[0] + s3[1]) + (s3[2] + s3[3]));
        rsc = rsqrtf(tot * (1.f / D) + EPS); }
#pragma unroll
      for (int ni = 0; ni < 2; ++ni)
#pragma unroll
        for (int q = 0; q < 4; ++q) {
          const int n = n0 + wn * 64 + ni * 32 + 8 * q + 4 * hh;
          float v0 = acc[mi][ni][4 * q] * rsc, v1 = acc[mi][ni][4 * q + 1] * rsc, v2 = acc[mi][ni][4 * q + 2] * rsc, v3 = acc[mi][ni][4 * q + 3] * rsc;
          if (EPI == 0) {
            const int sec = n0 >> 10;
            if (sec == 0 || sec == 3) { v0 *= sigm(v0); v1 *= sigm(v1); v2 *= sigm(v2); v3 *= sigm(v3); }
            *(u32x2*)((u16*)outp + (size_t)m * 4096 + n) = (u32x2){pk2(v0, v1), pk2(v2, v3)};
          } else if (EPI == 1) {
            const float sc = 0.125f * LOG2E;
            *(u32x2*)((u16*)outp + (size_t)m * 1024 + n) = (u32x2){pk2(v0 * sc, v1 * sc), pk2(v2 * sc, v3 * sc)};
          } else if (EPI == 2) {
            *(u32x2*)((u16*)outp + (size_t)m * 1024 + n) = (u32x2){pk2(v0, v1), pk2(v2, v3)};
          } else {
            float* dst;
            if (n < 1024) dst = (m < ROWS_P ? p.k_prompt + (size_t)m * 1024 : p.k_sample + (size_t)(m - ROWS_P) * 1024) + n;
            else dst = (m < ROWS_P ? p.v_prompt + (size_t)m * 1024 : p.v_sample + (size_t)(m - ROWS_P) * 1024) + (n - 1024);
            *(f32x4*)dst = (f32x4){v0, v1, v2, v3};
          }
        }
    }
  }
}

DI void ple_phase(const P& p, int layer, char* smem) {
  const int tid = ltid(), l = tid & 63, w = tid >> 6, wm = w >> 1, wn = w & 1, l32 = l & 31, hh = l >> 5;
  const u16* XB2 = (const u16*)p.BIG;
  const u16* PB = (const u16*)(p.BIG + (size_t)ROWS * 1024 * 2);
  const u16* Wg = p.wt_gate + (size_t)layer * 1024 * 1024;
  const u16* Wp = p.wt_ple + (size_t)layer * 1024 * 256;
  int tm, tn;
  for (int it = 0; next_tile(it, ROWS / 128, 8, tm, tn); ++it) {
    u16* PL = (u16*)(p.BIG + (size_t)ROWS * 1024 * 2 + (size_t)ROWS * 256 * 2);
    {
      f32x16 acc2[2][2];
      ZERO_ACC(acc2);
      gemm_core(PB, 256, IdMap{tm * 128}, Wp, 256, tn * 128, 256, acc2, smem, tid);
#pragma unroll
      for (int mi = 0; mi < 2; ++mi)
#pragma unroll
        for (int ni = 0; ni < 2; ++ni)
#pragma unroll
          for (int q = 0; q < 4; ++q)
            *(u32x2*)(PL + (size_t)(tm * 128 + wm * 64 + mi * 32 + l32) * D + tn * 128 + wn * 64 + ni * 32 + 8 * q + 4 * hh) =
                (u32x2){pk2(acc2[mi][ni][4 * q], acc2[mi][ni][4 * q + 1]), pk2(acc2[mi][ni][4 * q + 2], acc2[mi][ni][4 * q + 3])};
    }
    f32x16 acc[2][2];
    ZERO_ACC(acc);
    gemm_core(XB2, 1024, IdMap{tm * 128}, Wg, 1024, tn * 128, 1024, acc, smem, tid);
#pragma unroll
    for (int mi = 0; mi < 2; ++mi) {
      const int m = tm * 128 + wm * 64 + mi * 32 + l32;
      float ssq = 0.f;
#pragma unroll
      for (int ni = 0; ni < 2; ++ni)
#pragma unroll
        for (int q = 0; q < 4; ++q) {
          const int n = tn * 128 + wn * 64 + ni * 32 + 8 * q + 4 * hh;
          f32x4* xp = (f32x4*)(p.y + (size_t)m * D + n);
          f32x4 x = *xp;
          const u32x2 pv = *(const u32x2*)(PL + (size_t)m * D + n);
          x[0] += sigm(acc[mi][ni][4 * q]) * bflo(pv[0]);
          x[1] += sigm(acc[mi][ni][4 * q + 1]) * bfhi(pv[0]);
          x[2] += sigm(acc[mi][ni][4 * q + 2]) * bflo(pv[1]);
          x[3] += sigm(acc[mi][ni][4 * q + 3]) * bfhi(pv[1]);
          *xp = x;
          *(u32x2*)(p.XB + (size_t)m * D + n) = (u32x2){pk2(x[0], x[1]), pk2(x[2], x[3])};
          ssq += x[0] * x[0] + x[1] * x[1] + x[2] * x[2] + x[3] * x[3];
        }
      ssq += __shfl_xor(ssq, 32);
      if (hh == 0) p.ss[(size_t)m * 16 + tn * 2 + wn] = ssq;
    }
  }
}

DI void ffn_in_phase(const P& p, int layer, char* smem) {
  const int tid = ltid(), l = tid & 63, w = tid >> 6, wm = w >> 1, wn = w & 1, l32 = l & 31, hh = l >> 5;
  const u16* Wt = p.wt_ffn_in + (size_t)layer * 5632 * 1024;
  u16* HID = (u16*)p.BIG;
  float* GS = (float*)smem;
  const float* cw = p.conv_w + (size_t)layer * 3 * DFF;
  const float* cb = p.conv_b + (size_t)layer * DFF;
  int tm, tn;
  for (int it = 0; next_tile(it, 280, 44, tm, tn); ++it) {
    int seq, T, rowbase, t0; bool last;
    if (tm < 272) { seq = tm / 17; int j = tm - seq * 17; T = 2048; rowbase = seq * 2048; t0 = 126 * j - 2; last = (j == 16); }
    else { seq = 16 + (tm - 272); T = 32; rowbase = ROWS_P + (tm - 272) * 32; t0 = -2; last = true; }
    f32x16 acc[2][2];
    ZERO_ACC(acc);
    gemm_core(p.XB, 1024, ClampMap{rowbase, t0, T}, Wt, 1024, tn * 128, 1024, acc, smem, tid);
    const int chw = tn * 64 + wn * 32;
    if (t0 < 0 && wm == 0 && l32 < 2) {
#pragma unroll
      for (int q = 0; q < 4; ++q) {
        f32x4 sv = {0.f, 0.f, 0.f, 0.f};
        if (seq >= 16) sv = *(const f32x4*)(p.state_conv + ((size_t)(layer * 8 + (seq - 16)) * 2 + l32) * DFF + chw + 8 * q + 4 * hh);
#pragma unroll
        for (int c = 0; c < 4; ++c) acc[0][0][4 * q + c] = sv[c];
      }
    }
#pragma unroll
    for (int mi = 0; mi < 2; ++mi)
#pragma unroll
      for (int i = 0; i < 16; ++i) {
        const int chl = wn * 32 + 8 * (i >> 2) + 4 * hh + (i & 3);
        GS[chl * 132 + wm * 64 + mi * 32 + l32] = acc[mi][0][i];
      }
    __syncthreads();
#pragma unroll
    for (int q = 0; q < 4; ++q) {
      const int chq = chw + 8 * q + 4 * hh;
      const f32x4 b4 = *(const f32x4*)(cb + chq);
      const f32x4 w0 = *(const f32x4*)(cw + chq), w1 = *(const f32x4*)(cw + DFF + chq), w2 = *(const f32x4*)(cw + 2 * DFF + chq);
#pragma unroll
      for (int mi = 0; mi < 2; ++mi) {
        const int m = wm * 64 + mi * 32 + l32;
        const int t = t0 + m;
        if (m >= 2 && t < T) {
          float hv[4];
#pragma unroll
          for (int c = 0; c < 4; ++c) {
            const int chl = wn * 32 + 8 * q + 4 * hh + c;
            const float g0 = acc[mi][0][4 * q + c], g1 = GS[chl * 132 + m - 1], g2 = GS[chl * 132 + m - 2];
            const float cv = b4[c] + w0[c] * g2 + w1[c] * g1 + w2[c] * g0;
            hv[c] = cv * sigm(cv) * acc[mi][1][4 * q + c];
          }
          *(u32x2*)(HID + (size_t)(rowbase + t) * DFF + chq) = (u32x2){pk2(hv[0], hv[1]), pk2(hv[2], hv[3])};
          if (last && t >= T - 2) {
            float* co = seq < 16 ? p.conv_prompt + ((size_t)(layer * 16 + seq) * 2 + (t - (T - 2))) * DFF
                                 : p.conv_sample + ((size_t)(layer * 8 + (seq - 16)) * 2 + (t - (T - 2))) * DFF;
            *(f32x4*)(co + chq) = (f32x4){acc[mi][0][4 * q], acc[mi][0][4 * q + 1], acc[mi][0][4 * q + 2], acc[mi][0][4 * q + 3]};
          }
        }
      }
    }
    __syncthreads();
  }
}

DI void gla_state_phase(const P& p, int layer, char* smem) {
  const u16* PROJ = (const u16*)p.BIG;
  const int tid = ltid(), l = tid & 63, w = tid >> 6, l32 = l & 31, hh = l >> 5;
  float* SLOC = (float*)p.XB;
  float* DTOT = SLOC + (size_t)384 * 16384;
  const int k = tid >> 1, th = tid & 1;
  for (int item = blockIdx.x; item < 384; item += gridDim.x) {
    const int sh = item / 3, ch = item - sh * 3, s = sh >> 3, h = sh & 7;
    const int rowbase = s * 2048 + ch * 512;
    float lower = 0.f;
    if (layer == 1) lower = sigm(p.lb_raw[1024 + h * 128 + k] - p.lb_raw[h * 128 + k]);
    const float oml = 1.f - lower;
    f32x16 S[4];
#pragma unroll
    for (int kt = 0; kt < 4; ++kt)
#pragma unroll
      for (int i = 0; i < 16; ++i) S[kt][i] = 0.f;
    float btot = 0.f;
    u16 fr[8], vr[8];
#define GS_LOAD(BLK) { const size_t r0_ = (size_t)rowbase + (BLK) * 16; \
      const u16* pf_ = PROJ + (r0_ + 8 * th) * 4096 + 1024 + h * 128 + k; \
      const u16* pv_ = PROJ + r0_ * 4096 + 2048 + h * 128 + 32 * w + l32; \
      _Pragma("unroll") for (int t = 0; t < 8; ++t) fr[t] = pf_[(size_t)t * 4096]; \
      _Pragma("unroll") for (int jj = 0; jj < 8; ++jj) vr[jj] = pv_[(size_t)(8 * (jj >> 2) + 4 * hh + (jj & 3)) * 4096]; }
    GS_LOAD(0);
    for (int blk = 0; blk < 32; ++blk) {
      char* sb = smem + (blk & 1) * 8192;
      u16* KDT = (u16*)sb;
      float* DD = (float*)(KDT + 128 * 20);
      {
        float km[8], eb[8];
        float bs = 0.f;
#pragma unroll
        for (int t = 0; t < 8; ++t) {
          const float f = bf2f(fr[t]);
          const float g = lower + oml * sigm(f);
          bs += __logf(g);
          km[t] = 1.f - g; eb[t] = bs;
        }
        const float other = __shfl_xor(bs, 1);
        const float boff = th ? other : 0.f;
        const float bsum = bs + other;
        btot += bsum;
        unsigned kdp[4];
#pragma unroll
        for (int j = 0; j < 4; ++j)
          kdp[j] = pk2(km[2 * j] * __expf(bsum - boff - eb[2 * j]), km[2 * j + 1] * __expf(bsum - boff - eb[2 * j + 1]));
        *(u32x2*)(KDT + k * 20 + 8 * th) = (u32x2){kdp[0], kdp[1]};
        *(u32x2*)(KDT + k * 20 + 8 * th + 4) = (u32x2){kdp[2], kdp[3]};
        if (th == 0) DD[k] = __expf(bsum);
      }
      const bf16x8 vfrag = mk8u((unsigned)vr[0] | ((unsigned)vr[1] << 16), (unsigned)vr[2] | ((unsigned)vr[3] << 16),
                                (unsigned)vr[4] | ((unsigned)vr[5] << 16), (unsigned)vr[6] | ((unsigned)vr[7] << 16));
      if (blk + 1 < 32) GS_LOAD(blk + 1);
      __syncthreads();
#pragma unroll
      for (int kt = 0; kt < 4; ++kt) {
#pragma unroll
        for (int q = 0; q < 4; ++q) {
          const f32x4 d4 = *(const f32x4*)(DD + 32 * kt + 8 * q + 4 * hh);
#pragma unroll
          for (int c = 0; c < 4; ++c) S[kt][4 * q + c] *= d4[c];
        }
        const u32x2 lo = *(const u32x2*)(KDT + (32 * kt + l32) * 20 + 4 * hh);
        const u32x2 hi = *(const u32x2*)(KDT + (32 * kt + l32) * 20 + 8 + 4 * hh);
        S[kt] = __builtin_amdgcn_mfma_f32_32x32x16_bf16(mk8(lo, hi), vfrag, S[kt], 0, 0, 0);
      }
    }
#undef GS_LOAD
    {
      float* op = SLOC + (size_t)item * 16384 + 32 * w + l32;
#pragma unroll
      for (int kt = 0; kt < 4; ++kt)
#pragma unroll
        for (int i = 0; i < 16; ++i) op[(size_t)(32 * kt + (i & 3) + 8 * (i >> 2) + 4 * hh) * 128] = S[kt][i];
      if (th == 0) DTOT[(size_t)item * 128 + k] = __expf(btot);
    }
    __syncthreads();
  }
}

DI void gla_phase(const P& p, int layer, char* smem) {
  const u16* PROJ = (const u16*)p.BIG;
  const int tid = ltid(), l = tid & 63, w = tid >> 6, l32 = l & 31, hh = l >> 5, m16 = l & 15;
  float* REDB = (float*)(smem + 2 * 14336);
  const int k = tid >> 1, th = tid & 1;
  const float* SLOC = (const float*)p.XB;
  const float* DTOT = SLOC + (size_t)384 * 16384;
  for (int item = blockIdx.x; item < 576; item += gridDim.x) {
    const bool smp = item < 64;
    const int s = smp ? 16 + (item >> 3) : (item - 64) >> 5;
    const int h = smp ? (item & 7) : ((item - 64) >> 2) & 7;
    const int ch = smp ? 0 : (item - 64) & 3;
    const int T = smp ? 32 : 512;
    const int rowbase = smp ? ROWS_P + (s - 16) * 32 : s * 2048 + ch * 512;
    float lower = 0.f;
    if (layer == 1) lower = sigm(p.lb_raw[1024 + h * 128 + k] - p.lb_raw[h * 128 + k]);
    const float oml = 1.f - lower;
    f32x16 S[4];
    if (smp) {
      const float* sp = p.state_hgrn + ((size_t)(layer * 8 + (s - 16)) * 8 + h) * 16384 + 32 * w + l32;
#pragma unroll
      for (int kt = 0; kt < 4; ++kt)
#pragma unroll
        for (int i = 0; i < 16; ++i) S[kt][i] = sp[(size_t)(32 * kt + (i & 3) + 8 * (i >> 2) + 4 * hh) * 128];
    } else {
#pragma unroll
      for (int kt = 0; kt < 4; ++kt)
#pragma unroll
        for (int i = 0; i < 16; ++i) S[kt][i] = 0.f;
#pragma unroll 1
      for (int j = 0; j < ch; ++j) {
        const int it1 = (s * 8 + h) * 3 + j;
        const float* sl = SLOC + (size_t)it1 * 16384 + 32 * w + l32 + (size_t)(4 * hh) * 128;
        const float* dl = DTOT + (size_t)it1 * 128 + 4 * hh;
#pragma unroll
        for (int kt = 0; kt < 4; ++kt) {
#pragma unroll
          for (int q = 0; q < 4; ++q) {
            const float* slq = sl + (size_t)(32 * kt + 8 * q) * 128;
            const f32x4 d4 = *(const f32x4*)(dl + 32 * kt + 8 * q);
#pragma unroll
            for (int c = 0; c < 4; ++c) S[kt][4 * q + c] = S[kt][4 * q + c] * d4[c] + slq[c * 128];
            __builtin_amdgcn_sched_barrier(0);
          }
        }
      }
    }
    const int nblk = T >> 4;
    u16 fr[8], qr[8], vr[8];
#define GLA_LOADRAW(BLK) { const size_t r0_ = (size_t)rowbase + (BLK) * 16; \
      const u16* pf_ = PROJ + (r0_ + 8 * th) * 4096 + 1024 + h * 128 + k; \
      const u16* pq_ = PROJ + (r0_ + 8 * th) * 4096 + h * 128 + k; \
      _Pragma("unroll") for (int t = 0; t < 8; ++t) fr[t] = pf_[(size_t)t * 4096]; \
      _Pragma("unroll") for (int j = 0; j < 8; ++j) qr[j] = pq_[(size_t)j * 4096]; \
 }
#define GLA_LOADV(BLK) { const u16* pv_ = PROJ + ((size_t)rowbase + (BLK) * 16) * 4096 + 2048 + h * 128 + 32 * w + l32; \
      _Pragma("unroll") for (int jj = 0; jj < 8; ++jj) vr[jj] = pv_[(size_t)(8 * (jj >> 2) + 4 * hh + (jj & 3)) * 4096]; }
#define GLA_LOADGS(BLK) { const u16* pg_ = PROJ + ((size_t)rowbase + (BLK) * 16 + m16) * 4096 + 3072 + h * 128 + 32 * w + 4 * hh; \
      _Pragma("unroll") for (int q = 0; q < 4; ++q) gsl[q] = *(const u32x2*)(pg_ + 8 * q); }
#define GLA_FINAL(BLK) { const float* RED_ = REDB + ((BLK) & 1) * 64; \
      if (l32 < 16) { \
        const float tot = RED_[l32] + RED_[16 + l32] + RED_[32 + l32] + RED_[48 + l32]; \
        const float rn = rsqrtf(tot * (1.f / 128.f) + EPS); \
        u16* op_ = p.OG + ((size_t)rowbase + (BLK) * 16 + l32) * 1024 + h * 128 + 32 * w + 4 * hh; \
        const float* gp_ = p.g_hg + layer * 1024 + h * 128 + 32 * w + 4 * hh; \
        _Pragma("unroll") for (int q = 0; q < 4; ++q) { const f32x4 gh = *(const f32x4*)(gp_ + 8 * q); \
          *(u32x2*)(op_ + 8 * q) = (u32x2){pk2(oacc[4 * q] * rn * gh[0] * bflo(gsl[q][0]), oacc[4 * q + 1] * rn * gh[1] * bfhi(gsl[q][0])), \
                                          pk2(oacc[4 * q + 2] * rn * gh[2] * bflo(gsl[q][1]), oacc[4 * q + 3] * rn * gh[3] * bfhi(gsl[q][1]))}; } \
      } }
    GLA_LOADRAW(0);
    u32x2 gsl[4];
    for (int blk = 0; blk < nblk; ++blk) {
      GLA_LOADGS(blk);
      GLA_LOADV(blk);
      char* sb = smem + (blk & 1) * 14336;
      u16* QT = (u16*)sb;
      u16* KT = QT + 16 * 136;
      u16* KDT = KT + 16 * 136;
      float* DD = (float*)(KDT + 128 * 20);
      {
        float qtm[8], ktm[8];
        float bs = 0.f;
#pragma unroll
        for (int t = 0; t < 8; ++t) {
          const float f = bf2f(fr[t]);
          const float g = lower + oml * sigm(f);
          bs += __logf(g);
          const float eb = __expf(bs);
          qtm[t] = bf2f(qr[t]) * eb;
          ktm[t] = (1.f - g) * __builtin_amdgcn_rcpf(eb);
        }
        const float other = __shfl_xor(bs, 1);
        const float boff = th ? other : 0.f;
        const float bsum = bs + other;
        const float E1 = __expf(boff), E1i = __expf(-boff), EL = __expf(bsum);
        unsigned kdp[4];
        float kdprev = 0.f;
#pragma unroll
        for (int j = 0; j < 8; ++j) {
          const int t = 8 * th + j;
          const float qt = qtm[j] * E1;
          const float ktv = ktm[j] * E1i;
          const float kd = ktv * EL;
          QT[t * 136 + k] = (u16)(pk2(qt, 0.f) & 0xffffu);
          KT[t * 136 + k] = (u16)(pk2(ktv, 0.f) & 0xffffu);
          if (j & 1) kdp[j >> 1] = pk2(kdprev, kd); else kdprev = kd;
        }
        *(u32x2*)(KDT + k * 20 + 8 * th) = (u32x2){kdp[0], kdp[1]};
        *(u32x2*)(KDT + k * 20 + 8 * th + 4) = (u32x2){kdp[2], kdp[3]};
        if (th == 0) DD[k] = __expf(bsum);
      }
      if (blk + 1 < nblk) GLA_LOADRAW(blk + 1);
      __syncthreads();
      const bf16x8 vfrag = mk8u((unsigned)vr[0] | ((unsigned)vr[1] << 16), (unsigned)vr[2] | ((unsigned)vr[3] << 16),
                                (unsigned)vr[4] | ((unsigned)vr[5] << 16), (unsigned)vr[6] | ((unsigned)vr[7] << 16));
      f32x16 aacc, oacc;
#pragma unroll
      for (int i = 0; i < 16; ++i) { aacc[i] = 0.f; oacc[i] = 0.f; }
#pragma unroll
      for (int ks = 0; ks < 8; ++ks) {
        const bf16x8 ka = *(const bf16x8*)(KT + m16 * 136 + 16 * ks + 8 * hh);
        const bf16x8 qb = *(const bf16x8*)(QT + m16 * 136 + 16 * ks + 8 * hh);
        aacc = __builtin_amdgcn_mfma_f32_32x32x16_bf16(ka, qb, aacc, 0, 0, 0);
        const int kt = ks >> 1, s2 = ks & 1;
        const bf16x8 sa = mk8u(pk2(S[kt][8 * s2], S[kt][8 * s2 + 1]), pk2(S[kt][8 * s2 + 2], S[kt][8 * s2 + 3]),
                               pk2(S[kt][8 * s2 + 4], S[kt][8 * s2 + 5]), pk2(S[kt][8 * s2 + 6], S[kt][8 * s2 + 7]));
        const u32x2 lo = *(const u32x2*)(QT + m16 * 136 + 32 * kt + 16 * s2 + 4 * hh);
        const u32x2 hi = *(const u32x2*)(QT + m16 * 136 + 32 * kt + 16 * s2 + 8 + 4 * hh);
        oacc = __builtin_amdgcn_mfma_f32_32x32x16_bf16(sa, mk8(lo, hi), oacc, 0, 0, 0);
      }
      float am[8];
#pragma unroll
      for (int i = 0; i < 8; ++i) { const int m = (i & 3) + 8 * (i >> 2) + 4 * hh; am[i] = (m <= m16) ? aacc[i] : 0.f; }
      const bf16x8 afrag = mk8u(pk2(am[0], am[1]), pk2(am[2], am[3]), pk2(am[4], am[5]), pk2(am[6], am[7]));
      oacc = __builtin_amdgcn_mfma_f32_32x32x16_bf16(vfrag, afrag, oacc, 0, 0, 0);
#pragma unroll
      for (int kt = 0; kt < 4; ++kt) {
#pragma unroll
        for (int q = 0; q < 4; ++q) {
          const f32x4 d4 = *(const f32x4*)(DD + 32 * kt + 8 * q + 4 * hh);
#pragma unroll
          for (int c = 0; c < 4; ++c) S[kt][4 * q + c] *= d4[c];
        }
        const u32x2 lo = *(const u32x2*)(KDT + (32 * kt + l32) * 20 + 4 * hh);
        const u32x2 hi = *(const u32x2*)(KDT + (32 * kt + l32) * 20 + 8 + 4 * hh);
        S[kt] = __builtin_amdgcn_mfma_f32_32x32x16_bf16(mk8(lo, hi), vfrag, S[kt], 0, 0, 0);
      }
      float ss = 0.f;
#pragma unroll
      for (int i = 0; i < 16; ++i) ss += oacc[i] * oacc[i];
      ss += __shfl_xor(ss, 32);
      if (l < 16) REDB[(blk & 1) * 64 + w * 16 + l] = ss;
      __syncthreads();
      GLA_FINAL(blk);
    }
#undef GLA_LOADGS
#undef GLA_LOADV
#undef GLA_LOADRAW
#undef GLA_FINAL
    if (smp || ch == 3) {
      float* op = (smp ? p.hgrn_sample + ((size_t)(layer * 8 + (s - 16)) * 8 + h) * 16384
                       : p.hgrn_prompt + ((size_t)(layer * 16 + s) * 8 + h) * 16384) + 32 * w + l32;
#pragma unroll
      for (int kt = 0; kt < 4; ++kt)
#pragma unroll
        for (int i = 0; i < 16; ++i) op[(size_t)(32 * kt + (i & 3) + 8 * (i >> 2) + 4 * hh) * 128] = S[kt][i];
    }
  }
}

DI void kvconv_phase(const P& p) {
  const int tid = ltid();
  char* KVT = p.BIG + (size_t)ROWS * 1024 * 2;
  for (int t = blockIdx.x; t < 4096 + 1088; t += gridDim.x) {
    const float *kb, *vb; int nvalid = 64;
    if (t < 4096) { const int kt = t & 31, sh = t >> 5, s = sh >> 3, h = sh & 7; const size_t off = ((size_t)(s * 2048 + 64 * kt)) * 1024 + h * 128; kb = p.k_prompt + off; vb = p.v_prompt + off; }
    else { const int u = t - 4096; const int kt = u % 17, sh = u / 17, b = sh >> 3, h = sh & 7;
      if (kt < 16) { const size_t off = ((size_t)(b * 1024 + 64 * kt)) * 1024 + h * 128; kb = p.cache_k + off; vb = p.cache_v + off; }
      else { const size_t off = ((size_t)(b * 32)) * 1024 + h * 128; kb = p.k_sample + off; vb = p.v_sample + off; nvalid = 32; } }
    u16* kd = (u16*)(KVT + (size_t)t * 32768);
    u16* vd = kd + 8192;
#pragma unroll
    for (int pp = 0; pp < 4; ++pp) {
      const int key = 16 * pp + (tid >> 4), d8 = (tid & 15) * 8;
      f32x4 a = {0.f, 0.f, 0.f, 0.f}, b2 = {0.f, 0.f, 0.f, 0.f};
      if (key < nvalid) { a = *(const f32x4*)(kb + (size_t)key * 1024 + d8); b2 = *(const f32x4*)(kb + (size_t)key * 1024 + d8 + 4); }
      *(u32x4*)(kd + key * 128 + d8) = (u32x4){pk2(a[0], a[1]), pk2(a[2], a[3]), pk2(b2[0], b2[1]), pk2(b2[2], b2[3])};
    }
#pragma unroll
    for (int c = 0; c < 4; ++c) {
      const int v = tid & 127, cc = 4 * (tid >> 7) + c;
      float e[8];
#pragma unroll
      for (int j = 0; j < 8; ++j) { const int key = 8 * cc + j; e[j] = key < nvalid ? vb[(size_t)key * 1024 + v] : 0.f; }
      *(u32x4*)(vd + v * 64 + 8 * cc) = (u32x4){pk2(e[0], e[1]), pk2(e[2], e[3]), pk2(e[4], e[5]), pk2(e[6], e[7])};
    }
  }
}

DI void attn_phase(const P& p, int layer, char* smem) {
  const int jl = layer - 2;
  const u16* Q = (const u16*)p.BIG;
  const char* KVT = p.BIG + (size_t)ROWS * 1024 * 2;
  const int tid = ltid(), l = tid & 63, w = tid >> 6, l16 = l & 15, g = l >> 4;
  u16* KS = (u16*)smem;
  u16* VT = KS + 64 * 136;
  float* BT = (float*)(VT + 128 * 72);
  u16* QS = (u16*)(BT + 256);
  const float lam_init = 0.8f - 0.6f * __expf(-0.3f * (float)layer);
  float lam;
  {
    const float* lp = p.lam_b + jl * 256;
    float a = 0.f, b = 0.f;
    for (int d = 0; d < 64; ++d) { a += lp[d] * lp[64 + d]; b += lp[128 + d] * lp[192 + d]; }
    lam = __expf(a) - __expf(b) + lam_init;
  }
  for (int item = blockIdx.x; item < 4096 + 64; item += gridDim.x) {
    int b, h, nq, qrow0, qpos0, ntiles, tile0; bool smp;
    if (item < 4096) { const int jq = 31 - (item >> 7); const int bh = item & 127; b = bh >> 3; h = bh & 7; smp = false; nq = 64; qrow0 = b * 2048 + 64 * jq; qpos0 = 64 * jq; ntiles = jq + 1; tile0 = bh * 32; }
    else { const int si = item - 4096; b = si >> 3; h = si & 7; smp = true; nq = 32; qrow0 = ROWS_P + b * 32; qpos0 = 1024; ntiles = 17; tile0 = 4096 + si * 17; }
    __syncthreads();
    if (tid < 230) {
      const int rel = tid - 166;
      const int n = rel < 0 ? -rel : rel;
      int bk = n < 8 ? n : 8 + (n >= 13) + (n >= 20) + (n >= 30) + (n >= 46) + (n >= 70) + (n >= 108) + (n >= 166);
      if (rel > 0) bk += 16;
      BT[tid] = p.rel_bias[bk * 8 + h] * LOG2E;
    }
#pragma unroll
    for (int pp = 0; pp < 4; ++pp) {
      const int idx = pp * 256 + tid, r = idx >> 4, c16 = idx & 15;
      *(u32x4*)(QS + r * 136 + c16 * 8) = *(const u32x4*)(Q + (size_t)(qrow0 + min(r, nq - 1)) * 1024 + h * 128 + c16 * 8);
    }
    f32x4 oacc[2][8];
#pragma unroll
    for (int c = 0; c < 2; ++c)
#pragma unroll
      for (int vs = 0; vs < 8; ++vs) oacc[c][vs] = (f32x4){0.f, 0.f, 0.f, 0.f};
    float mrun[2] = {-1e30f, -1e30f}, lsum[2] = {0.f, 0.f};
    const int qpos = qpos0 + min(16 * w + l16, nq - 1);
    u32x4 rk[4], rv[4];
    {
      const u32x4* src = (const u32x4*)(KVT + (size_t)tile0 * 32768);
#pragma unroll
      for (int pp = 0; pp < 4; ++pp) { rk[pp] = src[pp * 256 + tid]; rv[pp] = src[1024 + pp * 256 + tid]; }
    }
    for (int kt = 0; kt < ntiles; ++kt) {
      const int nvalid = (smp && kt == 16) ? 32 : 64;
      if (kt > 0) __syncthreads();
#pragma unroll
      for (int pp = 0; pp < 4; ++pp) {
        const int idx = pp * 256 + tid;
        *(u32x4*)(KS + (idx >> 4) * 136 + (idx & 15) * 8) = rk[pp];
        *(u32x4*)(VT + (idx >> 3) * 72 + (idx & 7) * 8) = rv[pp];
      }
      if (kt + 1 < ntiles) {
        const u32x4* src = (const u32x4*)(KVT + (size_t)(tile0 + kt + 1) * 32768);
#pragma unroll
        for (int pp = 0; pp < 4; ++pp) { rk[pp] = src[pp * 256 + tid]; rv[pp] = src[1024 + pp * 256 + tid]; }
      }
      __syncthreads();
      f32x4 sacc[2][4];
#pragma unroll
      for (int c = 0; c < 2; ++c)
#pragma unroll
        for (int sub = 0; sub < 4; ++sub) {
          sacc[c][sub] = (f32x4){0.f, 0.f, 0.f, 0.f};
#pragma unroll
          for (int ks = 0; ks < 2; ++ks) {
            const bf16x8 kf = *(const bf16x8*)(KS + (16 * sub + l16) * 136 + c * 64 + 32 * ks + 8 * g);
            const bf16x8 qfr = *(const bf16x8*)(QS + (16 * w + l16) * 136 + c * 64 + 32 * ks + 8 * g);
            sacc[c][sub] = __builtin_amdgcn_mfma_f32_16x16x32_bf16(kf, qfr, sacc[c][sub], 0, 0, 0);
          }
        }
#pragma unroll
      for (int sub = 0; sub < 4; ++sub)
#pragma unroll
        for (int i = 0; i < 4; ++i) {
          const int kl = 16 * sub + 4 * g + i;
          int rel = 64 * kt + kl - qpos;
          rel = rel < -166 ? -166 : rel;
          const float bt = BT[rel + 166];
          const bool ok = kl < nvalid;
          sacc[0][sub][i] = ok ? sacc[0][sub][i] + bt : -30000.f;
          sacc[1][sub][i] = ok ? sacc[1][sub][i] + bt : -30000.f;
        }
      bf16x8 pf[2][2];
#pragma unroll
      for (int c = 0; c < 2; ++c) {
        float mx = -1e30f;
#pragma unroll
        for (int sub = 0; sub < 4; ++sub)
#pragma unroll
          for (int i = 0; i < 4; ++i) mx = fmaxf(mx, sacc[c][sub][i]);
        mx = fmaxf(mx, __shfl_xor(mx, 16));
        mx = fmaxf(mx, __shfl_xor(mx, 32));
        const float mnew = fmaxf(mrun[c], mx);
        const float alpha = __builtin_amdgcn_exp2f(mrun[c] - mnew);
        mrun[c] = mnew;
        float rs = 0.f;
#pragma unroll
        for (int sub = 0; sub < 4; ++sub)
#pragma unroll
          for (int i = 0; i < 4; ++i) { const float e = __builtin_amdgcn_exp2f(sacc[c][sub][i] - mnew); sacc[c][sub][i] = e; rs += e; }
        lsum[c] = lsum[c] * alpha + rs;
#pragma unroll
        for (int vs = 0; vs < 8; ++vs) oacc[c][vs] *= alpha;
#pragma unroll
        for (int j = 0; j < 2; ++j)
          pf[c][j] = mk8u(pk2(sacc[c][2 * j][0], sacc[c][2 * j][1]), pk2(sacc[c][2 * j][2], sacc[c][2 * j][3]),
                          pk2(sacc[c][2 * j + 1][0], sacc[c][2 * j + 1][1]), pk2(sacc[c][2 * j + 1][2], sacc[c][2 * j + 1][3]));
      }
#pragma unroll
      for (int j = 0; j < 2; ++j)
#pragma unroll
        for (int vs = 0; vs < 8; ++vs) {
          const u32x2 lo = *(const u32x2*)(VT + (16 * vs + l16) * 72 + 32 * j + 4 * g);
          const u32x2 hi = *(const u32x2*)(VT + (16 * vs + l16) * 72 + 32 * j + 16 + 4 * g);
          const bf16x8 vf = mk8(lo, hi);
          oacc[0][vs] = __builtin_amdgcn_mfma_f32_16x16x32_bf16(vf, pf[0][j], oacc[0][vs], 0, 0, 0);
          oacc[1][vs] = __builtin_amdgcn_mfma_f32_16x16x32_bf16(vf, pf[1][j], oacc[1][vs], 0, 0, 0);
        }
    }
#pragma unroll
    for (int c = 0; c < 2; ++c) { lsum[c] += __shfl_xor(lsum[c], 16); lsum[c] += __shfl_xor(lsum[c], 32); }
    const float inv0 = 1.f / lsum[0], inv1 = lam / lsum[1];
    float ss = 0.f;
#pragma unroll
    for (int vs = 0; vs < 8; ++vs)
#pragma unroll
      for (int i = 0; i < 4; ++i) { const float o = oacc[0][vs][i] * inv0 - oacc[1][vs][i] * inv1; oacc[0][vs][i] = o; ss += o * o; }
    ss += __shfl_xor(ss, 16);
    ss += __shfl_xor(ss, 32);
    const float rn = rsqrtf(ss * (1.f / 128.f) + EPS) * (1.f - lam_init);
    if (16 * w + l16 < nq) {
      const size_t row = (size_t)qrow0 + 16 * w + l16;
#pragma unroll
      for (int vs = 0; vs < 8; ++vs) {
        const int v = h * 128 + 16 * vs + 4 * g;
        const f32x4 gl = *(const f32x4*)(p.g_subln + jl * 1024 + v);
        *(u32x2*)(p.OG + row * 1024 + v) = (u32x2){pk2(oacc[0][vs][0] * rn * gl[0], oacc[0][vs][1] * rn * gl[1]),
                                                   pk2(oacc[0][vs][2] * rn * gl[2], oacc[0][vs][3] * rn * gl[3])};
      }
    }
  }
}

DI void gbar(unsigned* bar, unsigned& gen) {
  gen += 1;
  asm volatile("s_waitcnt vmcnt(0) lgkmcnt(0)" ::: "memory");
  __syncthreads();
  if (threadIdx.x < 64) {
    const unsigned g = blockIdx.x >> 4, ng = gridDim.x >> 4;
    bool last = false;
    if (threadIdx.x == 0) {
      __builtin_amdgcn_fence(__ATOMIC_RELEASE, "agent");
      asm volatile("s_waitcnt vmcnt(0)" ::: "memory");
      const unsigned o = __hip_atomic_fetch_add(bar + 64 * g, 1u, __ATOMIC_RELAXED, __HIP_MEMORY_SCOPE_AGENT);
      if (o + 1 == 16 * gen) {
        const unsigned o2 = __hip_atomic_fetch_add(bar + 64 * 64, 1u, __ATOMIC_RELAXED, __HIP_MEMORY_SCOPE_AGENT);
        last = (o2 + 1 == ng * gen);
      }
    }
    last = __shfl(last ? 1 : 0, 0) != 0;
    if (last && threadIdx.x < ng) __hip_atomic_store(bar + 64 * (65 + threadIdx.x), gen, __ATOMIC_RELAXED, __HIP_MEMORY_SCOPE_AGENT);
    if (threadIdx.x == 0) {
      while (__hip_atomic_load(bar + 64 * (65 + g), __ATOMIC_RELAXED, __HIP_MEMORY_SCOPE_AGENT) < gen) __builtin_amdgcn_s_sleep(2);
      __builtin_amdgcn_fence(__ATOMIC_ACQUIRE, "agent");
      asm volatile("s_waitcnt vmcnt(0)" ::: "memory");
    }
  }
  __syncthreads();
}

__global__ void __launch_bounds__(256, 2) yoco_megakernel(P p) {
  __shared__ __attribute__((aligned(16))) char smem[65536];
  cg::grid_group grid = cg::this_grid();
  if (blockIdx.x == 0 && threadIdx.x < 130) __hip_atomic_store(p.bar + 64 * threadIdx.x, 0u, __ATOMIC_RELAXED, __HIP_MEMORY_SCOPE_AGENT);
  prep_phase(p, smem);
  grid.sync();
  unsigned btarget = 0;
  u16* Mbuf = (u16*)p.BIG;
  u16* Fbuf = p.XB;
  u16* XB2 = (u16*)p.BIG;
  u16* PB = (u16*)(p.BIG + (size_t)ROWS * 1024 * 2);
  for (int i = 0; i < 4; ++i) {
    const float* gn = p.g_norms + i * 4 * D;
    if (i == 0) {
      rowop_phase(p, true, nullptr, nullptr, gn, p.XB, nullptr, nullptr, nullptr);
      gbar(p.bar, btarget);
    }
    if (i < 2) {
      REPG gemm_phase<0>(p, p.XB, 1024, p.wt_in_a + (size_t)i * 4096 * 1024, 4096, p.BIG, smem, i ? p.ss : nullptr);
      gbar(p.bar, btarget);
      gla_state_phase(p, i, smem);
      gbar(p.bar, btarget);
      for (int _r = 0; _r < REP_GLA; ++_r) gla_phase(p, i, smem);
      gbar(p.bar, btarget);
      REPG gemm_phase<2>(p, p.OG, 1024, p.wt_out_a + (size_t)i * 1024 * 1024, 1024, Mbuf, smem);
      gbar(p.bar, btarget);
    } else {
      if (i == 2) gemm_phase<3>(p, p.XB, 1024, p.wt_kv, 2048, nullptr, smem, p.ss);
      REPG gemm_phase<1>(p, p.XB, 1024, p.wt_q + (size_t)(i - 2) * 1024 * 1024, 1024, p.BIG, smem, p.ss);
      if (i == 2) gbar(p.bar, btarget);
      kvconv_phase(p);
      gbar(p.bar, btarget);
      for (int _r = 0; _r < REP_ATTN; ++_r) attn_phase(p, i, smem);
      gbar(p.bar, btarget);
      REPG gemm_phase<2>(p, p.OG, 1024, p.wt_out_b + (size_t)(i - 2) * 1024 * 1024, 1024, Mbuf, smem);
      gbar(p.bar, btarget);
    }
    rowop_phase(p, i == 0, Mbuf, gn + D, gn + 2 * D, p.XB, nullptr, nullptr, nullptr);
    gbar(p.bar, btarget);
    REPG ffn_in_phase(p, i, smem);
    gbar(p.bar, btarget);
    REPG gemm_phase<2>(p, (const u16*)p.BIG, DFF, p.wt_ffn_out + (size_t)i * 1024 * DFF, 1024, Fbuf, smem);
    gbar(p.bar, btarget);
    rowop_phase(p, false, Fbuf, gn + 3 * D, nullptr, XB2, p.p_prompt + (size_t)i * ROWS_P * 256, p.p_sample + (size_t)i * 256 * 256, PB);
    gbar(p.bar, btarget);
    ple_phase(p, i, smem);
    gbar(p.bar, btarget);
  }
}

extern "C" void kernel_launch(void* const* d_in, const int* in_sizes, int n_in, void* d_out, int out_size, void* d_ws,
                              size_t ws_size, hipStream_t stream) {
  static int grid_blocks = 0;
  if (!grid_blocks) {
    int dev = 0, cus = 0, per_cu = 0;
    hipGetDevice(&dev);
    hipDeviceGetAttribute(&cus, hipDeviceAttributeMultiprocessorCount, dev);
    hipOccupancyMaxActiveBlocksPerMultiprocessor(&per_cu, yoco_megakernel, 256, 0);
    if (per_cu > 2) per_cu = 2;
    grid_blocks = cus * per_cu;
    grid_blocks &= ~7;
  }
  P p{};
  const float* const* in = (const float* const*)d_in;
  p.x_prompt = in[0]; p.x_sample = in[1]; p.cache_k = in[2]; p.cache_v = in[3]; p.state_hgrn = in[4]; p.state_conv = in[5];
  p.p_prompt = in[6]; p.p_sample = in[7];
  p.g_norms = in[8]; const float* w_in_a = in[9]; p.lb_raw = in[10]; p.g_hg = in[11]; const float* w_out_a = in[12]; p.g_kv = in[13];
  const float* w_kv = in[14]; p.rel_bias = in[15]; const float* w_q_b = in[16]; p.lam_b = in[17]; p.g_subln = in[18];
  const float* w_out_b = in[19]; const float* w_ffn_in = in[20]; p.conv_w = in[21]; p.conv_b = in[22]; const float* w_ffn_out = in[23];
  const float* w_ple = in[24]; const float* w_ple_gate = in[25];
  float* o = (float*)d_out;
  p.y = o; o += (size_t)ROWS * D;
  p.k_prompt = o; o += (size_t)ROWS_P * D;
  p.v_prompt = o; o += (size_t)ROWS_P * D;
  p.k_sample = o; o += (size_t)256 * D;
  p.v_sample = o; o += (size_t)256 * D;
  p.hgrn_prompt = o; o += (size_t)2 * 16 * 8 * 16384;
  p.hgrn_sample = o; o += (size_t)2 * 8 * 8 * 16384;
  p.conv_prompt = o; o += (size_t)4 * 16 * 2 * DFF;
  p.conv_sample = o;
  u16* ws = (u16*)d_ws;
  p.wt_in_a = ws; ws += (size_t)2 * 4096 * 1024;
  p.wt_out_a = ws; ws += (size_t)2 * 1024 * 1024;
  p.wt_kv = ws; ws += (size_t)2048 * 1024;
  p.wt_q = ws; ws += (size_t)2 * 1024 * 1024;
  p.wt_out_b = ws; ws += (size_t)2 * 1024 * 1024;
  p.wt_ffn_in = ws; ws += (size_t)4 * 5632 * 1024;
  p.wt_ffn_out = ws; ws += (size_t)4 * 1024 * DFF;
  p.wt_ple = ws; ws += (size_t)4 * 1024 * 256;
  p.wt_gate = ws; ws += (size_t)4 * 1024 * 1024;
  p.XB = ws; ws += (size_t)ROWS * 1024;
  p.OG = ws; ws += (size_t)ROWS * 1024;
  p.BIG = (char*)ws;
  p.bar = (unsigned*)((char*)d_ws + ((size_t)500 << 20));
  p.ss = (float*)((char*)d_ws + ((size_t)501 << 20));
  int n = 0;
  for (int i = 0; i < 2; ++i) p.wd[n++] = WD{w_in_a + (size_t)i * 1024 * 4096, p.wt_in_a + (size_t)i * 4096 * 1024, i ? p.g_norms + 4 * D : nullptr, 1024, 4096, 0, 0};
  for (int i = 0; i < 2; ++i) p.wd[n++] = WD{w_out_a + (size_t)i * 1024 * 1024, p.wt_out_a + (size_t)i * 1024 * 1024, nullptr, 1024, 1024, 0, 0};
  p.wd[n++] = WD{w_kv, p.wt_kv, p.g_kv, 1024, 2048, 0, 0};
  for (int i = 0; i < 2; ++i) p.wd[n++] = WD{w_q_b + (size_t)i * 1024 * 1024, p.wt_q + (size_t)i * 1024 * 1024, p.g_norms + (size_t)(i + 2) * 4 * D, 1024, 1024, 0, 0};
  for (int i = 0; i < 2; ++i) p.wd[n++] = WD{w_out_b + (size_t)i * 1024 * 1024, p.wt_out_b + (size_t)i * 1024 * 1024, nullptr, 1024, 1024, 0, 0};
  for (int i = 0; i < 4; ++i) p.wd[n++] = WD{w_ffn_in + (size_t)i * 1024 * 5632, p.wt_ffn_in + (size_t)i * 5632 * 1024, nullptr, 1024, 5632, 1, 0};
  for (int i = 0; i < 4; ++i) p.wd[n++] = WD{w_ffn_out + (size_t)i * DFF * 1024, p.wt_ffn_out + (size_t)i * 1024 * DFF, nullptr, DFF, 1024, 0, 0};
  for (int i = 0; i < 4; ++i) p.wd[n++] = WD{w_ple + (size_t)i * 256 * 1024, p.wt_ple + (size_t)i * 1024 * 256, nullptr, 256, 1024, 0, 0};
  for (int i = 0; i < 4; ++i) p.wd[n++] = WD{w_ple_gate + (size_t)i * 1024 * 1024, p.wt_gate + (size_t)i * 1024 * 1024, nullptr, 1024, 1024, 0, 0};
  void* args[] = {&p};
  hipError_t e = hipLaunchCooperativeKernel((void*)yoco_megakernel, dim3(grid_blocks), dim3(256), args, 0, stream);
  if (e != hipSuccess) fprintf(stderr, "cooperative launch failed: %s (grid %d)\n", hipGetErrorString(e), grid_blocks);
}
```

```cpp
#include <hip/hip_runtime.h>
#include <hip/hip_cooperative_groups.h>
#include <cstdio>
namespace cg = cooperative_groups;

#define DI __device__ __forceinline__
typedef unsigned short u16;
typedef short bf16x8 __attribute__((ext_vector_type(8)));
typedef float f32x16 __attribute__((ext_vector_type(16)));
typedef float f32x4 __attribute__((ext_vector_type(4)));
typedef __bf16 bf2_t __attribute__((ext_vector_type(2)));
typedef float f2_t __attribute__((ext_vector_type(2)));
typedef unsigned u32x2 __attribute__((ext_vector_type(2)));
typedef unsigned u32x4 __attribute__((ext_vector_type(4)));

constexpr int D = 1024, ROWS_P = 32768, ROWS = 33024, DFF = 2816;
constexpr float EPS = 1e-6f;
constexpr float LOG2E = 1.4426950408889634f;
constexpr int NW = 25;
#ifndef REP_GEMM
#define REP_GEMM 1
#endif
#ifndef REP_GLA
#define REP_GLA 1
#endif
#ifndef REP_ATTN
#define REP_ATTN 1
#endif
#define REPG for (int _r = 0; _r < REP_GEMM; ++_r)

struct WD { const float* src; u16* dst; const float* gain; int K, N, mode, pad; };

struct P {
  const float *x_prompt, *x_sample, *cache_k, *cache_v, *state_hgrn, *state_conv, *p_prompt, *p_sample;
  const float *g_norms, *lb_raw, *g_hg, *g_kv, *rel_bias, *lam_b, *g_subln, *conv_w, *conv_b;
  float *y, *k_prompt, *v_prompt, *k_sample, *v_sample, *hgrn_prompt, *hgrn_sample, *conv_prompt, *conv_sample;
  u16 *wt_in_a, *wt_out_a, *wt_kv, *wt_q, *wt_out_b, *wt_ffn_in, *wt_ffn_out, *wt_ple, *wt_gate;
  u16 *XB, *OG; char* BIG; unsigned* bar; float* ss;
  WD wd[NW];
};

DI unsigned pk2(float a, float b) { f2_t v = {a, b}; bf2_t r = __builtin_convertvector(v, bf2_t); return __builtin_bit_cast(unsigned, r); }
DI int ltid() { int t = threadIdx.x; asm volatile("" : "+v"(t)); return t; }
DI float bf2f(u16 x) { return __uint_as_float(((unsigned)x) << 16); }
DI float bflo(unsigned x) { return __uint_as_float(x << 16); }
DI float bfhi(unsigned x) { return __uint_as_float(x & 0xffff0000u); }
DI float sigm(float x) { return 1.f / (1.f + __expf(-x)); }
DI float wave_sum(float v) {
#pragma unroll
  for (int o = 32; o; o >>= 1) v += __shfl_xor(v, o);
  return v;
}
DI bf16x8 mk8(u32x2 lo, u32x2 hi) { u32x4 t = {lo[0], lo[1], hi[0], hi[1]}; return __builtin_bit_cast(bf16x8, t); }
DI bf16x8 mk8u(unsigned a, unsigned b, unsigned c, unsigned d) { u32x4 t = {a, b, c, d}; return __builtin_bit_cast(bf16x8, t); }

DI void prep_phase(const P& p, char* smem) {
  float* T = (float*)smem;
  const int tid = ltid();
  int total = 0;
  for (int i = 0; i < NW; ++i) total += (p.wd[i].K >> 6) * (p.wd[i].N >> 6);
  for (int flat = blockIdx.x; flat < total; flat += gridDim.x) {
    int wi = 0, base = 0;
    for (;;) { int nt = (p.wd[wi].K >> 6) * (p.wd[wi].N >> 6); if (flat < base + nt) break; base += nt; ++wi; }
    const WD& d = p.wd[wi];
    const int tix = flat - base, ntn = d.N >> 6;
    const int k0 = (tix / ntn) << 6, n0 = (tix % ntn) << 6;
    {
      const int n = tid & 63, kb = tid >> 6;
#pragma unroll
      for (int j = 0; j < 16; ++j) { int k = kb + 4 * j; float v = d.src[(size_t)(k0 + k) * d.N + n0 + n]; if (d.gain) v *= d.gain[k0 + k]; T[k * 65 + n] = v; }
    }
    __syncthreads();
    {
      const int nn = tid >> 2, ks = tid & 3;
      int n = n0 + nn, drow = n;
      if (d.mode == 1) { int isu = n >= DFF; int ch = n - DFF * isu; drow = 256 * (ch >> 7) + 64 * ((ch >> 5) & 3) + 32 * isu + (ch & 31); }
      unsigned o[8];
#pragma unroll
      for (int j = 0; j < 8; ++j) o[j] = pk2(T[(16 * ks + 2 * j) * 65 + nn], T[(16 * ks + 2 * j + 1) * 65 + nn]);
      u16* fb = d.dst + (((size_t)(drow >> 5) * (d.K >> 4) + ((k0 >> 4) + ks)) * 64 + (drow & 31)) * 8;
      *(u32x4*)(fb) = (u32x4){o[0], o[1], o[2], o[3]};
      *(u32x4*)(fb + 256) = (u32x4){o[4], o[5], o[6], o[7]};
    }
    __syncthreads();
  }
}

DI void rowop_phase(const P& p, bool x_from_in, const u16* __restrict__ Madd, const float* __restrict__ gpost,
                    const float* __restrict__ gnext, u16* __restrict__ outH, const float* ple_p, const float* ple_s, u16* outP) {
  const int tidr = ltid();
  const int lane = tidr & 63;
  const int wave = (blockIdx.x * blockDim.x + tidr) >> 6;
  const int nwave = (gridDim.x * blockDim.x) >> 6;
  for (int rb = wave * 2; rb < ROWS; rb += nwave * 2) {
    f32x4 x[2][4];
    u32x2 m[2][4];
#pragma unroll
    for (int u = 0; u < 2; ++u) {
      const int r = rb + u;
      const float* xs = x_from_in ? (r < ROWS_P ? p.x_prompt + (size_t)r * D : p.x_sample + (size_t)(r - ROWS_P) * D) : p.y + (size_t)r * D;
#pragma unroll
      for (int j = 0; j < 4; ++j) x[u][j] = *(const f32x4*)(xs + 4 * lane + 256 * j);
      if (Madd) {
#pragma unroll
        for (int j = 0; j < 4; ++j) m[u][j] = *(const u32x2*)(Madd + (size_t)r * D + 4 * lane + 256 * j);
      }
    }
#pragma unroll
    for (int u = 0; u < 2; ++u) {
      const int r = rb + u;
      if (Madd) {
        f32x4 mf[4]; float ss = 0.f;
#pragma unroll
        for (int j = 0; j < 4; ++j) { mf[j] = (f32x4){bflo(m[u][j][0]), bfhi(m[u][j][0]), bflo(m[u][j][1]), bfhi(m[u][j][1])}; ss += mf[j][0] * mf[j][0] + mf[j][1] * mf[j][1] + mf[j][2] * mf[j][2] + mf[j][3] * mf[j][3]; }
        ss = wave_sum(ss);
        const float rs = rsqrtf(ss * (1.f / D) + EPS);
#pragma unroll
        for (int j = 0; j < 4; ++j) { f32x4 g = *(const f32x4*)(gpost + 4 * lane + 256 * j); x[u][j] += mf[j] * rs * g; }
#pragma unroll
        for (int j = 0; j < 4; ++j) *(f32x4*)(p.y + (size_t)r * D + 4 * lane + 256 * j) = x[u][j];
      }
      float rx = 1.f;
      if (gnext) {
        float ss = 0.f;
#pragma unroll
        for (int j = 0; j < 4; ++j) ss += x[u][j][0] * x[u][j][0] + x[u][j][1] * x[u][j][1] + x[u][j][2] * x[u][j][2] + x[u][j][3] * x[u][j][3];
        ss = wave_sum(ss);
        rx = rsqrtf(ss * (1.f / D) + EPS);
      }
#pragma unroll
      for (int j = 0; j < 4; ++j) {
        f32x4 h = x[u][j] * rx;
        if (gnext) h *= *(const f32x4*)(gnext + 4 * lane + 256 * j);
        *(u32x2*)(outH + (size_t)r * D + 4 * lane + 256 * j) = (u32x2){pk2(h[0], h[1]), pk2(h[2], h[3])};
      }
      if (outP) {
        const float* ps = r < ROWS_P ? ple_p + (size_t)r * 256 : ple_s + (size_t)(r - ROWS_P) * 256;
        f32x4 v = *(const f32x4*)(ps + 4 * lane);
        *(u32x2*)(outP + (size_t)r * 256 + 4 * lane) = (u32x2){pk2(v[0], v[1]), pk2(v[2], v[3])};
      }
    }
  }
}

template <class RowMap>
DI void gemm_core(const u16* __restrict__ A, int lda, RowMap rm, const u16* __restrict__ Bt, int n0, int K,
                  f32x16 (&acc)[4][2], char* smem, const int tid) {
  const int l = tid & 63, w = tid >> 6, l32 = l & 31, hh = l >> 5;
  const int lr = tid >> 3, lc = tid & 7;
  const u16* ap[4];
#pragma unroll
  for (int q = 0; q < 4; ++q) ap[q] = A + (size_t)rm(q * 32 + lr) * lda + lc * 8;
  const u16* bq0 = Bt + ((size_t)((n0 + w * 64) >> 5) * (K >> 4) * 64 + l) * 8;
  const u16* bq1 = bq0 + (size_t)(K >> 4) * 512;
  const unsigned woff = lr * 128 + ((lc ^ ((lr >> 1) & 7)) << 4);
  const int swz = (l32 >> 1) & 7;
  const unsigned aoff = l32 * 128;
  u32x4 ra0[4];
  bf16x8 bf0[4], bf1[4];
  const int nk = K >> 6;
#define GLOADA(RA, T) _Pragma("unroll") for (int q = 0; q < 4; ++q) { RA[q] = *(const u32x4*)(ap[q] + (T) * 64); }
#define SWRITEA(RA, BUF) { char* db_ = smem + (BUF) * 16384; _Pragma("unroll") for (int q = 0; q < 4; ++q) { *(u32x4*)(db_ + woff + q * 4096) = RA[q]; } }
#define COMPUTE(BUF, TN, MORE) { const char* sb = smem + (BUF) * 16384; _Pragma("unroll") for (int ks = 0; ks < 4; ++ks) { \
      const unsigned co = ((2 * ks + hh) ^ swz) << 4; \
      bf16x8 a0 = *(const bf16x8*)(sb + aoff + co); \
      bf16x8 a1 = *(const bf16x8*)(sb + aoff + 4096 + co); \
      bf16x8 a2 = *(const bf16x8*)(sb + aoff + 8192 + co); \
      bf16x8 a3 = *(const bf16x8*)(sb + aoff + 12288 + co); \
      acc[0][0] = __builtin_amdgcn_mfma_f32_32x32x16_bf16(bf0[ks], a0, acc[0][0], 0, 0, 0); \
      acc[0][1] = __builtin_amdgcn_mfma_f32_32x32x16_bf16(bf1[ks], a0, acc[0][1], 0, 0, 0); \
      acc[1][0] = __builtin_amdgcn_mfma_f32_32x32x16_bf16(bf0[ks], a1, acc[1][0], 0, 0, 0); \
      acc[1][1] = __builtin_amdgcn_mfma_f32_32x32x16_bf16(bf1[ks], a1, acc[1][1], 0, 0, 0); \
      acc[2][0] = __builtin_amdgcn_mfma_f32_32x32x16_bf16(bf0[ks], a2, acc[2][0], 0, 0, 0); \
      acc[2][1] = __builtin_amdgcn_mfma_f32_32x32x16_bf16(bf1[ks], a2, acc[2][1], 0, 0, 0); \
      acc[3][0] = __builtin_amdgcn_mfma_f32_32x32x16_bf16(bf0[ks], a3, acc[3][0], 0, 0, 0); \
      acc[3][1] = __builtin_amdgcn_mfma_f32_32x32x16_bf16(bf1[ks], a3, acc[3][1], 0, 0, 0); \
      if (MORE) { bf0[ks] = *(const bf16x8*)(bq0 + ((TN) * 4 + ks) * 512); bf1[ks] = *(const bf16x8*)(bq1 + ((TN) * 4 + ks) * 512); } \
      __builtin_amdgcn_sched_barrier(0); } }
  GLOADA(ra0, 0);
#pragma unroll
  for (int ks = 0; ks < 4; ++ks) { bf0[ks] = *(const bf16x8*)(bq0 + ks * 512); bf1[ks] = *(const bf16x8*)(bq1 + ks * 512); }
  SWRITEA(ra0, 0);
  __syncthreads();
  for (int kt = 0; kt < nk; kt += 2) {
    GLOADA(ra0, kt + 1);
    __builtin_amdgcn_sched_barrier(0);
    COMPUTE(0, kt + 1, true);
    SWRITEA(ra0, 1);
    __syncthreads();
    if (kt + 2 < nk) GLOADA(ra0, kt + 2);
    __builtin_amdgcn_sched_barrier(0);
    COMPUTE(1, kt + 2, kt + 2 < nk);
    if (kt + 2 < nk) SWRITEA(ra0, 0);
    __syncthreads();
  }
#undef GLOADA
#undef SWRITEA
#undef COMPUTE
}

DI bool next_tile(int it, int ntm, int ntn, int& tm, int& tn) {
  const int b = blockIdx.x, x = b & 7, slot = b >> 3, S = gridDim.x >> 3;
  const int nq = (ntm - x + 7) >> 3;
  const int L = slot + it * S;
  if (L >= nq * ntn) return false;
  const int gsize = 8 * ntn;
  const int grp = L / gsize, r = L - grp * gsize;
  const int gsz = min(8, nq - 8 * grp);
  tn = r / gsz;
  tm = x + 8 * (8 * grp + r % gsz);
  return true;
}

struct IdMap { int base; DI int operator()(int r) const { return base + r; } };
struct ClampMap { int rowbase, t0, T; DI int operator()(int r) const { int t = t0 + r; t = t < 0 ? 0 : (t > T - 1 ? T - 1 : t); return rowbase + t; } };

#define ZERO_ACC(a) _Pragma("unroll") for (int _i = 0; _i < 4; ++_i) _Pragma("unroll") for (int _j = 0; _j < 2; ++_j) _Pragma("unroll") for (int _e = 0; _e < 16; ++_e) a[_i][_j][_e] = 0.f;

template <int EPI>
DI void gemm_phase(const P& p, const u16* A, int K, const u16* Bt, int N, void* outp, char* smem, const float* rowss = nullptr) {
  const int tid = ltid(), l = tid & 63, w = tid >> 6, l32 = l & 31, hh = l >> 5;
  const int ntm = ROWS / 128, ntn = N / 256;
  int tm, tn;
  for (int it = 0; next_tile(it, ntm, ntn, tm, tn); ++it) {
    f32x16 acc[4][2];
    ZERO_ACC(acc);
    gemm_core(A, K, IdMap{tm * 128}, Bt, tn * 256, K, acc, smem, tid);
    const int n0 = tn * 256;
#pragma unroll
    for (int mi = 0; mi < 4; ++mi) {
      const int m = tm * 128 + mi * 32 + l32;
      float rsc = 1.f;
      if (rowss) { const f32x4* sp = (const f32x4*)(rowss + (size_t)m * 16); const f32x4 s0 = sp[0], s1 = sp[1], s2 = sp[2], s3 = sp[3];
        const float tot = ((s0[0] + s0[1]) + (s0[2] + s0[3])) + ((s1[0] + s1[1]) + (s1[2] + s1[3])) + ((s2[0] + s2[1]) + (s2[2] + s2[3])) + ((s3[0] + s3[1]) + (s3[2] + s3[3]));
        rsc = rsqrtf(tot * (1.f / D) + EPS); }
#pragma unroll
      for (int ni = 0; ni < 2; ++ni)
#pragma unroll
        for (int q = 0; q < 4; ++q) {
          const int n = n0 + w * 64 + ni * 32 + 8 * q + 4 * hh;
          float v0 = acc[mi][ni][4 * q] * rsc, v1 = acc[mi][ni][4 * q + 1] * rsc, v2 = acc[mi][ni][4 * q + 2] * rsc, v3 = acc[mi][ni][4 * q + 3] * rsc;
          if (EPI == 0) {
            const int sec = n0 >> 10;
            if (sec == 0 || sec == 3) { v0 *= sigm(v0); v1 *= sigm(v1); v2 *= sigm(v2); v3 *= sigm(v3); }
            *(u32x2*)((u16*)outp + (size_t)m * 4096 + n) = (u32x2){pk2(v0, v1), pk2(v2, v3)};
          } else if (EPI == 1) {
            const float sc = 0.125f * LOG2E;
            *(u32x2*)((u16*)outp + (size_t)m * 1024 + n) = (u32x2){pk2(v0 * sc, v1 * sc), pk2(v2 * sc, v3 * sc)};
          } else if (EPI == 2) {
            *(u32x2*)((u16*)outp + (size_t)m * 1024 + n) = (u32x2){pk2(v0, v1), pk2(v2, v3)};
          } else {
            float* dst;
            if (n < 1024) dst = (m < ROWS_P ? p.k_prompt + (size_t)m * 1024 : p.k_sample + (size_t)(m - ROWS_P) * 1024) + n;
            else dst = (m < ROWS_P ? p.v_prompt + (size_t)m * 1024 : p.v_sample + (size_t)(m - ROWS_P) * 1024) + (n - 1024);
            *(f32x4*)dst = (f32x4){v0, v1, v2, v3};
          }
        }
    }
  }
}

DI void ple_phase(const P& p, int layer, char* smem) {
  const int tid = ltid(), l = tid & 63, w = tid >> 6, l32 = l & 31, hh = l >> 5;
  const u16* XB2 = (const u16*)p.BIG;
  const u16* PB = (const u16*)(p.BIG + (size_t)ROWS * 1024 * 2);
  u16* PL = (u16*)(p.BIG + (size_t)ROWS * 1024 * 2 + (size_t)ROWS * 256 * 2);
  const u16* Wg = p.wt_gate + (size_t)layer * 1024 * 1024;
  const u16* Wp = p.wt_ple + (size_t)layer * 1024 * 256;
  int tm, tn;
  for (int it = 0; next_tile(it, ROWS / 128, 4, tm, tn); ++it) {
      f32x16 acc2[4][2];
      ZERO_ACC(acc2);
      gemm_core(PB, 256, IdMap{tm * 128}, Wp, tn * 256, 256, acc2, smem, tid);
#pragma unroll
      for (int mi = 0; mi < 4; ++mi)
#pragma unroll
        for (int ni = 0; ni < 2; ++ni)
#pragma unroll
          for (int q = 0; q < 4; ++q)
            *(u32x2*)(PL + (size_t)(tm * 128 + mi * 32 + l32) * D + tn * 256 + w * 64 + ni * 32 + 8 * q + 4 * hh) =
                (u32x2){pk2(acc2[mi][ni][4 * q], acc2[mi][ni][4 * q + 1]), pk2(acc2[mi][ni][4 * q + 2], acc2[mi][ni][4 * q + 3])};
  }
  for (int it = 0; next_tile(it, ROWS / 128, 4, tm, tn); ++it) {
    f32x16 acc[4][2];
    ZERO_ACC(acc);
    gemm_core(XB2, 1024, IdMap{tm * 128}, Wg, tn * 256, 1024, acc, smem, tid);
#pragma unroll
    for (int mi = 0; mi < 4; ++mi) {
      const int m = tm * 128 + mi * 32 + l32;
      float ssq = 0.f;
#pragma unroll
      for (int ni = 0; ni < 2; ++ni)
#pragma unroll
        for (int q = 0; q < 4; ++q) {
          const int n = tn * 256 + w * 64 + ni * 32 + 8 * q + 4 * hh;
          f32x4* xp = (f32x4*)(p.y + (size_t)m * D + n);
          f32x4 x = *xp;
          const u32x2 pv = *(const u32x2*)(PL + (size_t)m * D + n);
          x[0] += sigm(acc[mi][ni][4 * q]) * bflo(pv[0]);
          x[1] += sigm(acc[mi][ni][4 * q + 1]) * bfhi(pv[0]);
          x[2] += sigm(acc[mi][ni][4 * q + 2]) * bflo(pv[1]);
          x[3] += sigm(acc[mi][ni][4 * q + 3]) * bfhi(pv[1]);
          *xp = x;
          *(u32x2*)(p.XB + (size_t)m * D + n) = (u32x2){pk2(x[0], x[1]), pk2(x[2], x[3])};
          ssq += x[0] * x[0] + x[1] * x[1] + x[2] * x[2] + x[3] * x[3];
        }
      ssq += __shfl_xor(ssq, 32);
      if (hh == 0) p.ss[(size_t)m * 16 + tn * 4 + w] = ssq;
    }
  }
}

DI void ffn_in_phase(const P& p, int layer, char* smem) {
  const int tid = ltid(), l = tid & 63, w = tid >> 6, l32 = l & 31, hh = l >> 5;
  const u16* Wt = p.wt_ffn_in + (size_t)layer * 5632 * 1024;
  u16* HID = (u16*)p.BIG;
  const float* cw = p.conv_w + (size_t)layer * 3 * DFF;
  const float* cb = p.conv_b + (size_t)layer * DFF;
  int tm, tn;
  for (int it = 0; next_tile(it, 280, 22, tm, tn); ++it) {
    int seq, T, rowbase, t0; bool last;
    if (tm < 272) { seq = tm / 17; int j = tm - seq * 17; T = 2048; rowbase = seq * 2048; t0 = 126 * j - 2; last = (j == 16); }
    else { seq = 16 + (tm - 272); T = 32; rowbase = ROWS_P + (tm - 272) * 32; t0 = -2; last = true; }
    f32x16 acc[4][2];
    ZERO_ACC(acc);
    gemm_core(p.XB, 1024, ClampMap{rowbase, t0, T}, Wt, tn * 256, 1024, acc, smem, tid);
    const int chw = tn * 128 + w * 32;
    if (t0 < 0 && l32 < 2) {
#pragma unroll
      for (int q = 0; q < 4; ++q) {
        f32x4 sv = {0.f, 0.f, 0.f, 0.f};
        if (seq >= 16) sv = *(const f32x4*)(p.state_conv + ((size_t)(layer * 8 + (seq - 16)) * 2 + l32) * DFF + chw + 8 * q + 4 * hh);
#pragma unroll
        for (int c = 0; c < 4; ++c) acc[0][0][4 * q + c] = sv[c];
      }
    }
    const int lbase = l & 32;
#pragma unroll
    for (int q = 0; q < 4; ++q) {
      const int chq = chw + 8 * q + 4 * hh;
      const f32x4 b4 = *(const f32x4*)(cb + chq);
      const f32x4 w0 = *(const f32x4*)(cw + chq), w1 = *(const f32x4*)(cw + DFF + chq), w2 = *(const f32x4*)(cw + 2 * DFF + chq);
#pragma unroll
      for (int mi = 0; mi < 4; ++mi) {
        const int m = mi * 32 + l32;
        const int t = t0 + m;
        float hv[4];
#pragma unroll
        for (int c = 0; c < 4; ++c) {
          const float g0 = acc[mi][0][4 * q + c];
          float g1 = __shfl(g0, lbase + ((l32 + 31) & 31));
          float g2 = __shfl(g0, lbase + ((l32 + 30) & 31));
          if (mi > 0) {
            const float pg = acc[mi > 0 ? mi - 1 : 0][0][4 * q + c];
            const float p1 = __shfl(pg, lbase + 31), p2 = __shfl(pg, lbase + 30);
            if (l32 == 0) { g1 = p1; g2 = p2; }
            if (l32 == 1) { g2 = p1; }
          }
          const float cv = b4[c] + w0[c] * g2 + w1[c] * g1 + w2[c] * g0;
          hv[c] = cv * sigm(cv) * acc[mi][1][4 * q + c];
        }
        if (m >= 2 && t < T) {
          *(u32x2*)(HID + (size_t)(rowbase + t) * DFF + chq) = (u32x2){pk2(hv[0], hv[1]), pk2(hv[2], hv[3])};
          if (last && t >= T - 2) {
            float* co = seq < 16 ? p.conv_prompt + ((size_t)(layer * 16 + seq) * 2 + (t - (T - 2))) * DFF
                                 : p.conv_sample + ((size_t)(layer * 8 + (seq - 16)) * 2 + (t - (T - 2))) * DFF;
            *(f32x4*)(co + chq) = (f32x4){acc[mi][0][4 * q], acc[mi][0][4 * q + 1], acc[mi][0][4 * q + 2], acc[mi][0][4 * q + 3]};
          }
        }
      }
    }
  }
}

DI void gla_state_phase(const P& p, int layer, char* smem) {
  const u16* PROJ = (const u16*)p.BIG;
  const int tid = ltid(), l = tid & 63, w = tid >> 6, l32 = l & 31, hh = l >> 5;
  float* SLOC = (float*)p.XB;
  float* DTOT = SLOC + (size_t)384 * 16384;
  const int k = tid >> 1, th = tid & 1;
  for (int item = blockIdx.x; item < 384; item += gridDim.x) {
    const int sh = item / 3, ch = item - sh * 3, s = sh >> 3, h = sh & 7;
    const int rowbase = s * 2048 + ch * 512;
    float lower = 0.f;
    if (layer == 1) lower = sigm(p.lb_raw[1024 + h * 128 + k] - p.lb_raw[h * 128 + k]);
    const float oml = 1.f - lower;
    f32x16 S[4];
#pragma unroll
    for (int kt = 0; kt < 4; ++kt)
#pragma unroll
      for (int i = 0; i < 16; ++i) S[kt][i] = 0.f;
    float btot = 0.f;
    u16 fr[8], vr[8];
#define GS_LOAD(BLK) { const size_t r0_ = (size_t)rowbase + (BLK) * 16; \
      const u16* pf_ = PROJ + (r0_ + 8 * th) * 4096 + 1024 + h * 128 + k; \
      const u16* pv_ = PROJ + r0_ * 4096 + 2048 + h * 128 + 32 * w + l32; \
      _Pragma("unroll") for (int t = 0; t < 8; ++t) fr[t] = pf_[(size_t)t * 4096]; \
      _Pragma("unroll") for (int jj = 0; jj < 8; ++jj) vr[jj] = pv_[(size_t)(8 * (jj >> 2) + 4 * hh + (jj & 3)) * 4096]; }
    GS_LOAD(0);
    for (int blk = 0; blk < 32; ++blk) {
      char* sb = smem + (blk & 1) * 8192;
      u16* KDT = (u16*)sb;
      float* DD = (float*)(KDT + 128 * 20);
      {
        float km[8], eb[8];
        float bs = 0.f;
#pragma unroll
        for (int t = 0; t < 8; ++t) {
          const float f = bf2f(fr[t]);
          const float g = lower + oml * sigm(f);
          bs += __logf(g);
          km[t] = 1.f - g; eb[t] = bs;
        }
        const float other = __shfl_xor(bs, 1);
        const float boff = th ? other : 0.f;
        const float bsum = bs + other;
        btot += bsum;
        unsigned kdp[4];
#pragma unroll
        for (int j = 0; j < 4; ++j)
          kdp[j] = pk2(km[2 * j] * __expf(bsum - boff - eb[2 * j]), km[2 * j + 1] * __expf(bsum - boff - eb[2 * j + 1]));
        *(u32x2*)(KDT + k * 20 + 8 * th) = (u32x2){kdp[0], kdp[1]};
        *(u32x2*)(KDT + k * 20 + 8 * th + 4) = (u32x2){kdp[2], kdp[3]};
        if (th == 0) DD[k] = __expf(bsum);
      }
      const bf16x8 vfrag = mk8u((unsigned)vr[0] | ((unsigned)vr[1] << 16), (unsigned)vr[2] | ((unsigned)vr[3] << 16),
                                (unsigned)vr[4] | ((unsigned)vr[5] << 16), (unsigned)vr[6] | ((unsigned)vr[7] << 16));
      if (blk + 1 < 32) GS_LOAD(blk + 1);
      __syncthreads();
#pragma unroll
      for (int kt = 0; kt < 4; ++kt) {
#pragma unroll
        for (int q = 0; q < 4; ++q) {
          const f32x4 d4 = *(const f32x4*)(DD + 32 * kt + 8 * q + 4 * hh);
#pragma unroll
          for (int c = 0; c < 4; ++c) S[kt][4 * q + c] *= d4[c];
        }
        const u32x2 lo = *(const u32x2*)(KDT + (32 * kt + l32) * 20 + 4 * hh);
        const u32x2 hi = *(const u32x2*)(KDT + (32 * kt + l32) * 20 + 8 + 4 * hh);
        S[kt] = __builtin_amdgcn_mfma_f32_32x32x16_bf16(mk8(lo, hi), vfrag, S[kt], 0, 0, 0);
      }
    }
#undef GS_LOAD
    {
      float* op = SLOC + (size_t)item * 16384 + 32 * w + l32;
#pragma unroll
      for (int kt = 0; kt < 4; ++kt)
#pragma unroll
        for (int i = 0; i < 16; ++i) op[(size_t)(32 * kt + (i & 3) + 8 * (i >> 2) + 4 * hh) * 128] = S[kt][i];
      if (th == 0) DTOT[(size_t)item * 128 + k] = __expf(btot);
    }
    __syncthreads();
  }
}

DI void gla_phase(const P& p, int layer, char* smem) {
  const u16* PROJ = (const u16*)p.BIG;
  const int tid = ltid(), l = tid & 63, w = tid >> 6, l32 = l & 31, hh = l >> 5, m16 = l & 15;
  float* REDB = (float*)(smem + 2 * 14336);
  const int k = tid >> 1, th = tid & 1;
  const float* SLOC = (const float*)p.XB;
  const float* DTOT = SLOC + (size_t)384 * 16384;
  for (int item = blockIdx.x; item < 576; item += gridDim.x) {
    const bool smp = item < 64;
    const int s = smp ? 16 + (item >> 3) : (item - 64) >> 5;
    const int h = smp ? (item & 7) : ((item - 64) >> 2) & 7;
    const int ch = smp ? 0 : (item - 64) & 3;
    const int T = smp ? 32 : 512;
    const int rowbase = smp ? ROWS_P + (s - 16) * 32 : s * 2048 + ch * 512;
    float lower = 0.f;
    if (layer == 1) lower = sigm(p.lb_raw[1024 + h * 128 + k] - p.lb_raw[h * 128 + k]);
    const float oml = 1.f - lower;
    f32x16 S[4];
    if (smp) {
      const float* sp = p.state_hgrn + ((size_t)(layer * 8 + (s - 16)) * 8 + h) * 16384 + 32 * w + l32;
#pragma unroll
      for (int kt = 0; kt < 4; ++kt)
#pragma unroll
        for (int i = 0; i < 16; ++i) S[kt][i] = sp[(size_t)(32 * kt + (i & 3) + 8 * (i >> 2) + 4 * hh) * 128];
    } else {
#pragma unroll
      for (int kt = 0; kt < 4; ++kt)
#pragma unroll
        for (int i = 0; i < 16; ++i) S[kt][i] = 0.f;
#pragma unroll 1
      for (int j = 0; j < ch; ++j) {
        const int it1 = (s * 8 + h) * 3 + j;
        const float* sl = SLOC + (size_t)it1 * 16384 + 32 * w + l32 + (size_t)(4 * hh) * 128;
        const float* dl = DTOT + (size_t)it1 * 128 + 4 * hh;
#pragma unroll
        for (int kt = 0; kt < 4; ++kt) {
#pragma unroll
          for (int q = 0; q < 4; ++q) {
            const float* slq = sl + (size_t)(32 * kt + 8 * q) * 128;
            const f32x4 d4 = *(const f32x4*)(dl + 32 * kt + 8 * q);
#pragma unroll
            for (int c = 0; c < 4; ++c) S[kt][4 * q + c] = S[kt][4 * q + c] * d4[c] + slq[c * 128];
            __builtin_amdgcn_sched_barrier(0);
          }
        }
      }
    }
    const int nblk = T >> 4;
    u16 fr[8], qr[8], vr[8];
#define GLA_LOADRAW(BLK) { const size_t r0_ = (size_t)rowbase + (BLK) * 16; \
      const u16* pf_ = PROJ + (r0_ + 8 * th) * 4096 + 1024 + h * 128 + k; \
      const u16* pq_ = PROJ + (r0_ + 8 * th) * 4096 + h * 128 + k; \
      _Pragma("unroll") for (int t = 0; t < 8; ++t) fr[t] = pf_[(size_t)t * 4096]; \
      _Pragma("unroll") for (int j = 0; j < 8; ++j) qr[j] = pq_[(size_t)j * 4096]; \
 }
#define GLA_LOADV(BLK) { const u16* pv_ = PROJ + ((size_t)rowbase + (BLK) * 16) * 4096 + 2048 + h * 128 + 32 * w + l32; \
      _Pragma("unroll") for (int jj = 0; jj < 8; ++jj) vr[jj] = pv_[(size_t)(8 * (jj >> 2) + 4 * hh + (jj & 3)) * 4096]; }
#define GLA_LOADGS(BLK) { const u16* pg_ = PROJ + ((size_t)rowbase + (BLK) * 16 + m16) * 4096 + 3072 + h * 128 + 32 * w + 4 * hh; \
      _Pragma("unroll") for (int q = 0; q < 4; ++q) gsl[q] = *(const u32x2*)(pg_ + 8 * q); }
#define GLA_FINAL(BLK) { const float* RED_ = REDB + ((BLK) & 1) * 64; \
      if (l32 < 16) { \
        const float tot = RED_[l32] + RED_[16 + l32] + RED_[32 + l32] + RED_[48 + l32]; \
        const float rn = rsqrtf(tot * (1.f / 128.f) + EPS); \
        u16* op_ = p.OG + ((size_t)rowbase + (BLK) * 16 + l32) * 1024 + h * 128 + 32 * w + 4 * hh; \
        const float* gp_ = p.g_hg + layer * 1024 + h * 128 + 32 * w + 4 * hh; \
        _Pragma("unroll") for (int q = 0; q < 4; ++q) { const f32x4 gh = *(const f32x4*)(gp_ + 8 * q); \
          *(u32x2*)(op_ + 8 * q) = (u32x2){pk2(oacc[4 * q] * rn * gh[0] * bflo(gsl[q][0]), oacc[4 * q + 1] * rn * gh[1] * bfhi(gsl[q][0])), \
                                          pk2(oacc[4 * q + 2] * rn * gh[2] * bflo(gsl[q][1]), oacc[4 * q + 3] * rn * gh[3] * bfhi(gsl[q][1]))}; } \
      } }
    GLA_LOADRAW(0);
    u32x2 gsl[4];
    for (int blk = 0; blk < nblk; ++blk) {
      GLA_LOADGS(blk);
      GLA_LOADV(blk);
      char* sb = smem + (blk & 1) * 14336;
      u16* QT = (u16*)sb;
      u16* KT = QT + 16 * 136;
      u16* KDT = KT + 16 * 136;
      float* DD = (float*)(KDT + 128 * 20);
      {
        float qtm[8], ktm[8];
        float bs = 0.f;
#pragma unroll
        for (int t = 0; t < 8; ++t) {
          const float f = bf2f(fr[t]);
          const float g = lower + oml * sigm(f);
          bs += __logf(g);
          const float eb = __expf(bs);
          qtm[t] = bf2f(qr[t]) * eb;
          ktm[t] = (1.f - g) * __builtin_amdgcn_rcpf(eb);
        }
        const float other = __shfl_xor(bs, 1);
        const float boff = th ? other : 0.f;
        const float bsum = bs + other;
        const float E1 = __expf(boff), E1i = __expf(-boff), EL = __expf(bsum);
        unsigned kdp[4];
        float kdprev = 0.f;
#pragma unroll
        for (int j = 0; j < 8; ++j) {
          const int t = 8 * th + j;
          const float qt = qtm[j] * E1;
          const float ktv = ktm[j] * E1i;
          const float kd = ktv * EL;
          QT[t * 136 + k] = (u16)(pk2(qt, 0.f) & 0xffffu);
          KT[t * 136 + k] = (u16)(pk2(ktv, 0.f) & 0xffffu);
          if (j & 1) kdp[j >> 1] = pk2(kdprev, kd); else kdprev = kd;
        }
        *(u32x2*)(KDT + k * 20 + 8 * th) = (u32x2){kdp[0], kdp[1]};
        *(u32x2*)(KDT + k * 20 + 8 * th + 4) = (u32x2){kdp[2], kdp[3]};
        if (th == 0) DD[k] = __expf(bsum);
      }
      if (blk + 1 < nblk) GLA_LOADRAW(blk + 1);
      __syncthreads();
      const bf16x8 vfrag = mk8u((unsigned)vr[0] | ((unsigned)vr[1] << 16), (unsigned)vr[2] | ((unsigned)vr[3] << 16),
                                (unsigned)vr[4] | ((unsigned)vr[5] << 16), (unsigned)vr[6] | ((unsigned)vr[7] << 16));
      f32x16 aacc, oacc;
#pragma unroll
      for (int i = 0; i < 16; ++i) { aacc[i] = 0.f; oacc[i] = 0.f; }
#pragma unroll
      for (int ks = 0; ks < 8; ++ks) {
        const bf16x8 ka = *(const bf16x8*)(KT + m16 * 136 + 16 * ks + 8 * hh);
        const bf16x8 qb = *(const bf16x8*)(QT + m16 * 136 + 16 * ks + 8 * hh);
        aacc = __builtin_amdgcn_mfma_f32_32x32x16_bf16(ka, qb, aacc, 0, 0, 0);
        const int kt = ks >> 1, s2 = ks & 1;
        const bf16x8 sa = mk8u(pk2(S[kt][8 * s2], S[kt][8 * s2 + 1]), pk2(S[kt][8 * s2 + 2], S[kt][8 * s2 + 3]),
                               pk2(S[kt][8 * s2 + 4], S[kt][8 * s2 + 5]), pk2(S[kt][8 * s2 + 6], S[kt][8 * s2 + 7]));
        const u32x2 lo = *(const u32x2*)(QT + m16 * 136 + 32 * kt + 16 * s2 + 4 * hh);
        const u32x2 hi = *(const u32x2*)(QT + m16 * 136 + 32 * kt + 16 * s2 + 8 + 4 * hh);
        oacc = __builtin_amdgcn_mfma_f32_32x32x16_bf16(sa, mk8(lo, hi), oacc, 0, 0, 0);
      }
      float am[8];
#pragma unroll
      for (int i = 0; i < 8; ++i) { const int m = (i & 3) + 8 * (i >> 2) + 4 * hh; am[i] = (m <= m16) ? aacc[i] : 0.f; }
      const bf16x8 afrag = mk8u(pk2(am[0], am[1]), pk2(am[2], am[3]), pk2(am[4], am[5]), pk2(am[6], am[7]));
      oacc = __builtin_amdgcn_mfma_f32_32x32x16_bf16(vfrag, afrag, oacc, 0, 0, 0);
#pragma unroll
      for (int kt = 0; kt < 4; ++kt) {
#pragma unroll
        for (int q = 0; q < 4; ++q) {
          const f32x4 d4 = *(const f32x4*)(DD + 32 * kt + 8 * q + 4 * hh);
#pragma unroll
          for (int c = 0; c < 4; ++c) S[kt][4 * q + c] *= d4[c];
        }
        const u32x2 lo = *(const u32x2*)(KDT + (32 * kt + l32) * 20 + 4 * hh);
        const u32x2 hi = *(const u32x2*)(KDT + (32 * kt + l32) * 20 + 8 + 4 * hh);
        S[kt] = __builtin_amdgcn_mfma_f32_32x32x16_bf16(mk8(lo, hi), vfrag, S[kt], 0, 0, 0);
      }
      float ss = 0.f;
#pragma unroll
      for (int i = 0; i < 16; ++i) ss += oacc[i] * oacc[i];
      ss += __shfl_xor(ss, 32);
      if (l < 16) REDB[(blk & 1) * 64 + w * 16 + l] = ss;
      __syncthreads();
      GLA_FINAL(blk);
    }
#undef GLA_LOADGS
#undef GLA_LOADV
#undef GLA_LOADRAW
#undef GLA_FINAL
    if (smp || ch == 3) {
      float* op = (smp ? p.hgrn_sample + ((size_t)(layer * 8 + (s - 16)) * 8 + h) * 16384
                       : p.hgrn_prompt + ((size_t)(layer * 16 + s) * 8 + h) * 16384) + 32 * w + l32;
#pragma unroll
      for (int kt = 0; kt < 4; ++kt)
#pragma unroll
        for (int i = 0; i < 16; ++i) op[(size_t)(32 * kt + (i & 3) + 8 * (i >> 2) + 4 * hh) * 128] = S[kt][i];
    }
  }
}

DI void kvconv_phase(const P& p) {
  const int tid = ltid();
  char* KVT = p.BIG + (size_t)ROWS * 1024 * 2;
  for (int t = blockIdx.x; t < 4096 + 1088; t += gridDim.x) {
    const float *kb, *vb; int nvalid = 64;
    if (t < 4096) { const int kt = t & 31, sh = t >> 5, s = sh >> 3, h = sh & 7; const size_t off = ((size_t)(s * 2048 + 64 * kt)) * 1024 + h * 128; kb = p.k_prompt + off; vb = p.v_prompt + off; }
    else { const int u = t - 4096; const int kt = u % 17, sh = u / 17, b = sh >> 3, h = sh & 7;
      if (kt < 16) { const size_t off = ((size_t)(b * 1024 + 64 * kt)) * 1024 + h * 128; kb = p.cache_k + off; vb = p.cache_v + off; }
      else { const size_t off = ((size_t)(b * 32)) * 1024 + h * 128; kb = p.k_sample + off; vb = p.v_sample + off; nvalid = 32; } }
    u16* kd = (u16*)(KVT + (size_t)t * 32768);
    u16* vd = kd + 8192;
#pragma unroll
    for (int pp = 0; pp < 4; ++pp) {
      const int key = 16 * pp + (tid >> 4), d8 = (tid & 15) * 8;
      f32x4 a = {0.f, 0.f, 0.f, 0.f}, b2 = {0.f, 0.f, 0.f, 0.f};
      if (key < nvalid) { a = *(const f32x4*)(kb + (size_t)key * 1024 + d8); b2 = *(const f32x4*)(kb + (size_t)key * 1024 + d8 + 4); }
      *(u32x4*)(kd + key * 128 + d8) = (u32x4){pk2(a[0], a[1]), pk2(a[2], a[3]), pk2(b2[0], b2[1]), pk2(b2[2], b2[3])};
    }
#pragma unroll
    for (int c = 0; c < 4; ++c) {
      const int v = tid & 127, cc = 4 * (tid >> 7) + c;
      float e[8];
#pragma unroll
      for (int j = 0; j < 8; ++j) { const int key = 8 * cc + j; e[j] = key < nvalid ? vb[(size_t)key * 1024 + v] : 0.f; }
      *(u32x4*)(vd + v * 64 + 8 * cc) = (u32x4){pk2(e[0], e[1]), pk2(e[2], e[3]), pk2(e[4], e[5]), pk2(e[6], e[7])};
    }
  }
}

DI void attn_phase(const P& p, int layer, char* smem) {
  const int jl = layer - 2;
  const u16* Q = (const u16*)p.BIG;
  const char* KVT = p.BIG + (size_t)ROWS * 1024 * 2;
  const int tid = ltid(), l = tid & 63, w = tid >> 6, l16 = l & 15, g = l >> 4;
  u16* KS = (u16*)smem;
  u16* VT = KS + 64 * 136;
  float* BT = (float*)(VT + 128 * 72);
  u16* QS = (u16*)(BT + 256);
  const float lam_init = 0.8f - 0.6f * __expf(-0.3f * (float)layer);
  float lam;
  {
    const float* lp = p.lam_b + jl * 256;
    float a = 0.f, b = 0.f;
    for (int d = 0; d < 64; ++d) { a += lp[d] * lp[64 + d]; b += lp[128 + d] * lp[192 + d]; }
    lam = __expf(a) - __expf(b) + lam_init;
  }
  for (int item = blockIdx.x; item < 4096 + 64; item += gridDim.x) {
    int b, h, nq, qrow0, qpos0, ntiles, tile0; bool smp;
    if (item < 4096) { const int jq = 31 - (item >> 7); const int bh = item & 127; b = bh >> 3; h = bh & 7; smp = false; nq = 64; qrow0 = b * 2048 + 64 * jq; qpos0 = 64 * jq; ntiles = jq + 1; tile0 = bh * 32; }
    else { const int si = item - 4096; b = si >> 3; h = si & 7; smp = true; nq = 32; qrow0 = ROWS_P + b * 32; qpos0 = 1024; ntiles = 17; tile0 = 4096 + si * 17; }
    __syncthreads();
    if (tid < 230) {
      const int rel = tid - 166;
      const int n = rel < 0 ? -rel : rel;
      int bk = n < 8 ? n : 8 + (n >= 13) + (n >= 20) + (n >= 30) + (n >= 46) + (n >= 70) + (n >= 108) + (n >= 166);
      if (rel > 0) bk += 16;
      BT[tid] = p.rel_bias[bk * 8 + h] * LOG2E;
    }
#pragma unroll
    for (int pp = 0; pp < 4; ++pp) {
      const int idx = pp * 256 + tid, r = idx >> 4, c16 = idx & 15;
      *(u32x4*)(QS + r * 136 + c16 * 8) = *(const u32x4*)(Q + (size_t)(qrow0 + min(r, nq - 1)) * 1024 + h * 128 + c16 * 8);
    }
    f32x4 oacc[2][8];
#pragma unroll
    for (int c = 0; c < 2; ++c)
#pragma unroll
      for (int vs = 0; vs < 8; ++vs) oacc[c][vs] = (f32x4){0.f, 0.f, 0.f, 0.f};
    float mrun[2] = {-1e30f, -1e30f}, lsum[2] = {0.f, 0.f};
    const int qpos = qpos0 + min(16 * w + l16, nq - 1);
    u32x4 rk[4], rv[4];
    {
      const u32x4* src = (const u32x4*)(KVT + (size_t)tile0 * 32768);
#pragma unroll
      for (int pp = 0; pp < 4; ++pp) { rk[pp] = src[pp * 256 + tid]; rv[pp] = src[1024 + pp * 256 + tid]; }
    }
    for (int kt = 0; kt < ntiles; ++kt) {
      const int nvalid = (smp && kt == 16) ? 32 : 64;
      if (kt > 0) __syncthreads();
#pragma unroll
      for (int pp = 0; pp < 4; ++pp) {
        const int idx = pp * 256 + tid;
        *(u32x4*)(KS + (idx >> 4) * 136 + (idx & 15) * 8) = rk[pp];
        *(u32x4*)(VT + (idx >> 3) * 72 + (idx & 7) * 8) = rv[pp];
      }
      if (kt + 1 < ntiles) {
        const u32x4* src = (const u32x4*)(KVT + (size_t)(tile0 + kt + 1) * 32768);
#pragma unroll
        for (int pp = 0; pp < 4; ++pp) { rk[pp] = src[pp * 256 + tid]; rv[pp] = src[1024 + pp * 256 + tid]; }
      }
      __syncthreads();
      f32x4 sacc[2][4];
#pragma unroll
      for (int c = 0; c < 2; ++c)
#pragma unroll
        for (int sub = 0; sub < 4; ++sub) {
          sacc[c][sub] = (f32x4){0.f, 0.f, 0.f, 0.f};
#pragma unroll
          for (int ks = 0; ks < 2; ++ks) {
            const bf16x8 kf = *(const bf16x8*)(KS + (16 * sub + l16) * 136 + c * 64 + 32 * ks + 8 * g);
            const bf16x8 qfr = *(const bf16x8*)(QS + (16 * w + l16) * 136 + c * 64 + 32 * ks + 8 * g);
            sacc[c][sub] = __builtin_amdgcn_mfma_f32_16x16x32_bf16(kf, qfr, sacc[c][sub], 0, 0, 0);
          }
        }
#pragma unroll
      for (int sub = 0; sub < 4; ++sub)
#pragma unroll
        for (int i = 0; i < 4; ++i) {
          const int kl = 16 * sub + 4 * g + i;
          int rel = 64 * kt + kl - qpos;
          rel = rel < -166 ? -166 : rel;
          const float bt = BT[rel + 166];
          const bool ok = kl < nvalid;
          sacc[0][sub][i] = ok ? sacc[0][sub][i] + bt : -30000.f;
          sacc[1][sub][i] = ok ? sacc[1][sub][i] + bt : -30000.f;
        }
      bf16x8 pf[2][2];
#pragma unroll
      for (int c = 0; c < 2; ++c) {
        float mx = -1e30f;
#pragma unroll
        for (int sub = 0; sub < 4; ++sub)
#pragma unroll
          for (int i = 0; i < 4; ++i) mx = fmaxf(mx, sacc[c][sub][i]);
        mx = fmaxf(mx, __shfl_xor(mx, 16));
        mx = fmaxf(mx, __shfl_xor(mx, 32));
        const float mnew = fmaxf(mrun[c], mx);
        const float alpha = __builtin_amdgcn_exp2f(mrun[c] - mnew);
        mrun[c] = mnew;
        float rs = 0.f;
#pragma unroll
        for (int sub = 0; sub < 4; ++sub)
#pragma unroll
          for (int i = 0; i < 4; ++i) { const float e = __builtin_amdgcn_exp2f(sacc[c][sub][i] - mnew); sacc[c][sub][i] = e; rs += e; }
        lsum[c] = lsum[c] * alpha + rs;
#pragma unroll
        for (int vs = 0; vs < 8; ++vs) oacc[c][vs] *= alpha;
#pragma unroll
        for (int j = 0; j < 2; ++j)
          pf[c][j] = mk8u(pk2(sacc[c][2 * j][0], sacc[c][2 * j][1]), pk2(sacc[c][2 * j][2], sacc[c][2 * j][3]),
                          pk2(sacc[c][2 * j + 1][0], sacc[c][2 * j + 1][1]), pk2(sacc[c][2 * j + 1][2], sacc[c][2 * j + 1][3]));
      }
#pragma unroll
      for (int j = 0; j < 2; ++j)
#pragma unroll
        for (int vs = 0; vs < 8; ++vs) {
          const u32x2 lo = *(const u32x2*)(VT + (16 * vs + l16) * 72 + 32 * j + 4 * g);
          const u32x2 hi = *(const u32x2*)(VT + (16 * vs + l16) * 72 + 32 * j + 16 + 4 * g);
          const bf16x8 vf = mk8(lo, hi);
          oacc[0][vs] = __builtin_amdgcn_mfma_f32_16x16x32_bf16(vf, pf[0][j], oacc[0][vs], 0, 0, 0);
          oacc[1][vs] = __builtin_amdgcn_mfma_f32_16x16x32_bf16(vf, pf[1][j], oacc[1][vs], 0, 0, 0);
        }
    }
#pragma unroll
    for (int c = 0; c < 2; ++c) { lsum[c] += __shfl_xor(lsum[c], 16); lsum[c] += __shfl_xor(lsum[c], 32); }
    const float inv0 = 1.f / lsum[0], inv1 = lam / lsum[1];
    float ss = 0.f;
#pragma unroll
    for (int vs = 0; vs < 8; ++vs)
#pragma unroll
      for (int i = 0; i < 4; ++i) { const float o = oacc[0][vs][i] * inv0 - oacc[1][vs][i] * inv1; oacc[0][vs][i] = o; ss += o * o; }
    ss += __shfl_xor(ss, 16);
    ss += __shfl_xor(ss, 32);
    const float rn = rsqrtf(ss * (1.f / 128.f) + EPS) * (1.f - lam_init);
    if (16 * w + l16 < nq) {
      const size_t row = (size_t)qrow0 + 16 * w + l16;
#pragma unroll
      for (int vs = 0; vs < 8; ++vs) {
        const int v = h * 128 + 16 * vs + 4 * g;
        const f32x4 gl = *(const f32x4*)(p.g_subln + jl * 1024 + v);
        *(u32x2*)(p.OG + row * 1024 + v) = (u32x2){pk2(oacc[0][vs][0] * rn * gl[0], oacc[0][vs][1] * rn * gl[1]),
                                                   pk2(oacc[0][vs][2] * rn * gl[2], oacc[0][vs][3] * rn * gl[3])};
      }
    }
  }
}

DI void gbar(unsigned* bar, unsigned& gen) {
  gen += 1;
  asm volatile("" : "+s"(bar));
  const unsigned tix = (unsigned)ltid();
  asm volatile("s_waitcnt vmcnt(0) lgkmcnt(0)" ::: "memory");
  __syncthreads();
  if (tix < 64) {
    const unsigned g = blockIdx.x >> 4, ng = gridDim.x >> 4;
    bool last = false;
    if (tix == 0) {
      __builtin_amdgcn_fence(__ATOMIC_RELEASE, "agent");
      asm volatile("s_waitcnt vmcnt(0)" ::: "memory");
      const unsigned o = __hip_atomic_fetch_add(bar + 64 * g, 1u, __ATOMIC_RELAXED, __HIP_MEMORY_SCOPE_AGENT);
      if (o + 1 == 16 * gen) {
        const unsigned o2 = __hip_atomic_fetch_add(bar + 64 * 64, 1u, __ATOMIC_RELAXED, __HIP_MEMORY_SCOPE_AGENT);
        last = (o2 + 1 == ng * gen);
      }
    }
    last = __shfl(last ? 1 : 0, 0) != 0;
    if (last && tix < ng) __hip_atomic_store(bar + 64 * (65 + tix), gen, __ATOMIC_RELAXED, __HIP_MEMORY_SCOPE_AGENT);
    if (tix == 0) {
      while (__hip_atomic_load(bar + 64 * (65 + g), __ATOMIC_RELAXED, __HIP_MEMORY_SCOPE_AGENT) < gen) __builtin_amdgcn_s_sleep(2);
      __builtin_amdgcn_fence(__ATOMIC_ACQUIRE, "agent");
      asm volatile("s_waitcnt vmcnt(0)" ::: "memory");
    }
  }
  __syncthreads();
}

__global__ void __launch_bounds__(256, 2) yoco_megakernel(P p) {
  __shared__ __attribute__((aligned(16))) char smem[65536];
  cg::grid_group grid = cg::this_grid();
  if (blockIdx.x == 0 && threadIdx.x < 130) __hip_atomic_store(p.bar + 64 * threadIdx.x, 0u, __ATOMIC_RELAXED, __HIP_MEMORY_SCOPE_AGENT);
  prep_phase(p, smem);
  grid.sync();
  unsigned btarget = 0;
  u16* Mbuf = (u16*)p.BIG;
  u16* Fbuf = p.XB;
  u16* XB2 = (u16*)p.BIG;
  u16* PB = (u16*)(p.BIG + (size_t)ROWS * 1024 * 2);
  for (int i = 0; i < 4; ++i) {
    const float* gn = p.g_norms + i * 4 * D;
    if (i == 0) {
      rowop_phase(p, true, nullptr, nullptr, gn, p.XB, nullptr, nullptr, nullptr);
      gbar(p.bar, btarget);
    }
    if (i < 2) {
      REPG gemm_phase<0>(p, p.XB, 1024, p.wt_in_a + (size_t)i * 4096 * 1024, 4096, p.BIG, smem, i ? p.ss : nullptr);
      gbar(p.bar, btarget);
      gla_state_phase(p, i, smem);
      gbar(p.bar, btarget);
      for (int _r = 0; _r < REP_GLA; ++_r) gla_phase(p, i, smem);
      gbar(p.bar, btarget);
      REPG gemm_phase<2>(p, p.OG, 1024, p.wt_out_a + (size_t)i * 1024 * 1024, 1024, Mbuf, smem);
      gbar(p.bar, btarget);
    } else {
      if (i == 2) gemm_phase<3>(p, p.XB, 1024, p.wt_kv, 2048, nullptr, smem, p.ss);
      REPG gemm_phase<1>(p, p.XB, 1024, p.wt_q + (size_t)(i - 2) * 1024 * 1024, 1024, p.BIG, smem, p.ss);
      if (i == 2) gbar(p.bar, btarget);
      kvconv_phase(p);
      gbar(p.bar, btarget);
      for (int _r = 0; _r < REP_ATTN; ++_r) attn_phase(p, i, smem);
      gbar(p.bar, btarget);
      REPG gemm_phase<2>(p, p.OG, 1024, p.wt_out_b + (size_t)(i - 2) * 1024 * 1024, 1024, Mbuf, smem);
      gbar(p.bar, btarget);
    }
    rowop_phase(p, i == 0, Mbuf, gn + D, gn + 2 * D, p.XB, nullptr, nullptr, nullptr);
    gbar(p.bar, btarget);
    REPG ffn_in_phase(p, i, smem);
    gbar(p.bar, btarget);
    REPG gemm_phase<2>(p, (const u16*)p.BIG, DFF, p.wt_ffn_out + (size_t)i * 1024 * DFF, 1024, Fbuf, smem);
    gbar(p.bar, btarget);
    rowop_phase(p, false, Fbuf, gn + 3 * D, nullptr, XB2, p.p_prompt + (size_t)i * ROWS_P * 256, p.p_sample + (size_t)i * 256 * 256, PB);
    gbar(p.bar, btarget);
    ple_phase(p, i, smem);
    gbar(p.bar, btarget);
  }
}

extern "C" void kernel_launch(void* const* d_in, const int* in_sizes, int n_in, void* d_out, int out_size, void* d_ws,
                              size_t ws_size, hipStream_t stream) {
  static int grid_blocks = 0;
  if (!grid_blocks) {
    int dev = 0, cus = 0, per_cu = 0;
    hipGetDevice(&dev);
    hipDeviceGetAttribute(&cus, hipDeviceAttributeMultiprocessorCount, dev);
    hipOccupancyMaxActiveBlocksPerMultiprocessor(&per_cu, yoco_megakernel, 256, 0);
    if (per_cu > 2) per_cu = 2;
    grid_blocks = cus * per_cu;
    grid_blocks &= ~7;
  }
  P p{};
  const float* const* in = (const float* const*)d_in;
  p.x_prompt = in[0]; p.x_sample = in[1]; p.cache_k = in[2]; p.cache_v = in[3]; p.state_hgrn = in[4]; p.state_conv = in[5];
  p.p_prompt = in[6]; p.p_sample = in[7];
  p.g_norms = in[8]; const float* w_in_a = in[9]; p.lb_raw = in[10]; p.g_hg = in[11]; const float* w_out_a = in[12]; p.g_kv = in[13];
  const float* w_kv = in[14]; p.rel_bias = in[15]; const float* w_q_b = in[16]; p.lam_b = in[17]; p.g_subln = in[18];
  const float* w_out_b = in[19]; const float* w_ffn_in = in[20]; p.conv_w = in[21]; p.conv_b = in[22]; const float* w_ffn_out = in[23];
  const float* w_ple = in[24]; const float* w_ple_gate = in[25];
  float* o = (float*)d_out;
  p.y = o; o += (size_t)ROWS * D;
  p.k_prompt = o; o += (size_t)ROWS_P * D;
  p.v_prompt = o; o += (size_t)ROWS_P * D;
  p.k_sample = o; o += (size_t)256 * D;
  p.v_sample = o; o += (size_t)256 * D;
  p.hgrn_prompt = o; o += (size_t)2 * 16 * 8 * 16384;
  p.hgrn_sample = o; o += (size_t)2 * 8 * 8 * 16384;
  p.conv_prompt = o; o += (size_t)4 * 16 * 2 * DFF;
  p.conv_sample = o;
  u16* ws = (u16*)d_ws;
  p.wt_in_a = ws; ws += (size_t)2 * 4096 * 1024;
  p.wt_out_a = ws; ws += (size_t)2 * 1024 * 1024;
  p.wt_kv = ws; ws += (size_t)2048 * 1024;
  p.wt_q = ws; ws += (size_t)2 * 1024 * 1024;
  p.wt_out_b = ws; ws += (size_t)2 * 1024 * 1024;
  p.wt_ffn_in = ws; ws += (size_t)4 * 5632 * 1024;
  p.wt_ffn_out = ws; ws += (size_t)4 * 1024 * DFF;
  p.wt_ple = ws; ws += (size_t)4 * 1024 * 256;
  p.wt_gate = ws; ws += (size_t)4 * 1024 * 1024;
  p.XB = ws; ws += (size_t)ROWS * 1024;
  p.OG = ws; ws += (size_t)ROWS * 1024;
  p.BIG = (char*)ws;
  p.bar = (unsigned*)((char*)d_ws + ((size_t)500 << 20));
  p.ss = (float*)((char*)d_ws + ((size_t)501 << 20));
  int n = 0;
  for (int i = 0; i < 2; ++i) p.wd[n++] = WD{w_in_a + (size_t)i * 1024 * 4096, p.wt_in_a + (size_t)i * 4096 * 1024, i ? p.g_norms + 4 * D : nullptr, 1024, 4096, 0, 0};
  for (int i = 0; i < 2; ++i) p.wd[n++] = WD{w_out_a + (size_t)i * 1024 * 1024, p.wt_out_a + (size_t)i * 1024 * 1024, nullptr, 1024, 1024, 0, 0};
  p.wd[n++] = WD{w_kv, p.wt_kv, p.g_kv, 1024, 2048, 0, 0};
  for (int i = 0; i < 2; ++i) p.wd[n++] = WD{w_q_b + (size_t)i * 1024 * 1024, p.wt_q + (size_t)i * 1024 * 1024, p.g_norms + (size_t)(i + 2) * 4 * D, 1024, 1024, 0, 0};
  for (int i = 0; i < 2; ++i) p.wd[n++] = WD{w_out_b + (size_t)i * 1024 * 1024, p.wt_out_b + (size_t)i * 1024 * 1024, nullptr, 1024, 1024, 0, 0};
  for (int i = 0; i < 4; ++i) p.wd[n++] = WD{w_ffn_in + (size_t)i * 1024 * 5632, p.wt_ffn_in + (size_t)i * 5632 * 1024, nullptr, 1024, 5632, 1, 0};
  for (int i = 0; i < 4; ++i) p.wd[n++] = WD{w_ffn_out + (size_t)i * DFF * 1024, p.wt_ffn_out + (size_t)i * 1024 * DFF, nullptr, DFF, 1024, 0, 0};
  for (int i = 0; i < 4; ++i) p.wd[n++] = WD{w_ple + (size_t)i * 256 * 1024, p.wt_ple + (size_t)i * 1024 * 256, nullptr, 256, 1024, 0, 0};
  for (int i = 0; i < 4; ++i) p.wd[n++] = WD{w_ple_gate + (size_t)i * 1024 * 1024, p.wt_gate + (size_t)i * 1024 * 1024, nullptr, 1024, 1024, 0, 0};
  void* args[] = {&p};
  hipError_t e = hipLaunchCooperativeKernel((void*)yoco_megakernel, dim3(grid_blocks), dim3(256), args, 0, stream);
  if (e != hipSuccess) fprintf(stderr, "cooperative launch failed: %s (grid %d)\n", hipGetErrorString(e), grid_blocks);
}
```

```cpp
#include <hip/hip_runtime.h>
#include <hip/hip_cooperative_groups.h>
#include <cstdio>
namespace cg = cooperative_groups;

#define DI __device__ __forceinline__
typedef unsigned short u16;
typedef short bf16x8 __attribute__((ext_vector_type(8)));
typedef float f32x16 __attribute__((ext_vector_type(16)));
typedef float f32x4 __attribute__((ext_vector_type(4)));
typedef __bf16 bf2_t __attribute__((ext_vector_type(2)));
typedef float f2_t __attribute__((ext_vector_type(2)));
typedef unsigned u32x2 __attribute__((ext_vector_type(2)));
typedef unsigned u32x4 __attribute__((ext_vector_type(4)));

constexpr int D = 1024, ROWS_P = 32768, ROWS = 33024, DFF = 2816;
constexpr float EPS = 1e-6f;
constexpr float LOG2E = 1.4426950408889634f;
constexpr int NW = 25;
#ifndef REP_GEMM
#define REP_GEMM 1
#endif
#ifndef REP_GLA
#define REP_GLA 1
#endif
#ifndef REP_ATTN
#define REP_ATTN 1
#endif
#define REPG for (int _r = 0; _r < REP_GEMM; ++_r)

struct WD { const float* src; u16* dst; const float* gain; int K, N, mode, pad; };

struct P {
  const float *x_prompt, *x_sample, *cache_k, *cache_v, *state_hgrn, *state_conv, *p_prompt, *p_sample;
  const float *g_norms, *lb_raw, *g_hg, *g_kv, *rel_bias, *lam_b, *g_subln, *conv_w, *conv_b;
  float *y, *k_prompt, *v_prompt, *k_sample, *v_sample, *hgrn_prompt, *hgrn_sample, *conv_prompt, *conv_sample;
  u16 *wt_in_a, *wt_out_a, *wt_kv, *wt_q, *wt_out_b, *wt_ffn_in, *wt_ffn_out, *wt_ple, *wt_gate;
  u16 *XB, *OG; char* BIG; unsigned* bar; float* ss;
  WD wd[NW];
};

DI unsigned pk2(float a, float b) { f2_t v = {a, b}; bf2_t r = __builtin_convertvector(v, bf2_t); return __builtin_bit_cast(unsigned, r); }
DI int lbid() { int b = blockIdx.x; asm volatile("" : "+s"(b)); return b; }
DI int ltid() { int t = threadIdx.x; asm volatile("" : "+v"(t)); return t; }
DI float bf2f(u16 x) { return __uint_as_float(((unsigned)x) << 16); }
DI float bflo(unsigned x) { return __uint_as_float(x << 16); }
DI float bfhi(unsigned x) { return __uint_as_float(x & 0xffff0000u); }
DI float sigm(float x) { return 1.f / (1.f + __expf(-x)); }
DI float wave_sum(float v) {
#pragma unroll
  for (int o = 32; o; o >>= 1) v += __shfl_xor(v, o);
  return v;
}
DI bf16x8 mk8(u32x2 lo, u32x2 hi) { u32x4 t = {lo[0], lo[1], hi[0], hi[1]}; return __builtin_bit_cast(bf16x8, t); }
DI bf16x8 mk8u(unsigned a, unsigned b, unsigned c, unsigned d) { u32x4 t = {a, b, c, d}; return __builtin_bit_cast(bf16x8, t); }

DI void prep_phase(const P& p, char* smem) {
  float* T = (float*)smem;
  const int tid = ltid();
  int total = 0;
  for (int i = 0; i < NW; ++i) total += (p.wd[i].K >> 6) * (p.wd[i].N >> 6);
  for (int flat = lbid(); flat < total; flat += gridDim.x) {
    int wi = 0, base = 0;
    for (;;) { int nt = (p.wd[wi].K >> 6) * (p.wd[wi].N >> 6); if (flat < base + nt) break; base += nt; ++wi; }
    const WD& d = p.wd[wi];
    const int tix = flat - base, ntn = d.N >> 6;
    const int k0 = (tix / ntn) << 6, n0 = (tix % ntn) << 6;
    {
      const int n = tid & 63, kb = tid >> 6;
#pragma unroll
      for (int j = 0; j < 16; ++j) { int k = kb + 4 * j; float v = d.src[(size_t)(k0 + k) * d.N + n0 + n]; if (d.gain) v *= d.gain[k0 + k]; T[k * 65 + n] = v; }
    }
    __syncthreads();
    {
      const int nn = tid >> 2, ks = tid & 3;
      int n = n0 + nn, drow = n;
      if (d.mode == 1) { int isu = n >= DFF; int ch = n - DFF * isu; drow = 256 * (ch >> 7) + 64 * ((ch >> 5) & 3) + 32 * isu + (ch & 31); }
      unsigned o[8];
#pragma unroll
      for (int j = 0; j < 8; ++j) o[j] = pk2(T[(16 * ks + 2 * j) * 65 + nn], T[(16 * ks + 2 * j + 1) * 65 + nn]);
      u16* fb = d.dst + (((size_t)(drow >> 5) * (d.K >> 4) + ((k0 >> 4) + ks)) * 64 + (drow & 31)) * 8;
      *(u32x4*)(fb) = (u32x4){o[0], o[1], o[2], o[3]};
      *(u32x4*)(fb + 256) = (u32x4){o[4], o[5], o[6], o[7]};
    }
    __syncthreads();
  }
}

DI void rowop_phase(const P& p, bool x_from_in, const u16* __restrict__ Madd, const float* __restrict__ gpost,
                    const float* __restrict__ gnext, u16* __restrict__ outH, const float* ple_p, const float* ple_s, u16* outP) {
  const int tidr = ltid();
  const int lane = tidr & 63;
  const int wave = (lbid() * blockDim.x + tidr) >> 6;
  const int nwave = (gridDim.x * blockDim.x) >> 6;
  for (int rb = wave * 2; rb < ROWS; rb += nwave * 2) {
    f32x4 x[2][4];
    u32x2 m[2][4];
#pragma unroll
    for (int u = 0; u < 2; ++u) {
      const int r = rb + u;
      const float* xs = x_from_in ? (r < ROWS_P ? p.x_prompt + (size_t)r * D : p.x_sample + (size_t)(r - ROWS_P) * D) : p.y + (size_t)r * D;
#pragma unroll
      for (int j = 0; j < 4; ++j) x[u][j] = *(const f32x4*)(xs + 4 * lane + 256 * j);
      if (Madd) {
#pragma unroll
        for (int j = 0; j < 4; ++j) m[u][j] = *(const u32x2*)(Madd + (size_t)r * D + 4 * lane + 256 * j);
      }
    }
#pragma unroll
    for (int u = 0; u < 2; ++u) {
      const int r = rb + u;
      if (Madd) {
        f32x4 mf[4]; float ss = 0.f;
#pragma unroll
        for (int j = 0; j < 4; ++j) { mf[j] = (f32x4){bflo(m[u][j][0]), bfhi(m[u][j][0]), bflo(m[u][j][1]), bfhi(m[u][j][1])}; ss += mf[j][0] * mf[j][0] + mf[j][1] * mf[j][1] + mf[j][2] * mf[j][2] + mf[j][3] * mf[j][3]; }
        ss = wave_sum(ss);
        const float rs = rsqrtf(ss * (1.f / D) + EPS);
#pragma unroll
        for (int j = 0; j < 4; ++j) { f32x4 g = *(const f32x4*)(gpost + 4 * lane + 256 * j); x[u][j] += mf[j] * rs * g; }
#pragma unroll
        for (int j = 0; j < 4; ++j) *(f32x4*)(p.y + (size_t)r * D + 4 * lane + 256 * j) = x[u][j];
      }
      float rx = 1.f;
      if (gnext) {
        float ss = 0.f;
#pragma unroll
        for (int j = 0; j < 4; ++j) ss += x[u][j][0] * x[u][j][0] + x[u][j][1] * x[u][j][1] + x[u][j][2] * x[u][j][2] + x[u][j][3] * x[u][j][3];
        ss = wave_sum(ss);
        rx = rsqrtf(ss * (1.f / D) + EPS);
      }
#pragma unroll
      for (int j = 0; j < 4; ++j) {
        f32x4 h = x[u][j] * rx;
        if (gnext) h *= *(const f32x4*)(gnext + 4 * lane + 256 * j);
        *(u32x2*)(outH + (size_t)r * D + 4 * lane + 256 * j) = (u32x2){pk2(h[0], h[1]), pk2(h[2], h[3])};
      }
      if (outP) {
        const float* ps = r < ROWS_P ? ple_p + (size_t)r * 256 : ple_s + (size_t)(r - ROWS_P) * 256;
        f32x4 v = *(const f32x4*)(ps + 4 * lane);
        *(u32x2*)(outP + (size_t)r * 256 + 4 * lane) = (u32x2){pk2(v[0], v[1]), pk2(v[2], v[3])};
      }
    }
  }
}

template <class RowMap>
DI void gemm_core(const u16* __restrict__ A, int lda, RowMap rm, const u16* __restrict__ Bt, int n0, int K,
                  f32x16 (&acc)[4][2], char* smem, const int tid) {
  const int l = tid & 63, w = tid >> 6, l32 = l & 31, hh = l >> 5;
  const int lr = tid >> 3, lc = tid & 7;
  const u16* ap[4];
#pragma unroll
  for (int q = 0; q < 4; ++q) ap[q] = A + (size_t)rm(q * 32 + lr) * lda + lc * 8;
  const u16* bq0 = Bt + ((size_t)((n0 + w * 64) >> 5) * (K >> 4) * 64 + l) * 8;
  const u16* bq1 = bq0 + (size_t)(K >> 4) * 512;
  const unsigned woff = lr * 128 + ((lc ^ ((lr >> 1) & 7)) << 4);
  const int swz = (l32 >> 1) & 7;
  const unsigned aoff = l32 * 128;
  u32x4 ra0[4];
  bf16x8 bf0[4], bf1[4];
  const int nk = K >> 6;
#define GLOADA(RA, T) _Pragma("unroll") for (int q = 0; q < 4; ++q) { RA[q] = *(const u32x4*)(ap[q] + (T) * 64); }
#define SWRITEA(RA, BUF) { char* db_ = smem + (BUF) * 16384; _Pragma("unroll") for (int q = 0; q < 4; ++q) { *(u32x4*)(db_ + woff + q * 4096) = RA[q]; } }
#define COMPUTE(BUF, TN, MORE) { const char* sb = smem + (BUF) * 16384; _Pragma("unroll") for (int ks = 0; ks < 4; ++ks) { \
      const unsigned co = ((2 * ks + hh) ^ swz) << 4; \
      bf16x8 a0 = *(const bf16x8*)(sb + aoff + co); \
      bf16x8 a1 = *(const bf16x8*)(sb + aoff + 4096 + co); \
      bf16x8 a2 = *(const bf16x8*)(sb + aoff + 8192 + co); \
      bf16x8 a3 = *(const bf16x8*)(sb + aoff + 12288 + co); \
      acc[0][0] = __builtin_amdgcn_mfma_f32_32x32x16_bf16(bf0[ks], a0, acc[0][0], 0, 0, 0); \
      acc[0][1] = __builtin_amdgcn_mfma_f32_32x32x16_bf16(bf1[ks], a0, acc[0][1], 0, 0, 0); \
      acc[1][0] = __builtin_amdgcn_mfma_f32_32x32x16_bf16(bf0[ks], a1, acc[1][0], 0, 0, 0); \
      acc[1][1] = __builtin_amdgcn_mfma_f32_32x32x16_bf16(bf1[ks], a1, acc[1][1], 0, 0, 0); \
      acc[2][0] = __builtin_amdgcn_mfma_f32_32x32x16_bf16(bf0[ks], a2, acc[2][0], 0, 0, 0); \
      acc[2][1] = __builtin_amdgcn_mfma_f32_32x32x16_bf16(bf1[ks], a2, acc[2][1], 0, 0, 0); \
      acc[3][0] = __builtin_amdgcn_mfma_f32_32x32x16_bf16(bf0[ks], a3, acc[3][0], 0, 0, 0); \
      acc[3][1] = __builtin_amdgcn_mfma_f32_32x32x16_bf16(bf1[ks], a3, acc[3][1], 0, 0, 0); \
      if (MORE) { bf0[ks] = *(const bf16x8*)(bq0 + ((TN) * 4 + ks) * 512); bf1[ks] = *(const bf16x8*)(bq1 + ((TN) * 4 + ks) * 512); } \
      __builtin_amdgcn_sched_barrier(0); } }
  GLOADA(ra0, 0);
#pragma unroll
  for (int ks = 0; ks < 4; ++ks) { bf0[ks] = *(const bf16x8*)(bq0 + ks * 512); bf1[ks] = *(const bf16x8*)(bq1 + ks * 512); }
  SWRITEA(ra0, 0);
  __syncthreads();
  for (int kt = 0; kt < nk; kt += 2) {
    GLOADA(ra0, kt + 1);
    __builtin_amdgcn_sched_barrier(0);
    COMPUTE(0, kt + 1, true);
    SWRITEA(ra0, 1);
    __syncthreads();
    if (kt + 2 < nk) GLOADA(ra0, kt + 2);
    __builtin_amdgcn_sched_barrier(0);
    COMPUTE(1, kt + 2, kt + 2 < nk);
    if (kt + 2 < nk) SWRITEA(ra0, 0);
    __syncthreads();
  }
#undef GLOADA
#undef SWRITEA
#undef COMPUTE
}

template <class RowMap>
DI void gemm_core_mini(const u16* __restrict__ A, int lda, RowMap rm, const u16* __restrict__ Bt, int n0, int K,
                       f32x16 (&acc)[2], char* smem, const int tid) {
  const int l = tid & 63, w = tid >> 6, l32 = l & 31, hh = l >> 5;
  const int lr = tid >> 3, lc = tid & 7;
  const u16* ap[4];
#pragma unroll
  for (int q = 0; q < 4; ++q) ap[q] = A + (size_t)rm(q * 32 + lr) * lda + lc * 8;
  const u16* bq0 = Bt + ((size_t)(n0 >> 5) * (K >> 4) * 64 + l) * 8;
  const u16* bq1 = bq0 + (size_t)(K >> 4) * 512;
  const unsigned woff = lr * 128 + ((lc ^ ((lr >> 1) & 7)) << 4);
  const int swz = (l32 >> 1) & 7;
  const unsigned aoff = (w * 32 + l32) * 128;
  u32x4 ra0[4];
  bf16x8 bf0[4], bf1[4];
  const int nk = K >> 6;
#define GLOADA(RA, T) _Pragma("unroll") for (int q = 0; q < 4; ++q) { RA[q] = *(const u32x4*)(ap[q] + (T) * 64); }
#define SWRITEA(RA, BUF) { char* db_ = smem + (BUF) * 16384; _Pragma("unroll") for (int q = 0; q < 4; ++q) { *(u32x4*)(db_ + woff + q * 4096) = RA[q]; } }
#define COMPUTE(BUF, TN, MORE) { const char* sb = smem + (BUF) * 16384; _Pragma("unroll") for (int ks = 0; ks < 4; ++ks) { \
      const unsigned co = ((2 * ks + hh) ^ swz) << 4; \
      bf16x8 a0 = *(const bf16x8*)(sb + aoff + co); \
      acc[0] = __builtin_amdgcn_mfma_f32_32x32x16_bf16(bf0[ks], a0, acc[0], 0, 0, 0); \
      acc[1] = __builtin_amdgcn_mfma_f32_32x32x16_bf16(bf1[ks], a0, acc[1], 0, 0, 0); \
      if (MORE) { bf0[ks] = *(const bf16x8*)(bq0 + ((TN) * 4 + ks) * 512); bf1[ks] = *(const bf16x8*)(bq1 + ((TN) * 4 + ks) * 512); } \
      __builtin_amdgcn_sched_barrier(0); } }
  GLOADA(ra0, 0);
#pragma unroll
  for (int ks = 0; ks < 4; ++ks) { bf0[ks] = *(const bf16x8*)(bq0 + ks * 512); bf1[ks] = *(const bf16x8*)(bq1 + ks * 512); }
  SWRITEA(ra0, 0);
  __syncthreads();
  for (int kt = 0; kt < nk; kt += 2) {
    GLOADA(ra0, kt + 1);
    __builtin_amdgcn_sched_barrier(0);
    COMPUTE(0, kt + 1, true);
    SWRITEA(ra0, 1);
    __syncthreads();
    if (kt + 2 < nk) GLOADA(ra0, kt + 2);
    __builtin_amdgcn_sched_barrier(0);
    COMPUTE(1, kt + 2, kt + 2 < nk);
    if (kt + 2 < nk) SWRITEA(ra0, 0);
    __syncthreads();
  }
#undef GLOADA
#undef SWRITEA
#undef COMPUTE
}

DI bool next_tile(int it, int ntm, int ntn, int& tm, int& tn) {
  const int b = lbid(), x = b & 7, slot = b >> 3, S = gridDim.x >> 3;
  const int nq = (ntm - x + 7) >> 3;
  const int L = slot + it * S;
  if (L >= nq * ntn) return false;
  const int gsize = 8 * ntn;
  const int grp = L / gsize, r = L - grp * gsize;
  const int gsz = min(8, nq - 8 * grp);
  tn = r / gsz;
  tm = x + 8 * (8 * grp + r % gsz);
  return true;
}

DI void list_entry(int L, int ntm, int ntn, int& tm, int& tn) {
  const int x = lbid() & 7;
  const int nq = (ntm - x + 7) >> 3;
  const int gsize = 8 * ntn;
  const int grp = L / gsize, r = L - grp * gsize;
  const int gsz = min(8, nq - 8 * grp);
  tn = r / gsz;
  tm = x + 8 * (8 * grp + r % gsz);
}
DI void list_info(int ntm, int ntn, int& full, int& nleft) {
  const int x = lbid() & 7, S = gridDim.x >> 3;
  const int len = ((ntm - x + 7) >> 3) * ntn;
  full = (len / S) * S;
  nleft = len - full;
  if (4 * nleft > S) { full = len; nleft = 0; }
}

struct IdMap { int base; DI int operator()(int r) const { return base + r; } };
struct ClampMap { int rowbase, t0, T; DI int operator()(int r) const { int t = t0 + r; t = t < 0 ? 0 : (t > T - 1 ? T - 1 : t); return rowbase + t; } };

#define ZERO_ACC(a) _Pragma("unroll") for (int _i = 0; _i < 4; ++_i) _Pragma("unroll") for (int _j = 0; _j < 2; ++_j) _Pragma("unroll") for (int _e = 0; _e < 16; ++_e) a[_i][_j][_e] = 0.f;

DI float row_rs(const float* rowss, int m) {
  const f32x4* sp = (const f32x4*)(rowss + (size_t)m * 16); const f32x4 s0 = sp[0], s1 = sp[1], s2 = sp[2], s3 = sp[3];
  const float tot = ((s0[0] + s0[1]) + (s0[2] + s0[3])) + ((s1[0] + s1[1]) + (s1[2] + s1[3])) + ((s2[0] + s2[1]) + (s2[2] + s2[3])) + ((s3[0] + s3[1]) + (s3[2] + s3[3]));
  return rsqrtf(tot * (1.f / D) + EPS);
}
template <int EPI>
DI void epi4(const P& p, void* outp, int m, int n, float v0, float v1, float v2, float v3) {
  if (EPI == 0) {
    const int sec = n >> 10;
    if (sec == 0 || sec == 3) { v0 *= sigm(v0); v1 *= sigm(v1); v2 *= sigm(v2); v3 *= sigm(v3); }
    *(u32x2*)((u16*)outp + (size_t)m * 4096 + n) = (u32x2){pk2(v0, v1), pk2(v2, v3)};
  } else if (EPI == 1) {
    const float sc = 0.125f * LOG2E;
    *(u32x2*)((u16*)outp + (size_t)m * 1024 + n) = (u32x2){pk2(v0 * sc, v1 * sc), pk2(v2 * sc, v3 * sc)};
  } else if (EPI == 2) {
    *(u32x2*)((u16*)outp + (size_t)m * 1024 + n) = (u32x2){pk2(v0, v1), pk2(v2, v3)};
  } else {
    float* dst;
    if (n < 1024) dst = (m < ROWS_P ? p.k_prompt + (size_t)m * 1024 : p.k_sample + (size_t)(m - ROWS_P) * 1024) + n;
    else dst = (m < ROWS_P ? p.v_prompt + (size_t)m * 1024 : p.v_sample + (size_t)(m - ROWS_P) * 1024) + (n - 1024);
    *(f32x4*)dst = (f32x4){v0, v1, v2, v3};
  }
}
template <int EPI>
DI void gemm_phase(const P& p, const u16* A, int K, const u16* Bt, int N, void* outp, char* smem, const float* rowss = nullptr) {
  const int tid = ltid(), l = tid & 63, w = tid >> 6, l32 = l & 31, hh = l >> 5;
  const int ntm = ROWS / 128, ntn = N / 256;
  const int slot = lbid() >> 3, S = gridDim.x >> 3;
  int full, nleft, tm, tn;
  list_info(ntm, ntn, full, nleft);
  for (int L = slot; L < full; L += S) {
    list_entry(L, ntm, ntn, tm, tn);
    f32x16 acc[4][2];
    ZERO_ACC(acc);
    gemm_core(A, K, IdMap{tm * 128}, Bt, tn * 256, K, acc, smem, ltid());
#pragma unroll
    for (int mi = 0; mi < 4; ++mi) {
      const int m = tm * 128 + mi * 32 + l32;
      float rsc = 1.f;
      if (rowss) rsc = row_rs(rowss, m);
#pragma unroll
      for (int ni = 0; ni < 2; ++ni)
#pragma unroll
        for (int q = 0; q < 4; ++q)
          epi4<EPI>(p, outp, m, tn * 256 + w * 64 + ni * 32 + 8 * q + 4 * hh,
                    acc[mi][ni][4 * q] * rsc, acc[mi][ni][4 * q + 1] * rsc, acc[mi][ni][4 * q + 2] * rsc, acc[mi][ni][4 * q + 3] * rsc);
    }
  }
  if (slot < 4 * nleft) {
    list_entry(full + (slot >> 2), ntm, ntn, tm, tn);
    const int n0 = tn * 256 + (slot & 3) * 64;
    f32x16 acc[2];
#pragma unroll
    for (int e = 0; e < 16; ++e) { acc[0][e] = 0.f; acc[1][e] = 0.f; }
    gemm_core_mini(A, K, IdMap{tm * 128}, Bt, n0, K, acc, smem, ltid());
    const int m = tm * 128 + w * 32 + l32;
    float rsc = 1.f;
    if (rowss) rsc = row_rs(rowss, m);
#pragma unroll
    for (int ni = 0; ni < 2; ++ni)
#pragma unroll
      for (int q = 0; q < 4; ++q)
        epi4<EPI>(p, outp, m, n0 + ni * 32 + 8 * q + 4 * hh,
                  acc[ni][4 * q] * rsc, acc[ni][4 * q + 1] * rsc, acc[ni][4 * q + 2] * rsc, acc[ni][4 * q + 3] * rsc);
  }
}

DI void ple_epi(const P& p, const u16* PL, int m, int n, float a0, float a1, float a2, float a3, float& ssq) {
  f32x4* xp = (f32x4*)(p.y + (size_t)m * D + n);
  f32x4 x = *xp;
  const u32x2 pv = *(const u32x2*)(PL + (size_t)m * D + n);
  x[0] += sigm(a0) * bflo(pv[0]);
  x[1] += sigm(a1) * bfhi(pv[0]);
  x[2] += sigm(a2) * bflo(pv[1]);
  x[3] += sigm(a3) * bfhi(pv[1]);
  *xp = x;
  *(u32x2*)(p.XB + (size_t)m * D + n) = (u32x2){pk2(x[0], x[1]), pk2(x[2], x[3])};
  ssq += x[0] * x[0] + x[1] * x[1] + x[2] * x[2] + x[3] * x[3];
}
DI void ple_phase(const P& p, int layer, char* smem) {
  const int tid = ltid(), l = tid & 63, w = tid >> 6, l32 = l & 31, hh = l >> 5;
  const u16* XB2 = (const u16*)p.BIG;
  const u16* PB = (const u16*)(p.BIG + (size_t)ROWS * 1024 * 2);
  u16* PL = (u16*)(p.BIG + (size_t)ROWS * 1024 * 2 + (size_t)ROWS * 256 * 2);
  const u16* Wg = p.wt_gate + (size_t)layer * 1024 * 1024;
  const u16* Wp = p.wt_ple + (size_t)layer * 1024 * 256;
  const int ntm = ROWS / 128, ntn = 4;
  const int slot = lbid() >> 3, S = gridDim.x >> 3;
  int full, nleft, tm, tn;
  list_info(ntm, ntn, full, nleft);
  for (int L = slot; L < full; L += S) {
    list_entry(L, ntm, ntn, tm, tn);
    f32x16 acc2[4][2];
    ZERO_ACC(acc2);
    gemm_core(PB, 256, IdMap{tm * 128}, Wp, tn * 256, 256, acc2, smem, ltid());
#pragma unroll
    for (int mi = 0; mi < 4; ++mi)
#pragma unroll
      for (int ni = 0; ni < 2; ++ni)
#pragma unroll
        for (int q = 0; q < 4; ++q)
          *(u32x2*)(PL + (size_t)(tm * 128 + mi * 32 + l32) * D + tn * 256 + w * 64 + ni * 32 + 8 * q + 4 * hh) =
              (u32x2){pk2(acc2[mi][ni][4 * q], acc2[mi][ni][4 * q + 1]), pk2(acc2[mi][ni][4 * q + 2], acc2[mi][ni][4 * q + 3])};
  }
  if (slot < 4 * nleft) {
    list_entry(full + (slot >> 2), ntm, ntn, tm, tn);
    const int n0 = tn * 256 + (slot & 3) * 64;
    f32x16 acc2[2];
#pragma unroll
    for (int e = 0; e < 16; ++e) { acc2[0][e] = 0.f; acc2[1][e] = 0.f; }
    gemm_core_mini(PB, 256, IdMap{tm * 128}, Wp, n0, 256, acc2, smem, ltid());
#pragma unroll
    for (int ni = 0; ni < 2; ++ni)
#pragma unroll
      for (int q = 0; q < 4; ++q)
        *(u32x2*)(PL + (size_t)(tm * 128 + w * 32 + l32) * D + n0 + ni * 32 + 8 * q + 4 * hh) =
            (u32x2){pk2(acc2[ni][4 * q], acc2[ni][4 * q + 1]), pk2(acc2[ni][4 * q + 2], acc2[ni][4 * q + 3])};
  }
  for (int L = slot; L < full; L += S) {
    list_entry(L, ntm, ntn, tm, tn);
    f32x16 acc[4][2];
    ZERO_ACC(acc);
    gemm_core(XB2, 1024, IdMap{tm * 128}, Wg, tn * 256, 1024, acc, smem, ltid());
#pragma unroll
    for (int mi = 0; mi < 4; ++mi) {
      const int m = tm * 128 + mi * 32 + l32;
      float ssq = 0.f;
#pragma unroll
      for (int ni = 0; ni < 2; ++ni)
#pragma unroll
        for (int q = 0; q < 4; ++q)
          ple_epi(p, PL, m, tn * 256 + w * 64 + ni * 32 + 8 * q + 4 * hh, acc[mi][ni][4 * q], acc[mi][ni][4 * q + 1], acc[mi][ni][4 * q + 2], acc[mi][ni][4 * q + 3], ssq);
      ssq += __shfl_xor(ssq, 32);
      if (hh == 0) p.ss[(size_t)m * 16 + tn * 4 + w] = ssq;
    }
  }
  if (slot < 4 * nleft) {
    list_entry(full + (slot >> 2), ntm, ntn, tm, tn);
    const int ws = slot & 3, n0 = tn * 256 + ws * 64;
    f32x16 acc[2];
#pragma unroll
    for (int e = 0; e < 16; ++e) { acc[0][e] = 0.f; acc[1][e] = 0.f; }
    gemm_core_mini(XB2, 1024, IdMap{tm * 128}, Wg, n0, 1024, acc, smem, ltid());
    const int m = tm * 128 + w * 32 + l32;
    float ssq = 0.f;
#pragma unroll
    for (int ni = 0; ni < 2; ++ni)
#pragma unroll
      for (int q = 0; q < 4; ++q)
        ple_epi(p, PL, m, n0 + ni * 32 + 8 * q + 4 * hh, acc[ni][4 * q], acc[ni][4 * q + 1], acc[ni][4 * q + 2], acc[ni][4 * q + 3], ssq);
    ssq += __shfl_xor(ssq, 32);
    if (hh == 0) p.ss[(size_t)m * 16 + tn * 4 + ws] = ssq;
  }
}

DI void ffn_in_phase(const P& p, int layer, char* smem) {
  const int tid = ltid(), l = tid & 63, w = tid >> 6, l32 = l & 31, hh = l >> 5;
  const u16* Wt = p.wt_ffn_in + (size_t)layer * 5632 * 1024;
  u16* HID = (u16*)p.BIG;
  const float* cw = p.conv_w + (size_t)layer * 3 * DFF;
  const float* cb = p.conv_b + (size_t)layer * DFF;
  int tm, tn;
  for (int it = 0; next_tile(it, 280, 22, tm, tn); ++it) {
    int seq, T, rowbase, t0; bool last;
    if (tm < 272) { seq = tm / 17; int j = tm - seq * 17; T = 2048; rowbase = seq * 2048; t0 = 126 * j - 2; last = (j == 16); }
    else { seq = 16 + (tm - 272); T = 32; rowbase = ROWS_P + (tm - 272) * 32; t0 = -2; last = true; }
    f32x16 acc[4][2];
    ZERO_ACC(acc);
    gemm_core(p.XB, 1024, ClampMap{rowbase, t0, T}, Wt, tn * 256, 1024, acc, smem, tid);
    const int chw = tn * 128 + w * 32;
    if (t0 < 0 && l32 < 2) {
#pragma unroll
      for (int q = 0; q < 4; ++q) {
        f32x4 sv = {0.f, 0.f, 0.f, 0.f};
        if (seq >= 16) sv = *(const f32x4*)(p.state_conv + ((size_t)(layer * 8 + (seq - 16)) * 2 + l32) * DFF + chw + 8 * q + 4 * hh);
#pragma unroll
        for (int c = 0; c < 4; ++c) acc[0][0][4 * q + c] = sv[c];
      }
    }
    const int lbase = l & 32;
#pragma unroll
    for (int q = 0; q < 4; ++q) {
      const int chq = chw + 8 * q + 4 * hh;
      const f32x4 b4 = *(const f32x4*)(cb + chq);
      const f32x4 w0 = *(const f32x4*)(cw + chq), w1 = *(const f32x4*)(cw + DFF + chq), w2 = *(const f32x4*)(cw + 2 * DFF + chq);
#pragma unroll
      for (int mi = 0; mi < 4; ++mi) {
        const int m = mi * 32 + l32;
        const int t = t0 + m;
        float hv[4];
#pragma unroll
        for (int c = 0; c < 4; ++c) {
          const float g0 = acc[mi][0][4 * q + c];
          float g1 = __shfl(g0, lbase + ((l32 + 31) & 31));
          float g2 = __shfl(g0, lbase + ((l32 + 30) & 31));
          if (mi > 0) {
            const float pg = acc[mi > 0 ? mi - 1 : 0][0][4 * q + c];
            const float p1 = __shfl(pg, lbase + 31), p2 = __shfl(pg, lbase + 30);
            if (l32 == 0) { g1 = p1; g2 = p2; }
            if (l32 == 1) { g2 = p1; }
          }
          const float cv = b4[c] + w0[c] * g2 + w1[c] * g1 + w2[c] * g0;
          hv[c] = cv * sigm(cv) * acc[mi][1][4 * q + c];
        }
        if (m >= 2 && t < T) {
          *(u32x2*)(HID + (size_t)(rowbase + t) * DFF + chq) = (u32x2){pk2(hv[0], hv[1]), pk2(hv[2], hv[3])};
          if (last && t >= T - 2) {
            float* co = seq < 16 ? p.conv_prompt + ((size_t)(layer * 16 + seq) * 2 + (t - (T - 2))) * DFF
                                 : p.conv_sample + ((size_t)(layer * 8 + (seq - 16)) * 2 + (t - (T - 2))) * DFF;
            *(f32x4*)(co + chq) = (f32x4){acc[mi][0][4 * q], acc[mi][0][4 * q + 1], acc[mi][0][4 * q + 2], acc[mi][0][4 * q + 3]};
          }
        }
      }
    }
  }
}

DI void gla_state_phase(const P& p, int layer, char* smem) {
  const u16* PROJ = (const u16*)p.BIG;
  const int tid = ltid(), l = tid & 63, w = tid >> 6, l32 = l & 31, hh = l >> 5;
  float* SLOC = (float*)p.XB;
  float* DTOT = SLOC + (size_t)384 * 16384;
  const int k = tid >> 1, th = tid & 1;
  for (int item = lbid(); item < 384; item += gridDim.x) {
    const int sh = item / 3, ch = item - sh * 3, s = sh >> 3, h = sh & 7;
    const int rowbase = s * 2048 + ch * 512;
    float lower = 0.f;
    if (layer == 1) lower = sigm(p.lb_raw[1024 + h * 128 + k] - p.lb_raw[h * 128 + k]);
    const float oml = 1.f - lower;
    f32x16 S[4];
#pragma unroll
    for (int kt = 0; kt < 4; ++kt)
#pragma unroll
      for (int i = 0; i < 16; ++i) S[kt][i] = 0.f;
    float btot = 0.f;
    u16 fr[8], vr[8];
#define GS_LOAD(BLK) { const size_t r0_ = (size_t)rowbase + (BLK) * 16; \
      const u16* pf_ = PROJ + (r0_ + 8 * th) * 4096 + 1024 + h * 128 + k; \
      const u16* pv_ = PROJ + r0_ * 4096 + 2048 + h * 128 + 32 * w + l32; \
      _Pragma("unroll") for (int t = 0; t < 8; ++t) fr[t] = pf_[(size_t)t * 4096]; \
      _Pragma("unroll") for (int jj = 0; jj < 8; ++jj) vr[jj] = pv_[(size_t)(8 * (jj >> 2) + 4 * hh + (jj & 3)) * 4096]; }
    GS_LOAD(0);
    for (int blk = 0; blk < 32; ++blk) {
      char* sb = smem + (blk & 1) * 8192;
      u16* KDT = (u16*)sb;
      float* DD = (float*)(KDT + 128 * 20);
      {
        float km[8], eb[8];
        float bs = 0.f;
#pragma unroll
        for (int t = 0; t < 8; ++t) {
          const float f = bf2f(fr[t]);
          const float g = lower + oml * sigm(f);
          bs += __logf(g);
          km[t] = 1.f - g; eb[t] = bs;
        }
        const float other = __shfl_xor(bs, 1);
        const float boff = th ? other : 0.f;
        const float bsum = bs + other;
        btot += bsum;
        unsigned kdp[4];
#pragma unroll
        for (int j = 0; j < 4; ++j)
          kdp[j] = pk2(km[2 * j] * __expf(bsum - boff - eb[2 * j]), km[2 * j + 1] * __expf(bsum - boff - eb[2 * j + 1]));
        *(u32x2*)(KDT + k * 20 + 8 * th) = (u32x2){kdp[0], kdp[1]};
        *(u32x2*)(KDT + k * 20 + 8 * th + 4) = (u32x2){kdp[2], kdp[3]};
        if (th == 0) DD[k] = __expf(bsum);
      }
      const bf16x8 vfrag = mk8u((unsigned)vr[0] | ((unsigned)vr[1] << 16), (unsigned)vr[2] | ((unsigned)vr[3] << 16),
                                (unsigned)vr[4] | ((unsigned)vr[5] << 16), (unsigned)vr[6] | ((unsigned)vr[7] << 16));
      if (blk + 1 < 32) GS_LOAD(blk + 1);
      __syncthreads();
#pragma unroll
      for (int kt = 0; kt < 4; ++kt) {
#pragma unroll
        for (int q = 0; q < 4; ++q) {
          const f32x4 d4 = *(const f32x4*)(DD + 32 * kt + 8 * q + 4 * hh);
#pragma unroll
          for (int c = 0; c < 4; ++c) S[kt][4 * q + c] *= d4[c];
        }
        const u32x2 lo = *(const u32x2*)(KDT + (32 * kt + l32) * 20 + 4 * hh);
        const u32x2 hi = *(const u32x2*)(KDT + (32 * kt + l32) * 20 + 8 + 4 * hh);
        S[kt] = __builtin_amdgcn_mfma_f32_32x32x16_bf16(mk8(lo, hi), vfrag, S[kt], 0, 0, 0);
      }
    }
#undef GS_LOAD
    {
      float* op = SLOC + (size_t)item * 16384 + 32 * w + l32;
#pragma unroll
      for (int kt = 0; kt < 4; ++kt)
#pragma unroll
        for (int i = 0; i < 16; ++i) op[(size_t)(32 * kt + (i & 3) + 8 * (i >> 2) + 4 * hh) * 128] = S[kt][i];
      if (th == 0) DTOT[(size_t)item * 128 + k] = __expf(btot);
    }
    __syncthreads();
  }
}

DI void gla_phase(const P& p, int layer, char* smem) {
  const u16* PROJ = (const u16*)p.BIG;
  const int tid = ltid(), l = tid & 63, w = tid >> 6, l32 = l & 31, hh = l >> 5, m16 = l & 15;
  float* REDB = (float*)(smem + 2 * 14336);
  const int k = tid >> 1, th = tid & 1;
  const float* SLOC = (const float*)p.XB;
  const float* DTOT = SLOC + (size_t)384 * 16384;
  for (int item = lbid(); item < 576; item += gridDim.x) {
    const bool smp = item < 64;
    const int s = smp ? 16 + (item >> 3) : (item - 64) >> 5;
    const int h = smp ? (item & 7) : ((item - 64) >> 2) & 7;
    const int ch = smp ? 0 : (item - 64) & 3;
    const int T = smp ? 32 : 512;
    const int rowbase = smp ? ROWS_P + (s - 16) * 32 : s * 2048 + ch * 512;
    float lower = 0.f;
    if (layer == 1) lower = sigm(p.lb_raw[1024 + h * 128 + k] - p.lb_raw[h * 128 + k]);
    const float oml = 1.f - lower;
    f32x16 S[4];
    if (smp) {
      const float* sp = p.state_hgrn + ((size_t)(layer * 8 + (s - 16)) * 8 + h) * 16384 + 32 * w + l32;
#pragma unroll
      for (int kt = 0; kt < 4; ++kt)
#pragma unroll
        for (int i = 0; i < 16; ++i) S[kt][i] = sp[(size_t)(32 * kt + (i & 3) + 8 * (i >> 2) + 4 * hh) * 128];
    } else {
#pragma unroll
      for (int kt = 0; kt < 4; ++kt)
#pragma unroll
        for (int i = 0; i < 16; ++i) S[kt][i] = 0.f;
#pragma unroll 1
      for (int j = 0; j < ch; ++j) {
        const int it1 = (s * 8 + h) * 3 + j;
        const float* sl = SLOC + (size_t)it1 * 16384 + 32 * w + l32 + (size_t)(4 * hh) * 128;
        const float* dl = DTOT + (size_t)it1 * 128 + 4 * hh;
#pragma unroll
        for (int kt = 0; kt < 4; ++kt) {
#pragma unroll
          for (int q = 0; q < 4; ++q) {
            const float* slq = sl + (size_t)(32 * kt + 8 * q) * 128;
            const f32x4 d4 = *(const f32x4*)(dl + 32 * kt + 8 * q);
#pragma unroll
            for (int c = 0; c < 4; ++c) S[kt][4 * q + c] = S[kt][4 * q + c] * d4[c] + slq[c * 128];
            __builtin_amdgcn_sched_barrier(0);
          }
        }
      }
    }
    const int nblk = T >> 4;
    u16 fr[8], qr[8], vr[8];
#define GLA_LOADRAW(BLK) { const size_t r0_ = (size_t)rowbase + (BLK) * 16; \
      const u16* pf_ = PROJ + (r0_ + 8 * th) * 4096 + 1024 + h * 128 + k; \
      const u16* pq_ = PROJ + (r0_ + 8 * th) * 4096 + h * 128 + k; \
      _Pragma("unroll") for (int t = 0; t < 8; ++t) fr[t] = pf_[(size_t)t * 4096]; \
      _Pragma("unroll") for (int j = 0; j < 8; ++j) qr[j] = pq_[(size_t)j * 4096]; \
 }
#define GLA_LOADV(BLK) { const u16* pv_ = PROJ + ((size_t)rowbase + (BLK) * 16) * 4096 + 2048 + h * 128 + 32 * w + l32; \
      _Pragma("unroll") for (int jj = 0; jj < 8; ++jj) vr[jj] = pv_[(size_t)(8 * (jj >> 2) + 4 * hh + (jj & 3)) * 4096]; }
#define GLA_LOADGS(BLK) { const u16* pg_ = PROJ + ((size_t)rowbase + (BLK) * 16 + m16) * 4096 + 3072 + h * 128 + 32 * w + 4 * hh; \
      _Pragma("unroll") for (int q = 0; q < 4; ++q) gsl[q] = *(const u32x2*)(pg_ + 8 * q); }
#define GLA_FINAL(BLK) { const float* RED_ = REDB + ((BLK) & 1) * 64; \
      if (l32 < 16) { \
        const float tot = RED_[l32] + RED_[16 + l32] + RED_[32 + l32] + RED_[48 + l32]; \
        const float rn = rsqrtf(tot * (1.f / 128.f) + EPS); \
        u16* op_ = p.OG + ((size_t)rowbase + (BLK) * 16 + l32) * 1024 + h * 128 + 32 * w + 4 * hh; \
        const float* gp_ = p.g_hg + layer * 1024 + h * 128 + 32 * w + 4 * hh; \
        _Pragma("unroll") for (int q = 0; q < 4; ++q) { const f32x4 gh = *(const f32x4*)(gp_ + 8 * q); \
          *(u32x2*)(op_ + 8 * q) = (u32x2){pk2(oacc[4 * q] * rn * gh[0] * bflo(gsl[q][0]), oacc[4 * q + 1] * rn * gh[1] * bfhi(gsl[q][0])), \
                                          pk2(oacc[4 * q + 2] * rn * gh[2] * bflo(gsl[q][1]), oacc[4 * q + 3] * rn * gh[3] * bfhi(gsl[q][1]))}; } \
      } }
    GLA_LOADRAW(0);
    u32x2 gsl[4];
    for (int blk = 0; blk < nblk; ++blk) {
      GLA_LOADGS(blk);
      GLA_LOADV(blk);
      char* sb = smem + (blk & 1) * 14336;
      u16* QT = (u16*)sb;
      u16* KT = QT + 16 * 136;
      u16* KDT = KT + 16 * 136;
      float* DD = (float*)(KDT + 128 * 20);
      {
        float qtm[8], ktm[8];
        float bs = 0.f;
#pragma unroll
        for (int t = 0; t < 8; ++t) {
          const float f = bf2f(fr[t]);
          const float g = lower + oml * sigm(f);
          bs += __logf(g);
          const float eb = __expf(bs);
          qtm[t] = bf2f(qr[t]) * eb;
          ktm[t] = (1.f - g) * __builtin_amdgcn_rcpf(eb);
        }
        const float other = __shfl_xor(bs, 1);
        const float boff = th ? other : 0.f;
        const float bsum = bs + other;
        const float E1 = __expf(boff), E1i = __expf(-boff), EL = __expf(bsum);
        unsigned kdp[4];
        float kdprev = 0.f;
#pragma unroll
        for (int j = 0; j < 8; ++j) {
          const int t = 8 * th + j;
          const float qt = qtm[j] * E1;
          const float ktv = ktm[j] * E1i;
          const float kd = ktv * EL;
          QT[t * 136 + k] = (u16)(pk2(qt, 0.f) & 0xffffu);
          KT[t * 136 + k] = (u16)(pk2(ktv, 0.f) & 0xffffu);
          if (j & 1) kdp[j >> 1] = pk2(kdprev, kd); else kdprev = kd;
        }
        *(u32x2*)(KDT + k * 20 + 8 * th) = (u32x2){kdp[0], kdp[1]};
        *(u32x2*)(KDT + k * 20 + 8 * th + 4) = (u32x2){kdp[2], kdp[3]};
        if (th == 0) DD[k] = __expf(bsum);
      }
      if (blk + 1 < nblk) GLA_LOADRAW(blk + 1);
      __syncthreads();
      const bf16x8 vfrag = mk8u((unsigned)vr[0] | ((unsigned)vr[1] << 16), (unsigned)vr[2] | ((unsigned)vr[3] << 16),
                                (unsigned)vr[4] | ((unsigned)vr[5] << 16), (unsigned)vr[6] | ((unsigned)vr[7] << 16));
      f32x16 aacc, oacc;
#pragma unroll
      for (int i = 0; i < 16; ++i) { aacc[i] = 0.f; oacc[i] = 0.f; }
#pragma unroll
      for (int ks = 0; ks < 8; ++ks) {
        const bf16x8 ka = *(const bf16x8*)(KT + m16 * 136 + 16 * ks + 8 * hh);
        const bf16x8 qb = *(const bf16x8*)(QT + m16 * 136 + 16 * ks + 8 * hh);
        aacc = __builtin_amdgcn_mfma_f32_32x32x16_bf16(ka, qb, aacc, 0, 0, 0);
        const int kt = ks >> 1, s2 = ks & 1;
        const bf16x8 sa = mk8u(pk2(S[kt][8 * s2], S[kt][8 * s2 + 1]), pk2(S[kt][8 * s2 + 2], S[kt][8 * s2 + 3]),
                               pk2(S[kt][8 * s2 + 4], S[kt][8 * s2 + 5]), pk2(S[kt][8 * s2 + 6], S[kt][8 * s2 + 7]));
        const u32x2 lo = *(const u32x2*)(QT + m16 * 136 + 32 * kt + 16 * s2 + 4 * hh);
        const u32x2 hi = *(const u32x2*)(QT + m16 * 136 + 32 * kt + 16 * s2 + 8 + 4 * hh);
        oacc = __builtin_amdgcn_mfma_f32_32x32x16_bf16(sa, mk8(lo, hi), oacc, 0, 0, 0);
      }
      float am[8];
#pragma unroll
      for (int i = 0; i < 8; ++i) { const int m = (i & 3) + 8 * (i >> 2) + 4 * hh; am[i] = (m <= m16) ? aacc[i] : 0.f; }
      const bf16x8 afrag = mk8u(pk2(am[0], am[1]), pk2(am[2], am[3]), pk2(am[4], am[5]), pk2(am[6], am[7]));
      oacc = __builtin_amdgcn_mfma_f32_32x32x16_bf16(vfrag, afrag, oacc, 0, 0, 0);
#pragma unroll
      for (int kt = 0; kt < 4; ++kt) {
#pragma unroll
        for (int q = 0; q < 4; ++q) {
          const f32x4 d4 = *(const f32x4*)(DD + 32 * kt + 8 * q + 4 * hh);
#pragma unroll
          for (int c = 0; c < 4; ++c) S[kt][4 * q + c] *= d4[c];
        }
        const u32x2 lo = *(const u32x2*)(KDT + (32 * kt + l32) * 20 + 4 * hh);
        const u32x2 hi = *(const u32x2*)(KDT + (32 * kt + l32) * 20 + 8 + 4 * hh);
        S[kt] = __builtin_amdgcn_mfma_f32_32x32x16_bf16(mk8(lo, hi), vfrag, S[kt], 0, 0, 0);
      }
      float ss = 0.f;
#pragma unroll
      for (int i = 0; i < 16; ++i) ss += oacc[i] * oacc[i];
      ss += __shfl_xor(ss, 32);
      if (l < 16) REDB[(blk & 1) * 64 + w * 16 + l] = ss;
      __syncthreads();
      GLA_FINAL(blk);
    }
#undef GLA_LOADGS
#undef GLA_LOADV
#undef GLA_LOADRAW
#undef GLA_FINAL
    if (smp || ch == 3) {
      float* op = (smp ? p.hgrn_sample + ((size_t)(layer * 8 + (s - 16)) * 8 + h) * 16384
                       : p.hgrn_prompt + ((size_t)(layer * 16 + s) * 8 + h) * 16384) + 32 * w + l32;
#pragma unroll
      for (int kt = 0; kt < 4; ++kt)
#pragma unroll
        for (int i = 0; i < 16; ++i) op[(size_t)(32 * kt + (i & 3) + 8 * (i >> 2) + 4 * hh) * 128] = S[kt][i];
    }
  }
}

DI void kvconv_phase(const P& p) {
  const int tid = ltid();
  char* KVT = p.BIG + (size_t)ROWS * 1024 * 2;
  for (int t = lbid(); t < 4096 + 1088; t += gridDim.x) {
    const float *kb, *vb; int nvalid = 64;
    if (t < 4096) { const int kt = t & 31, sh = t >> 5, s = sh >> 3, h = sh & 7; const size_t off = ((size_t)(s * 2048 + 64 * kt)) * 1024 + h * 128; kb = p.k_prompt + off; vb = p.v_prompt + off; }
    else { const int u = t - 4096; const int kt = u % 17, sh = u / 17, b = sh >> 3, h = sh & 7;
      if (kt < 16) { const size_t off = ((size_t)(b * 1024 + 64 * kt)) * 1024 + h * 128; kb = p.cache_k + off; vb = p.cache_v + off; }
      else { const size_t off = ((size_t)(b * 32)) * 1024 + h * 128; kb = p.k_sample + off; vb = p.v_sample + off; nvalid = 32; } }
    u16* kd = (u16*)(KVT + (size_t)t * 32768);
    u16* vd = kd + 8192;
#pragma unroll
    for (int pp = 0; pp < 4; ++pp) {
      const int key = 16 * pp + (tid >> 4), d8 = (tid & 15) * 8;
      f32x4 a = {0.f, 0.f, 0.f, 0.f}, b2 = {0.f, 0.f, 0.f, 0.f};
      if (key < nvalid) { a = *(const f32x4*)(kb + (size_t)key * 1024 + d8); b2 = *(const f32x4*)(kb + (size_t)key * 1024 + d8 + 4); }
      *(u32x4*)(kd + key * 128 + d8) = (u32x4){pk2(a[0], a[1]), pk2(a[2], a[3]), pk2(b2[0], b2[1]), pk2(b2[2], b2[3])};
    }
#pragma unroll
    for (int c = 0; c < 4; ++c) {
      const int v = tid & 127, cc = 4 * (tid >> 7) + c;
      float e[8];
#pragma unroll
      for (int j = 0; j < 8; ++j) { const int key = 8 * cc + j; e[j] = key < nvalid ? vb[(size_t)key * 1024 + v] : 0.f; }
      *(u32x4*)(vd + v * 64 + 8 * cc) = (u32x4){pk2(e[0], e[1]), pk2(e[2], e[3]), pk2(e[4], e[5]), pk2(e[6], e[7])};
    }
  }
}

DI void attn_phase(const P& p, int layer, char* smem) {
  const int jl = layer - 2;
  const u16* Q = (const u16*)p.BIG;
  const char* KVT = p.BIG + (size_t)ROWS * 1024 * 2;
  const int tid = ltid(), l = tid & 63, w = tid >> 6, l16 = l & 15, g = l >> 4;
  u16* KS = (u16*)smem;
  u16* VT = KS + 64 * 136;
  float* BT = (float*)(VT + 128 * 72);
  u16* QS = (u16*)(BT + 256);
  const float lam_init = 0.8f - 0.6f * __expf(-0.3f * (float)layer);
  float lam;
  {
    const float* lp = p.lam_b + jl * 256;
    float a = 0.f, b = 0.f;
    for (int d = 0; d < 64; ++d) { a += lp[d] * lp[64 + d]; b += lp[128 + d] * lp[192 + d]; }
    lam = __expf(a) - __expf(b) + lam_init;
  }
  for (int item = lbid(); item < 4096 + 64; item += gridDim.x) {
    int b, h, nq, qrow0, qpos0, ntiles, tile0; bool smp;
    if (item < 4096) { const int jq = 31 - (item >> 7); const int bh = item & 127; b = bh >> 3; h = bh & 7; smp = false; nq = 64; qrow0 = b * 2048 + 64 * jq; qpos0 = 64 * jq; ntiles = jq + 1; tile0 = bh * 32; }
    else { const int si = item - 4096; b = si >> 3; h = si & 7; smp = true; nq = 32; qrow0 = ROWS_P + b * 32; qpos0 = 1024; ntiles = 17; tile0 = 4096 + si * 17; }
    __syncthreads();
    if (tid < 230) {
      const int rel = tid - 166;
      const int n = rel < 0 ? -rel : rel;
      int bk = n < 8 ? n : 8 + (n >= 13) + (n >= 20) + (n >= 30) + (n >= 46) + (n >= 70) + (n >= 108) + (n >= 166);
      if (rel > 0) bk += 16;
      BT[tid] = p.rel_bias[bk * 8 + h] * LOG2E;
    }
#pragma unroll
    for (int pp = 0; pp < 4; ++pp) {
      const int idx = pp * 256 + tid, r = idx >> 4, c16 = idx & 15;
      *(u32x4*)(QS + r * 136 + c16 * 8) = *(const u32x4*)(Q + (size_t)(qrow0 + min(r, nq - 1)) * 1024 + h * 128 + c16 * 8);
    }
    f32x4 oacc[2][8];
#pragma unroll
    for (int c = 0; c < 2; ++c)
#pragma unroll
      for (int vs = 0; vs < 8; ++vs) oacc[c][vs] = (f32x4){0.f, 0.f, 0.f, 0.f};
    float mrun[2] = {-1e30f, -1e30f}, lsum[2] = {0.f, 0.f};
    const int qpos = qpos0 + min(16 * w + l16, nq - 1);
    u32x4 rk[4], rv[4];
    {
      const u32x4* src = (const u32x4*)(KVT + (size_t)tile0 * 32768);
#pragma unroll
      for (int pp = 0; pp < 4; ++pp) { rk[pp] = src[pp * 256 + tid]; rv[pp] = src[1024 + pp * 256 + tid]; }
    }
    for (int kt = 0; kt < ntiles; ++kt) {
      const int nvalid = (smp && kt == 16) ? 32 : 64;
      if (kt > 0) __syncthreads();
#pragma unroll
      for (int pp = 0; pp < 4; ++pp) {
        const int idx = pp * 256 + tid;
        *(u32x4*)(KS + (idx >> 4) * 136 + (idx & 15) * 8) = rk[pp];
        *(u32x4*)(VT + (idx >> 3) * 72 + (idx & 7) * 8) = rv[pp];
      }
      if (kt + 1 < ntiles) {
        const u32x4* src = (const u32x4*)(KVT + (size_t)(tile0 + kt + 1) * 32768);
#pragma unroll
        for (int pp = 0; pp < 4; ++pp) { rk[pp] = src[pp * 256 + tid]; rv[pp] = src[1024 + pp * 256 + tid]; }
      }
      __syncthreads();
      f32x4 sacc[2][4];
#pragma unroll
      for (int c = 0; c < 2; ++c)
#pragma unroll
        for (int sub = 0; sub < 4; ++sub) {
          sacc[c][sub] = (f32x4){0.f, 0.f, 0.f, 0.f};
#pragma unroll
          for (int ks = 0; ks < 2; ++ks) {
            const bf16x8 kf = *(const bf16x8*)(KS + (16 * sub + l16) * 136 + c * 64 + 32 * ks + 8 * g);
            const bf16x8 qfr = *(const bf16x8*)(QS + (16 * w + l16) * 136 + c * 64 + 32 * ks + 8 * g);
            sacc[c][sub] = __builtin_amdgcn_mfma_f32_16x16x32_bf16(kf, qfr, sacc[c][sub], 0, 0, 0);
          }
        }
#pragma unroll
      for (int sub = 0; sub < 4; ++sub)
#pragma unroll
        for (int i = 0; i < 4; ++i) {
          const int kl = 16 * sub + 4 * g + i;
          int rel = 64 * kt + kl - qpos;
          rel = rel < -166 ? -166 : rel;
          const float bt = BT[rel + 166];
          const bool ok = kl < nvalid;
          sacc[0][sub][i] = ok ? sacc[0][sub][i] + bt : -30000.f;
          sacc[1][sub][i] = ok ? sacc[1][sub][i] + bt : -30000.f;
        }
      bf16x8 pf[2][2];
#pragma unroll
      for (int c = 0; c < 2; ++c) {
        float mx = -1e30f;
#pragma unroll
        for (int sub = 0; sub < 4; ++sub)
#pragma unroll
          for (int i = 0; i < 4; ++i) mx = fmaxf(mx, sacc[c][sub][i]);
        mx = fmaxf(mx, __shfl_xor(mx, 16));
        mx = fmaxf(mx, __shfl_xor(mx, 32));
        const float mnew = fmaxf(mrun[c], mx);
        const float alpha = __builtin_amdgcn_exp2f(mrun[c] - mnew);
        mrun[c] = mnew;
        float rs = 0.f;
#pragma unroll
        for (int sub = 0; sub < 4; ++sub)
#pragma unroll
          for (int i = 0; i < 4; ++i) { const float e = __builtin_amdgcn_exp2f(sacc[c][sub][i] - mnew); sacc[c][sub][i] = e; rs += e; }
        lsum[c] = lsum[c] * alpha + rs;
#pragma unroll
        for (int vs = 0; vs < 8; ++vs) oacc[c][vs] *= alpha;
#pragma unroll
        for (int j = 0; j < 2; ++j)
          pf[c][j] = mk8u(pk2(sacc[c][2 * j][0], sacc[c][2 * j][1]), pk2(sacc[c][2 * j][2], sacc[c][2 * j][3]),
                          pk2(sacc[c][2 * j + 1][0], sacc[c][2 * j + 1][1]), pk2(sacc[c][2 * j + 1][2], sacc[c][2 * j + 1][3]));
      }
#pragma unroll
      for (int j = 0; j < 2; ++j)
#pragma unroll
        for (int vs = 0; vs < 8; ++vs) {
          const u32x2 lo = *(const u32x2*)(VT + (16 * vs + l16) * 72 + 32 * j + 4 * g);
          const u32x2 hi = *(const u32x2*)(VT + (16 * vs + l16) * 72 + 32 * j + 16 + 4 * g);
          const bf16x8 vf = mk8(lo, hi);
          oacc[0][vs] = __builtin_amdgcn_mfma_f32_16x16x32_bf16(vf, pf[0][j], oacc[0][vs], 0, 0, 0);
          oacc[1][vs] = __builtin_amdgcn_mfma_f32_16x16x32_bf16(vf, pf[1][j], oacc[1][vs], 0, 0, 0);
        }
    }
#pragma unroll
    for (int c = 0; c < 2; ++c) { lsum[c] += __shfl_xor(lsum[c], 16); lsum[c] += __shfl_xor(lsum[c], 32); }
    const float inv0 = 1.f / lsum[0], inv1 = lam / lsum[1];
    float ss = 0.f;
#pragma unroll
    for (int vs = 0; vs < 8; ++vs)
#pragma unroll
      for (int i = 0; i < 4; ++i) { const float o = oacc[0][vs][i] * inv0 - oacc[1][vs][i] * inv1; oacc[0][vs][i] = o; ss += o * o; }
    ss += __shfl_xor(ss, 16);
    ss += __shfl_xor(ss, 32);
    const float rn = rsqrtf(ss * (1.f / 128.f) + EPS) * (1.f - lam_init);
    if (16 * w + l16 < nq) {
      const size_t row = (size_t)qrow0 + 16 * w + l16;
#pragma unroll
      for (int vs = 0; vs < 8; ++vs) {
        const int v = h * 128 + 16 * vs + 4 * g;
        const f32x4 gl = *(const f32x4*)(p.g_subln + jl * 1024 + v);
        *(u32x2*)(p.OG + row * 1024 + v) = (u32x2){pk2(oacc[0][vs][0] * rn * gl[0], oacc[0][vs][1] * rn * gl[1]),
                                                   pk2(oacc[0][vs][2] * rn * gl[2], oacc[0][vs][3] * rn * gl[3])};
      }
    }
  }
}

DI void gbar(unsigned* bar, unsigned& gen) {
  gen += 1;
  asm volatile("" : "+s"(bar));
  const unsigned tix = (unsigned)ltid();
  asm volatile("s_waitcnt vmcnt(0) lgkmcnt(0)" ::: "memory");
  __syncthreads();
  if (tix < 64) {
    const unsigned g = lbid() >> 4, ng = gridDim.x >> 4;
    bool last = false;
    if (tix == 0) {
      __builtin_amdgcn_fence(__ATOMIC_RELEASE, "agent");
      asm volatile("s_waitcnt vmcnt(0)" ::: "memory");
      const unsigned o = __hip_atomic_fetch_add(bar + 64 * g, 1u, __ATOMIC_RELAXED, __HIP_MEMORY_SCOPE_AGENT);
      if (o + 1 == 16 * gen) {
        const unsigned o2 = __hip_atomic_fetch_add(bar + 64 * 64, 1u, __ATOMIC_RELAXED, __HIP_MEMORY_SCOPE_AGENT);
        last = (o2 + 1 == ng * gen);
      }
    }
    last = __shfl(last ? 1 : 0, 0) != 0;
    if (last && tix < ng) __hip_atomic_store(bar + 64 * (65 + tix), gen, __ATOMIC_RELAXED, __HIP_MEMORY_SCOPE_AGENT);
    if (tix == 0) {
      while (__hip_atomic_load(bar + 64 * (65 + g), __ATOMIC_RELAXED, __HIP_MEMORY_SCOPE_AGENT) < gen) __builtin_amdgcn_s_sleep(2);
      __builtin_amdgcn_fence(__ATOMIC_ACQUIRE, "agent");
      asm volatile("s_waitcnt vmcnt(0)" ::: "memory");
    }
  }
  __syncthreads();
}

__global__ void __launch_bounds__(256, 2) yoco_megakernel(P p) {
  __shared__ __attribute__((aligned(16))) char smem[65536];
  cg::grid_group grid = cg::this_grid();
  if (blockIdx.x == 0 && threadIdx.x < 130) __hip_atomic_store(p.bar + 64 * threadIdx.x, 0u, __ATOMIC_RELAXED, __HIP_MEMORY_SCOPE_AGENT);
  prep_phase(p, smem);
  grid.sync();
  unsigned btarget = 0;
  u16* Mbuf = (u16*)p.BIG;
  u16* Fbuf = p.XB;
  u16* XB2 = (u16*)p.BIG;
  u16* PB = (u16*)(p.BIG + (size_t)ROWS * 1024 * 2);
#pragma unroll
  for (int i = 0; i < 4; ++i) {
    const float* gn = p.g_norms + i * 4 * D;
    if (i == 0) {
      rowop_phase(p, true, nullptr, nullptr, gn, p.XB, nullptr, nullptr, nullptr);
      gbar(p.bar, btarget);
    }
    if (i < 2) {
      REPG gemm_phase<0>(p, p.XB, 1024, p.wt_in_a + (size_t)i * 4096 * 1024, 4096, p.BIG, smem, i ? p.ss : nullptr);
      gbar(p.bar, btarget);
      gla_state_phase(p, i, smem);
      gbar(p.bar, btarget);
      for (int _r = 0; _r < REP_GLA; ++_r) gla_phase(p, i, smem);
      gbar(p.bar, btarget);
      REPG gemm_phase<2>(p, p.OG, 1024, p.wt_out_a + (size_t)i * 1024 * 1024, 1024, Mbuf, smem);
      gbar(p.bar, btarget);
    } else {
      if (i == 2) gemm_phase<3>(p, p.XB, 1024, p.wt_kv, 2048, nullptr, smem, p.ss);
      REPG gemm_phase<1>(p, p.XB, 1024, p.wt_q + (size_t)(i - 2) * 1024 * 1024, 1024, p.BIG, smem, p.ss);
      if (i == 2) gbar(p.bar, btarget);
      kvconv_phase(p);
      gbar(p.bar, btarget);
      for (int _r = 0; _r < REP_ATTN; ++_r) attn_phase(p, i, smem);
      gbar(p.bar, btarget);
      REPG gemm_phase<2>(p, p.OG, 1024, p.wt_out_b + (size_t)(i - 2) * 1024 * 1024, 1024, Mbuf, smem);
      gbar(p.bar, btarget);
    }
    rowop_phase(p, i == 0, Mbuf, gn + D, gn + 2 * D, p.XB, nullptr, nullptr, nullptr);
    gbar(p.bar, btarget);
    REPG ffn_in_phase(p, i, smem);
    gbar(p.bar, btarget);
    REPG gemm_phase<2>(p, (const u16*)p.BIG, DFF, p.wt_ffn_out + (size_t)i * 1024 * DFF, 1024, Fbuf, smem);
    gbar(p.bar, btarget);
    rowop_phase(p, false, Fbuf, gn + 3 * D, nullptr, XB2, p.p_prompt + (size_t)i * ROWS_P * 256, p.p_sample + (size_t)i * 256 * 256, PB);
    gbar(p.bar, btarget);
    ple_phase(p, i, smem);
    gbar(p.bar, btarget);
  }
}

extern "C" void kernel_launch(void* const* d_in, const int* in_sizes, int n_in, void* d_out, int out_size, void* d_ws,
                              size_t ws_size, hipStream_t stream) {
  static int grid_blocks = 0;
  if (!grid_blocks) {
    int dev = 0, cus = 0, per_cu = 0;
    hipGetDevice(&dev);
    hipDeviceGetAttribute(&cus, hipDeviceAttributeMultiprocessorCount, dev);
    hipOccupancyMaxActiveBlocksPerMultiprocessor(&per_cu, yoco_megakernel, 256, 0);
    if (per_cu > 2) per_cu = 2;
    grid_blocks = cus * per_cu;
    grid_blocks &= ~7;
  }
  P p{};
  const float* const* in = (const float* const*)d_in;
  p.x_prompt = in[0]; p.x_sample = in[1]; p.cache_k = in[2]; p.cache_v = in[3]; p.state_hgrn = in[4]; p.state_conv = in[5];
  p.p_prompt = in[6]; p.p_sample = in[7];
  p.g_norms = in[8]; const float* w_in_a = in[9]; p.lb_raw = in[10]; p.g_hg = in[11]; const float* w_out_a = in[12]; p.g_kv = in[13];
  const float* w_kv = in[14]; p.rel_bias = in[15]; const float* w_q_b = in[16]; p.lam_b = in[17]; p.g_subln = in[18];
  const float* w_out_b = in[19]; const float* w_ffn_in = in[20]; p.conv_w = in[21]; p.conv_b = in[22]; const float* w_ffn_out = in[23];
  const float* w_ple = in[24]; const float* w_ple_gate = in[25];
  float* o = (float*)d_out;
  p.y = o; o += (size_t)ROWS * D;
  p.k_prompt = o; o += (size_t)ROWS_P * D;
  p.v_prompt = o; o += (size_t)ROWS_P * D;
  p.k_sample = o; o += (size_t)256 * D;
  p.v_sample = o; o += (size_t)256 * D;
  p.hgrn_prompt = o; o += (size_t)2 * 16 * 8 * 16384;
  p.hgrn_sample = o; o += (size_t)2 * 8 * 8 * 16384;
  p.conv_prompt = o; o += (size_t)4 * 16 * 2 * DFF;
  p.conv_sample = o;
  u16* ws = (u16*)d_ws;
  p.wt_in_a = ws; ws += (size_t)2 * 4096 * 1024;
  p.wt_out_a = ws; ws += (size_t)2 * 1024 * 1024;
  p.wt_kv = ws; ws += (size_t)2048 * 1024;
  p.wt_q = ws; ws += (size_t)2 * 1024 * 1024;
  p.wt_out_b = ws; ws += (size_t)2 * 1024 * 1024;
  p.wt_ffn_in = ws; ws += (size_t)4 * 5632 * 1024;
  p.wt_ffn_out = ws; ws += (size_t)4 * 1024 * DFF;
  p.wt_ple = ws; ws += (size_t)4 * 1024 * 256;
  p.wt_gate = ws; ws += (size_t)4 * 1024 * 1024;
  p.XB = ws; ws += (size_t)ROWS * 1024;
  p.OG = ws; ws += (size_t)ROWS * 1024;
  p.BIG = (char*)ws;
  p.bar = (unsigned*)((char*)d_ws + ((size_t)500 << 20));
  p.ss = (float*)((char*)d_ws + ((size_t)501 << 20));
  int n = 0;
  for (int i = 0; i < 2; ++i) p.wd[n++] = WD{w_in_a + (size_t)i * 1024 * 4096, p.wt_in_a + (size_t)i * 4096 * 1024, i ? p.g_norms + 4 * D : nullptr, 1024, 4096, 0, 0};
  for (int i = 0; i < 2; ++i) p.wd[n++] = WD{w_out_a + (size_t)i * 1024 * 1024, p.wt_out_a + (size_t)i * 1024 * 1024, nullptr, 1024, 1024, 0, 0};
  p.wd[n++] = WD{w_kv, p.wt_kv, p.g_kv, 1024, 2048, 0, 0};
  for (int i = 0; i < 2; ++i) p.wd[n++] = WD{w_q_b + (size_t)i * 1024 * 1024, p.wt_q + (size_t)i * 1024 * 1024, p.g_norms + (size_t)(i + 2) * 4 * D, 1024, 1024, 0, 0};
  for (int i = 0; i < 2; ++i) p.wd[n++] = WD{w_out_b + (size_t)i * 1024 * 1024, p.wt_out_b + (size_t)i * 1024 * 1024, nullptr, 1024, 1024, 0, 0};
  for (int i = 0; i < 4; ++i) p.wd[n++] = WD{w_ffn_in + (size_t)i * 1024 * 5632, p.wt_ffn_in + (size_t)i * 5632 * 1024, nullptr, 1024, 5632, 1, 0};
  for (int i = 0; i < 4; ++i) p.wd[n++] = WD{w_ffn_out + (size_t)i * DFF * 1024, p.wt_ffn_out + (size_t)i * 1024 * DFF, nullptr, DFF, 1024, 0, 0};
  for (int i = 0; i < 4; ++i) p.wd[n++] = WD{w_ple + (size_t)i * 256 * 1024, p.wt_ple + (size_t)i * 1024 * 256, nullptr, 256, 1024, 0, 0};
  for (int i = 0; i < 4; ++i) p.wd[n++] = WD{w_ple_gate + (size_t)i * 1024 * 1024, p.wt_gate + (size_t)i * 1024 * 1024, nullptr, 1024, 1024, 0, 0};
  void* args[] = {&p};
  hipError_t e = hipLaunchCooperativeKernel((void*)yoco_megakernel, dim3(grid_blocks), dim3(256), args, 0, stream);
  if (e != hipSuccess) fprintf(stderr, "cooperative launch failed: %s (grid %d)\n", hipGetErrorString(e), grid_blocks);
}
```

```cpp
#include <hip/hip_runtime.h>
#include <hip/hip_cooperative_groups.h>
#include <cstdio>
namespace cg = cooperative_groups;

#define DI __device__ __forceinline__
typedef unsigned short u16;
typedef short bf16x8 __attribute__((ext_vector_type(8)));
typedef float f32x16 __attribute__((ext_vector_type(16)));
typedef float f32x4 __attribute__((ext_vector_type(4)));
typedef __bf16 bf2_t __attribute__((ext_vector_type(2)));
typedef float f2_t __attribute__((ext_vector_type(2)));
typedef unsigned u32x2 __attribute__((ext_vector_type(2)));
typedef unsigned u32x4 __attribute__((ext_vector_type(4)));

constexpr int D = 1024, ROWS_P = 32768, ROWS = 33024, DFF = 2816;
constexpr float EPS = 1e-6f;
constexpr float LOG2E = 1.4426950408889634f;
constexpr int NW = 25;
#ifndef REP_GEMM
#define REP_GEMM 1
#endif
#ifndef REP_GLA
#define REP_GLA 1
#endif
#ifndef REP_ATTN
#define REP_ATTN 1
#endif
#define REPG for (int _r = 0; _r < REP_GEMM; ++_r)

struct WD { const float* src; u16* dst; const float* gain; int K, N, mode, pad; };

struct P {
  const float *x_prompt, *x_sample, *cache_k, *cache_v, *state_hgrn, *state_conv, *p_prompt, *p_sample;
  const float *g_norms, *lb_raw, *g_hg, *g_kv, *rel_bias, *lam_b, *g_subln, *conv_w, *conv_b;
  float *y, *k_prompt, *v_prompt, *k_sample, *v_sample, *hgrn_prompt, *hgrn_sample, *conv_prompt, *conv_sample;
  u16 *wt_in_a, *wt_out_a, *wt_kv, *wt_q, *wt_out_b, *wt_ffn_in, *wt_ffn_out, *wt_ple, *wt_gate;
  u16 *XB, *OG; char* BIG; unsigned* bar; float* ss;
  WD wd[NW];
};

DI unsigned pk2(float a, float b) { f2_t v = {a, b}; bf2_t r = __builtin_convertvector(v, bf2_t); return __builtin_bit_cast(unsigned, r); }
DI int lbid() { int b = blockIdx.x; asm volatile("" : "+s"(b)); return b; }
DI int ltid() { int t = threadIdx.x; asm volatile("" : "+v"(t)); return t; }
DI float bf2f(u16 x) { return __uint_as_float(((unsigned)x) << 16); }
DI float bflo(unsigned x) { return __uint_as_float(x << 16); }
DI float bfhi(unsigned x) { return __uint_as_float(x & 0xffff0000u); }
DI float sigm(float x) { return 1.f / (1.f + __expf(-x)); }
DI float wave_sum(float v) {
#pragma unroll
  for (int o = 32; o; o >>= 1) v += __shfl_xor(v, o);
  return v;
}
DI bf16x8 mk8(u32x2 lo, u32x2 hi) { u32x4 t = {lo[0], lo[1], hi[0], hi[1]}; return __builtin_bit_cast(bf16x8, t); }
DI bf16x8 mk8u(unsigned a, unsigned b, unsigned c, unsigned d) { u32x4 t = {a, b, c, d}; return __builtin_bit_cast(bf16x8, t); }

DI void prep_phase(const P& p, char* smem) {
  float* T = (float*)smem;
  const int tid = ltid();
  int total = 0;
  for (int i = 0; i < NW; ++i) total += (p.wd[i].K >> 6) * (p.wd[i].N >> 6);
  for (int flat = lbid(); flat < total; flat += gridDim.x) {
    int wi = 0, base = 0;
    for (;;) { int nt = (p.wd[wi].K >> 6) * (p.wd[wi].N >> 6); if (flat < base + nt) break; base += nt; ++wi; }
    const WD& d = p.wd[wi];
    const int tix = flat - base, ntn = d.N >> 6;
    const int k0 = (tix / ntn) << 6, n0 = (tix % ntn) << 6;
    {
      const int n = tid & 63, kb = tid >> 6;
#pragma unroll
      for (int j = 0; j < 16; ++j) { int k = kb + 4 * j; float v = d.src[(size_t)(k0 + k) * d.N + n0 + n]; if (d.gain) v *= d.gain[k0 + k]; T[k * 65 + n] = v; }
    }
    __syncthreads();
    {
      const int nn = tid >> 2, ks = tid & 3;
      int n = n0 + nn, drow = n;
      if (d.mode == 1) { int isu = n >= DFF; int ch = n - DFF * isu; drow = 256 * (ch >> 7) + 64 * ((ch >> 5) & 3) + 32 * isu + (ch & 31); }
      unsigned o[8];
#pragma unroll
      for (int j = 0; j < 8; ++j) o[j] = pk2(T[(16 * ks + 2 * j) * 65 + nn], T[(16 * ks + 2 * j + 1) * 65 + nn]);
      u16* fb = d.dst + (((size_t)(drow >> 5) * (d.K >> 4) + ((k0 >> 4) + ks)) * 64 + (drow & 31)) * 8;
      *(u32x4*)(fb) = (u32x4){o[0], o[1], o[2], o[3]};
      *(u32x4*)(fb + 256) = (u32x4){o[4], o[5], o[6], o[7]};
    }
    __syncthreads();
  }
}

DI void rowop_phase(const P& p, bool x_from_in, const u16* __restrict__ Madd, const float* __restrict__ gpost,
                    const float* __restrict__ gnext, u16* __restrict__ outH, const float* ple_p, const float* ple_s, u16* outP) {
  const int tidr = ltid();
  const int lane = tidr & 63;
  const int wave = (lbid() * blockDim.x + tidr) >> 6;
  const int nwave = (gridDim.x * blockDim.x) >> 6;
  for (int rb = wave * 2; rb < ROWS; rb += nwave * 2) {
    f32x4 x[2][4];
    u32x2 m[2][4];
#pragma unroll
    for (int u = 0; u < 2; ++u) {
      const int r = rb + u;
      const float* xs = x_from_in ? (r < ROWS_P ? p.x_prompt + (size_t)r * D : p.x_sample + (size_t)(r - ROWS_P) * D) : p.y + (size_t)r * D;
#pragma unroll
      for (int j = 0; j < 4; ++j) x[u][j] = *(const f32x4*)(xs + 4 * lane + 256 * j);
      if (Madd) {
#pragma unroll
        for (int j = 0; j < 4; ++j) m[u][j] = *(const u32x2*)(Madd + (size_t)r * D + 4 * lane + 256 * j);
      }
    }
#pragma unroll
    for (int u = 0; u < 2; ++u) {
      const int r = rb + u;
      if (Madd) {
        f32x4 mf[4]; float ss = 0.f;
#pragma unroll
        for (int j = 0; j < 4; ++j) { mf[j] = (f32x4){bflo(m[u][j][0]), bfhi(m[u][j][0]), bflo(m[u][j][1]), bfhi(m[u][j][1])}; ss += mf[j][0] * mf[j][0] + mf[j][1] * mf[j][1] + mf[j][2] * mf[j][2] + mf[j][3] * mf[j][3]; }
        ss = wave_sum(ss);
        const float rs = rsqrtf(ss * (1.f / D) + EPS);
#pragma unroll
        for (int j = 0; j < 4; ++j) { f32x4 g = *(const f32x4*)(gpost + 4 * lane + 256 * j); x[u][j] += mf[j] * rs * g; }
#pragma unroll
        for (int j = 0; j < 4; ++j) *(f32x4*)(p.y + (size_t)r * D + 4 * lane + 256 * j) = x[u][j];
      }
      float rx = 1.f;
      if (gnext) {
        float ss = 0.f;
#pragma unroll
        for (int j = 0; j < 4; ++j) ss += x[u][j][0] * x[u][j][0] + x[u][j][1] * x[u][j][1] + x[u][j][2] * x[u][j][2] + x[u][j][3] * x[u][j][3];
        ss = wave_sum(ss);
        rx = rsqrtf(ss * (1.f / D) + EPS);
      }
#pragma unroll
      for (int j = 0; j < 4; ++j) {
        f32x4 h = x[u][j] * rx;
        if (gnext) h *= *(const f32x4*)(gnext + 4 * lane + 256 * j);
        *(u32x2*)(outH + (size_t)r * D + 4 * lane + 256 * j) = (u32x2){pk2(h[0], h[1]), pk2(h[2], h[3])};
      }
      if (outP) {
        const float* ps = r < ROWS_P ? ple_p + (size_t)r * 256 : ple_s + (size_t)(r - ROWS_P) * 256;
        f32x4 v = *(const f32x4*)(ps + 4 * lane);
        *(u32x2*)(outP + (size_t)r * 256 + 4 * lane) = (u32x2){pk2(v[0], v[1]), pk2(v[2], v[3])};
      }
    }
  }
}

template <class RowMap>
DI void gemm_core(const u16* __restrict__ A, int lda, RowMap rm, const u16* __restrict__ Bt, int n0, int K,
                  f32x16 (&acc)[4][2], char* smem, const int tid) {
  const int l = tid & 63, w = tid >> 6, l32 = l & 31, hh = l >> 5;
  const int lr = tid >> 3, lc = tid & 7;
  const u16* ap[4];
#pragma unroll
  for (int q = 0; q < 4; ++q) ap[q] = A + (size_t)rm(q * 32 + lr) * lda + lc * 8;
  const u16* bq0 = Bt + ((size_t)((n0 + w * 64) >> 5) * (K >> 4) * 64 + l) * 8;
  const u16* bq1 = bq0 + (size_t)(K >> 4) * 512;
  const unsigned woff = lr * 144 + lc * 16;
  const unsigned aoff = l32 * 144 + hh * 16;
  u32x4 ra0[4];
  bf16x8 bf0[4], bf1[4];
  const int nk = K >> 6;
#define GLOADA(RA, T) _Pragma("unroll") for (int q = 0; q < 4; ++q) { RA[q] = *(const u32x4*)(ap[q] + (T) * 64); }
#define SWRITEA(RA, BUF) { char* db_ = smem + (BUF) * 18432; _Pragma("unroll") for (int q = 0; q < 4; ++q) { *(u32x4*)(db_ + woff + q * 4608) = RA[q]; } }
#define COMPUTE(BUF, TN, MORE) { const char* sb = smem + (BUF) * 18432; _Pragma("unroll") for (int ks = 0; ks < 4; ++ks) { \
      const unsigned co = ks * 32; \
      bf16x8 a0 = *(const bf16x8*)(sb + aoff + co); \
      bf16x8 a1 = *(const bf16x8*)(sb + aoff + 4608 + co); \
      bf16x8 a2 = *(const bf16x8*)(sb + aoff + 9216 + co); \
      bf16x8 a3 = *(const bf16x8*)(sb + aoff + 13824 + co); \
      acc[0][0] = __builtin_amdgcn_mfma_f32_32x32x16_bf16(bf0[ks], a0, acc[0][0], 0, 0, 0); \
      acc[0][1] = __builtin_amdgcn_mfma_f32_32x32x16_bf16(bf1[ks], a0, acc[0][1], 0, 0, 0); \
      acc[1][0] = __builtin_amdgcn_mfma_f32_32x32x16_bf16(bf0[ks], a1, acc[1][0], 0, 0, 0); \
      acc[1][1] = __builtin_amdgcn_mfma_f32_32x32x16_bf16(bf1[ks], a1, acc[1][1], 0, 0, 0); \
      acc[2][0] = __builtin_amdgcn_mfma_f32_32x32x16_bf16(bf0[ks], a2, acc[2][0], 0, 0, 0); \
      acc[2][1] = __builtin_amdgcn_mfma_f32_32x32x16_bf16(bf1[ks], a2, acc[2][1], 0, 0, 0); \
      acc[3][0] = __builtin_amdgcn_mfma_f32_32x32x16_bf16(bf0[ks], a3, acc[3][0], 0, 0, 0); \
      acc[3][1] = __builtin_amdgcn_mfma_f32_32x32x16_bf16(bf1[ks], a3, acc[3][1], 0, 0, 0); \
      if (MORE) { bf0[ks] = *(const bf16x8*)(bq0 + ((TN) * 4 + ks) * 512); bf1[ks] = *(const bf16x8*)(bq1 + ((TN) * 4 + ks) * 512); } \
      __builtin_amdgcn_sched_barrier(0); } }
  GLOADA(ra0, 0);
#pragma unroll
  for (int ks = 0; ks < 4; ++ks) { bf0[ks] = *(const bf16x8*)(bq0 + ks * 512); bf1[ks] = *(const bf16x8*)(bq1 + ks * 512); }
  SWRITEA(ra0, 0);
  __syncthreads();
  for (int kt = 0; kt < nk; kt += 2) {
    GLOADA(ra0, kt + 1);
    __builtin_amdgcn_sched_barrier(0);
    COMPUTE(0, kt + 1, true);
    SWRITEA(ra0, 1);
    __syncthreads();
    if (kt + 2 < nk) GLOADA(ra0, kt + 2);
    __builtin_amdgcn_sched_barrier(0);
    COMPUTE(1, kt + 2, kt + 2 < nk);
    if (kt + 2 < nk) SWRITEA(ra0, 0);
    __syncthreads();
  }
#undef GLOADA
#undef SWRITEA
#undef COMPUTE
}

template <class RowMap>
DI void gemm_core_mini(const u16* __restrict__ A, int lda, RowMap rm, const u16* __restrict__ Bt, int n0, int K,
                       f32x16 (&acc)[2], char* smem, const int tid) {
  const int l = tid & 63, w = tid >> 6, l32 = l & 31, hh = l >> 5;
  const int lr = tid >> 3, lc = tid & 7;
  const u16* ap[4];
#pragma unroll
  for (int q = 0; q < 4; ++q) ap[q] = A + (size_t)rm(q * 32 + lr) * lda + lc * 8;
  const u16* bq0 = Bt + ((size_t)(n0 >> 5) * (K >> 4) * 64 + l) * 8;
  const u16* bq1 = bq0 + (size_t)(K >> 4) * 512;
  const unsigned woff = lr * 144 + lc * 16;
  const unsigned aoff = (w * 32 + l32) * 144 + hh * 16;
  u32x4 ra0[4];
  bf16x8 bf0[4], bf1[4];
  const int nk = K >> 6;
#define GLOADA(RA, T) _Pragma("unroll") for (int q = 0; q < 4; ++q) { RA[q] = *(const u32x4*)(ap[q] + (T) * 64); }
#define SWRITEA(RA, BUF) { char* db_ = smem + (BUF) * 18432; _Pragma("unroll") for (int q = 0; q < 4; ++q) { *(u32x4*)(db_ + woff + q * 4608) = RA[q]; } }
#define COMPUTE(BUF, TN, MORE) { const char* sb = smem + (BUF) * 18432; _Pragma("unroll") for (int ks = 0; ks < 4; ++ks) { \
      const unsigned co = ks * 32; \
      bf16x8 a0 = *(const bf16x8*)(sb + aoff + co); \
      acc[0] = __builtin_amdgcn_mfma_f32_32x32x16_bf16(bf0[ks], a0, acc[0], 0, 0, 0); \
      acc[1] = __builtin_amdgcn_mfma_f32_32x32x16_bf16(bf1[ks], a0, acc[1], 0, 0, 0); \
      if (MORE) { bf0[ks] = *(const bf16x8*)(bq0 + ((TN) * 4 + ks) * 512); bf1[ks] = *(const bf16x8*)(bq1 + ((TN) * 4 + ks) * 512); } \
      __builtin_amdgcn_sched_barrier(0); } }
  GLOADA(ra0, 0);
#pragma unroll
  for (int ks = 0; ks < 4; ++ks) { bf0[ks] = *(const bf16x8*)(bq0 + ks * 512); bf1[ks] = *(const bf16x8*)(bq1 + ks * 512); }
  SWRITEA(ra0, 0);
  __syncthreads();
  for (int kt = 0; kt < nk; kt += 2) {
    GLOADA(ra0, kt + 1);
    __builtin_amdgcn_sched_barrier(0);
    COMPUTE(0, kt + 1, true);
    SWRITEA(ra0, 1);
    __syncthreads();
    if (kt + 2 < nk) GLOADA(ra0, kt + 2);
    __builtin_amdgcn_sched_barrier(0);
    COMPUTE(1, kt + 2, kt + 2 < nk);
    if (kt + 2 < nk) SWRITEA(ra0, 0);
    __syncthreads();
  }
#undef GLOADA
#undef SWRITEA
#undef COMPUTE
}

DI bool next_tile(int it, int ntm, int ntn, int& tm, int& tn) {
  const int b = lbid(), x = b & 7, slot = b >> 3, S = gridDim.x >> 3;
  const int nq = (ntm - x + 7) >> 3;
  const int L = slot + it * S;
  if (L >= nq * ntn) return false;
  const int gsize = 8 * ntn;
  const int grp = L / gsize, r = L - grp * gsize;
  const int gsz = min(8, nq - 8 * grp);
  tn = r / gsz;
  tm = x + 8 * (8 * grp + r % gsz);
  return true;
}

DI void list_entry(int L, int ntm, int ntn, int& tm, int& tn) {
  const int x = lbid() & 7;
  const int nq = (ntm - x + 7) >> 3;
  const int gsize = 8 * ntn;
  const int grp = L / gsize, r = L - grp * gsize;
  const int gsz = min(8, nq - 8 * grp);
  tn = r / gsz;
  tm = x + 8 * (8 * grp + r % gsz);
}
DI void list_info(int ntm, int ntn, int& full, int& nleft) {
  const int x = lbid() & 7, S = gridDim.x >> 3;
  const int len = ((ntm - x + 7) >> 3) * ntn;
  full = (len / S) * S;
  nleft = len - full;
  if (4 * nleft > S) { full = len; nleft = 0; }
}

struct IdMap { int base; DI int operator()(int r) const { return base + r; } };
struct ClampMap { int rowbase, t0, T; DI int operator()(int r) const { int t = t0 + r; t = t < 0 ? 0 : (t > T - 1 ? T - 1 : t); return rowbase + t; } };
struct ClampMap2 { int rowbase, t0, T, srow; DI int operator()(int r) const { if (srow >= 0 && r >= 64) { int t = r - 66; t = t < 0 ? 0 : (t > 31 ? 31 : t); return srow + t; } int t = t0 + r; t = t < 0 ? 0 : (t > T - 1 ? T - 1 : t); return rowbase + t; } };

#define ZERO_ACC(a) _Pragma("unroll") for (int _i = 0; _i < 4; ++_i) _Pragma("unroll") for (int _j = 0; _j < 2; ++_j) _Pragma("unroll") for (int _e = 0; _e < 16; ++_e) a[_i][_j][_e] = 0.f;

DI float row_rs(const float* rowss, int m) {
  const f32x4* sp = (const f32x4*)(rowss + (size_t)m * 16); const f32x4 s0 = sp[0], s1 = sp[1], s2 = sp[2], s3 = sp[3];
  const float tot = ((s0[0] + s0[1]) + (s0[2] + s0[3])) + ((s1[0] + s1[1]) + (s1[2] + s1[3])) + ((s2[0] + s2[1]) + (s2[2] + s2[3])) + ((s3[0] + s3[1]) + (s3[2] + s3[3]));
  return rsqrtf(tot * (1.f / D) + EPS);
}
template <int EPI>
DI void epi4(const P& p, void* outp, int m, int n, float v0, float v1, float v2, float v3) {
  if (EPI == 0) {
    const int sec = n >> 10;
    if (sec == 0 || sec == 3) { v0 *= sigm(v0); v1 *= sigm(v1); v2 *= sigm(v2); v3 *= sigm(v3); }
    *(u32x2*)((u16*)outp + (size_t)m * 4096 + n) = (u32x2){pk2(v0, v1), pk2(v2, v3)};
  } else if (EPI == 1) {
    const float sc = 0.125f * LOG2E;
    *(u32x2*)((u16*)outp + (size_t)m * 1024 + n) = (u32x2){pk2(v0 * sc, v1 * sc), pk2(v2 * sc, v3 * sc)};
  } else if (EPI == 2) {
    *(u32x2*)((u16*)outp + (size_t)m * 1024 + n) = (u32x2){pk2(v0, v1), pk2(v2, v3)};
  } else {
    float* dst;
    if (n < 1024) dst = (m < ROWS_P ? p.k_prompt + (size_t)m * 1024 : p.k_sample + (size_t)(m - ROWS_P) * 1024) + n;
    else dst = (m < ROWS_P ? p.v_prompt + (size_t)m * 1024 : p.v_sample + (size_t)(m - ROWS_P) * 1024) + (n - 1024);
    *(f32x4*)dst = (f32x4){v0, v1, v2, v3};
  }
}
template <int EPI>
DI void gemm_phase(const P& p, const u16* A, int K, const u16* Bt, int N, void* outp, char* smem, const float* rowss = nullptr) {
  const int tid = ltid(), l = tid & 63, w = tid >> 6, l32 = l & 31, hh = l >> 5;
  const int ntm = ROWS / 128, ntn = N / 256;
  const int slot = lbid() >> 3, S = gridDim.x >> 3;
  int full, nleft, tm, tn;
  list_info(ntm, ntn, full, nleft);
  for (int L = slot; L < full; L += S) {
    list_entry(L, ntm, ntn, tm, tn);
    f32x16 acc[4][2];
    ZERO_ACC(acc);
    gemm_core(A, K, IdMap{tm * 128}, Bt, tn * 256, K, acc, smem, ltid());
#pragma unroll
    for (int mi = 0; mi < 4; ++mi) {
      const int m = tm * 128 + mi * 32 + l32;
      float rsc = 1.f;
      if (rowss) rsc = row_rs(rowss, m);
#pragma unroll
      for (int ni = 0; ni < 2; ++ni)
#pragma unroll
        for (int q = 0; q < 4; ++q)
          epi4<EPI>(p, outp, m, tn * 256 + w * 64 + ni * 32 + 8 * q + 4 * hh,
                    acc[mi][ni][4 * q] * rsc, acc[mi][ni][4 * q + 1] * rsc, acc[mi][ni][4 * q + 2] * rsc, acc[mi][ni][4 * q + 3] * rsc);
    }
  }
  if (slot < 4 * nleft) {
    list_entry(full + (slot >> 2), ntm, ntn, tm, tn);
    const int n0 = tn * 256 + (slot & 3) * 64;
    f32x16 acc[2];
#pragma unroll
    for (int e = 0; e < 16; ++e) { acc[0][e] = 0.f; acc[1][e] = 0.f; }
    gemm_core_mini(A, K, IdMap{tm * 128}, Bt, n0, K, acc, smem, ltid());
    const int m = tm * 128 + w * 32 + l32;
    float rsc = 1.f;
    if (rowss) rsc = row_rs(rowss, m);
#pragma unroll
    for (int ni = 0; ni < 2; ++ni)
#pragma unroll
      for (int q = 0; q < 4; ++q)
        epi4<EPI>(p, outp, m, n0 + ni * 32 + 8 * q + 4 * hh,
                  acc[ni][4 * q] * rsc, acc[ni][4 * q + 1] * rsc, acc[ni][4 * q + 2] * rsc, acc[ni][4 * q + 3] * rsc);
  }
}

DI void ple_epi(const P& p, const u16* PL, int m, int n, float a0, float a1, float a2, float a3, float& ssq) {
  f32x4* xp = (f32x4*)(p.y + (size_t)m * D + n);
  f32x4 x = *xp;
  const u32x2 pv = *(const u32x2*)(PL + (size_t)m * D + n);
  x[0] += sigm(a0) * bflo(pv[0]);
  x[1] += sigm(a1) * bfhi(pv[0]);
  x[2] += sigm(a2) * bflo(pv[1]);
  x[3] += sigm(a3) * bfhi(pv[1]);
  *xp = x;
  *(u32x2*)(p.XB + (size_t)m * D + n) = (u32x2){pk2(x[0], x[1]), pk2(x[2], x[3])};
  ssq += x[0] * x[0] + x[1] * x[1] + x[2] * x[2] + x[3] * x[3];
}
DI void ple_phase(const P& p, int layer, char* smem) {
  const int tid = ltid(), l = tid & 63, w = tid >> 6, l32 = l & 31, hh = l >> 5;
  const u16* XB2 = (const u16*)p.BIG;
  const u16* PB = (const u16*)(p.BIG + (size_t)ROWS * 1024 * 2);
  u16* PL = (u16*)(p.BIG + (size_t)ROWS * 1024 * 2 + (size_t)ROWS * 256 * 2);
  const u16* Wg = p.wt_gate + (size_t)layer * 1024 * 1024;
  const u16* Wp = p.wt_ple + (size_t)layer * 1024 * 256;
  const int ntm = ROWS / 128, ntn = 4;
  const int slot = lbid() >> 3, S = gridDim.x >> 3;
  int full, nleft, tm, tn;
  list_info(ntm, ntn, full, nleft);
  for (int L = slot; L < full; L += S) {
    list_entry(L, ntm, ntn, tm, tn);
    f32x16 acc2[4][2];
    ZERO_ACC(acc2);
    gemm_core(PB, 256, IdMap{tm * 128}, Wp, tn * 256, 256, acc2, smem, ltid());
#pragma unroll
    for (int mi = 0; mi < 4; ++mi)
#pragma unroll
      for (int ni = 0; ni < 2; ++ni)
#pragma unroll
        for (int q = 0; q < 4; ++q)
          *(u32x2*)(PL + (size_t)(tm * 128 + mi * 32 + l32) * D + tn * 256 + w * 64 + ni * 32 + 8 * q + 4 * hh) =
              (u32x2){pk2(acc2[mi][ni][4 * q], acc2[mi][ni][4 * q + 1]), pk2(acc2[mi][ni][4 * q + 2], acc2[mi][ni][4 * q + 3])};
  }
  if (slot < 4 * nleft) {
    list_entry(full + (slot >> 2), ntm, ntn, tm, tn);
    const int n0 = tn * 256 + (slot & 3) * 64;
    f32x16 acc2[2];
#pragma unroll
    for (int e = 0; e < 16; ++e) { acc2[0][e] = 0.f; acc2[1][e] = 0.f; }
    gemm_core_mini(PB, 256, IdMap{tm * 128}, Wp, n0, 256, acc2, smem, ltid());
#pragma unroll
    for (int ni = 0; ni < 2; ++ni)
#pragma unroll
      for (int q = 0; q < 4; ++q)
        *(u32x2*)(PL + (size_t)(tm * 128 + w * 32 + l32) * D + n0 + ni * 32 + 8 * q + 4 * hh) =
            (u32x2){pk2(acc2[ni][4 * q], acc2[ni][4 * q + 1]), pk2(acc2[ni][4 * q + 2], acc2[ni][4 * q + 3])};
  }
  for (int L = slot; L < full; L += S) {
    list_entry(L, ntm, ntn, tm, tn);
    f32x16 acc[4][2];
    ZERO_ACC(acc);
    gemm_core(XB2, 1024, IdMap{tm * 128}, Wg, tn * 256, 1024, acc, smem, ltid());
#pragma unroll
    for (int mi = 0; mi < 4; ++mi) {
      const int m = tm * 128 + mi * 32 + l32;
      float ssq = 0.f;
#pragma unroll
      for (int ni = 0; ni < 2; ++ni)
#pragma unroll
        for (int q = 0; q < 4; ++q)
          ple_epi(p, PL, m, tn * 256 + w * 64 + ni * 32 + 8 * q + 4 * hh, acc[mi][ni][4 * q], acc[mi][ni][4 * q + 1], acc[mi][ni][4 * q + 2], acc[mi][ni][4 * q + 3], ssq);
      ssq += __shfl_xor(ssq, 32);
      if (hh == 0) p.ss[(size_t)m * 16 + tn * 4 + w] = ssq;
    }
  }
  if (slot < 4 * nleft) {
    list_entry(full + (slot >> 2), ntm, ntn, tm, tn);
    const int ws = slot & 3, n0 = tn * 256 + ws * 64;
    f32x16 acc[2];
#pragma unroll
    for (int e = 0; e < 16; ++e) { acc[0][e] = 0.f; acc[1][e] = 0.f; }
    gemm_core_mini(XB2, 1024, IdMap{tm * 128}, Wg, n0, 1024, acc, smem, ltid());
    const int m = tm * 128 + w * 32 + l32;
    float ssq = 0.f;
#pragma unroll
    for (int ni = 0; ni < 2; ++ni)
#pragma unroll
      for (int q = 0; q < 4; ++q)
        ple_epi(p, PL, m, n0 + ni * 32 + 8 * q + 4 * hh, acc[ni][4 * q], acc[ni][4 * q + 1], acc[ni][4 * q + 2], acc[ni][4 * q + 3], ssq);
    ssq += __shfl_xor(ssq, 32);
    if (hh == 0) p.ss[(size_t)m * 16 + tn * 4 + ws] = ssq;
  }
}

DI void ffn_in_phase(const P& p, int layer, char* smem) {
  const int tid = ltid(), l = tid & 63, w = tid >> 6, l32 = l & 31, hh = l >> 5;
  const u16* Wt = p.wt_ffn_in + (size_t)layer * 5632 * 1024;
  u16* HID = (u16*)p.BIG;
  const float* cw = p.conv_w + (size_t)layer * 3 * DFF;
  const float* cb = p.conv_b + (size_t)layer * DFF;
  int tm, tn;
  for (int it = 0; next_tile(it, 272, 22, tm, tn); ++it) {
    const int seq = tm / 17, j = tm - seq * 17;
    const int T = 2048, rowbase = seq * 2048, t0 = 126 * j - 2;
    const bool last = (j == 16);
    const bool has_smp = last && seq < 8;
    const int srow = ROWS_P + seq * 32;
    f32x16 acc[4][2];
    ZERO_ACC(acc);
    gemm_core(p.XB, 1024, ClampMap2{rowbase, t0, T, has_smp ? srow : -1}, Wt, tn * 256, 1024, acc, smem, tid);
    const int chw = tn * 128 + w * 32;
    if (t0 < 0 && l32 < 2) {
#pragma unroll
      for (int q = 0; q < 4; ++q)
#pragma unroll
        for (int c = 0; c < 4; ++c) acc[0][0][4 * q + c] = 0.f;
    }
    if (has_smp && l32 < 2) {
#pragma unroll
      for (int q = 0; q < 4; ++q) {
        const f32x4 sv = *(const f32x4*)(p.state_conv + ((size_t)(layer * 8 + seq) * 2 + l32) * DFF + chw + 8 * q + 4 * hh);
#pragma unroll
        for (int c = 0; c < 4; ++c) acc[2][0][4 * q + c] = sv[c];
      }
    }
    const int lbase = l & 32;
#pragma unroll
    for (int q = 0; q < 4; ++q) {
      const int chq = chw + 8 * q + 4 * hh;
      const f32x4 b4 = *(const f32x4*)(cb + chq);
      const f32x4 w0 = *(const f32x4*)(cw + chq), w1 = *(const f32x4*)(cw + DFF + chq), w2 = *(const f32x4*)(cw + 2 * DFF + chq);
#pragma unroll
      for (int mi = 0; mi < 4; ++mi) {
        const int m = mi * 32 + l32;
        const bool seg1 = has_smp && mi >= 2;
        const int t = seg1 ? m - 66 : t0 + m;
        const int Tm = seg1 ? 32 : T;
        float hv[4];
#pragma unroll
        for (int c = 0; c < 4; ++c) {
          const float g0 = acc[mi][0][4 * q + c];
          float g1 = __shfl(g0, lbase + ((l32 + 31) & 31));
          float g2 = __shfl(g0, lbase + ((l32 + 30) & 31));
          if (mi > 0) {
            const float pg = acc[mi > 0 ? mi - 1 : 0][0][4 * q + c];
            const float p1 = __shfl(pg, lbase + 31), p2 = __shfl(pg, lbase + 30);
            if (l32 == 0) { g1 = p1; g2 = p2; }
            if (l32 == 1) { g2 = p1; }
          }
          const float cv = b4[c] + w0[c] * g2 + w1[c] * g1 + w2[c] * g0;
          hv[c] = cv * sigm(cv) * acc[mi][1][4 * q + c];
        }
        if ((seg1 ? m >= 66 : m >= 2) && t < Tm) {
          *(u32x2*)(HID + (size_t)((seg1 ? srow : rowbase) + t) * DFF + chq) = (u32x2){pk2(hv[0], hv[1]), pk2(hv[2], hv[3])};
          if (last && t >= Tm - 2) {
            float* co = seg1 ? p.conv_sample + ((size_t)(layer * 8 + seq) * 2 + (t - 30)) * DFF
                             : p.conv_prompt + ((size_t)(layer * 16 + seq) * 2 + (t - (T - 2))) * DFF;
            *(f32x4*)(co + chq) = (f32x4){acc[mi][0][4 * q], acc[mi][0][4 * q + 1], acc[mi][0][4 * q + 2], acc[mi][0][4 * q + 3]};
          }
        }
      }
    }
  }
}

DI void gla_state_phase(const P& p, int layer, char* smem) {
  const u16* PROJ = (const u16*)p.BIG;
  const int tid = ltid(), l = tid & 63, w = tid >> 6, l32 = l & 31, hh = l >> 5;
  float* SLOC = (float*)p.XB;
  float* DTOT = SLOC + (size_t)384 * 16384;
  const int k = tid >> 1, th = tid & 1;
  for (int item = lbid(); item < 384; item += gridDim.x) {
    const int sh = item / 3, ch = item - sh * 3, s = sh >> 3, h = sh & 7;
    const int rowbase = s * 2048 + ch * 512;
    float lower = 0.f;
    if (layer == 1) lower = sigm(p.lb_raw[1024 + h * 128 + k] - p.lb_raw[h * 128 + k]);
    const float oml = 1.f - lower;
    f32x16 S[4];
#pragma unroll
    for (int kt = 0; kt < 4; ++kt)
#pragma unroll
      for (int i = 0; i < 16; ++i) S[kt][i] = 0.f;
    float btot = 0.f;
    u16 fr[8], vr[8];
#define GS_LOAD(BLK) { const size_t r0_ = (size_t)rowbase + (BLK) * 16; \
      const u16* pf_ = PROJ + (r0_ + 8 * th) * 4096 + 1024 + h * 128 + k; \
      const u16* pv_ = PROJ + r0_ * 4096 + 2048 + h * 128 + 32 * w + l32; \
      _Pragma("unroll") for (int t = 0; t < 8; ++t) fr[t] = pf_[(size_t)t * 4096]; \
      _Pragma("unroll") for (int jj = 0; jj < 8; ++jj) vr[jj] = pv_[(size_t)(8 * (jj >> 2) + 4 * hh + (jj & 3)) * 4096]; }
    GS_LOAD(0);
    for (int blk = 0; blk < 32; ++blk) {
      char* sb = smem + (blk & 1) * 8192;
      u16* KDT = (u16*)sb;
      float* DD = (float*)(KDT + 128 * 20);
      {
        float km[8], eb[8];
        float bs = 0.f;
#pragma unroll
        for (int t = 0; t < 8; ++t) {
          const float f = bf2f(fr[t]);
          const float g = lower + oml * sigm(f);
          bs += __logf(g);
          km[t] = 1.f - g; eb[t] = bs;
        }
        const float other = __shfl_xor(bs, 1);
        const float boff = th ? other : 0.f;
        const float bsum = bs + other;
        btot += bsum;
        unsigned kdp[4];
#pragma unroll
        for (int j = 0; j < 4; ++j)
          kdp[j] = pk2(km[2 * j] * __expf(bsum - boff - eb[2 * j]), km[2 * j + 1] * __expf(bsum - boff - eb[2 * j + 1]));
        *(u32x2*)(KDT + k * 20 + 8 * th) = (u32x2){kdp[0], kdp[1]};
        *(u32x2*)(KDT + k * 20 + 8 * th + 4) = (u32x2){kdp[2], kdp[3]};
        if (th == 0) DD[k] = __expf(bsum);
      }
      const bf16x8 vfrag = mk8u((unsigned)vr[0] | ((unsigned)vr[1] << 16), (unsigned)vr[2] | ((unsigned)vr[3] << 16),
                                (unsigned)vr[4] | ((unsigned)vr[5] << 16), (unsigned)vr[6] | ((unsigned)vr[7] << 16));
      if (blk + 1 < 32) GS_LOAD(blk + 1);
      __syncthreads();
#pragma unroll
      for (int kt = 0; kt < 4; ++kt) {
#pragma unroll
        for (int q = 0; q < 4; ++q) {
          const f32x4 d4 = *(const f32x4*)(DD + 32 * kt + 8 * q + 4 * hh);
#pragma unroll
          for (int c = 0; c < 4; ++c) S[kt][4 * q + c] *= d4[c];
        }
        const u32x2 lo = *(const u32x2*)(KDT + (32 * kt + l32) * 20 + 4 * hh);
        const u32x2 hi = *(const u32x2*)(KDT + (32 * kt + l32) * 20 + 8 + 4 * hh);
        S[kt] = __builtin_amdgcn_mfma_f32_32x32x16_bf16(mk8(lo, hi), vfrag, S[kt], 0, 0, 0);
      }
    }
#undef GS_LOAD
    {
      float* op = SLOC + (size_t)item * 16384 + 32 * w + l32;
#pragma unroll
      for (int kt = 0; kt < 4; ++kt)
#pragma unroll
        for (int i = 0; i < 16; ++i) op[(size_t)(32 * kt + (i & 3) + 8 * (i >> 2) + 4 * hh) * 128] = S[kt][i];
      if (th == 0) DTOT[(size_t)item * 128 + k] = __expf(btot);
    }
    __syncthreads();
  }
}

DI void gla_phase(const P& p, int layer, char* smem) {
  const u16* PROJ = (const u16*)p.BIG;
  const int tid = ltid(), l = tid & 63, w = tid >> 6, l32 = l & 31, hh = l >> 5, m16 = l & 15;
  float* REDB = (float*)(smem + 2 * 14336);
  const int k = tid >> 1, th = tid & 1;
  const float* SLOC = (const float*)p.XB;
  const float* DTOT = SLOC + (size_t)384 * 16384;
  for (int item = lbid(); item < 576; item += gridDim.x) {
    const bool smp = item < 64;
    const int s = smp ? 16 + (item >> 3) : (item - 64) >> 5;
    const int h = smp ? (item & 7) : ((item - 64) >> 2) & 7;
    const int ch = smp ? 0 : (item - 64) & 3;
    const int T = smp ? 32 : 512;
    const int rowbase = smp ? ROWS_P + (s - 16) * 32 : s * 2048 + ch * 512;
    float lower = 0.f;
    if (layer == 1) lower = sigm(p.lb_raw[1024 + h * 128 + k] - p.lb_raw[h * 128 + k]);
    const float oml = 1.f - lower;
    f32x16 S[4];
    if (smp) {
      const float* sp = p.state_hgrn + ((size_t)(layer * 8 + (s - 16)) * 8 + h) * 16384 + 32 * w + l32;
#pragma unroll
      for (int kt = 0; kt < 4; ++kt)
#pragma unroll
        for (int i = 0; i < 16; ++i) S[kt][i] = sp[(size_t)(32 * kt + (i & 3) + 8 * (i >> 2) + 4 * hh) * 128];
    } else {
#pragma unroll
      for (int kt = 0; kt < 4; ++kt)
#pragma unroll
        for (int i = 0; i < 16; ++i) S[kt][i] = 0.f;
#pragma unroll 1
      for (int j = 0; j < ch; ++j) {
        const int it1 = (s * 8 + h) * 3 + j;
        const float* sl = SLOC + (size_t)it1 * 16384 + 32 * w + l32 + (size_t)(4 * hh) * 128;
        const float* dl = DTOT + (size_t)it1 * 128 + 4 * hh;
#pragma unroll
        for (int kt = 0; kt < 4; ++kt) {
#pragma unroll
          for (int q = 0; q < 4; ++q) {
            const float* slq = sl + (size_t)(32 * kt + 8 * q) * 128;
            const f32x4 d4 = *(const f32x4*)(dl + 32 * kt + 8 * q);
#pragma unroll
            for (int c = 0; c < 4; ++c) S[kt][4 * q + c] = S[kt][4 * q + c] * d4[c] + slq[c * 128];
            __builtin_amdgcn_sched_barrier(0);
          }
        }
      }
    }
    const int nblk = T >> 4;
    u16 fr[8], qr[8], vr[8];
#define GLA_LOADRAW(BLK) { const size_t r0_ = (size_t)rowbase + (BLK) * 16; \
      const u16* pf_ = PROJ + (r0_ + 8 * th) * 4096 + 1024 + h * 128 + k; \
      const u16* pq_ = PROJ + (r0_ + 8 * th) * 4096 + h * 128 + k; \
      _Pragma("unroll") for (int t = 0; t < 8; ++t) fr[t] = pf_[(size_t)t * 4096]; \
      _Pragma("unroll") for (int j = 0; j < 8; ++j) qr[j] = pq_[(size_t)j * 4096]; \
 }
#define GLA_LOADV(BLK) { const u16* pv_ = PROJ + ((size_t)rowbase + (BLK) * 16) * 4096 + 2048 + h * 128 + 32 * w + l32; \
      _Pragma("unroll") for (int jj = 0; jj < 8; ++jj) vr[jj] = pv_[(size_t)(8 * (jj >> 2) + 4 * hh + (jj & 3)) * 4096]; }
#define GLA_LOADGS(BLK) { const u16* pg_ = PROJ + ((size_t)rowbase + (BLK) * 16 + m16) * 4096 + 3072 + h * 128 + 32 * w + 4 * hh; \
      _Pragma("unroll") for (int q = 0; q < 4; ++q) gsl[q] = *(const u32x2*)(pg_ + 8 * q); }
#define GLA_FINAL(BLK) { const float* RED_ = REDB + ((BLK) & 1) * 64; \
      if (l32 < 16) { \
        const float tot = RED_[l32] + RED_[16 + l32] + RED_[32 + l32] + RED_[48 + l32]; \
        const float rn = rsqrtf(tot * (1.f / 128.f) + EPS); \
        u16* op_ = p.OG + ((size_t)rowbase + (BLK) * 16 + l32) * 1024 + h * 128 + 32 * w + 4 * hh; \
        const float* gp_ = p.g_hg + layer * 1024 + h * 128 + 32 * w + 4 * hh; \
        _Pragma("unroll") for (int q = 0; q < 4; ++q) { const f32x4 gh = *(const f32x4*)(gp_ + 8 * q); \
          *(u32x2*)(op_ + 8 * q) = (u32x2){pk2(oacc[4 * q] * rn * gh[0] * bflo(gsl[q][0]), oacc[4 * q + 1] * rn * gh[1] * bfhi(gsl[q][0])), \
                                          pk2(oacc[4 * q + 2] * rn * gh[2] * bflo(gsl[q][1]), oacc[4 * q + 3] * rn * gh[3] * bfhi(gsl[q][1]))}; } \
      } }
    GLA_LOADRAW(0);
    u32x2 gsl[4];
    for (int blk = 0; blk < nblk; ++blk) {
      GLA_LOADGS(blk);
      GLA_LOADV(blk);
      char* sb = smem + (blk & 1) * 14336;
      u16* QT = (u16*)sb;
      u16* KT = QT + 16 * 136;
      u16* KDT = KT + 16 * 136;
      float* DD = (float*)(KDT + 128 * 20);
      {
        float qtm[8], ktm[8];
        float bs = 0.f;
#pragma unroll
        for (int t = 0; t < 8; ++t) {
          const float f = bf2f(fr[t]);
          const float g = lower + oml * sigm(f);
          bs += __logf(g);
          const float eb = __expf(bs);
          qtm[t] = bf2f(qr[t]) * eb;
          ktm[t] = (1.f - g) * __builtin_amdgcn_rcpf(eb);
        }
        const float other = __shfl_xor(bs, 1);
        const float boff = th ? other : 0.f;
        const float bsum = bs + other;
        const float E1 = __expf(boff), E1i = __expf(-boff), EL = __expf(bsum);
        unsigned kdp[4];
        float kdprev = 0.f;
#pragma unroll
        for (int j = 0; j < 8; ++j) {
          const int t = 8 * th + j;
          const float qt = qtm[j] * E1;
          const float ktv = ktm[j] * E1i;
          const float kd = ktv * EL;
          QT[t * 136 + k] = (u16)(pk2(qt, 0.f) & 0xffffu);
          KT[t * 136 + k] = (u16)(pk2(ktv, 0.f) & 0xffffu);
          if (j & 1) kdp[j >> 1] = pk2(kdprev, kd); else kdprev = kd;
        }
        *(u32x2*)(KDT + k * 20 + 8 * th) = (u32x2){kdp[0], kdp[1]};
        *(u32x2*)(KDT + k * 20 + 8 * th + 4) = (u32x2){kdp[2], kdp[3]};
        if (th == 0) DD[k] = __expf(bsum);
      }
      if (blk + 1 < nblk) GLA_LOADRAW(blk + 1);
      __syncthreads();
      const bf16x8 vfrag = mk8u((unsigned)vr[0] | ((unsigned)vr[1] << 16), (unsigned)vr[2] | ((unsigned)vr[3] << 16),
                                (unsigned)vr[4] | ((unsigned)vr[5] << 16), (unsigned)vr[6] | ((unsigned)vr[7] << 16));
      f32x16 aacc, oacc;
#pragma unroll
      for (int i = 0; i < 16; ++i) { aacc[i] = 0.f; oacc[i] = 0.f; }
#pragma unroll
      for (int ks = 0; ks < 8; ++ks) {
        const bf16x8 ka = *(const bf16x8*)(KT + m16 * 136 + 16 * ks + 8 * hh);
        const bf16x8 qb = *(const bf16x8*)(QT + m16 * 136 + 16 * ks + 8 * hh);
        aacc = __builtin_amdgcn_mfma_f32_32x32x16_bf16(ka, qb, aacc, 0, 0, 0);
        const int kt = ks >> 1, s2 = ks & 1;
        const bf16x8 sa = mk8u(pk2(S[kt][8 * s2], S[kt][8 * s2 + 1]), pk2(S[kt][8 * s2 + 2], S[kt][8 * s2 + 3]),
                               pk2(S[kt][8 * s2 + 4], S[kt][8 * s2 + 5]), pk2(S[kt][8 * s2 + 6], S[kt][8 * s2 + 7]));
        const u32x2 lo = *(const u32x2*)(QT + m16 * 136 + 32 * kt + 16 * s2 + 4 * hh);
        const u32x2 hi = *(const u32x2*)(QT + m16 * 136 + 32 * kt + 16 * s2 + 8 + 4 * hh);
        oacc = __builtin_amdgcn_mfma_f32_32x32x16_bf16(sa, mk8(lo, hi), oacc, 0, 0, 0);
      }
      float am[8];
#pragma unroll
      for (int i = 0; i < 8; ++i) { const int m = (i & 3) + 8 * (i >> 2) + 4 * hh; am[i] = (m <= m16) ? aacc[i] : 0.f; }
      const bf16x8 afrag = mk8u(pk2(am[0], am[1]), pk2(am[2], am[3]), pk2(am[4], am[5]), pk2(am[6], am[7]));
      oacc = __builtin_amdgcn_mfma_f32_32x32x16_bf16(vfrag, afrag, oacc, 0, 0, 0);
#pragma unroll
      for (int kt = 0; kt < 4; ++kt) {
#pragma unroll
        for (int q = 0; q < 4; ++q) {
          const f32x4 d4 = *(const f32x4*)(DD + 32 * kt + 8 * q + 4 * hh);
#pragma unroll
          for (int c = 0; c < 4; ++c) S[kt][4 * q + c] *= d4[c];
        }
        const u32x2 lo = *(const u32x2*)(KDT + (32 * kt + l32) * 20 + 4 * hh);
        const u32x2 hi = *(const u32x2*)(KDT + (32 * kt + l32) * 20 + 8 + 4 * hh);
        S[kt] = __builtin_amdgcn_mfma_f32_32x32x16_bf16(mk8(lo, hi), vfrag, S[kt], 0, 0, 0);
      }
      float ss = 0.f;
#pragma unroll
      for (int i = 0; i < 16; ++i) ss += oacc[i] * oacc[i];
      ss += __shfl_xor(ss, 32);
      if (l < 16) REDB[(blk & 1) * 64 + w * 16 + l] = ss;
      __syncthreads();
      GLA_FINAL(blk);
    }
#undef GLA_LOADGS
#undef GLA_LOADV
#undef GLA_LOADRAW
#undef GLA_FINAL
    if (smp || ch == 3) {
      float* op = (smp ? p.hgrn_sample + ((size_t)(layer * 8 + (s - 16)) * 8 + h) * 16384
                       : p.hgrn_prompt + ((size_t)(layer * 16 + s) * 8 + h) * 16384) + 32 * w + l32;
#pragma unroll
      for (int kt = 0; kt < 4; ++kt)
#pragma unroll
        for (int i = 0; i < 16; ++i) op[(size_t)(32 * kt + (i & 3) + 8 * (i >> 2) + 4 * hh) * 128] = S[kt][i];
    }
  }
}

DI void kvconv_phase(const P& p) {
  const int tid = ltid();
  char* KVT = p.BIG + (size_t)ROWS * 1024 * 2;
  for (int t = lbid(); t < 4096 + 1088; t += gridDim.x) {
    const float *kb, *vb; int nvalid = 64;
    if (t < 4096) { const int kt = t & 31, sh = t >> 5, s = sh >> 3, h = sh & 7; const size_t off = ((size_t)(s * 2048 + 64 * kt)) * 1024 + h * 128; kb = p.k_prompt + off; vb = p.v_prompt + off; }
    else { const int u = t - 4096; const int kt = u % 17, sh = u / 17, b = sh >> 3, h = sh & 7;
      if (kt < 16) { const size_t off = ((size_t)(b * 1024 + 64 * kt)) * 1024 + h * 128; kb = p.cache_k + off; vb = p.cache_v + off; }
      else { const size_t off = ((size_t)(b * 32)) * 1024 + h * 128; kb = p.k_sample + off; vb = p.v_sample + off; nvalid = 32; } }
    u16* kd = (u16*)(KVT + (size_t)t * 32768);
    u16* vd = kd + 8192;
#pragma unroll
    for (int pp = 0; pp < 4; ++pp) {
      const int key = 16 * pp + (tid >> 4), d8 = (tid & 15) * 8;
      f32x4 a = {0.f, 0.f, 0.f, 0.f}, b2 = {0.f, 0.f, 0.f, 0.f};
      if (key < nvalid) { a = *(const f32x4*)(kb + (size_t)key * 1024 + d8); b2 = *(const f32x4*)(kb + (size_t)key * 1024 + d8 + 4); }
      *(u32x4*)(kd + key * 128 + d8) = (u32x4){pk2(a[0], a[1]), pk2(a[2], a[3]), pk2(b2[0], b2[1]), pk2(b2[2], b2[3])};
    }
#pragma unroll
    for (int c = 0; c < 4; ++c) {
      const int v = tid & 127, cc = 4 * (tid >> 7) + c;
      float e[8];
#pragma unroll
      for (int j = 0; j < 8; ++j) { const int key = 8 * cc + j; e[j] = key < nvalid ? vb[(size_t)key * 1024 + v] : 0.f; }
      *(u32x4*)(vd + v * 64 + 8 * cc) = (u32x4){pk2(e[0], e[1]), pk2(e[2], e[3]), pk2(e[4], e[5]), pk2(e[6], e[7])};
    }
  }
}

DI void attn_phase(const P& p, int layer, char* smem) {
  const int jl = layer - 2;
  const u16* Q = (const u16*)p.BIG;
  const char* KVT = p.BIG + (size_t)ROWS * 1024 * 2;
  const int tid = ltid(), l = tid & 63, w = tid >> 6, l16 = l & 15, g = l >> 4;
  u16* KS = (u16*)smem;
  u16* VT = KS + 64 * 136;
  float* BT = (float*)(VT + 128 * 72);
  u16* QS = (u16*)(BT + 256);
  const float lam_init = 0.8f - 0.6f * __expf(-0.3f * (float)layer);
  float lam;
  {
    const float* lp = p.lam_b + jl * 256;
    float a = 0.f, b = 0.f;
    for (int d = 0; d < 64; ++d) { a += lp[d] * lp[64 + d]; b += lp[128 + d] * lp[192 + d]; }
    lam = __expf(a) - __expf(b) + lam_init;
  }
  for (int item = lbid(); item < 4096 + 64; item += gridDim.x) {
    int b, h, nq, qrow0, qpos0, ntiles, tile0; bool smp;
    if (item < 4096) { const int jq = 31 - (item >> 7); const int bh = item & 127; b = bh >> 3; h = bh & 7; smp = false; nq = 64; qrow0 = b * 2048 + 64 * jq; qpos0 = 64 * jq; ntiles = jq + 1; tile0 = bh * 32; }
    else { const int si = item - 4096; b = si >> 3; h = si & 7; smp = true; nq = 32; qrow0 = ROWS_P + b * 32; qpos0 = 1024; ntiles = 17; tile0 = 4096 + si * 17; }
    __syncthreads();
    if (tid < 230) {
      const int rel = tid - 166;
      const int n = rel < 0 ? -rel : rel;
      int bk = n < 8 ? n : 8 + (n >= 13) + (n >= 20) + (n >= 30) + (n >= 46) + (n >= 70) + (n >= 108) + (n >= 166);
      if (rel > 0) bk += 16;
      BT[tid] = p.rel_bias[bk * 8 + h] * LOG2E;
    }
#pragma unroll
    for (int pp = 0; pp < 4; ++pp) {
      const int idx = pp * 256 + tid, r = idx >> 4, c16 = idx & 15;
      *(u32x4*)(QS + r * 136 + c16 * 8) = *(const u32x4*)(Q + (size_t)(qrow0 + min(r, nq - 1)) * 1024 + h * 128 + c16 * 8);
    }
    f32x4 oacc[2][8];
#pragma unroll
    for (int c = 0; c < 2; ++c)
#pragma unroll
      for (int vs = 0; vs < 8; ++vs) oacc[c][vs] = (f32x4){0.f, 0.f, 0.f, 0.f};
    float mrun[2] = {-1e30f, -1e30f}, lsum[2] = {0.f, 0.f};
    const int qpos = qpos0 + min(16 * w + l16, nq - 1);
    u32x4 rk[4], rv[4];
    {
      const u32x4* src = (const u32x4*)(KVT + (size_t)tile0 * 32768);
#pragma unroll
      for (int pp = 0; pp < 4; ++pp) { rk[pp] = src[pp * 256 + tid]; rv[pp] = src[1024 + pp * 256 + tid]; }
    }
    for (int kt = 0; kt < ntiles; ++kt) {
      const int nvalid = (smp && kt == 16) ? 32 : 64;
      if (kt > 0) __syncthreads();
#pragma unroll
      for (int pp = 0; pp < 4; ++pp) {
        const int idx = pp * 256 + tid;
        *(u32x4*)(KS + (idx >> 4) * 136 + (idx & 15) * 8) = rk[pp];
        *(u32x4*)(VT + (idx >> 3) * 72 + (idx & 7) * 8) = rv[pp];
      }
      if (kt + 1 < ntiles) {
        const u32x4* src = (const u32x4*)(KVT + (size_t)(tile0 + kt + 1) * 32768);
#pragma unroll
        for (int pp = 0; pp < 4; ++pp) { rk[pp] = src[pp * 256 + tid]; rv[pp] = src[1024 + pp * 256 + tid]; }
      }
      __syncthreads();
      f32x4 sacc[2][4];
#pragma unroll
      for (int c = 0; c < 2; ++c)
#pragma unroll
        for (int sub = 0; sub < 4; ++sub) {
          sacc[c][sub] = (f32x4){0.f, 0.f, 0.f, 0.f};
#pragma unroll
          for (int ks = 0; ks < 2; ++ks) {
            const bf16x8 kf = *(const bf16x8*)(KS + (16 * sub + l16) * 136 + c * 64 + 32 * ks + 8 * g);
            const bf16x8 qfr = *(const bf16x8*)(QS + (16 * w + l16) * 136 + c * 64 + 32 * ks + 8 * g);
            sacc[c][sub] = __builtin_amdgcn_mfma_f32_16x16x32_bf16(kf, qfr, sacc[c][sub], 0, 0, 0);
          }
        }
#pragma unroll
      for (int sub = 0; sub < 4; ++sub)
#pragma unroll
        for (int i = 0; i < 4; ++i) {
          const int kl = 16 * sub + 4 * g + i;
          int rel = 64 * kt + kl - qpos;
          rel = rel < -166 ? -166 : rel;
          const float bt = BT[rel + 166];
          const bool ok = kl < nvalid;
          sacc[0][sub][i] = ok ? sacc[0][sub][i] + bt : -30000.f;
          sacc[1][sub][i] = ok ? sacc[1][sub][i] + bt : -30000.f;
        }
      bf16x8 pf[2][2];
#pragma unroll
      for (int c = 0; c < 2; ++c) {
        float mx = -1e30f;
#pragma unroll
        for (int sub = 0; sub < 4; ++sub)
#pragma unroll
          for (int i = 0; i < 4; ++i) mx = fmaxf(mx, sacc[c][sub][i]);
        mx = fmaxf(mx, __shfl_xor(mx, 16));
        mx = fmaxf(mx, __shfl_xor(mx, 32));
        const float mnew = fmaxf(mrun[c], mx);
        const float alpha = __builtin_amdgcn_exp2f(mrun[c] - mnew);
        mrun[c] = mnew;
        float rs = 0.f;
#pragma unroll
        for (int sub = 0; sub < 4; ++sub)
#pragma unroll
          for (int i = 0; i < 4; ++i) { const float e = __builtin_amdgcn_exp2f(sacc[c][sub][i] - mnew); sacc[c][sub][i] = e; rs += e; }
        lsum[c] = lsum[c] * alpha + rs;
#pragma unroll
        for (int vs = 0; vs < 8; ++vs) oacc[c][vs] *= alpha;
#pragma unroll
        for (int j = 0; j < 2; ++j)
          pf[c][j] = mk8u(pk2(sacc[c][2 * j][0], sacc[c][2 * j][1]), pk2(sacc[c][2 * j][2], sacc[c][2 * j][3]),
                          pk2(sacc[c][2 * j + 1][0], sacc[c][2 * j + 1][1]), pk2(sacc[c][2 * j + 1][2], sacc[c][2 * j + 1][3]));
      }
#pragma unroll
      for (int j = 0; j < 2; ++j)
#pragma unroll
        for (int vs = 0; vs < 8; ++vs) {
          const u32x2 lo = *(const u32x2*)(VT + (16 * vs + l16) * 72 + 32 * j + 4 * g);
          const u32x2 hi = *(const u32x2*)(VT + (16 * vs + l16) * 72 + 32 * j + 16 + 4 * g);
          const bf16x8 vf = mk8(lo, hi);
          oacc[0][vs] = __builtin_amdgcn_mfma_f32_16x16x32_bf16(vf, pf[0][j], oacc[0][vs], 0, 0, 0);
          oacc[1][vs] = __builtin_amdgcn_mfma_f32_16x16x32_bf16(vf, pf[1][j], oacc[1][vs], 0, 0, 0);
        }
    }
#pragma unroll
    for (int c = 0; c < 2; ++c) { lsum[c] += __shfl_xor(lsum[c], 16); lsum[c] += __shfl_xor(lsum[c], 32); }
    const float inv0 = 1.f / lsum[0], inv1 = lam / lsum[1];
    float ss = 0.f;
#pragma unroll
    for (int vs = 0; vs < 8; ++vs)
#pragma unroll
      for (int i = 0; i < 4; ++i) { const float o = oacc[0][vs][i] * inv0 - oacc[1][vs][i] * inv1; oacc[0][vs][i] = o; ss += o * o; }
    ss += __shfl_xor(ss, 16);
    ss += __shfl_xor(ss, 32);
    const float rn = rsqrtf(ss * (1.f / 128.f) + EPS) * (1.f - lam_init);
    if (16 * w + l16 < nq) {
      const size_t row = (size_t)qrow0 + 16 * w + l16;
#pragma unroll
      for (int vs = 0; vs < 8; ++vs) {
        const int v = h * 128 + 16 * vs + 4 * g;
        const f32x4 gl = *(const f32x4*)(p.g_subln + jl * 1024 + v);
        *(u32x2*)(p.OG + row * 1024 + v) = (u32x2){pk2(oacc[0][vs][0] * rn * gl[0], oacc[0][vs][1] * rn * gl[1]),
                                                   pk2(oacc[0][vs][2] * rn * gl[2], oacc[0][vs][3] * rn * gl[3])};
      }
    }
  }
}

DI void gbar(unsigned* bar, unsigned& gen) {
  gen += 1;
  asm volatile("" : "+s"(bar));
  const unsigned tix = (unsigned)ltid();
  asm volatile("s_waitcnt vmcnt(0) lgkmcnt(0)" ::: "memory");
  __syncthreads();
  if (tix < 64) {
    const unsigned g = lbid() >> 4, ng = gridDim.x >> 4;
    bool last = false;
    if (tix == 0) {
      __builtin_amdgcn_fence(__ATOMIC_RELEASE, "agent");
      asm volatile("s_waitcnt vmcnt(0)" ::: "memory");
      const unsigned o = __hip_atomic_fetch_add(bar + 64 * g, 1u, __ATOMIC_RELAXED, __HIP_MEMORY_SCOPE_AGENT);
      if (o + 1 == 16 * gen) {
        const unsigned o2 = __hip_atomic_fetch_add(bar + 64 * 64, 1u, __ATOMIC_RELAXED, __HIP_MEMORY_SCOPE_AGENT);
        last = (o2 + 1 == ng * gen);
      }
    }
    last = __shfl(last ? 1 : 0, 0) != 0;
    if (last && tix < ng) __hip_atomic_store(bar + 64 * (65 + tix), gen, __ATOMIC_RELAXED, __HIP_MEMORY_SCOPE_AGENT);
    if (tix == 0) {
      while (__hip_atomic_load(bar + 64 * (65 + g), __ATOMIC_RELAXED, __HIP_MEMORY_SCOPE_AGENT) < gen) __builtin_amdgcn_s_sleep(2);
      __builtin_amdgcn_fence(__ATOMIC_ACQUIRE, "agent");
      asm volatile("s_waitcnt vmcnt(0)" ::: "memory");
    }
  }
  __syncthreads();
}

__global__ void __launch_bounds__(256, 2) yoco_megakernel(P p) {
  __shared__ __attribute__((aligned(16))) char smem[65536];
  cg::grid_group grid = cg::this_grid();
  if (blockIdx.x == 0 && threadIdx.x < 130) __hip_atomic_store(p.bar + 64 * threadIdx.x, 0u, __ATOMIC_RELAXED, __HIP_MEMORY_SCOPE_AGENT);
  prep_phase(p, smem);
  grid.sync();
  unsigned btarget = 0;
  u16* Mbuf = (u16*)p.BIG;
  u16* Fbuf = p.XB;
  u16* XB2 = (u16*)p.BIG;
  u16* PB = (u16*)(p.BIG + (size_t)ROWS * 1024 * 2);
#pragma unroll
  for (int i = 0; i < 4; ++i) {
    const float* gn = p.g_norms + i * 4 * D;
    if (i == 0) {
      rowop_phase(p, true, nullptr, nullptr, gn, p.XB, nullptr, nullptr, nullptr);
      gbar(p.bar, btarget);
    }
    if (i < 2) {
      REPG gemm_phase<0>(p, p.XB, 1024, p.wt_in_a + (size_t)i * 4096 * 1024, 4096, p.BIG, smem, i ? p.ss : nullptr);
      gbar(p.bar, btarget);
      gla_state_phase(p, i, smem);
      gbar(p.bar, btarget);
      for (int _r = 0; _r < REP_GLA; ++_r) gla_phase(p, i, smem);
      gbar(p.bar, btarget);
      REPG gemm_phase<2>(p, p.OG, 1024, p.wt_out_a + (size_t)i * 1024 * 1024, 1024, Mbuf, smem);
      gbar(p.bar, btarget);
    } else {
      if (i == 2) gemm_phase<3>(p, p.XB, 1024, p.wt_kv, 2048, nullptr, smem, p.ss);
      REPG gemm_phase<1>(p, p.XB, 1024, p.wt_q + (size_t)(i - 2) * 1024 * 1024, 1024, p.BIG, smem, p.ss);
      if (i == 2) gbar(p.bar, btarget);
      kvconv_phase(p);
      gbar(p.bar, btarget);
      for (int _r = 0; _r < REP_ATTN; ++_r) attn_phase(p, i, smem);
      gbar(p.bar, btarget);
      REPG gemm_phase<2>(p, p.OG, 1024, p.wt_out_b + (size_t)(i - 2) * 1024 * 1024, 1024, Mbuf, smem);
      gbar(p.bar, btarget);
    }
    rowop_phase(p, i == 0, Mbuf, gn + D, gn + 2 * D, p.XB, nullptr, nullptr, nullptr);
    gbar(p.bar, btarget);
    REPG ffn_in_phase(p, i, smem);
    gbar(p.bar, btarget);
    REPG gemm_phase<2>(p, (const u16*)p.BIG, DFF, p.wt_ffn_out + (size_t)i * 1024 * DFF, 1024, Fbuf, smem);
    gbar(p.bar, btarget);
    rowop_phase(p, false, Fbuf, gn + 3 * D, nullptr, XB2, p.p_prompt + (size_t)i * ROWS_P * 256, p.p_sample + (size_t)i * 256 * 256, PB);
    gbar(p.bar, btarget);
    ple_phase(p, i, smem);
    gbar(p.bar, btarget);
  }
}

extern "C" void kernel_launch(void* const* d_in, const int* in_sizes, int n_in, void* d_out, int out_size, void* d_ws,
                              size_t ws_size, hipStream_t stream) {
  static int grid_blocks = 0;
  if (!grid_blocks) {
    int dev = 0, cus = 0, per_cu = 0;
    hipGetDevice(&dev);
    hipDeviceGetAttribute(&cus, hipDeviceAttributeMultiprocessorCount, dev);
    hipOccupancyMaxActiveBlocksPerMultiprocessor(&per_cu, yoco_megakernel, 256, 0);
    if (per_cu > 2) per_cu = 2;
    grid_blocks = cus * per_cu;
    grid_blocks &= ~7;
  }
  P p{};
  const float* const* in = (const float* const*)d_in;
  p.x_prompt = in[0]; p.x_sample = in[1]; p.cache_k = in[2]; p.cache_v = in[3]; p.state_hgrn = in[4]; p.state_conv = in[5];
  p.p_prompt = in[6]; p.p_sample = in[7];
  p.g_norms = in[8]; const float* w_in_a = in[9]; p.lb_raw = in[10]; p.g_hg = in[11]; const float* w_out_a = in[12]; p.g_kv = in[13];
  const float* w_kv = in[14]; p.rel_bias = in[15]; const float* w_q_b = in[16]; p.lam_b = in[17]; p.g_subln = in[18];
  const float* w_out_b = in[19]; const float* w_ffn_in = in[20]; p.conv_w = in[21]; p.conv_b = in[22]; const float* w_ffn_out = in[23];
  const float* w_ple = in[24]; const float* w_ple_gate = in[25];
  float* o = (float*)d_out;
  p.y = o; o += (size_t)ROWS * D;
  p.k_prompt = o; o += (size_t)ROWS_P * D;
  p.v_prompt = o; o += (size_t)ROWS_P * D;
  p.k_sample = o; o += (size_t)256 * D;
  p.v_sample = o; o += (size_t)256 * D;
  p.hgrn_prompt = o; o += (size_t)2 * 16 * 8 * 16384;
  p.hgrn_sample = o; o += (size_t)2 * 8 * 8 * 16384;
  p.conv_prompt = o; o += (size_t)4 * 16 * 2 * DFF;
  p.conv_sample = o;
  u16* ws = (u16*)d_ws;
  p.wt_in_a = ws; ws += (size_t)2 * 4096 * 1024;
  p.wt_out_a = ws; ws += (size_t)2 * 1024 * 1024;
  p.wt_kv = ws; ws += (size_t)2048 * 1024;
  p.wt_q = ws; ws += (size_t)2 * 1024 * 1024;
  p.wt_out_b = ws; ws += (size_t)2 * 1024 * 1024;
  p.wt_ffn_in = ws; ws += (size_t)4 * 5632 * 1024;
  p.wt_ffn_out = ws; ws += (size_t)4 * 1024 * DFF;
  p.wt_ple = ws; ws += (size_t)4 * 1024 * 256;
  p.wt_gate = ws; ws += (size_t)4 * 1024 * 1024;
  p.XB = ws; ws += (size_t)ROWS * 1024;
  p.OG = ws; ws += (size_t)ROWS * 1024;
  p.BIG = (char*)ws;
  p.bar = (unsigned*)((char*)d_ws + ((size_t)500 << 20));
  p.ss = (float*)((char*)d_ws + ((size_t)501 << 20));
  int n = 0;
  for (int i = 0; i < 2; ++i) p.wd[n++] = WD{w_in_a + (size_t)i * 1024 * 4096, p.wt_in_a + (size_t)i * 4096 * 1024, i ? p.g_norms + 4 * D : nullptr, 1024, 4096, 0, 0};
  for (int i = 0; i < 2; ++i) p.wd[n++] = WD{w_out_a + (size_t)i * 1024 * 1024, p.wt_out_a + (size_t)i * 1024 * 1024, nullptr, 1024, 1024, 0, 0};
  p.wd[n++] = WD{w_kv, p.wt_kv, p.g_kv, 1024, 2048, 0, 0};
  for (int i = 0; i < 2; ++i) p.wd[n++] = WD{w_q_b + (size_t)i * 1024 * 1024, p.wt_q + (size_t)i * 1024 * 1024, p.g_norms + (size_t)(i + 2) * 4 * D, 1024, 1024, 0, 0};
  for (int i = 0; i < 2; ++i) p.wd[n++] = WD{w_out_b + (size_t)i * 1024 * 1024, p.wt_out_b + (size_t)i * 1024 * 1024, nullptr, 1024, 1024, 0, 0};
  for (int i = 0; i < 4; ++i) p.wd[n++] = WD{w_ffn_in + (size_t)i * 1024 * 5632, p.wt_ffn_in + (size_t)i * 5632 * 1024, nullptr, 1024, 5632, 1, 0};
  for (int i = 0; i < 4; ++i) p.wd[n++] = WD{w_ffn_out + (size_t)i * DFF * 1024, p.wt_ffn_out + (size_t)i * 1024 * DFF, nullptr, DFF, 1024, 0, 0};
  for (int i = 0; i < 4; ++i) p.wd[n++] = WD{w_ple + (size_t)i * 256 * 1024, p.wt_ple + (size_t)i * 1024 * 256, nullptr, 256, 1024, 0, 0};
  for (int i = 0; i < 4; ++i) p.wd[n++] = WD{w_ple_gate + (size_t)i * 1024 * 1024, p.wt_gate + (size_t)i * 1024 * 1024, nullptr, 1024, 1024, 0, 0};
  void* args[] = {&p};
  hipError_t e = hipLaunchCooperativeKernel((void*)yoco_megakernel, dim3(grid_blocks), dim3(256), args, 0, stream);
  if (e != hipSuccess) fprintf(stderr, "cooperative launch failed: %s (grid %d)\n", hipGetErrorString(e), grid_blocks);
}
```

```cpp
#include <hip/hip_runtime.h>
#include <hip/hip_cooperative_groups.h>
#include <cstdio>
namespace cg = cooperative_groups;

#define DI __device__ __forceinline__
typedef unsigned short u16;
typedef short bf16x8 __attribute__((ext_vector_type(8)));
typedef float f32x16 __attribute__((ext_vector_type(16)));
typedef float f32x4 __attribute__((ext_vector_type(4)));
typedef __bf16 bf2_t __attribute__((ext_vector_type(2)));
typedef float f2_t __attribute__((ext_vector_type(2)));
typedef unsigned u32x2 __attribute__((ext_vector_type(2)));
typedef unsigned u32x4 __attribute__((ext_vector_type(4)));

constexpr int D = 1024, ROWS_P = 32768, ROWS = 33024, DFF = 2816;
constexpr float EPS = 1e-6f;
constexpr float LOG2E = 1.4426950408889634f;
constexpr int NW = 25;
#ifndef REP_GEMM
#define REP_GEMM 1
#endif
#ifndef REP_GLA
#define REP_GLA 1
#endif
#ifndef REP_ATTN
#define REP_ATTN 1
#endif
#define REPG for (int _r = 0; _r < REP_GEMM; ++_r)

struct WD { const float* src; u16* dst; const float* gain; int K, N, mode, pad; };

struct P {
  const float *x_prompt, *x_sample, *cache_k, *cache_v, *state_hgrn, *state_conv, *p_prompt, *p_sample;
  const float *g_norms, *lb_raw, *g_hg, *g_kv, *rel_bias, *lam_b, *g_subln, *conv_w, *conv_b;
  float *y, *k_prompt, *v_prompt, *k_sample, *v_sample, *hgrn_prompt, *hgrn_sample, *conv_prompt, *conv_sample;
  u16 *wt_in_a, *wt_out_a, *wt_kv, *wt_q, *wt_out_b, *wt_ffn_in, *wt_ffn_out, *wt_ple, *wt_gate;
  u16 *XB, *OG; char* BIG; unsigned* bar; float* ss; float* ss2;
  WD wd[NW];
};

DI unsigned pk2(float a, float b) { f2_t v = {a, b}; bf2_t r = __builtin_convertvector(v, bf2_t); return __builtin_bit_cast(unsigned, r); }
DI int lbid() { int b = blockIdx.x; asm volatile("" : "+s"(b)); return b; }
DI int ltid() { int t = threadIdx.x; asm volatile("" : "+v"(t)); return t; }
DI float bf2f(u16 x) { return __uint_as_float(((unsigned)x) << 16); }
DI float bflo(unsigned x) { return __uint_as_float(x << 16); }
DI float bfhi(unsigned x) { return __uint_as_float(x & 0xffff0000u); }
DI float sigm(float x) { return 1.f / (1.f + __expf(-x)); }
DI float wave_sum(float v) {
#pragma unroll
  for (int o = 32; o; o >>= 1) v += __shfl_xor(v, o);
  return v;
}
DI bf16x8 mk8(u32x2 lo, u32x2 hi) { u32x4 t = {lo[0], lo[1], hi[0], hi[1]}; return __builtin_bit_cast(bf16x8, t); }
DI bf16x8 mk8u(unsigned a, unsigned b, unsigned c, unsigned d) { u32x4 t = {a, b, c, d}; return __builtin_bit_cast(bf16x8, t); }

DI void prep_phase(const P& p, char* smem) {
  float* T = (float*)smem;
  const int tid = ltid();
  int total = 0;
  for (int i = 0; i < NW; ++i) total += (p.wd[i].K >> 6) * (p.wd[i].N >> 6);
  for (int flat = lbid(); flat < total; flat += gridDim.x) {
    int wi = 0, base = 0;
    for (;;) { int nt = (p.wd[wi].K >> 6) * (p.wd[wi].N >> 6); if (flat < base + nt) break; base += nt; ++wi; }
    const WD& d = p.wd[wi];
    const int tix = flat - base, ntn = d.N >> 6;
    const int k0 = (tix / ntn) << 6, n0 = (tix % ntn) << 6;
    {
      const int n = tid & 63, kb = tid >> 6;
#pragma unroll
      for (int j = 0; j < 16; ++j) { int k = kb + 4 * j; float v = d.src[(size_t)(k0 + k) * d.N + n0 + n]; if (d.gain) v *= d.gain[k0 + k]; T[k * 65 + n] = v; }
    }
    __syncthreads();
    {
      const int nn = tid >> 2, ks = tid & 3;
      int n = n0 + nn, drow = n;
      if (d.mode == 1) { int isu = n >= DFF; int ch = n - DFF * isu; drow = 256 * (ch >> 7) + 64 * ((ch >> 5) & 3) + 32 * isu + (ch & 31); }
      unsigned o[8];
#pragma unroll
      for (int j = 0; j < 8; ++j) o[j] = pk2(T[(16 * ks + 2 * j) * 65 + nn], T[(16 * ks + 2 * j + 1) * 65 + nn]);
      u16* fb = d.dst + (((size_t)(drow >> 5) * (d.K >> 4) + ((k0 >> 4) + ks)) * 64 + (drow & 31)) * 8;
      *(u32x4*)(fb) = (u32x4){o[0], o[1], o[2], o[3]};
      *(u32x4*)(fb + 256) = (u32x4){o[4], o[5], o[6], o[7]};
    }
    __syncthreads();
  }
}

DI void rowop_phase(const P& p, bool x_from_in, const u16* __restrict__ Madd, const float* __restrict__ gpost,
                    const float* __restrict__ gnext, u16* __restrict__ outH, const float* ple_p, const float* ple_s, u16* outP) {
  const int tidr = ltid();
  const int lane = tidr & 63;
  const int wave = (lbid() * blockDim.x + tidr) >> 6;
  const int nwave = (gridDim.x * blockDim.x) >> 6;
  for (int rb = wave * 2; rb < ROWS; rb += nwave * 2) {
    f32x4 x[2][4];
    u32x2 m[2][4];
#pragma unroll
    for (int u = 0; u < 2; ++u) {
      const int r = rb + u;
      const float* xs = x_from_in ? (r < ROWS_P ? p.x_prompt + (size_t)r * D : p.x_sample + (size_t)(r - ROWS_P) * D) : p.y + (size_t)r * D;
#pragma unroll
      for (int j = 0; j < 4; ++j) x[u][j] = *(const f32x4*)(xs + 4 * lane + 256 * j);
      if (Madd) {
#pragma unroll
        for (int j = 0; j < 4; ++j) m[u][j] = *(const u32x2*)(Madd + (size_t)r * D + 4 * lane + 256 * j);
      }
    }
#pragma unroll
    for (int u = 0; u < 2; ++u) {
      const int r = rb + u;
      if (Madd) {
        f32x4 mf[4]; float ss = 0.f;
#pragma unroll
        for (int j = 0; j < 4; ++j) { mf[j] = (f32x4){bflo(m[u][j][0]), bfhi(m[u][j][0]), bflo(m[u][j][1]), bfhi(m[u][j][1])}; ss += mf[j][0] * mf[j][0] + mf[j][1] * mf[j][1] + mf[j][2] * mf[j][2] + mf[j][3] * mf[j][3]; }
        ss = wave_sum(ss);
        const float rs = rsqrtf(ss * (1.f / D) + EPS);
#pragma unroll
        for (int j = 0; j < 4; ++j) { f32x4 g = *(const f32x4*)(gpost + 4 * lane + 256 * j); x[u][j] += mf[j] * rs * g; }
#pragma unroll
        for (int j = 0; j < 4; ++j) *(f32x4*)(p.y + (size_t)r * D + 4 * lane + 256 * j) = x[u][j];
      }
      float rx = 1.f;
      if (gnext) {
        float ss = 0.f;
#pragma unroll
        for (int j = 0; j < 4; ++j) ss += x[u][j][0] * x[u][j][0] + x[u][j][1] * x[u][j][1] + x[u][j][2] * x[u][j][2] + x[u][j][3] * x[u][j][3];
        ss = wave_sum(ss);
        rx = rsqrtf(ss * (1.f / D) + EPS);
      }
#pragma unroll
      for (int j = 0; j < 4; ++j) {
        f32x4 h = x[u][j] * rx;
        if (gnext) h *= *(const f32x4*)(gnext + 4 * lane + 256 * j);
        *(u32x2*)(outH + (size_t)r * D + 4 * lane + 256 * j) = (u32x2){pk2(h[0], h[1]), pk2(h[2], h[3])};
      }
      if (outP) {
        const float* ps = r < ROWS_P ? ple_p + (size_t)r * 256 : ple_s + (size_t)(r - ROWS_P) * 256;
        f32x4 v = *(const f32x4*)(ps + 4 * lane);
        *(u32x2*)(outP + (size_t)r * 256 + 4 * lane) = (u32x2){pk2(v[0], v[1]), pk2(v[2], v[3])};
      }
    }
  }
}

DI void rowop2_phase(const P& p, bool x_from_in, u16* __restrict__ XR, const u16* __restrict__ Madd, const float* __restrict__ gpost,
                     float* __restrict__ ssout, const float* ple_p, const float* ple_s, u16* outP) {
  const int tidr = ltid();
  const int lane = tidr & 63;
  const int wave = (lbid() * blockDim.x + tidr) >> 6;
  const int nwave = (gridDim.x * blockDim.x) >> 6;
  for (int rb = wave * 2; rb < ROWS; rb += nwave * 2) {
    f32x4 x[2][4];
    u32x2 m[2][4];
#pragma unroll
    for (int u = 0; u < 2; ++u) {
      const int r = rb + u;
      if (x_from_in) {
        const float* xs = r < ROWS_P ? p.x_prompt + (size_t)r * D : p.x_sample + (size_t)(r - ROWS_P) * D;
#pragma unroll
        for (int j = 0; j < 4; ++j) x[u][j] = *(const f32x4*)(xs + 4 * lane + 256 * j);
      } else {
#pragma unroll
        for (int j = 0; j < 4; ++j) { const u32x2 t = *(const u32x2*)(XR + (size_t)r * D + 4 * lane + 256 * j); x[u][j] = (f32x4){bflo(t[0]), bfhi(t[0]), bflo(t[1]), bfhi(t[1])}; }
      }
#pragma unroll
      for (int j = 0; j < 4; ++j) m[u][j] = *(const u32x2*)(Madd + (size_t)r * D + 4 * lane + 256 * j);
    }
#pragma unroll
    for (int u = 0; u < 2; ++u) {
      const int r = rb + u;
      f32x4 mf[4]; float ss = 0.f;
#pragma unroll
      for (int j = 0; j < 4; ++j) { mf[j] = (f32x4){bflo(m[u][j][0]), bfhi(m[u][j][0]), bflo(m[u][j][1]), bfhi(m[u][j][1])}; ss += mf[j][0] * mf[j][0] + mf[j][1] * mf[j][1] + mf[j][2] * mf[j][2] + mf[j][3] * mf[j][3]; }
      ss = wave_sum(ss);
      const float rs = rsqrtf(ss * (1.f / D) + EPS);
      float sx = 0.f;
#pragma unroll
      for (int j = 0; j < 4; ++j) {
        const f32x4 g = *(const f32x4*)(gpost + 4 * lane + 256 * j);
        const f32x4 xn = x[u][j] + mf[j] * rs * g;
        const u32x2 o = (u32x2){pk2(xn[0], xn[1]), pk2(xn[2], xn[3])};
        *(u32x2*)(XR + (size_t)r * D + 4 * lane + 256 * j) = o;
        const float q0 = bflo(o[0]), q1 = bfhi(o[0]), q2 = bflo(o[1]), q3 = bfhi(o[1]);
        sx += q0 * q0 + q1 * q1 + q2 * q2 + q3 * q3;
      }
      if (ssout) { sx = wave_sum(sx); if (lane == 0) ssout[r] = sx; }
      if (outP) {
        const float* ps = r < ROWS_P ? ple_p + (size_t)r * 256 : ple_s + (size_t)(r - ROWS_P) * 256;
        f32x4 v = *(const f32x4*)(ps + 4 * lane);
        *(u32x2*)(outP + (size_t)r * 256 + 4 * lane) = (u32x2){pk2(v[0], v[1]), pk2(v[2], v[3])};
      }
    }
  }
}

template <class RowMap>
DI void gemm_core(const u16* __restrict__ A, int lda, RowMap rm, const u16* __restrict__ Bt, int n0, int K,
                  f32x16 (&acc)[4][2], char* smem, const int tid) {
  const int l = tid & 63, w = tid >> 6, l32 = l & 31, hh = l >> 5;
  const int lr = tid >> 3, lc = tid & 7;
  const u16* ap[4];
#pragma unroll
  for (int q = 0; q < 4; ++q) ap[q] = A + (size_t)rm(q * 32 + lr) * lda + lc * 8;
  const u16* bq0 = Bt + ((size_t)((n0 + w * 64) >> 5) * (K >> 4) * 64 + l) * 8;
  const u16* bq1 = bq0 + (size_t)(K >> 4) * 512;
  const unsigned woff = lr * 144 + lc * 16;
  const unsigned aoff = l32 * 144 + hh * 16;
  u32x4 ra0[4];
  bf16x8 bf0[4], bf1[4];
  const int nk = K >> 6;
#define GLOADA(RA, T) _Pragma("unroll") for (int q = 0; q < 4; ++q) { RA[q] = *(const u32x4*)(ap[q] + (T) * 64); }
#define SWRITEA(RA, BUF) { char* db_ = smem + (BUF) * 18432; _Pragma("unroll") for (int q = 0; q < 4; ++q) { *(u32x4*)(db_ + woff + q * 4608) = RA[q]; } }
#define COMPUTE(BUF, TN, MORE) { const char* sb = smem + (BUF) * 18432; _Pragma("unroll") for (int ks = 0; ks < 4; ++ks) { \
      const unsigned co = ks * 32; \
      bf16x8 a0 = *(const bf16x8*)(sb + aoff + co); \
      bf16x8 a1 = *(const bf16x8*)(sb + aoff + 4608 + co); \
      bf16x8 a2 = *(const bf16x8*)(sb + aoff + 9216 + co); \
      bf16x8 a3 = *(const bf16x8*)(sb + aoff + 13824 + co); \
      acc[0][0] = __builtin_amdgcn_mfma_f32_32x32x16_bf16(bf0[ks], a0, acc[0][0], 0, 0, 0); \
      acc[0][1] = __builtin_amdgcn_mfma_f32_32x32x16_bf16(bf1[ks], a0, acc[0][1], 0, 0, 0); \
      acc[1][0] = __builtin_amdgcn_mfma_f32_32x32x16_bf16(bf0[ks], a1, acc[1][0], 0, 0, 0); \
      acc[1][1] = __builtin_amdgcn_mfma_f32_32x32x16_bf16(bf1[ks], a1, acc[1][1], 0, 0, 0); \
      acc[2][0] = __builtin_amdgcn_mfma_f32_32x32x16_bf16(bf0[ks], a2, acc[2][0], 0, 0, 0); \
      acc[2][1] = __builtin_amdgcn_mfma_f32_32x32x16_bf16(bf1[ks], a2, acc[2][1], 0, 0, 0); \
      acc[3][0] = __builtin_amdgcn_mfma_f32_32x32x16_bf16(bf0[ks], a3, acc[3][0], 0, 0, 0); \
      acc[3][1] = __builtin_amdgcn_mfma_f32_32x32x16_bf16(bf1[ks], a3, acc[3][1], 0, 0, 0); \
      if (MORE) { bf0[ks] = *(const bf16x8*)(bq0 + ((TN) * 4 + ks) * 512); bf1[ks] = *(const bf16x8*)(bq1 + ((TN) * 4 + ks) * 512); } \
      __builtin_amdgcn_sched_barrier(0); } }
  GLOADA(ra0, 0);
#pragma unroll
  for (int ks = 0; ks < 4; ++ks) { bf0[ks] = *(const bf16x8*)(bq0 + ks * 512); bf1[ks] = *(const bf16x8*)(bq1 + ks * 512); }
  SWRITEA(ra0, 0);
  __syncthreads();
  for (int kt = 0; kt < nk; kt += 2) {
    GLOADA(ra0, kt + 1);
    __builtin_amdgcn_sched_barrier(0);
    COMPUTE(0, kt + 1, true);
    SWRITEA(ra0, 1);
    __syncthreads();
    if (kt + 2 < nk) GLOADA(ra0, kt + 2);
    __builtin_amdgcn_sched_barrier(0);
    COMPUTE(1, kt + 2, kt + 2 < nk);
    if (kt + 2 < nk) SWRITEA(ra0, 0);
    __syncthreads();
  }
#undef GLOADA
#undef SWRITEA
#undef COMPUTE
}

template <class RowMap>
DI void gemm_core_mini(const u16* __restrict__ A, int lda, RowMap rm, const u16* __restrict__ Bt, int n0, int K,
                       f32x16 (&acc)[2], char* smem, const int tid) {
  const int l = tid & 63, w = tid >> 6, l32 = l & 31, hh = l >> 5;
  const int lr = tid >> 3, lc = tid & 7;
  const u16* ap[4];
#pragma unroll
  for (int q = 0; q < 4; ++q) ap[q] = A + (size_t)rm(q * 32 + lr) * lda + lc * 8;
  const u16* bq0 = Bt + ((size_t)(n0 >> 5) * (K >> 4) * 64 + l) * 8;
  const u16* bq1 = bq0 + (size_t)(K >> 4) * 512;
  const unsigned woff = lr * 144 + lc * 16;
  const unsigned aoff = (w * 32 + l32) * 144 + hh * 16;
  u32x4 ra0[4];
  bf16x8 bf0[4], bf1[4];
  const int nk = K >> 6;
#define GLOADA(RA, T) _Pragma("unroll") for (int q = 0; q < 4; ++q) { RA[q] = *(const u32x4*)(ap[q] + (T) * 64); }
#define SWRITEA(RA, BUF) { char* db_ = smem + (BUF) * 18432; _Pragma("unroll") for (int q = 0; q < 4; ++q) { *(u32x4*)(db_ + woff + q * 4608) = RA[q]; } }
#define COMPUTE(BUF, TN, MORE) { const char* sb = smem + (BUF) * 18432; _Pragma("unroll") for (int ks = 0; ks < 4; ++ks) { \
      const unsigned co = ks * 32; \
      bf16x8 a0 = *(const bf16x8*)(sb + aoff + co); \
      acc[0] = __builtin_amdgcn_mfma_f32_32x32x16_bf16(bf0[ks], a0, acc[0], 0, 0, 0); \
      acc[1] = __builtin_amdgcn_mfma_f32_32x32x16_bf16(bf1[ks], a0, acc[1], 0, 0, 0); \
      if (MORE) { bf0[ks] = *(const bf16x8*)(bq0 + ((TN) * 4 + ks) * 512); bf1[ks] = *(const bf16x8*)(bq1 + ((TN) * 4 + ks) * 512); } \
      __builtin_amdgcn_sched_barrier(0); } }
  GLOADA(ra0, 0);
#pragma unroll
  for (int ks = 0; ks < 4; ++ks) { bf0[ks] = *(const bf16x8*)(bq0 + ks * 512); bf1[ks] = *(const bf16x8*)(bq1 + ks * 512); }
  SWRITEA(ra0, 0);
  __syncthreads();
  for (int kt = 0; kt < nk; kt += 2) {
    GLOADA(ra0, kt + 1);
    __builtin_amdgcn_sched_barrier(0);
    COMPUTE(0, kt + 1, true);
    SWRITEA(ra0, 1);
    __syncthreads();
    if (kt + 2 < nk) GLOADA(ra0, kt + 2);
    __builtin_amdgcn_sched_barrier(0);
    COMPUTE(1, kt + 2, kt + 2 < nk);
    if (kt + 2 < nk) SWRITEA(ra0, 0);
    __syncthreads();
  }
#undef GLOADA
#undef SWRITEA
#undef COMPUTE
}

DI bool next_tile(int it, int ntm, int ntn, int& tm, int& tn) {
  const int b = lbid(), x = b & 7, slot = b >> 3, S = gridDim.x >> 3;
  const int nq = (ntm - x + 7) >> 3;
  const int L = slot + it * S;
  if (L >= nq * ntn) return false;
  const int gsize = 8 * ntn;
  const int grp = L / gsize, r = L - grp * gsize;
  const int gsz = min(8, nq - 8 * grp);
  tn = r / gsz;
  tm = x + 8 * (8 * grp + r % gsz);
  return true;
}

DI void list_entry(int L, int ntm, int ntn, int& tm, int& tn) {
  const int x = lbid() & 7;
  const int nq = (ntm - x + 7) >> 3;
  const int gsize = 8 * ntn;
  const int grp = L / gsize, r = L - grp * gsize;
  const int gsz = min(8, nq - 8 * grp);
  tn = r / gsz;
  tm = x + 8 * (8 * grp + r % gsz);
}
DI void list_info(int ntm, int ntn, int& full, int& nleft) {
  const int x = lbid() & 7, S = gridDim.x >> 3;
  const int len = ((ntm - x + 7) >> 3) * ntn;
  full = (len / S) * S;
  nleft = len - full;
  if (4 * nleft > S) { full = len; nleft = 0; }
}

struct IdMap { int base; DI int operator()(int r) const { return base + r; } };
struct ClampMap { int rowbase, t0, T; DI int operator()(int r) const { int t = t0 + r; t = t < 0 ? 0 : (t > T - 1 ? T - 1 : t); return rowbase + t; } };
struct ClampMap2 { int rowbase, t0, T, srow; DI int operator()(int r) const { if (srow >= 0 && r >= 64) { int t = r - 66; t = t < 0 ? 0 : (t > 31 ? 31 : t); return srow + t; } int t = t0 + r; t = t < 0 ? 0 : (t > T - 1 ? T - 1 : t); return rowbase + t; } };

#define ZERO_ACC(a) _Pragma("unroll") for (int _i = 0; _i < 4; ++_i) _Pragma("unroll") for (int _j = 0; _j < 2; ++_j) _Pragma("unroll") for (int _e = 0; _e < 16; ++_e) a[_i][_j][_e] = 0.f;

DI float row_rs(const float* rowss, int m) {
  const f32x4* sp = (const f32x4*)(rowss + (size_t)m * 16); const f32x4 s0 = sp[0], s1 = sp[1], s2 = sp[2], s3 = sp[3];
  const float tot = ((s0[0] + s0[1]) + (s0[2] + s0[3])) + ((s1[0] + s1[1]) + (s1[2] + s1[3])) + ((s2[0] + s2[1]) + (s2[2] + s2[3])) + ((s3[0] + s3[1]) + (s3[2] + s3[3]));
  return rsqrtf(tot * (1.f / D) + EPS);
}
template <int EPI>
DI void epi4(const P& p, void* outp, int m, int n, float v0, float v1, float v2, float v3) {
  if (EPI == 0) {
    const int sec = n >> 10;
    if (sec == 0 || sec == 3) { v0 *= sigm(v0); v1 *= sigm(v1); v2 *= sigm(v2); v3 *= sigm(v3); }
    *(u32x2*)((u16*)outp + (size_t)m * 4096 + n) = (u32x2){pk2(v0, v1), pk2(v2, v3)};
  } else if (EPI == 1) {
    const float sc = 0.125f * LOG2E;
    *(u32x2*)((u16*)outp + (size_t)m * 1024 + n) = (u32x2){pk2(v0 * sc, v1 * sc), pk2(v2 * sc, v3 * sc)};
  } else if (EPI == 2) {
    *(u32x2*)((u16*)outp + (size_t)m * 1024 + n) = (u32x2){pk2(v0, v1), pk2(v2, v3)};
  } else {
    float* dst;
    if (n < 1024) dst = (m < ROWS_P ? p.k_prompt + (size_t)m * 1024 : p.k_sample + (size_t)(m - ROWS_P) * 1024) + n;
    else dst = (m < ROWS_P ? p.v_prompt + (size_t)m * 1024 : p.v_sample + (size_t)(m - ROWS_P) * 1024) + (n - 1024);
    *(f32x4*)dst = (f32x4){v0, v1, v2, v3};
  }
}
template <int EPI>
DI void gemm_phase(const P& p, const u16* A, int K, const u16* Bt, int N, void* outp, char* smem, const float* rowss = nullptr) {
  const int tid = ltid(), l = tid & 63, w = tid >> 6, l32 = l & 31, hh = l >> 5;
  const int ntm = ROWS / 128, ntn = N / 256;
  const int slot = lbid() >> 3, S = gridDim.x >> 3;
  int full, nleft, tm, tn;
  list_info(ntm, ntn, full, nleft);
  for (int L = slot; L < full; L += S) {
    list_entry(L, ntm, ntn, tm, tn);
    f32x16 acc[4][2];
    ZERO_ACC(acc);
    gemm_core(A, K, IdMap{tm * 128}, Bt, tn * 256, K, acc, smem, ltid());
#pragma unroll
    for (int mi = 0; mi < 4; ++mi) {
      const int m = tm * 128 + mi * 32 + l32;
      float rsc = 1.f;
      if (rowss) rsc = row_rs(rowss, m);
#pragma unroll
      for (int ni = 0; ni < 2; ++ni)
#pragma unroll
        for (int q = 0; q < 4; ++q)
          epi4<EPI>(p, outp, m, tn * 256 + w * 64 + ni * 32 + 8 * q + 4 * hh,
                    acc[mi][ni][4 * q] * rsc, acc[mi][ni][4 * q + 1] * rsc, acc[mi][ni][4 * q + 2] * rsc, acc[mi][ni][4 * q + 3] * rsc);
    }
  }
  if (slot < 4 * nleft) {
    list_entry(full + (slot >> 2), ntm, ntn, tm, tn);
    const int n0 = tn * 256 + (slot & 3) * 64;
    f32x16 acc[2];
#pragma unroll
    for (int e = 0; e < 16; ++e) { acc[0][e] = 0.f; acc[1][e] = 0.f; }
    gemm_core_mini(A, K, IdMap{tm * 128}, Bt, n0, K, acc, smem, ltid());
    const int m = tm * 128 + w * 32 + l32;
    float rsc = 1.f;
    if (rowss) rsc = row_rs(rowss, m);
#pragma unroll
    for (int ni = 0; ni < 2; ++ni)
#pragma unroll
      for (int q = 0; q < 4; ++q)
        epi4<EPI>(p, outp, m, n0 + ni * 32 + 8 * q + 4 * hh,
                  acc[ni][4 * q] * rsc, acc[ni][4 * q + 1] * rsc, acc[ni][4 * q + 2] * rsc, acc[ni][4 * q + 3] * rsc);
  }
}

DI void ple_epi(const P& p, const u16* PL, const u16* XIN, u16* XOUT, int m, int n, float a0, float a1, float a2, float a3, float& ssq) {
  const u32x2 xi = *(const u32x2*)(XIN + (size_t)m * D + n);
  f32x4 x = (f32x4){bflo(xi[0]), bfhi(xi[0]), bflo(xi[1]), bfhi(xi[1])};
  const u32x2 pv = *(const u32x2*)(PL + (size_t)m * D + n);
  x[0] += sigm(a0) * bflo(pv[0]);
  x[1] += sigm(a1) * bfhi(pv[0]);
  x[2] += sigm(a2) * bflo(pv[1]);
  x[3] += sigm(a3) * bfhi(pv[1]);
  if (XOUT) {
    const u32x2 o = (u32x2){pk2(x[0], x[1]), pk2(x[2], x[3])};
    *(u32x2*)(XOUT + (size_t)m * D + n) = o;
    const float q0 = bflo(o[0]), q1 = bfhi(o[0]), q2 = bflo(o[1]), q3 = bfhi(o[1]);
    ssq += q0 * q0 + q1 * q1 + q2 * q2 + q3 * q3;
  } else {
    *(f32x4*)(p.y + (size_t)m * D + n) = x;
  }
}
DI void ple_phase(const P& p, int layer, const u16* XIN, u16* XOUT, char* smem) {
  const int tid = ltid(), l = tid & 63, w = tid >> 6, l32 = l & 31, hh = l >> 5;
  const u16* XB2 = XIN;
  const u16* PB = (const u16*)p.BIG;
  u16* PL = (u16*)(p.BIG + ((size_t)32 << 20));
  const u16* Wg = p.wt_gate + (size_t)layer * 1024 * 1024;
  const u16* Wp = p.wt_ple + (size_t)layer * 1024 * 256;
  const int ntm = ROWS / 128, ntn = 4;
  const int slot = lbid() >> 3, S = gridDim.x >> 3;
  int full, nleft, tm, tn;
  list_info(ntm, ntn, full, nleft);
  for (int L = slot; L < full; L += S) {
    list_entry(L, ntm, ntn, tm, tn);
    f32x16 acc2[4][2];
    ZERO_ACC(acc2);
    gemm_core(PB, 256, IdMap{tm * 128}, Wp, tn * 256, 256, acc2, smem, ltid());
#pragma unroll
    for (int mi = 0; mi < 4; ++mi)
#pragma unroll
      for (int ni = 0; ni < 2; ++ni)
#pragma unroll
        for (int q = 0; q < 4; ++q)
          *(u32x2*)(PL + (size_t)(tm * 128 + mi * 32 + l32) * D + tn * 256 + w * 64 + ni * 32 + 8 * q + 4 * hh) =
              (u32x2){pk2(acc2[mi][ni][4 * q], acc2[mi][ni][4 * q + 1]), pk2(acc2[mi][ni][4 * q + 2], acc2[mi][ni][4 * q + 3])};
  }
  if (slot < 4 * nleft) {
    list_entry(full + (slot >> 2), ntm, ntn, tm, tn);
    const int n0 = tn * 256 + (slot & 3) * 64;
    f32x16 acc2[2];
#pragma unroll
    for (int e = 0; e < 16; ++e) { acc2[0][e] = 0.f; acc2[1][e] = 0.f; }
    gemm_core_mini(PB, 256, IdMap{tm * 128}, Wp, n0, 256, acc2, smem, ltid());
#pragma unroll
    for (int ni = 0; ni < 2; ++ni)
#pragma unroll
      for (int q = 0; q < 4; ++q)
        *(u32x2*)(PL + (size_t)(tm * 128 + w * 32 + l32) * D + n0 + ni * 32 + 8 * q + 4 * hh) =
            (u32x2){pk2(acc2[ni][4 * q], acc2[ni][4 * q + 1]), pk2(acc2[ni][4 * q + 2], acc2[ni][4 * q + 3])};
  }
  for (int L = slot; L < full; L += S) {
    list_entry(L, ntm, ntn, tm, tn);
    f32x16 acc[4][2];
    ZERO_ACC(acc);
    gemm_core(XB2, 1024, IdMap{tm * 128}, Wg, tn * 256, 1024, acc, smem, ltid());
#pragma unroll
    for (int mi = 0; mi < 4; ++mi) {
      const int m = tm * 128 + mi * 32 + l32;
      float ssq = 0.f;
#pragma unroll
      for (int ni = 0; ni < 2; ++ni)
#pragma unroll
        for (int q = 0; q < 4; ++q)
          ple_epi(p, PL, XIN, XOUT, m, tn * 256 + w * 64 + ni * 32 + 8 * q + 4 * hh, acc[mi][ni][4 * q], acc[mi][ni][4 * q + 1], acc[mi][ni][4 * q + 2], acc[mi][ni][4 * q + 3], ssq);
      ssq += __shfl_xor(ssq, 32);
      if (hh == 0) p.ss[(size_t)m * 16 + tn * 4 + w] = ssq;
    }
  }
  if (slot < 4 * nleft) {
    list_entry(full + (slot >> 2), ntm, ntn, tm, tn);
    const int ws = slot & 3, n0 = tn * 256 + ws * 64;
    f32x16 acc[2];
#pragma unroll
    for (int e = 0; e < 16; ++e) { acc[0][e] = 0.f; acc[1][e] = 0.f; }
    gemm_core_mini(XB2, 1024, IdMap{tm * 128}, Wg, n0, 1024, acc, smem, ltid());
    const int m = tm * 128 + w * 32 + l32;
    float ssq = 0.f;
#pragma unroll
    for (int ni = 0; ni < 2; ++ni)
#pragma unroll
      for (int q = 0; q < 4; ++q)
        ple_epi(p, PL, XIN, XOUT, m, n0 + ni * 32 + 8 * q + 4 * hh, acc[ni][4 * q], acc[ni][4 * q + 1], acc[ni][4 * q + 2], acc[ni][4 * q + 3], ssq);
    ssq += __shfl_xor(ssq, 32);
    if (hh == 0) p.ss[(size_t)m * 16 + tn * 4 + ws] = ssq;
  }
}

DI void ffn_in_phase(const P& p, int layer, const u16* XR, char* smem) {
  const int tid = ltid(), l = tid & 63, w = tid >> 6, l32 = l & 31, hh = l >> 5;
  const u16* Wt = p.wt_ffn_in + (size_t)layer * 5632 * 1024;
  u16* HID = (u16*)p.BIG;
  const float* cw = p.conv_w + (size_t)layer * 3 * DFF;
  const float* cb = p.conv_b + (size_t)layer * DFF;
  int tm, tn;
  for (int it = 0; next_tile(it, 272, 22, tm, tn); ++it) {
    const int seq = tm / 17, j = tm - seq * 17;
    const int T = 2048, rowbase = seq * 2048, t0 = 126 * j - 2;
    const bool last = (j == 16);
    const bool has_smp = last && seq < 8;
    const int srow = ROWS_P + seq * 32;
    f32x16 acc[4][2];
    ZERO_ACC(acc);
    const ClampMap2 rmap{rowbase, t0, T, has_smp ? srow : -1};
    gemm_core(XR, 1024, rmap, Wt, tn * 256, 1024, acc, smem, tid);
#pragma unroll
    for (int mi = 0; mi < 4; ++mi) {
      const float rsr = rsqrtf(p.ss2[rmap(mi * 32 + l32)] * (1.f / D) + EPS);
#pragma unroll
      for (int e = 0; e < 16; ++e) { acc[mi][0][e] *= rsr; acc[mi][1][e] *= rsr; }
    }
    const int chw = tn * 128 + w * 32;
    if (t0 < 0 && l32 < 2) {
#pragma unroll
      for (int q = 0; q < 4; ++q)
#pragma unroll
        for (int c = 0; c < 4; ++c) acc[0][0][4 * q + c] = 0.f;
    }
    if (has_smp && l32 < 2) {
#pragma unroll
      for (int q = 0; q < 4; ++q) {
        const f32x4 sv = *(const f32x4*)(p.state_conv + ((size_t)(layer * 8 + seq) * 2 + l32) * DFF + chw + 8 * q + 4 * hh);
#pragma unroll
        for (int c = 0; c < 4; ++c) acc[2][0][4 * q + c] = sv[c];
      }
    }
    const int lbase = l & 32;
#pragma unroll
    for (int q = 0; q < 4; ++q) {
      const int chq = chw + 8 * q + 4 * hh;
      const f32x4 b4 = *(const f32x4*)(cb + chq);
      const f32x4 w0 = *(const f32x4*)(cw + chq), w1 = *(const f32x4*)(cw + DFF + chq), w2 = *(const f32x4*)(cw + 2 * DFF + chq);
#pragma unroll
      for (int mi = 0; mi < 4; ++mi) {
        const int m = mi * 32 + l32;
        const bool seg1 = has_smp && mi >= 2;
        const int t = seg1 ? m - 66 : t0 + m;
        const int Tm = seg1 ? 32 : T;
        float hv[4];
#pragma unroll
        for (int c = 0; c < 4; ++c) {
          const float g0 = acc[mi][0][4 * q + c];
          float g1 = __shfl(g0, lbase + ((l32 + 31) & 31));
          float g2 = __shfl(g0, lbase + ((l32 + 30) & 31));
          if (mi > 0) {
            const float pg = acc[mi > 0 ? mi - 1 : 0][0][4 * q + c];
            const float p1 = __shfl(pg, lbase + 31), p2 = __shfl(pg, lbase + 30);
            if (l32 == 0) { g1 = p1; g2 = p2; }
            if (l32 == 1) { g2 = p1; }
          }
          const float cv = b4[c] + w0[c] * g2 + w1[c] * g1 + w2[c] * g0;
          hv[c] = cv * sigm(cv) * acc[mi][1][4 * q + c];
        }
        if ((seg1 ? m >= 66 : m >= 2) && t < Tm) {
          *(u32x2*)(HID + (size_t)((seg1 ? srow : rowbase) + t) * DFF + chq) = (u32x2){pk2(hv[0], hv[1]), pk2(hv[2], hv[3])};
          if (last && t >= Tm - 2) {
            float* co = seg1 ? p.conv_sample + ((size_t)(layer * 8 + seq) * 2 + (t - 30)) * DFF
                             : p.conv_prompt + ((size_t)(layer * 16 + seq) * 2 + (t - (T - 2))) * DFF;
            *(f32x4*)(co + chq) = (f32x4){acc[mi][0][4 * q], acc[mi][0][4 * q + 1], acc[mi][0][4 * q + 2], acc[mi][0][4 * q + 3]};
          }
        }
      }
    }
  }
}

DI void gla_state_phase(const P& p, int layer, char* smem) {
  const u16* PROJ = (const u16*)p.BIG;
  const int tid = ltid(), l = tid & 63, w = tid >> 6, l32 = l & 31, hh = l >> 5;
  float* SLOC = (float*)((char*)p.y + (size_t)ROWS * 1024 * 2);
  float* DTOT = SLOC + (size_t)384 * 16384;
  const int k = tid >> 1, th = tid & 1;
  for (int item = lbid(); item < 384; item += gridDim.x) {
    const int sh = item / 3, ch = item - sh * 3, s = sh >> 3, h = sh & 7;
    const int rowbase = s * 2048 + ch * 512;
    float lower = 0.f;
    if (layer == 1) lower = sigm(p.lb_raw[1024 + h * 128 + k] - p.lb_raw[h * 128 + k]);
    const float oml = 1.f - lower;
    f32x16 S[4];
#pragma unroll
    for (int kt = 0; kt < 4; ++kt)
#pragma unroll
      for (int i = 0; i < 16; ++i) S[kt][i] = 0.f;
    float btot = 0.f;
    u16 fr[8], vr[8];
#define GS_LOAD(BLK) { const size_t r0_ = (size_t)rowbase + (BLK) * 16; \
      const u16* pf_ = PROJ + (r0_ + 8 * th) * 4096 + 1024 + h * 128 + k; \
      const u16* pv_ = PROJ + r0_ * 4096 + 2048 + h * 128 + 32 * w + l32; \
      _Pragma("unroll") for (int t = 0; t < 8; ++t) fr[t] = pf_[(size_t)t * 4096]; \
      _Pragma("unroll") for (int jj = 0; jj < 8; ++jj) vr[jj] = pv_[(size_t)(8 * (jj >> 2) + 4 * hh + (jj & 3)) * 4096]; }
    GS_LOAD(0);
    for (int blk = 0; blk < 32; ++blk) {
      char* sb = smem + (blk & 1) * 8192;
      u16* KDT = (u16*)sb;
      float* DD = (float*)(KDT + 128 * 20);
      {
        float km[8], eb[8];
        float bs = 0.f;
#pragma unroll
        for (int t = 0; t < 8; ++t) {
          const float f = bf2f(fr[t]);
          const float g = lower + oml * sigm(f);
          bs += __logf(g);
          km[t] = 1.f - g; eb[t] = bs;
        }
        const float other = __shfl_xor(bs, 1);
        const float boff = th ? other : 0.f;
        const float bsum = bs + other;
        btot += bsum;
        unsigned kdp[4];
#pragma unroll
        for (int j = 0; j < 4; ++j)
          kdp[j] = pk2(km[2 * j] * __expf(bsum - boff - eb[2 * j]), km[2 * j + 1] * __expf(bsum - boff - eb[2 * j + 1]));
        *(u32x2*)(KDT + k * 20 + 8 * th) = (u32x2){kdp[0], kdp[1]};
        *(u32x2*)(KDT + k * 20 + 8 * th + 4) = (u32x2){kdp[2], kdp[3]};
        if (th == 0) DD[k] = __expf(bsum);
      }
      const bf16x8 vfrag = mk8u((unsigned)vr[0] | ((unsigned)vr[1] << 16), (unsigned)vr[2] | ((unsigned)vr[3] << 16),
                                (unsigned)vr[4] | ((unsigned)vr[5] << 16), (unsigned)vr[6] | ((unsigned)vr[7] << 16));
      if (blk + 1 < 32) GS_LOAD(blk + 1);
      __syncthreads();
#pragma unroll
      for (int kt = 0; kt < 4; ++kt) {
#pragma unroll
        for (int q = 0; q < 4; ++q) {
          const f32x4 d4 = *(const f32x4*)(DD + 32 * kt + 8 * q + 4 * hh);
#pragma unroll
          for (int c = 0; c < 4; ++c) S[kt][4 * q + c] *= d4[c];
        }
        const u32x2 lo = *(const u32x2*)(KDT + (32 * kt + l32) * 20 + 4 * hh);
        const u32x2 hi = *(const u32x2*)(KDT + (32 * kt + l32) * 20 + 8 + 4 * hh);
        S[kt] = __builtin_amdgcn_mfma_f32_32x32x16_bf16(mk8(lo, hi), vfrag, S[kt], 0, 0, 0);
      }
    }
#undef GS_LOAD
    {
      float* op = SLOC + (size_t)item * 16384 + 32 * w + l32;
#pragma unroll
      for (int kt = 0; kt < 4; ++kt)
#pragma unroll
        for (int i = 0; i < 16; ++i) op[(size_t)(32 * kt + (i & 3) + 8 * (i >> 2) + 4 * hh) * 128] = S[kt][i];
      if (th == 0) DTOT[(size_t)item * 128 + k] = __expf(btot);
    }
    __syncthreads();
  }
}

DI void gla_phase(const P& p, int layer, char* smem) {
  const u16* PROJ = (const u16*)p.BIG;
  const int tid = ltid(), l = tid & 63, w = tid >> 6, l32 = l & 31, hh = l >> 5, m16 = l & 15;
  float* REDB = (float*)(smem + 2 * 14336);
  const int k = tid >> 1, th = tid & 1;
  const float* SLOC = (const float*)((const char*)p.y + (size_t)ROWS * 1024 * 2);
  const float* DTOT = SLOC + (size_t)384 * 16384;
  for (int item = lbid(); item < 576; item += gridDim.x) {
    const bool smp = item < 64;
    const int s = smp ? 16 + (item >> 3) : (item - 64) >> 5;
    const int h = smp ? (item & 7) : ((item - 64) >> 2) & 7;
    const int ch = smp ? 0 : (item - 64) & 3;
    const int T = smp ? 32 : 512;
    const int rowbase = smp ? ROWS_P + (s - 16) * 32 : s * 2048 + ch * 512;
    float lower = 0.f;
    if (layer == 1) lower = sigm(p.lb_raw[1024 + h * 128 + k] - p.lb_raw[h * 128 + k]);
    const float oml = 1.f - lower;
    f32x16 S[4];
    if (smp) {
      const float* sp = p.state_hgrn + ((size_t)(layer * 8 + (s - 16)) * 8 + h) * 16384 + 32 * w + l32;
#pragma unroll
      for (int kt = 0; kt < 4; ++kt)
#pragma unroll
        for (int i = 0; i < 16; ++i) S[kt][i] = sp[(size_t)(32 * kt + (i & 3) + 8 * (i >> 2) + 4 * hh) * 128];
    } else {
#pragma unroll
      for (int kt = 0; kt < 4; ++kt)
#pragma unroll
        for (int i = 0; i < 16; ++i) S[kt][i] = 0.f;
#pragma unroll 1
      for (int j = 0; j < ch; ++j) {
        const int it1 = (s * 8 + h) * 3 + j;
        const float* sl = SLOC + (size_t)it1 * 16384 + 32 * w + l32 + (size_t)(4 * hh) * 128;
        const float* dl = DTOT + (size_t)it1 * 128 + 4 * hh;
#pragma unroll
        for (int kt = 0; kt < 4; ++kt) {
#pragma unroll
          for (int q = 0; q < 4; ++q) {
            const float* slq = sl + (size_t)(32 * kt + 8 * q) * 128;
            const f32x4 d4 = *(const f32x4*)(dl + 32 * kt + 8 * q);
#pragma unroll
            for (int c = 0; c < 4; ++c) S[kt][4 * q + c] = S[kt][4 * q + c] * d4[c] + slq[c * 128];
            __builtin_amdgcn_sched_barrier(0);
          }
        }
      }
    }
    const int nblk = T >> 4;
    u16 fr[8], qr[8], vr[8];
#define GLA_LOADRAW(BLK) { const size_t r0_ = (size_t)rowbase + (BLK) * 16; \
      const u16* pf_ = PROJ + (r0_ + 8 * th) * 4096 + 1024 + h * 128 + k; \
      const u16* pq_ = PROJ + (r0_ + 8 * th) * 4096 + h * 128 + k; \
      _Pragma("unroll") for (int t = 0; t < 8; ++t) fr[t] = pf_[(size_t)t * 4096]; \
      _Pragma("unroll") for (int j = 0; j < 8; ++j) qr[j] = pq_[(size_t)j * 4096]; \
 }
#define GLA_LOADV(BLK) { const u16* pv_ = PROJ + ((size_t)rowbase + (BLK) * 16) * 4096 + 2048 + h * 128 + 32 * w + l32; \
      _Pragma("unroll") for (int jj = 0; jj < 8; ++jj) vr[jj] = pv_[(size_t)(8 * (jj >> 2) + 4 * hh + (jj & 3)) * 4096]; }
#define GLA_LOADGS(BLK) { const u16* pg_ = PROJ + ((size_t)rowbase + (BLK) * 16 + m16) * 4096 + 3072 + h * 128 + 32 * w + 4 * hh; \
      _Pragma("unroll") for (int q = 0; q < 4; ++q) gsl[q] = *(const u32x2*)(pg_ + 8 * q); }
#define GLA_FINAL(BLK) { const float* RED_ = REDB + ((BLK) & 1) * 64; \
      if (l32 < 16) { \
        const float tot = RED_[l32] + RED_[16 + l32] + RED_[32 + l32] + RED_[48 + l32]; \
        const float rn = rsqrtf(tot * (1.f / 128.f) + EPS); \
        u16* op_ = p.OG + ((size_t)rowbase + (BLK) * 16 + l32) * 1024 + h * 128 + 32 * w + 4 * hh; \
        const float* gp_ = p.g_hg + layer * 1024 + h * 128 + 32 * w + 4 * hh; \
        _Pragma("unroll") for (int q = 0; q < 4; ++q) { const f32x4 gh = *(const f32x4*)(gp_ + 8 * q); \
          *(u32x2*)(op_ + 8 * q) = (u32x2){pk2(oacc[4 * q] * rn * gh[0] * bflo(gsl[q][0]), oacc[4 * q + 1] * rn * gh[1] * bfhi(gsl[q][0])), \
                                          pk2(oacc[4 * q + 2] * rn * gh[2] * bflo(gsl[q][1]), oacc[4 * q + 3] * rn * gh[3] * bfhi(gsl[q][1]))}; } \
      } }
    GLA_LOADRAW(0);
    u32x2 gsl[4];
    for (int blk = 0; blk < nblk; ++blk) {
      GLA_LOADGS(blk);
      GLA_LOADV(blk);
      char* sb = smem + (blk & 1) * 14336;
      u16* QT = (u16*)sb;
      u16* KT = QT + 16 * 136;
      u16* KDT = KT + 16 * 136;
      float* DD = (float*)(KDT + 128 * 20);
      {
        float qtm[8], ktm[8];
        float bs = 0.f;
#pragma unroll
        for (int t = 0; t < 8; ++t) {
          const float f = bf2f(fr[t]);
          const float g = lower + oml * sigm(f);
          bs += __logf(g);
          const float eb = __expf(bs);
          qtm[t] = bf2f(qr[t]) * eb;
          ktm[t] = (1.f - g) * __builtin_amdgcn_rcpf(eb);
        }
        const float other = __shfl_xor(bs, 1);
        const float boff = th ? other : 0.f;
        const float bsum = bs + other;
        const float E1 = __expf(boff), E1i = __expf(-boff), EL = __expf(bsum);
        unsigned kdp[4];
        float kdprev = 0.f;
#pragma unroll
        for (int j = 0; j < 8; ++j) {
          const int t = 8 * th + j;
          const float qt = qtm[j] * E1;
          const float ktv = ktm[j] * E1i;
          const float kd = ktv * EL;
          QT[t * 136 + k] = (u16)(pk2(qt, 0.f) & 0xffffu);
          KT[t * 136 + k] = (u16)(pk2(ktv, 0.f) & 0xffffu);
          if (j & 1) kdp[j >> 1] = pk2(kdprev, kd); else kdprev = kd;
        }
        *(u32x2*)(KDT + k * 20 + 8 * th) = (u32x2){kdp[0], kdp[1]};
        *(u32x2*)(KDT + k * 20 + 8 * th + 4) = (u32x2){kdp[2], kdp[3]};
        if (th == 0) DD[k] = __expf(bsum);
      }
      if (blk + 1 < nblk) GLA_LOADRAW(blk + 1);
      __syncthreads();
      const bf16x8 vfrag = mk8u((unsigned)vr[0] | ((unsigned)vr[1] << 16), (unsigned)vr[2] | ((unsigned)vr[3] << 16),
                                (unsigned)vr[4] | ((unsigned)vr[5] << 16), (unsigned)vr[6] | ((unsigned)vr[7] << 16));
      f32x16 aacc, oacc;
#pragma unroll
      for (int i = 0; i < 16; ++i) { aacc[i] = 0.f; oacc[i] = 0.f; }
#pragma unroll
      for (int ks = 0; ks < 8; ++ks) {
        const bf16x8 ka = *(const bf16x8*)(KT + m16 * 136 + 16 * ks + 8 * hh);
        const bf16x8 qb = *(const bf16x8*)(QT + m16 * 136 + 16 * ks + 8 * hh);
        aacc = __builtin_amdgcn_mfma_f32_32x32x16_bf16(ka, qb, aacc, 0, 0, 0);
        const int kt = ks >> 1, s2 = ks & 1;
        const bf16x8 sa = mk8u(pk2(S[kt][8 * s2], S[kt][8 * s2 + 1]), pk2(S[kt][8 * s2 + 2], S[kt][8 * s2 + 3]),
                               pk2(S[kt][8 * s2 + 4], S[kt][8 * s2 + 5]), pk2(S[kt][8 * s2 + 6], S[kt][8 * s2 + 7]));
        const u32x2 lo = *(const u32x2*)(QT + m16 * 136 + 32 * kt + 16 * s2 + 4 * hh);
        const u32x2 hi = *(const u32x2*)(QT + m16 * 136 + 32 * kt + 16 * s2 + 8 + 4 * hh);
        oacc = __builtin_amdgcn_mfma_f32_32x32x16_bf16(sa, mk8(lo, hi), oacc, 0, 0, 0);
      }
      float am[8];
#pragma unroll
      for (int i = 0; i < 8; ++i) { const int m = (i & 3) + 8 * (i >> 2) + 4 * hh; am[i] = (m <= m16) ? aacc[i] : 0.f; }
      const bf16x8 afrag = mk8u(pk2(am[0], am[1]), pk2(am[2], am[3]), pk2(am[4], am[5]), pk2(am[6], am[7]));
      oacc = __builtin_amdgcn_mfma_f32_32x32x16_bf16(vfrag, afrag, oacc, 0, 0, 0);
#pragma unroll
      for (int kt = 0; kt < 4; ++kt) {
#pragma unroll
        for (int q = 0; q < 4; ++q) {
          const f32x4 d4 = *(const f32x4*)(DD + 32 * kt + 8 * q + 4 * hh);
#pragma unroll
          for (int c = 0; c < 4; ++c) S[kt][4 * q + c] *= d4[c];
        }
        const u32x2 lo = *(const u32x2*)(KDT + (32 * kt + l32) * 20 + 4 * hh);
        const u32x2 hi = *(const u32x2*)(KDT + (32 * kt + l32) * 20 + 8 + 4 * hh);
        S[kt] = __builtin_amdgcn_mfma_f32_32x32x16_bf16(mk8(lo, hi), vfrag, S[kt], 0, 0, 0);
      }
      float ss = 0.f;
#pragma unroll
      for (int i = 0; i < 16; ++i) ss += oacc[i] * oacc[i];
      ss += __shfl_xor(ss, 32);
      if (l < 16) REDB[(blk & 1) * 64 + w * 16 + l] = ss;
      __syncthreads();
      GLA_FINAL(blk);
    }
#undef GLA_LOADGS
#undef GLA_LOADV
#undef GLA_LOADRAW
#undef GLA_FINAL
    if (smp || ch == 3) {
      float* op = (smp ? p.hgrn_sample + ((size_t)(layer * 8 + (s - 16)) * 8 + h) * 16384
                       : p.hgrn_prompt + ((size_t)(layer * 16 + s) * 8 + h) * 16384) + 32 * w + l32;
#pragma unroll
      for (int kt = 0; kt < 4; ++kt)
#pragma unroll
        for (int i = 0; i < 16; ++i) op[(size_t)(32 * kt + (i & 3) + 8 * (i >> 2) + 4 * hh) * 128] = S[kt][i];
    }
  }
}

DI void kvconv_phase(const P& p) {
  const int tid = ltid();
  char* KVT = p.BIG + (size_t)ROWS * 1024 * 2;
  for (int t = lbid(); t < 4096 + 1088; t += gridDim.x) {
    const float *kb, *vb; int nvalid = 64;
    if (t < 4096) { const int kt = t & 31, sh = t >> 5, s = sh >> 3, h = sh & 7; const size_t off = ((size_t)(s * 2048 + 64 * kt)) * 1024 + h * 128; kb = p.k_prompt + off; vb = p.v_prompt + off; }
    else { const int u = t - 4096; const int kt = u % 17, sh = u / 17, b = sh >> 3, h = sh & 7;
      if (kt < 16) { const size_t off = ((size_t)(b * 1024 + 64 * kt)) * 1024 + h * 128; kb = p.cache_k + off; vb = p.cache_v + off; }
      else { const size_t off = ((size_t)(b * 32)) * 1024 + h * 128; kb = p.k_sample + off; vb = p.v_sample + off; nvalid = 32; } }
    u16* kd = (u16*)(KVT + (size_t)t * 32768);
    u16* vd = kd + 8192;
#pragma unroll
    for (int pp = 0; pp < 4; ++pp) {
      const int key = 16 * pp + (tid >> 4), d8 = (tid & 15) * 8;
      f32x4 a = {0.f, 0.f, 0.f, 0.f}, b2 = {0.f, 0.f, 0.f, 0.f};
      if (key < nvalid) { a = *(const f32x4*)(kb + (size_t)key * 1024 + d8); b2 = *(const f32x4*)(kb + (size_t)key * 1024 + d8 + 4); }
      *(u32x4*)(kd + key * 128 + d8) = (u32x4){pk2(a[0], a[1]), pk2(a[2], a[3]), pk2(b2[0], b2[1]), pk2(b2[2], b2[3])};
    }
#pragma unroll
    for (int c = 0; c < 4; ++c) {
      const int v = tid & 127, cc = 4 * (tid >> 7) + c;
      float e[8];
#pragma unroll
      for (int j = 0; j < 8; ++j) { const int key = 8 * cc + j; e[j] = key < nvalid ? vb[(size_t)key * 1024 + v] : 0.f; }
      *(u32x4*)(vd + v * 64 + 8 * cc) = (u32x4){pk2(e[0], e[1]), pk2(e[2], e[3]), pk2(e[4], e[5]), pk2(e[6], e[7])};
    }
  }
}

DI void attn_phase(const P& p, int layer, char* smem) {
  const int jl = layer - 2;
  const u16* Q = (const u16*)p.BIG;
  const char* KVT = p.BIG + (size_t)ROWS * 1024 * 2;
  const int tid = ltid(), l = tid & 63, w = tid >> 6, l16 = l & 15, g = l >> 4;
  u16* KS = (u16*)smem;
  u16* VT = KS + 64 * 136;
  float* BT = (float*)(VT + 128 * 72);
  u16* QS = (u16*)(BT + 256);
  const float lam_init = 0.8f - 0.6f * __expf(-0.3f * (float)layer);
  float lam;
  {
    const float* lp = p.lam_b + jl * 256;
    float a = 0.f, b = 0.f;
    for (int d = 0; d < 64; ++d) { a += lp[d] * lp[64 + d]; b += lp[128 + d] * lp[192 + d]; }
    lam = __expf(a) - __expf(b) + lam_init;
  }
  for (int item = lbid(); item < 4096 + 64; item += gridDim.x) {
    int b, h, nq, qrow0, qpos0, ntiles, tile0; bool smp;
    if (item < 4096) { const int jq = 31 - (item >> 7); const int bh = item & 127; b = bh >> 3; h = bh & 7; smp = false; nq = 64; qrow0 = b * 2048 + 64 * jq; qpos0 = 64 * jq; ntiles = jq + 1; tile0 = bh * 32; }
    else { const int si = item - 4096; b = si >> 3; h = si & 7; smp = true; nq = 32; qrow0 = ROWS_P + b * 32; qpos0 = 1024; ntiles = 17; tile0 = 4096 + si * 17; }
    __syncthreads();
    if (tid < 230) {
      const int rel = tid - 166;
      const int n = rel < 0 ? -rel : rel;
      int bk = n < 8 ? n : 8 + (n >= 13) + (n >= 20) + (n >= 30) + (n >= 46) + (n >= 70) + (n >= 108) + (n >= 166);
      if (rel > 0) bk += 16;
      BT[tid] = p.rel_bias[bk * 8 + h] * LOG2E;
    }
#pragma unroll
    for (int pp = 0; pp < 4; ++pp) {
      const int idx = pp * 256 + tid, r = idx >> 4, c16 = idx & 15;
      *(u32x4*)(QS + r * 136 + c16 * 8) = *(const u32x4*)(Q + (size_t)(qrow0 + min(r, nq - 1)) * 1024 + h * 128 + c16 * 8);
    }
    f32x4 oacc[2][8];
#pragma unroll
    for (int c = 0; c < 2; ++c)
#pragma unroll
      for (int vs = 0; vs < 8; ++vs) oacc[c][vs] = (f32x4){0.f, 0.f, 0.f, 0.f};
    float mrun[2] = {-1e30f, -1e30f}, lsum[2] = {0.f, 0.f};
    const int qpos = qpos0 + min(16 * w + l16, nq - 1);
    u32x4 rk[4], rv[4];
    {
      const u32x4* src = (const u32x4*)(KVT + (size_t)tile0 * 32768);
#pragma unroll
      for (int pp = 0; pp < 4; ++pp) { rk[pp] = src[pp * 256 + tid]; rv[pp] = src[1024 + pp * 256 + tid]; }
    }
    for (int kt = 0; kt < ntiles; ++kt) {
      const int nvalid = (smp && kt == 16) ? 32 : 64;
      if (kt > 0) __syncthreads();
#pragma unroll
      for (int pp = 0; pp < 4; ++pp) {
        const int idx = pp * 256 + tid;
        *(u32x4*)(KS + (idx >> 4) * 136 + (idx & 15) * 8) = rk[pp];
        *(u32x4*)(VT + (idx >> 3) * 72 + (idx & 7) * 8) = rv[pp];
      }
      if (kt + 1 < ntiles) {
        const u32x4* src = (const u32x4*)(KVT + (size_t)(tile0 + kt + 1) * 32768);
#pragma unroll
        for (int pp = 0; pp < 4; ++pp) { rk[pp] = src[pp * 256 + tid]; rv[pp] = src[1024 + pp * 256 + tid]; }
      }
      __syncthreads();
      f32x4 sacc[2][4];
#pragma unroll
      for (int c = 0; c < 2; ++c)
#pragma unroll
        for (int sub = 0; sub < 4; ++sub) {
          sacc[c][sub] = (f32x4){0.f, 0.f, 0.f, 0.f};
#pragma unroll
          for (int ks = 0; ks < 2; ++ks) {
            const bf16x8 kf = *(const bf16x8*)(KS + (16 * sub + l16) * 136 + c * 64 + 32 * ks + 8 * g);
            const bf16x8 qfr = *(const bf16x8*)(QS + (16 * w + l16) * 136 + c * 64 + 32 * ks + 8 * g);
            sacc[c][sub] = __builtin_amdgcn_mfma_f32_16x16x32_bf16(kf, qfr, sacc[c][sub], 0, 0, 0);
          }
        }
#pragma unroll
      for (int sub = 0; sub < 4; ++sub)
#pragma unroll
        for (int i = 0; i < 4; ++i) {
          const int kl = 16 * sub + 4 * g + i;
          int rel = 64 * kt + kl - qpos;
          rel = rel < -166 ? -166 : rel;
          const float bt = BT[rel + 166];
          const bool ok = kl < nvalid;
          sacc[0][sub][i] = ok ? sacc[0][sub][i] + bt : -30000.f;
          sacc[1][sub][i] = ok ? sacc[1][sub][i] + bt : -30000.f;
        }
      bf16x8 pf[2][2];
#pragma unroll
      for (int c = 0; c < 2; ++c) {
        float mx = -1e30f;
#pragma unroll
        for (int sub = 0; sub < 4; ++sub)
#pragma unroll
          for (int i = 0; i < 4; ++i) mx = fmaxf(mx, sacc[c][sub][i]);
        mx = fmaxf(mx, __shfl_xor(mx, 16));
        mx = fmaxf(mx, __shfl_xor(mx, 32));
        const float mnew = fmaxf(mrun[c], mx);
        const float alpha = __builtin_amdgcn_exp2f(mrun[c] - mnew);
        mrun[c] = mnew;
        float rs = 0.f;
#pragma unroll
        for (int sub = 0; sub < 4; ++sub)
#pragma unroll
          for (int i = 0; i < 4; ++i) { const float e = __builtin_amdgcn_exp2f(sacc[c][sub][i] - mnew); sacc[c][sub][i] = e; rs += e; }
        lsum[c] = lsum[c] * alpha + rs;
#pragma unroll
        for (int vs = 0; vs < 8; ++vs) oacc[c][vs] *= alpha;
#pragma unroll
        for (int j = 0; j < 2; ++j)
          pf[c][j] = mk8u(pk2(sacc[c][2 * j][0], sacc[c][2 * j][1]), pk2(sacc[c][2 * j][2], sacc[c][2 * j][3]),
                          pk2(sacc[c][2 * j + 1][0], sacc[c][2 * j + 1][1]), pk2(sacc[c][2 * j + 1][2], sacc[c][2 * j + 1][3]));
      }
#pragma unroll
      for (int j = 0; j < 2; ++j)
#pragma unroll
        for (int vs = 0; vs < 8; ++vs) {
          const u32x2 lo = *(const u32x2*)(VT + (16 * vs + l16) * 72 + 32 * j + 4 * g);
          const u32x2 hi = *(const u32x2*)(VT + (16 * vs + l16) * 72 + 32 * j + 16 + 4 * g);
          const bf16x8 vf = mk8(lo, hi);
          oacc[0][vs] = __builtin_amdgcn_mfma_f32_16x16x32_bf16(vf, pf[0][j], oacc[0][vs], 0, 0, 0);
          oacc[1][vs] = __builtin_amdgcn_mfma_f32_16x16x32_bf16(vf, pf[1][j], oacc[1][vs], 0, 0, 0);
        }
    }
#pragma unroll
    for (int c = 0; c < 2; ++c) { lsum[c] += __shfl_xor(lsum[c], 16); lsum[c] += __shfl_xor(lsum[c], 32); }
    const float inv0 = 1.f / lsum[0], inv1 = lam / lsum[1];
    float ss = 0.f;
#pragma unroll
    for (int vs = 0; vs < 8; ++vs)
#pragma unroll
      for (int i = 0; i < 4; ++i) { const float o = oacc[0][vs][i] * inv0 - oacc[1][vs][i] * inv1; oacc[0][vs][i] = o; ss += o * o; }
    ss += __shfl_xor(ss, 16);
    ss += __shfl_xor(ss, 32);
    const float rn = rsqrtf(ss * (1.f / 128.f) + EPS) * (1.f - lam_init);
    if (16 * w + l16 < nq) {
      const size_t row = (size_t)qrow0 + 16 * w + l16;
#pragma unroll
      for (int vs = 0; vs < 8; ++vs) {
        const int v = h * 128 + 16 * vs + 4 * g;
        const f32x4 gl = *(const f32x4*)(p.g_subln + jl * 1024 + v);
        *(u32x2*)(p.OG + row * 1024 + v) = (u32x2){pk2(oacc[0][vs][0] * rn * gl[0], oacc[0][vs][1] * rn * gl[1]),
                                                   pk2(oacc[0][vs][2] * rn * gl[2], oacc[0][vs][3] * rn * gl[3])};
      }
    }
  }
}

DI void gbar(unsigned* bar, unsigned& gen) {
  gen += 1;
  asm volatile("" : "+s"(bar));
  const unsigned tix = (unsigned)ltid();
  asm volatile("s_waitcnt vmcnt(0) lgkmcnt(0)" ::: "memory");
  __syncthreads();
  if (tix < 64) {
    const unsigned g = lbid() >> 4, ng = gridDim.x >> 4;
    bool last = false;
    if (tix == 0) {
      __builtin_amdgcn_fence(__ATOMIC_RELEASE, "agent");
      asm volatile("s_waitcnt vmcnt(0)" ::: "memory");
      const unsigned o = __hip_atomic_fetch_add(bar + 64 * g, 1u, __ATOMIC_RELAXED, __HIP_MEMORY_SCOPE_AGENT);
      if (o + 1 == 16 * gen) {
        const unsigned o2 = __hip_atomic_fetch_add(bar + 64 * 64, 1u, __ATOMIC_RELAXED, __HIP_MEMORY_SCOPE_AGENT);
        last = (o2 + 1 == ng * gen);
      }
    }
    last = __shfl(last ? 1 : 0, 0) != 0;
    if (last && tix < ng) __hip_atomic_store(bar + 64 * (65 + tix), gen, __ATOMIC_RELAXED, __HIP_MEMORY_SCOPE_AGENT);
    if (tix == 0) {
      while (__hip_atomic_load(bar + 64 * (65 + g), __ATOMIC_RELAXED, __HIP_MEMORY_SCOPE_AGENT) < gen) __builtin_amdgcn_s_sleep(2);
      __builtin_amdgcn_fence(__ATOMIC_ACQUIRE, "agent");
      asm volatile("s_waitcnt vmcnt(0)" ::: "memory");
    }
  }
  __syncthreads();
}

__global__ void __launch_bounds__(256, 2) yoco_megakernel(P p) {
  __shared__ __attribute__((aligned(16))) char smem[65536];
  cg::grid_group grid = cg::this_grid();
  if (blockIdx.x == 0 && threadIdx.x < 130) __hip_atomic_store(p.bar + 64 * threadIdx.x, 0u, __ATOMIC_RELAXED, __HIP_MEMORY_SCOPE_AGENT);
  prep_phase(p, smem);
  grid.sync();
  unsigned btarget = 0;
  u16* Mbuf = (u16*)p.BIG;
  u16* Fbuf = (u16*)(p.BIG + ((size_t)180 << 20));
  u16* PB = (u16*)p.BIG;
  u16* XRA = (u16*)p.y;
  u16* XRB = p.XB;
  for (int i = 0; i < 4; ++i) {
    const float* gn = p.g_norms + i * 4 * D;
    u16* cur = (i & 1) ? XRB : XRA;
    u16* nxt = (i == 3) ? nullptr : ((i & 1) ? XRA : XRB);
    if (i == 0) {
      rowop_phase(p, true, nullptr, nullptr, gn, p.XB, nullptr, nullptr, nullptr);
      gbar(p.bar, btarget);
    }
    if (i < 2) {
      REPG gemm_phase<0>(p, i ? cur : p.XB, 1024, p.wt_in_a + (size_t)i * 4096 * 1024, 4096, p.BIG, smem, i ? p.ss : nullptr);
      gbar(p.bar, btarget);
      gla_state_phase(p, i, smem);
      gbar(p.bar, btarget);
      for (int _r = 0; _r < REP_GLA; ++_r) gla_phase(p, i, smem);
      gbar(p.bar, btarget);
      REPG gemm_phase<2>(p, p.OG, 1024, p.wt_out_a + (size_t)i * 1024 * 1024, 1024, Mbuf, smem);
      gbar(p.bar, btarget);
    } else {
      if (i == 2) gemm_phase<3>(p, cur, 1024, p.wt_kv, 2048, nullptr, smem, p.ss);
      REPG gemm_phase<1>(p, cur, 1024, p.wt_q + (size_t)(i - 2) * 1024 * 1024, 1024, p.BIG, smem, p.ss);
      if (i == 2) gbar(p.bar, btarget);
      kvconv_phase(p);
      gbar(p.bar, btarget);
      for (int _r = 0; _r < REP_ATTN; ++_r) attn_phase(p, i, smem);
      gbar(p.bar, btarget);
      REPG gemm_phase<2>(p, p.OG, 1024, p.wt_out_b + (size_t)(i - 2) * 1024 * 1024, 1024, Mbuf, smem);
      gbar(p.bar, btarget);
    }
    rowop2_phase(p, i == 0, cur, Mbuf, gn + D, p.ss2, nullptr, nullptr, nullptr);
    gbar(p.bar, btarget);
    REPG ffn_in_phase(p, i, cur, smem);
    gbar(p.bar, btarget);
    REPG gemm_phase<2>(p, (const u16*)p.BIG, DFF, p.wt_ffn_out + (size_t)i * 1024 * DFF, 1024, Fbuf, smem);
    gbar(p.bar, btarget);
    rowop2_phase(p, false, cur, Fbuf, gn + 3 * D, nullptr, p.p_prompt + (size_t)i * ROWS_P * 256, p.p_sample + (size_t)i * 256 * 256, PB);
    gbar(p.bar, btarget);
    ple_phase(p, i, cur, nxt, smem);
    gbar(p.bar, btarget);
  }
}

extern "C" void kernel_launch(void* const* d_in, const int* in_sizes, int n_in, void* d_out, int out_size, void* d_ws,
                              size_t ws_size, hipStream_t stream) {
  static int grid_blocks = 0;
  if (!grid_blocks) {
    int dev = 0, cus = 0, per_cu = 0;
    hipGetDevice(&dev);
    hipDeviceGetAttribute(&cus, hipDeviceAttributeMultiprocessorCount, dev);
    hipOccupancyMaxActiveBlocksPerMultiprocessor(&per_cu, yoco_megakernel, 256, 0);
    if (per_cu > 2) per_cu = 2;
    grid_blocks = cus * per_cu;
    grid_blocks &= ~7;
  }
  P p{};
  const float* const* in = (const float* const*)d_in;
  p.x_prompt = in[0]; p.x_sample = in[1]; p.cache_k = in[2]; p.cache_v = in[3]; p.state_hgrn = in[4]; p.state_conv = in[5];
  p.p_prompt = in[6]; p.p_sample = in[7];
  p.g_norms = in[8]; const float* w_in_a = in[9]; p.lb_raw = in[10]; p.g_hg = in[11]; const float* w_out_a = in[12]; p.g_kv = in[13];
  const float* w_kv = in[14]; p.rel_bias = in[15]; const float* w_q_b = in[16]; p.lam_b = in[17]; p.g_subln = in[18];
  const float* w_out_b = in[19]; const float* w_ffn_in = in[20]; p.conv_w = in[21]; p.conv_b = in[22]; const float* w_ffn_out = in[23];
  const float* w_ple = in[24]; const float* w_ple_gate = in[25];
  float* o = (float*)d_out;
  p.y = o; o += (size_t)ROWS * D;
  p.k_prompt = o; o += (size_t)ROWS_P * D;
  p.v_prompt = o; o += (size_t)ROWS_P * D;
  p.k_sample = o; o += (size_t)256 * D;
  p.v_sample = o; o += (size_t)256 * D;
  p.hgrn_prompt = o; o += (size_t)2 * 16 * 8 * 16384;
  p.hgrn_sample = o; o += (size_t)2 * 8 * 8 * 16384;
  p.conv_prompt = o; o += (size_t)4 * 16 * 2 * DFF;
  p.conv_sample = o;
  u16* ws = (u16*)d_ws;
  p.wt_in_a = ws; ws += (size_t)2 * 4096 * 1024;
  p.wt_out_a = ws; ws += (size_t)2 * 1024 * 1024;
  p.wt_kv = ws; ws += (size_t)2048 * 1024;
  p.wt_q = ws; ws += (size_t)2 * 1024 * 1024;
  p.wt_out_b = ws; ws += (size_t)2 * 1024 * 1024;
  p.wt_ffn_in = ws; ws += (size_t)4 * 5632 * 1024;
  p.wt_ffn_out = ws; ws += (size_t)4 * 1024 * DFF;
  p.wt_ple = ws; ws += (size_t)4 * 1024 * 256;
  p.wt_gate = ws; ws += (size_t)4 * 1024 * 1024;
  p.XB = ws; ws += (size_t)ROWS * 1024;
  p.OG = ws; ws += (size_t)ROWS * 1024;
  p.BIG = (char*)ws;
  p.bar = (unsigned*)((char*)d_ws + ((size_t)500 << 20));
  p.ss = (float*)((char*)d_ws + ((size_t)501 << 20));
  p.ss2 = (float*)((char*)d_ws + ((size_t)504 << 20));
  int n = 0;
  for (int i = 0; i < 2; ++i) p.wd[n++] = WD{w_in_a + (size_t)i * 1024 * 4096, p.wt_in_a + (size_t)i * 4096 * 1024, i ? p.g_norms + 4 * D : nullptr, 1024, 4096, 0, 0};
  for (int i = 0; i < 2; ++i) p.wd[n++] = WD{w_out_a + (size_t)i * 1024 * 1024, p.wt_out_a + (size_t)i * 1024 * 1024, nullptr, 1024, 1024, 0, 0};
  p.wd[n++] = WD{w_kv, p.wt_kv, p.g_kv, 1024, 2048, 0, 0};
  for (int i = 0; i < 2; ++i) p.wd[n++] = WD{w_q_b + (size_t)i * 1024 * 1024, p.wt_q + (size_t)i * 1024 * 1024, p.g_norms + (size_t)(i + 2) * 4 * D, 1024, 1024, 0, 0};
  for (int i = 0; i < 2; ++i) p.wd[n++] = WD{w_out_b + (size_t)i * 1024 * 1024, p.wt_out_b + (size_t)i * 1024 * 1024, nullptr, 1024, 1024, 0, 0};
  for (int i = 0; i < 4; ++i) p.wd[n++] = WD{w_ffn_in + (size_t)i * 1024 * 5632, p.wt_ffn_in + (size_t)i * 5632 * 1024, p.g_norms + (size_t)(i * 4 + 2) * D, 1024, 5632, 1, 0};
  for (int i = 0; i < 4; ++i) p.wd[n++] = WD{w_ffn_out + (size_t)i * DFF * 1024, p.wt_ffn_out + (size_t)i * 1024 * DFF, nullptr, DFF, 1024, 0, 0};
  for (int i = 0; i < 4; ++i) p.wd[n++] = WD{w_ple + (size_t)i * 256 * 1024, p.wt_ple + (size_t)i * 1024 * 256, nullptr, 256, 1024, 0, 0};
  for (int i = 0; i < 4; ++i) p.wd[n++] = WD{w_ple_gate + (size_t)i * 1024 * 1024, p.wt_gate + (size_t)i * 1024 * 1024, nullptr, 1024, 1024, 0, 0};
  void* args[] = {&p};
  hipError_t e = hipLaunchCooperativeKernel((void*)yoco_megakernel, dim3(grid_blocks), dim3(256), args, 0, stream);
  if (e != hipSuccess) fprintf(stderr, "cooperative launch failed: %s (grid %d)\n", hipGetErrorString(e), grid_blocks);
}
```

```cpp
#include <hip/hip_runtime.h>
#include <hip/hip_cooperative_groups.h>
#include <cstdio>
namespace cg = cooperative_groups;

#define DI __device__ __forceinline__
typedef unsigned short u16;
typedef short bf16x8 __attribute__((ext_vector_type(8)));
typedef float f32x16 __attribute__((ext_vector_type(16)));
typedef float f32x4 __attribute__((ext_vector_type(4)));
typedef __bf16 bf2_t __attribute__((ext_vector_type(2)));
typedef float f2_t __attribute__((ext_vector_type(2)));
typedef unsigned u32x2 __attribute__((ext_vector_type(2)));
typedef unsigned u32x4 __attribute__((ext_vector_type(4)));

constexpr int D = 1024, ROWS_P = 32768, ROWS = 33024, DFF = 2816;
constexpr float EPS = 1e-6f;
constexpr float LOG2E = 1.4426950408889634f;
constexpr int NW = 25;
#ifndef REP_GEMM
#define REP_GEMM 1
#endif
#ifndef REP_GLA
#define REP_GLA 1
#endif
#ifndef REP_ATTN
#define REP_ATTN 1
#endif
#define REPG for (int _r = 0; _r < REP_GEMM; ++_r)

struct WD { const float* src; u16* dst; const float* gain; int K, N, mode, pad; };

struct P {
  const float *x_prompt, *x_sample, *cache_k, *cache_v, *state_hgrn, *state_conv, *p_prompt, *p_sample;
  const float *g_norms, *lb_raw, *g_hg, *g_kv, *rel_bias, *lam_b, *g_subln, *conv_w, *conv_b;
  float *y, *k_prompt, *v_prompt, *k_sample, *v_sample, *hgrn_prompt, *hgrn_sample, *conv_prompt, *conv_sample;
  u16 *wt_in_a, *wt_out_a, *wt_kv, *wt_q, *wt_out_b, *wt_ffn_in, *wt_ffn_out, *wt_ple, *wt_gate;
  u16 *XB, *OG; char* BIG; unsigned* bar; float* ss; float* ss2;
  WD wd[NW];
};

DI unsigned pk2(float a, float b) { f2_t v = {a, b}; bf2_t r = __builtin_convertvector(v, bf2_t); return __builtin_bit_cast(unsigned, r); }
DI int lbid() { int b = blockIdx.x; asm volatile("" : "+s"(b)); return b; }
DI int ltid() { int t = threadIdx.x; asm volatile("" : "+v"(t)); return t; }
DI float bf2f(u16 x) { return __uint_as_float(((unsigned)x) << 16); }
DI float bflo(unsigned x) { return __uint_as_float(x << 16); }
DI float bfhi(unsigned x) { return __uint_as_float(x & 0xffff0000u); }
DI float sigm(float x) { return 1.f / (1.f + __expf(-x)); }
DI float wave_sum(float v) {
#pragma unroll
  for (int o = 32; o; o >>= 1) v += __shfl_xor(v, o);
  return v;
}
DI bf16x8 mk8(u32x2 lo, u32x2 hi) { u32x4 t = {lo[0], lo[1], hi[0], hi[1]}; return __builtin_bit_cast(bf16x8, t); }
DI bf16x8 mk8u(unsigned a, unsigned b, unsigned c, unsigned d) { u32x4 t = {a, b, c, d}; return __builtin_bit_cast(bf16x8, t); }

DI void prep_tile_info(const P& p, int flat, int& wi, int& k0, int& n0) {
  int base = 0; wi = 0;
  for (;;) { int nt = (p.wd[wi].K >> 6) * (p.wd[wi].N >> 6); if (flat < base + nt) break; base += nt; ++wi; }
  const int tix = flat - base, ntn = p.wd[wi].N >> 6;
  k0 = (tix / ntn) << 6; n0 = (tix % ntn) << 6;
}
DI void prep_phase(const P& p, char* smem) {
  float* T = (float*)smem;
  const int tid = ltid();
  int total = 0;
  for (int i = 0; i < NW; ++i) total += (p.wd[i].K >> 6) * (p.wd[i].N >> 6);
  const int n = tid & 63, kb = tid >> 6;
  float v[16];
  int flat = lbid();
  int wi = 0, k0 = 0, n0 = 0;
  if (flat < total) {
    prep_tile_info(p, flat, wi, k0, n0);
    const WD& d = p.wd[wi];
#pragma unroll
    for (int j = 0; j < 16; ++j) { const int kk = kb + 4 * j; v[j] = d.src[(size_t)(k0 + kk) * d.N + n0 + n]; if (d.gain) v[j] *= d.gain[k0 + kk]; }
  }
  for (; flat < total; flat += gridDim.x) {
    const WD& d = p.wd[wi];
    const int ck0 = k0, cn0 = n0;
#pragma unroll
    for (int j = 0; j < 16; ++j) T[(kb + 4 * j) * 65 + n] = v[j];
    const int nf = flat + gridDim.x;
    if (nf < total) {
      prep_tile_info(p, nf, wi, k0, n0);
      const WD& d2 = p.wd[wi];
#pragma unroll
      for (int j = 0; j < 16; ++j) { const int kk = kb + 4 * j; v[j] = d2.src[(size_t)(k0 + kk) * d2.N + n0 + n]; if (d2.gain) v[j] *= d2.gain[k0 + kk]; }
    }
    __syncthreads();
    {
      const int nn = tid >> 2, ks = tid & 3;
      int nc = cn0 + nn, drow = nc;
      if (d.mode == 1) { int isu = nc >= DFF; int ch = nc - DFF * isu; drow = 256 * (ch >> 7) + 64 * ((ch >> 5) & 3) + 32 * isu + (ch & 31); }
      unsigned o[8];
#pragma unroll
      for (int j = 0; j < 8; ++j) o[j] = pk2(T[(16 * ks + 2 * j) * 65 + nn], T[(16 * ks + 2 * j + 1) * 65 + nn]);
      u16* fb = d.dst + (((size_t)(drow >> 5) * (d.K >> 4) + ((ck0 >> 4) + ks)) * 64 + (drow & 31)) * 8;
      *(u32x4*)(fb) = (u32x4){o[0], o[1], o[2], o[3]};
      *(u32x4*)(fb + 256) = (u32x4){o[4], o[5], o[6], o[7]};
    }
    __syncthreads();
  }
}

DI void rowop_phase(const P& p, bool x_from_in, const u16* __restrict__ Madd, const float* __restrict__ gpost,
                    const float* __restrict__ gnext, u16* __restrict__ outH, const float* ple_p, const float* ple_s, u16* outP) {
  const int tidr = ltid();
  const int lane = tidr & 63;
  const int wave = (lbid() * blockDim.x + tidr) >> 6;
  const int nwave = (gridDim.x * blockDim.x) >> 6;
  for (int rb = wave * 2; rb < ROWS; rb += nwave * 2) {
    f32x4 x[2][4];
    u32x2 m[2][4];
#pragma unroll
    for (int u = 0; u < 2; ++u) {
      const int r = rb + u;
      const float* xs = x_from_in ? (r < ROWS_P ? p.x_prompt + (size_t)r * D : p.x_sample + (size_t)(r - ROWS_P) * D) : p.y + (size_t)r * D;
#pragma unroll
      for (int j = 0; j < 4; ++j) x[u][j] = *(const f32x4*)(xs + 4 * lane + 256 * j);
      if (Madd) {
#pragma unroll
        for (int j = 0; j < 4; ++j) m[u][j] = *(const u32x2*)(Madd + (size_t)r * D + 4 * lane + 256 * j);
      }
    }
#pragma unroll
    for (int u = 0; u < 2; ++u) {
      const int r = rb + u;
      if (Madd) {
        f32x4 mf[4]; float ss = 0.f;
#pragma unroll
        for (int j = 0; j < 4; ++j) { mf[j] = (f32x4){bflo(m[u][j][0]), bfhi(m[u][j][0]), bflo(m[u][j][1]), bfhi(m[u][j][1])}; ss += mf[j][0] * mf[j][0] + mf[j][1] * mf[j][1] + mf[j][2] * mf[j][2] + mf[j][3] * mf[j][3]; }
        ss = wave_sum(ss);
        const float rs = rsqrtf(ss * (1.f / D) + EPS);
#pragma unroll
        for (int j = 0; j < 4; ++j) { f32x4 g = *(const f32x4*)(gpost + 4 * lane + 256 * j); x[u][j] += mf[j] * rs * g; }
#pragma unroll
        for (int j = 0; j < 4; ++j) *(f32x4*)(p.y + (size_t)r * D + 4 * lane + 256 * j) = x[u][j];
      }
      float rx = 1.f;
      if (gnext) {
        float ss = 0.f;
#pragma unroll
        for (int j = 0; j < 4; ++j) ss += x[u][j][0] * x[u][j][0] + x[u][j][1] * x[u][j][1] + x[u][j][2] * x[u][j][2] + x[u][j][3] * x[u][j][3];
        ss = wave_sum(ss);
        rx = rsqrtf(ss * (1.f / D) + EPS);
      }
#pragma unroll
      for (int j = 0; j < 4; ++j) {
        f32x4 h = x[u][j] * rx;
        if (gnext) h *= *(const f32x4*)(gnext + 4 * lane + 256 * j);
        *(u32x2*)(outH + (size_t)r * D + 4 * lane + 256 * j) = (u32x2){pk2(h[0], h[1]), pk2(h[2], h[3])};
      }
      if (outP) {
        const float* ps = r < ROWS_P ? ple_p + (size_t)r * 256 : ple_s + (size_t)(r - ROWS_P) * 256;
        f32x4 v = *(const f32x4*)(ps + 4 * lane);
        *(u32x2*)(outP + (size_t)r * 256 + 4 * lane) = (u32x2){pk2(v[0], v[1]), pk2(v[2], v[3])};
      }
    }
  }
}

DI void rowop2_phase(const P& p, bool x_from_in, u16* __restrict__ XR, const u16* __restrict__ Madd, const float* __restrict__ gpost,
                     float* __restrict__ ssout, const float* ple_p, const float* ple_s, u16* outP) {
  const int tidr = ltid();
  const int lane = tidr & 63;
  const int wave = (lbid() * blockDim.x + tidr) >> 6;
  const int nwave = (gridDim.x * blockDim.x) >> 6;
  for (int rb = wave * 2; rb < ROWS; rb += nwave * 2) {
    f32x4 x[2][4];
    u32x2 m[2][4];
#pragma unroll
    for (int u = 0; u < 2; ++u) {
      const int r = rb + u;
      if (x_from_in) {
        const float* xs = r < ROWS_P ? p.x_prompt + (size_t)r * D : p.x_sample + (size_t)(r - ROWS_P) * D;
#pragma unroll
        for (int j = 0; j < 4; ++j) x[u][j] = *(const f32x4*)(xs + 4 * lane + 256 * j);
      } else {
#pragma unroll
        for (int j = 0; j < 4; ++j) { const u32x2 t = *(const u32x2*)(XR + (size_t)r * D + 4 * lane + 256 * j); x[u][j] = (f32x4){bflo(t[0]), bfhi(t[0]), bflo(t[1]), bfhi(t[1])}; }
      }
#pragma unroll
      for (int j = 0; j < 4; ++j) m[u][j] = *(const u32x2*)(Madd + (size_t)r * D + 4 * lane + 256 * j);
    }
#pragma unroll
    for (int u = 0; u < 2; ++u) {
      const int r = rb + u;
      f32x4 mf[4]; float ss = 0.f;
#pragma unroll
      for (int j = 0; j < 4; ++j) { mf[j] = (f32x4){bflo(m[u][j][0]), bfhi(m[u][j][0]), bflo(m[u][j][1]), bfhi(m[u][j][1])}; ss += mf[j][0] * mf[j][0] + mf[j][1] * mf[j][1] + mf[j][2] * mf[j][2] + mf[j][3] * mf[j][3]; }
      ss = wave_sum(ss);
      const float rs = rsqrtf(ss * (1.f / D) + EPS);
      float sx = 0.f;
#pragma unroll
      for (int j = 0; j < 4; ++j) {
        const f32x4 g = *(const f32x4*)(gpost + 4 * lane + 256 * j);
        const f32x4 xn = x[u][j] + mf[j] * rs * g;
        const u32x2 o = (u32x2){pk2(xn[0], xn[1]), pk2(xn[2], xn[3])};
        *(u32x2*)(XR + (size_t)r * D + 4 * lane + 256 * j) = o;
        const float q0 = bflo(o[0]), q1 = bfhi(o[0]), q2 = bflo(o[1]), q3 = bfhi(o[1]);
        sx += q0 * q0 + q1 * q1 + q2 * q2 + q3 * q3;
      }
      if (ssout) { sx = wave_sum(sx); if (lane == 0) ssout[r] = sx; }
      if (outP) {
        const float* ps = r < ROWS_P ? ple_p + (size_t)r * 256 : ple_s + (size_t)(r - ROWS_P) * 256;
        f32x4 v = *(const f32x4*)(ps + 4 * lane);
        *(u32x2*)(outP + (size_t)r * 256 + 4 * lane) = (u32x2){pk2(v[0], v[1]), pk2(v[2], v[3])};
      }
    }
  }
}

template <class RowMap>
DI void gemm_core(const u16* __restrict__ A, int lda, RowMap rm, const u16* __restrict__ Bt, int n0, int K,
                  f32x16 (&acc)[4][2], char* smem, const int tid) {
  const int l = tid & 63, w = tid >> 6, l32 = l & 31, hh = l >> 5;
  const int lr = tid >> 3, lc = tid & 7;
  const u16* ap[4];
#pragma unroll
  for (int q = 0; q < 4; ++q) ap[q] = A + (size_t)rm(q * 32 + lr) * lda + lc * 8;
  const u16* bq0 = Bt + ((size_t)((n0 + w * 64) >> 5) * (K >> 4) * 64 + l) * 8;
  const u16* bq1 = bq0 + (size_t)(K >> 4) * 512;
  const unsigned woff = lr * 144 + lc * 16;
  const unsigned aoff = l32 * 144 + hh * 16;
  u32x4 ra0[4];
  bf16x8 bf0[4], bf1[4];
  const int nk = K >> 6;
#define GLOADA(RA, T) _Pragma("unroll") for (int q = 0; q < 4; ++q) { RA[q] = *(const u32x4*)(ap[q] + (T) * 64); }
#define SWRITEA(RA, BUF) { char* db_ = smem + (BUF) * 18432; _Pragma("unroll") for (int q = 0; q < 4; ++q) { *(u32x4*)(db_ + woff + q * 4608) = RA[q]; } }
#define COMPUTE(BUF, TN, MORE) { const char* sb = smem + (BUF) * 18432; _Pragma("unroll") for (int ks = 0; ks < 4; ++ks) { \
      const unsigned co = ks * 32; \
      bf16x8 a0 = *(const bf16x8*)(sb + aoff + co); \
      bf16x8 a1 = *(const bf16x8*)(sb + aoff + 4608 + co); \
      bf16x8 a2 = *(const bf16x8*)(sb + aoff + 9216 + co); \
      bf16x8 a3 = *(const bf16x8*)(sb + aoff + 13824 + co); \
      acc[0][0] = __builtin_amdgcn_mfma_f32_32x32x16_bf16(bf0[ks], a0, acc[0][0], 0, 0, 0); \
      acc[0][1] = __builtin_amdgcn_mfma_f32_32x32x16_bf16(bf1[ks], a0, acc[0][1], 0, 0, 0); \
      acc[1][0] = __builtin_amdgcn_mfma_f32_32x32x16_bf16(bf0[ks], a1, acc[1][0], 0, 0, 0); \
      acc[1][1] = __builtin_amdgcn_mfma_f32_32x32x16_bf16(bf1[ks], a1, acc[1][1], 0, 0, 0); \
      acc[2][0] = __builtin_amdgcn_mfma_f32_32x32x16_bf16(bf0[ks], a2, acc[2][0], 0, 0, 0); \
      acc[2][1] = __builtin_amdgcn_mfma_f32_32x32x16_bf16(bf1[ks], a2, acc[2][1], 0, 0, 0); \
      acc[3][0] = __builtin_amdgcn_mfma_f32_32x32x16_bf16(bf0[ks], a3, acc[3][0], 0, 0, 0); \
      acc[3][1] = __builtin_amdgcn_mfma_f32_32x32x16_bf16(bf1[ks], a3, acc[3][1], 0, 0, 0); \
      if (MORE) { bf0[ks] = *(const bf16x8*)(bq0 + ((TN) * 4 + ks) * 512); bf1[ks] = *(const bf16x8*)(bq1 + ((TN) * 4 + ks) * 512); } \
      __builtin_amdgcn_sched_barrier(0); } }
  GLOADA(ra0, 0);
#pragma unroll
  for (int ks = 0; ks < 4; ++ks) { bf0[ks] = *(const bf16x8*)(bq0 + ks * 512); bf1[ks] = *(const bf16x8*)(bq1 + ks * 512); }
  SWRITEA(ra0, 0);
  __syncthreads();
  for (int kt = 0; kt < nk; kt += 2) {
    GLOADA(ra0, kt + 1);
    __builtin_amdgcn_sched_barrier(0);
    COMPUTE(0, kt + 1, true);
    SWRITEA(ra0, 1);
    __syncthreads();
    if (kt + 2 < nk) GLOADA(ra0, kt + 2);
    __builtin_amdgcn_sched_barrier(0);
    COMPUTE(1, kt + 2, kt + 2 < nk);
    if (kt + 2 < nk) SWRITEA(ra0, 0);
    __syncthreads();
  }
#undef GLOADA
#undef SWRITEA
#undef COMPUTE
}

template <class RowMap>
DI void gemm_core_mini(const u16* __restrict__ A, int lda, RowMap rm, const u16* __restrict__ Bt, int n0, int K,
                       f32x16 (&acc)[2], char* smem, const int tid) {
  const int l = tid & 63, w = tid >> 6, l32 = l & 31, hh = l >> 5;
  const int lr = tid >> 3, lc = tid & 7;
  const u16* ap[4];
#pragma unroll
  for (int q = 0; q < 4; ++q) ap[q] = A + (size_t)rm(q * 32 + lr) * lda + lc * 8;
  const u16* bq0 = Bt + ((size_t)(n0 >> 5) * (K >> 4) * 64 + l) * 8;
  const u16* bq1 = bq0 + (size_t)(K >> 4) * 512;
  const unsigned woff = lr * 144 + lc * 16;
  const unsigned aoff = (w * 32 + l32) * 144 + hh * 16;
  u32x4 ra0[4];
  bf16x8 bf0[4], bf1[4];
  const int nk = K >> 6;
#define GLOADA(RA, T) _Pragma("unroll") for (int q = 0; q < 4; ++q) { RA[q] = *(const u32x4*)(ap[q] + (T) * 64); }
#define SWRITEA(RA, BUF) { char* db_ = smem + (BUF) * 18432; _Pragma("unroll") for (int q = 0; q < 4; ++q) { *(u32x4*)(db_ + woff + q * 4608) = RA[q]; } }
#define COMPUTE(BUF, TN, MORE) { const char* sb = smem + (BUF) * 18432; _Pragma("unroll") for (int ks = 0; ks < 4; ++ks) { \
      const unsigned co = ks * 32; \
      bf16x8 a0 = *(const bf16x8*)(sb + aoff + co); \
      acc[0] = __builtin_amdgcn_mfma_f32_32x32x16_bf16(bf0[ks], a0, acc[0], 0, 0, 0); \
      acc[1] = __builtin_amdgcn_mfma_f32_32x32x16_bf16(bf1[ks], a0, acc[1], 0, 0, 0); \
      if (MORE) { bf0[ks] = *(const bf16x8*)(bq0 + ((TN) * 4 + ks) * 512); bf1[ks] = *(const bf16x8*)(bq1 + ((TN) * 4 + ks) * 512); } \
      __builtin_amdgcn_sched_barrier(0); } }
  GLOADA(ra0, 0);
#pragma unroll
  for (int ks = 0; ks < 4; ++ks) { bf0[ks] = *(const bf16x8*)(bq0 + ks * 512); bf1[ks] = *(const bf16x8*)(bq1 + ks * 512); }
  SWRITEA(ra0, 0);
  __syncthreads();
  for (int kt = 0; kt < nk; kt += 2) {
    GLOADA(ra0, kt + 1);
    __builtin_amdgcn_sched_barrier(0);
    COMPUTE(0, kt + 1, true);
    SWRITEA(ra0, 1);
    __syncthreads();
    if (kt + 2 < nk) GLOADA(ra0, kt + 2);
    __builtin_amdgcn_sched_barrier(0);
    COMPUTE(1, kt + 2, kt + 2 < nk);
    if (kt + 2 < nk) SWRITEA(ra0, 0);
    __syncthreads();
  }
#undef GLOADA
#undef SWRITEA
#undef COMPUTE
}

DI bool next_tile(int it, int ntm, int ntn, int& tm, int& tn) {
  const int b = lbid(), x = b & 7, slot = b >> 3, S = gridDim.x >> 3;
  const int nq = (ntm - x + 7) >> 3;
  const int L = slot + it * S;
  if (L >= nq * ntn) return false;
  const int gsize = 8 * ntn;
  const int grp = L / gsize, r = L - grp * gsize;
  const int gsz = min(8, nq - 8 * grp);
  tn = r / gsz;
  tm = x + 8 * (8 * grp + r % gsz);
  return true;
}

DI void list_entry(int L, int ntm, int ntn, int& tm, int& tn) {
  const int x = lbid() & 7;
  const int nq = (ntm - x + 7) >> 3;
  const int gsize = 8 * ntn;
  const int grp = L / gsize, r = L - grp * gsize;
  const int gsz = min(8, nq - 8 * grp);
  tn = r / gsz;
  tm = x + 8 * (8 * grp + r % gsz);
}
DI void list_info(int ntm, int ntn, int& full, int& nleft) {
  const int x = lbid() & 7, S = gridDim.x >> 3;
  const int len = ((ntm - x + 7) >> 3) * ntn;
  full = (len / S) * S;
  nleft = len - full;
  if (4 * nleft > S) { full = len; nleft = 0; }
}

struct IdMap { int base; DI int operator()(int r) const { return base + r; } };
struct ClampMap { int rowbase, t0, T; DI int operator()(int r) const { int t = t0 + r; t = t < 0 ? 0 : (t > T - 1 ? T - 1 : t); return rowbase + t; } };
struct ClampMap2 { int rowbase, t0, T, srow; DI int operator()(int r) const { if (srow >= 0 && r >= 64) { int t = r - 66; t = t < 0 ? 0 : (t > 31 ? 31 : t); return srow + t; } int t = t0 + r; t = t < 0 ? 0 : (t > T - 1 ? T - 1 : t); return rowbase + t; } };

#define ZERO_ACC(a) _Pragma("unroll") for (int _i = 0; _i < 4; ++_i) _Pragma("unroll") for (int _j = 0; _j < 2; ++_j) _Pragma("unroll") for (int _e = 0; _e < 16; ++_e) a[_i][_j][_e] = 0.f;

DI float row_rs(const float* rowss, int m) {
  const f32x4* sp = (const f32x4*)(rowss + (size_t)m * 16); const f32x4 s0 = sp[0], s1 = sp[1], s2 = sp[2], s3 = sp[3];
  const float tot = ((s0[0] + s0[1]) + (s0[2] + s0[3])) + ((s1[0] + s1[1]) + (s1[2] + s1[3])) + ((s2[0] + s2[1]) + (s2[2] + s2[3])) + ((s3[0] + s3[1]) + (s3[2] + s3[3]));
  return rsqrtf(tot * (1.f / D) + EPS);
}
template <int EPI>
DI void epi4(const P& p, void* outp, int m, int n, float v0, float v1, float v2, float v3) {
  if (EPI == 0) {
    const int sec = n >> 10;
    if (sec == 0 || sec == 3) { v0 *= sigm(v0); v1 *= sigm(v1); v2 *= sigm(v2); v3 *= sigm(v3); }
    *(u32x2*)((u16*)outp + (size_t)m * 4096 + n) = (u32x2){pk2(v0, v1), pk2(v2, v3)};
  } else if (EPI == 1) {
    const float sc = 0.125f * LOG2E;
    *(u32x2*)((u16*)outp + (size_t)m * 1024 + n) = (u32x2){pk2(v0 * sc, v1 * sc), pk2(v2 * sc, v3 * sc)};
  } else if (EPI == 2) {
    *(u32x2*)((u16*)outp + (size_t)m * 1024 + n) = (u32x2){pk2(v0, v1), pk2(v2, v3)};
  } else {
    float* dst;
    if (n < 1024) dst = (m < ROWS_P ? p.k_prompt + (size_t)m * 1024 : p.k_sample + (size_t)(m - ROWS_P) * 1024) + n;
    else dst = (m < ROWS_P ? p.v_prompt + (size_t)m * 1024 : p.v_sample + (size_t)(m - ROWS_P) * 1024) + (n - 1024);
    *(f32x4*)dst = (f32x4){v0, v1, v2, v3};
  }
}
template <int EPI>
DI void gemm_phase(const P& p, const u16* A, int K, const u16* Bt, int N, void* outp, char* smem, const float* rowss = nullptr) {
  const int tid = ltid(), l = tid & 63, w = tid >> 6, l32 = l & 31, hh = l >> 5;
  const int ntm = ROWS / 128, ntn = N / 256;
  const int slot = lbid() >> 3, S = gridDim.x >> 3;
  int full, nleft, tm, tn;
  list_info(ntm, ntn, full, nleft);
  for (int L = slot; L < full; L += S) {
    list_entry(L, ntm, ntn, tm, tn);
    f32x16 acc[4][2];
    ZERO_ACC(acc);
    gemm_core(A, K, IdMap{tm * 128}, Bt, tn * 256, K, acc, smem, ltid());
#pragma unroll
    for (int mi = 0; mi < 4; ++mi) {
      const int m = tm * 128 + mi * 32 + l32;
      float rsc = 1.f;
      if (rowss) rsc = row_rs(rowss, m);
#pragma unroll
      for (int ni = 0; ni < 2; ++ni)
#pragma unroll
        for (int q = 0; q < 4; ++q)
          epi4<EPI>(p, outp, m, tn * 256 + w * 64 + ni * 32 + 8 * q + 4 * hh,
                    acc[mi][ni][4 * q] * rsc, acc[mi][ni][4 * q + 1] * rsc, acc[mi][ni][4 * q + 2] * rsc, acc[mi][ni][4 * q + 3] * rsc);
    }
  }
  if (slot < 4 * nleft) {
    list_entry(full + (slot >> 2), ntm, ntn, tm, tn);
    const int n0 = tn * 256 + (slot & 3) * 64;
    f32x16 acc[2];
#pragma unroll
    for (int e = 0; e < 16; ++e) { acc[0][e] = 0.f; acc[1][e] = 0.f; }
    gemm_core_mini(A, K, IdMap{tm * 128}, Bt, n0, K, acc, smem, ltid());
    const int m = tm * 128 + w * 32 + l32;
    float rsc = 1.f;
    if (rowss) rsc = row_rs(rowss, m);
#pragma unroll
    for (int ni = 0; ni < 2; ++ni)
#pragma unroll
      for (int q = 0; q < 4; ++q)
        epi4<EPI>(p, outp, m, n0 + ni * 32 + 8 * q + 4 * hh,
                  acc[ni][4 * q] * rsc, acc[ni][4 * q + 1] * rsc, acc[ni][4 * q + 2] * rsc, acc[ni][4 * q + 3] * rsc);
  }
}

DI void ple_epi(const P& p, const u16* PL, const u16* XIN, u16* XOUT, int m, int n, float a0, float a1, float a2, float a3, float& ssq) {
  const u32x2 xi = *(const u32x2*)(XIN + (size_t)m * D + n);
  f32x4 x = (f32x4){bflo(xi[0]), bfhi(xi[0]), bflo(xi[1]), bfhi(xi[1])};
  const u32x2 pv = *(const u32x2*)(PL + (size_t)m * D + n);
  x[0] += sigm(a0) * bflo(pv[0]);
  x[1] += sigm(a1) * bfhi(pv[0]);
  x[2] += sigm(a2) * bflo(pv[1]);
  x[3] += sigm(a3) * bfhi(pv[1]);
  if (XOUT) {
    const u32x2 o = (u32x2){pk2(x[0], x[1]), pk2(x[2], x[3])};
    *(u32x2*)(XOUT + (size_t)m * D + n) = o;
    const float q0 = bflo(o[0]), q1 = bfhi(o[0]), q2 = bflo(o[1]), q3 = bfhi(o[1]);
    ssq += q0 * q0 + q1 * q1 + q2 * q2 + q3 * q3;
  } else {
    *(f32x4*)(p.y + (size_t)m * D + n) = x;
  }
}
DI void ple_phase(const P& p, int layer, const u16* XIN, u16* XOUT, char* smem) {
  const int tid = ltid(), l = tid & 63, w = tid >> 6, l32 = l & 31, hh = l >> 5;
  const u16* XB2 = XIN;
  const u16* PB = (const u16*)p.BIG;
  u16* PL = (u16*)(p.BIG + ((size_t)32 << 20));
  const u16* Wg = p.wt_gate + (size_t)layer * 1024 * 1024;
  const u16* Wp = p.wt_ple + (size_t)layer * 1024 * 256;
  const int ntm = ROWS / 128, ntn = 4;
  const int slot = lbid() >> 3, S = gridDim.x >> 3;
  int full, nleft, tm, tn;
  list_info(ntm, ntn, full, nleft);
  for (int L = slot; L < full; L += S) {
    list_entry(L, ntm, ntn, tm, tn);
    f32x16 acc2[4][2];
    ZERO_ACC(acc2);
    gemm_core(PB, 256, IdMap{tm * 128}, Wp, tn * 256, 256, acc2, smem, ltid());
#pragma unroll
    for (int mi = 0; mi < 4; ++mi)
#pragma unroll
      for (int ni = 0; ni < 2; ++ni)
#pragma unroll
        for (int q = 0; q < 4; ++q)
          *(u32x2*)(PL + (size_t)(tm * 128 + mi * 32 + l32) * D + tn * 256 + w * 64 + ni * 32 + 8 * q + 4 * hh) =
              (u32x2){pk2(acc2[mi][ni][4 * q], acc2[mi][ni][4 * q + 1]), pk2(acc2[mi][ni][4 * q + 2], acc2[mi][ni][4 * q + 3])};
  }
  if (slot < 4 * nleft) {
    list_entry(full + (slot >> 2), ntm, ntn, tm, tn);
    const int n0 = tn * 256 + (slot & 3) * 64;
    f32x16 acc2[2];
#pragma unroll
    for (int e = 0; e < 16; ++e) { acc2[0][e] = 0.f; acc2[1][e] = 0.f; }
    gemm_core_mini(PB, 256, IdMap{tm * 128}, Wp, n0, 256, acc2, smem, ltid());
#pragma unroll
    for (int ni = 0; ni < 2; ++ni)
#pragma unroll
      for (int q = 0; q < 4; ++q)
        *(u32x2*)(PL + (size_t)(tm * 128 + w * 32 + l32) * D + n0 + ni * 32 + 8 * q + 4 * hh) =
            (u32x2){pk2(acc2[ni][4 * q], acc2[ni][4 * q + 1]), pk2(acc2[ni][4 * q + 2], acc2[ni][4 * q + 3])};
  }
  for (int L = slot; L < full; L += S) {
    list_entry(L, ntm, ntn, tm, tn);
    f32x16 acc[4][2];
    ZERO_ACC(acc);
    gemm_core(XB2, 1024, IdMap{tm * 128}, Wg, tn * 256, 1024, acc, smem, ltid());
#pragma unroll
    for (int mi = 0; mi < 4; ++mi) {
      const int m = tm * 128 + mi * 32 + l32;
      float ssq = 0.f;
#pragma unroll
      for (int ni = 0; ni < 2; ++ni)
#pragma unroll
        for (int q = 0; q < 4; ++q)
          ple_epi(p, PL, XIN, XOUT, m, tn * 256 + w * 64 + ni * 32 + 8 * q + 4 * hh, acc[mi][ni][4 * q], acc[mi][ni][4 * q + 1], acc[mi][ni][4 * q + 2], acc[mi][ni][4 * q + 3], ssq);
      ssq += __shfl_xor(ssq, 32);
      if (hh == 0) p.ss[(size_t)m * 16 + tn * 4 + w] = ssq;
    }
  }
  if (slot < 4 * nleft) {
    list_entry(full + (slot >> 2), ntm, ntn, tm, tn);
    const int ws = slot & 3, n0 = tn * 256 + ws * 64;
    f32x16 acc[2];
#pragma unroll
    for (int e = 0; e < 16; ++e) { acc[0][e] = 0.f; acc[1][e] = 0.f; }
    gemm_core_mini(XB2, 1024, IdMap{tm * 128}, Wg, n0, 1024, acc, smem, ltid());
    const int m = tm * 128 + w * 32 + l32;
    float ssq = 0.f;
#pragma unroll
    for (int ni = 0; ni < 2; ++ni)
#pragma unroll
      for (int q = 0; q < 4; ++q)
        ple_epi(p, PL, XIN, XOUT, m, n0 + ni * 32 + 8 * q + 4 * hh, acc[ni][4 * q], acc[ni][4 * q + 1], acc[ni][4 * q + 2], acc[ni][4 * q + 3], ssq);
    ssq += __shfl_xor(ssq, 32);
    if (hh == 0) p.ss[(size_t)m * 16 + tn * 4 + ws] = ssq;
  }
}

DI void ffn_in_phase(const P& p, int layer, const u16* XR, char* smem) {
  const int tid = ltid(), l = tid & 63, w = tid >> 6, l32 = l & 31, hh = l >> 5;
  const u16* Wt = p.wt_ffn_in + (size_t)layer * 5632 * 1024;
  u16* HID = (u16*)p.BIG;
  const float* cw = p.conv_w + (size_t)layer * 3 * DFF;
  const float* cb = p.conv_b + (size_t)layer * DFF;
  int tm, tn;
  for (int it = 0; next_tile(it, 272, 22, tm, tn); ++it) {
    const int seq = tm / 17, j = tm - seq * 17;
    const int T = 2048, rowbase = seq * 2048, t0 = 126 * j - 2;
    const bool last = (j == 16);
    const bool has_smp = last && seq < 8;
    const int srow = ROWS_P + seq * 32;
    f32x16 acc[4][2];
    ZERO_ACC(acc);
    const ClampMap2 rmap{rowbase, t0, T, has_smp ? srow : -1};
    gemm_core(XR, 1024, rmap, Wt, tn * 256, 1024, acc, smem, tid);
#pragma unroll
    for (int mi = 0; mi < 4; ++mi) {
      const float rsr = rsqrtf(p.ss2[rmap(mi * 32 + l32)] * (1.f / D) + EPS);
#pragma unroll
      for (int e = 0; e < 16; ++e) { acc[mi][0][e] *= rsr; acc[mi][1][e] *= rsr; }
    }
    const int chw = tn * 128 + w * 32;
    if (t0 < 0 && l32 < 2) {
#pragma unroll
      for (int q = 0; q < 4; ++q)
#pragma unroll
        for (int c = 0; c < 4; ++c) acc[0][0][4 * q + c] = 0.f;
    }
    if (has_smp && l32 < 2) {
#pragma unroll
      for (int q = 0; q < 4; ++q) {
        const f32x4 sv = *(const f32x4*)(p.state_conv + ((size_t)(layer * 8 + seq) * 2 + l32) * DFF + chw + 8 * q + 4 * hh);
#pragma unroll
        for (int c = 0; c < 4; ++c) acc[2][0][4 * q + c] = sv[c];
      }
    }
    const int lbase = l & 32;
#pragma unroll
    for (int q = 0; q < 4; ++q) {
      const int chq = chw + 8 * q + 4 * hh;
      const f32x4 b4 = *(const f32x4*)(cb + chq);
      const f32x4 w0 = *(const f32x4*)(cw + chq), w1 = *(const f32x4*)(cw + DFF + chq), w2 = *(const f32x4*)(cw + 2 * DFF + chq);
#pragma unroll
      for (int mi = 0; mi < 4; ++mi) {
        const int m = mi * 32 + l32;
        const bool seg1 = has_smp && mi >= 2;
        const int t = seg1 ? m - 66 : t0 + m;
        const int Tm = seg1 ? 32 : T;
        float hv[4];
#pragma unroll
        for (int c = 0; c < 4; ++c) {
          const float g0 = acc[mi][0][4 * q + c];
          float g1 = __shfl(g0, lbase + ((l32 + 31) & 31));
          float g2 = __shfl(g0, lbase + ((l32 + 30) & 31));
          if (mi > 0) {
            const float pg = acc[mi > 0 ? mi - 1 : 0][0][4 * q + c];
            const float p1 = __shfl(pg, lbase + 31), p2 = __shfl(pg, lbase + 30);
            if (l32 == 0) { g1 = p1; g2 = p2; }
            if (l32 == 1) { g2 = p1; }
          }
          const float cv = b4[c] + w0[c] * g2 + w1[c] * g1 + w2[c] * g0;
          hv[c] = cv * sigm(cv) * acc[mi][1][4 * q + c];
        }
        if ((seg1 ? m >= 66 : m >= 2) && t < Tm) {
          *(u32x2*)(HID + (size_t)((seg1 ? srow : rowbase) + t) * DFF + chq) = (u32x2){pk2(hv[0], hv[1]), pk2(hv[2], hv[3])};
          if (last && t >= Tm - 2) {
            float* co = seg1 ? p.conv_sample + ((size_t)(layer * 8 + seq) * 2 + (t - 30)) * DFF
                             : p.conv_prompt + ((size_t)(layer * 16 + seq) * 2 + (t - (T - 2))) * DFF;
            *(f32x4*)(co + chq) = (f32x4){acc[mi][0][4 * q], acc[mi][0][4 * q + 1], acc[mi][0][4 * q + 2], acc[mi][0][4 * q + 3]};
          }
        }
      }
    }
  }
}

DI void gla_state_phase(const P& p, int layer, char* smem) {
  const u16* PROJ = (const u16*)p.BIG;
  const int tid = ltid(), l = tid & 63, w = tid >> 6, l32 = l & 31, hh = l >> 5;
  float* SLOC = (float*)((char*)p.y + (size_t)ROWS * 1024 * 2);
  float* DTOT = SLOC + (size_t)384 * 16384;
  const int k = tid >> 1, th = tid & 1;
  for (int item = lbid(); item < 384; item += gridDim.x) {
    const int sh = item / 3, ch = item - sh * 3, s = sh >> 3, h = sh & 7;
    const int rowbase = s * 2048 + ch * 512;
    float lower = 0.f;
    if (layer == 1) lower = sigm(p.lb_raw[1024 + h * 128 + k] - p.lb_raw[h * 128 + k]);
    const float oml = 1.f - lower;
    f32x16 S[4];
#pragma unroll
    for (int kt = 0; kt < 4; ++kt)
#pragma unroll
      for (int i = 0; i < 16; ++i) S[kt][i] = 0.f;
    float btot = 0.f;
    u16 fr[8], vr[8];
#define GS_LOAD(BLK) { const size_t r0_ = (size_t)rowbase + (BLK) * 16; \
      const u16* pf_ = PROJ + (r0_ + 8 * th) * 4096 + 1024 + h * 128 + k; \
      const u16* pv_ = PROJ + r0_ * 4096 + 2048 + h * 128 + 32 * w + l32; \
      _Pragma("unroll") for (int t = 0; t < 8; ++t) fr[t] = pf_[(size_t)t * 4096]; \
      _Pragma("unroll") for (int jj = 0; jj < 8; ++jj) vr[jj] = pv_[(size_t)(8 * (jj >> 2) + 4 * hh + (jj & 3)) * 4096]; }
    GS_LOAD(0);
    for (int blk = 0; blk < 32; ++blk) {
      char* sb = smem + (blk & 1) * 8192;
      u16* KDT = (u16*)sb;
      float* DD = (float*)(KDT + 128 * 20);
      {
        float km[8], eb[8];
        float bs = 0.f;
#pragma unroll
        for (int t = 0; t < 8; ++t) {
          const float f = bf2f(fr[t]);
          const float g = lower + oml * sigm(f);
          bs += __logf(g);
          km[t] = 1.f - g; eb[t] = bs;
        }
        const float other = __shfl_xor(bs, 1);
        const float boff = th ? other : 0.f;
        const float bsum = bs + other;
        btot += bsum;
        unsigned kdp[4];
#pragma unroll
        for (int j = 0; j < 4; ++j)
          kdp[j] = pk2(km[2 * j] * __expf(bsum - boff - eb[2 * j]), km[2 * j + 1] * __expf(bsum - boff - eb[2 * j + 1]));
        *(u32x2*)(KDT + k * 20 + 8 * th) = (u32x2){kdp[0], kdp[1]};
        *(u32x2*)(KDT + k * 20 + 8 * th + 4) = (u32x2){kdp[2], kdp[3]};
        if (th == 0) DD[k] = __expf(bsum);
      }
      const bf16x8 vfrag = mk8u((unsigned)vr[0] | ((unsigned)vr[1] << 16), (unsigned)vr[2] | ((unsigned)vr[3] << 16),
                                (unsigned)vr[4] | ((unsigned)vr[5] << 16), (unsigned)vr[6] | ((unsigned)vr[7] << 16));
      if (blk + 1 < 32) GS_LOAD(blk + 1);
      __syncthreads();
#pragma unroll
      for (int kt = 0; kt < 4; ++kt) {
#pragma unroll
        for (int q = 0; q < 4; ++q) {
          const f32x4 d4 = *(const f32x4*)(DD + 32 * kt + 8 * q + 4 * hh);
#pragma unroll
          for (int c = 0; c < 4; ++c) S[kt][4 * q + c] *= d4[c];
        }
        const u32x2 lo = *(const u32x2*)(KDT + (32 * kt + l32) * 20 + 4 * hh);
        const u32x2 hi = *(const u32x2*)(KDT + (32 * kt + l32) * 20 + 8 + 4 * hh);
        S[kt] = __builtin_amdgcn_mfma_f32_32x32x16_bf16(mk8(lo, hi), vfrag, S[kt], 0, 0, 0);
      }
    }
#undef GS_LOAD
    {
      float* op = SLOC + (size_t)item * 16384 + 32 * w + l32;
#pragma unroll
      for (int kt = 0; kt < 4; ++kt)
#pragma unroll
        for (int i = 0; i < 16; ++i) op[(size_t)(32 * kt + (i & 3) + 8 * (i >> 2) + 4 * hh) * 128] = S[kt][i];
      if (th == 0) DTOT[(size_t)item * 128 + k] = __expf(btot);
    }
    __syncthreads();
  }
}

DI void gla_phase(const P& p, int layer, char* smem) {
  const u16* PROJ = (const u16*)p.BIG;
  const int tid = ltid(), l = tid & 63, w = tid >> 6, l32 = l & 31, hh = l >> 5, m16 = l & 15;
  float* REDB = (float*)(smem + 2 * 14336);
  const int k = tid >> 1, th = tid & 1;
  const float* SLOC = (const float*)((const char*)p.y + (size_t)ROWS * 1024 * 2);
  const float* DTOT = SLOC + (size_t)384 * 16384;
  for (int item = lbid(); item < 576; item += gridDim.x) {
    const bool smp = item < 64;
    const int s = smp ? 16 + (item >> 3) : (item - 64) >> 5;
    const int h = smp ? (item & 7) : ((item - 64) >> 2) & 7;
    const int ch = smp ? 0 : (item - 64) & 3;
    const int T = smp ? 32 : 512;
    const int rowbase = smp ? ROWS_P + (s - 16) * 32 : s * 2048 + ch * 512;
    float lower = 0.f;
    if (layer == 1) lower = sigm(p.lb_raw[1024 + h * 128 + k] - p.lb_raw[h * 128 + k]);
    const float oml = 1.f - lower;
    f32x16 S[4];
    if (smp) {
      const float* sp = p.state_hgrn + ((size_t)(layer * 8 + (s - 16)) * 8 + h) * 16384 + 32 * w + l32;
#pragma unroll
      for (int kt = 0; kt < 4; ++kt)
#pragma unroll
        for (int i = 0; i < 16; ++i) S[kt][i] = sp[(size_t)(32 * kt + (i & 3) + 8 * (i >> 2) + 4 * hh) * 128];
    } else {
#pragma unroll
      for (int kt = 0; kt < 4; ++kt)
#pragma unroll
        for (int i = 0; i < 16; ++i) S[kt][i] = 0.f;
#pragma unroll 1
      for (int j = 0; j < ch; ++j) {
        const int it1 = (s * 8 + h) * 3 + j;
        const float* sl = SLOC + (size_t)it1 * 16384 + 32 * w + l32 + (size_t)(4 * hh) * 128;
        const float* dl = DTOT + (size_t)it1 * 128 + 4 * hh;
#pragma unroll
        for (int kt = 0; kt < 4; ++kt) {
#pragma unroll
          for (int q = 0; q < 4; ++q) {
            const float* slq = sl + (size_t)(32 * kt + 8 * q) * 128;
            const f32x4 d4 = *(const f32x4*)(dl + 32 * kt + 8 * q);
#pragma unroll
            for (int c = 0; c < 4; ++c) S[kt][4 * q + c] = S[kt][4 * q + c] * d4[c] + slq[c * 128];
            __builtin_amdgcn_sched_barrier(0);
          }
        }
      }
    }
    const int nblk = T >> 4;
    u16 fr[8], qr[8], vr[8];
#define GLA_LOADRAW(BLK) { const size_t r0_ = (size_t)rowbase + (BLK) * 16; \
      const u16* pf_ = PROJ + (r0_ + 8 * th) * 4096 + 1024 + h * 128 + k; \
      const u16* pq_ = PROJ + (r0_ + 8 * th) * 4096 + h * 128 + k; \
      _Pragma("unroll") for (int t = 0; t < 8; ++t) fr[t] = pf_[(size_t)t * 4096]; \
      _Pragma("unroll") for (int j = 0; j < 8; ++j) qr[j] = pq_[(size_t)j * 4096]; \
 }
#define GLA_LOADV(BLK) { const u16* pv_ = PROJ + ((size_t)rowbase + (BLK) * 16) * 4096 + 2048 + h * 128 + 32 * w + l32; \
      _Pragma("unroll") for (int jj = 0; jj < 8; ++jj) vr[jj] = pv_[(size_t)(8 * (jj >> 2) + 4 * hh + (jj & 3)) * 4096]; }
#define GLA_LOADGS(BLK) { const u16* pg_ = PROJ + ((size_t)rowbase + (BLK) * 16 + m16) * 4096 + 3072 + h * 128 + 32 * w + 4 * hh; \
      _Pragma("unroll") for (int q = 0; q < 4; ++q) gsl[q] = *(const u32x2*)(pg_ + 8 * q); }
#define GLA_FINAL(BLK) { const float* RED_ = REDB + ((BLK) & 1) * 64; \
      if (l32 < 16) { \
        const float tot = RED_[l32] + RED_[16 + l32] + RED_[32 + l32] + RED_[48 + l32]; \
        const float rn = rsqrtf(tot * (1.f / 128.f) + EPS); \
        u16* op_ = p.OG + ((size_t)rowbase + (BLK) * 16 + l32) * 1024 + h * 128 + 32 * w + 4 * hh; \
        const float* gp_ = p.g_hg + layer * 1024 + h * 128 + 32 * w + 4 * hh; \
        _Pragma("unroll") for (int q = 0; q < 4; ++q) { const f32x4 gh = *(const f32x4*)(gp_ + 8 * q); \
          *(u32x2*)(op_ + 8 * q) = (u32x2){pk2(oacc[4 * q] * rn * gh[0] * bflo(gsl[q][0]), oacc[4 * q + 1] * rn * gh[1] * bfhi(gsl[q][0])), \
                                          pk2(oacc[4 * q + 2] * rn * gh[2] * bflo(gsl[q][1]), oacc[4 * q + 3] * rn * gh[3] * bfhi(gsl[q][1]))}; } \
      } }
    GLA_LOADRAW(0);
    u32x2 gsl[4];
    for (int blk = 0; blk < nblk; ++blk) {
      GLA_LOADGS(blk);
      GLA_LOADV(blk);
      char* sb = smem + (blk & 1) * 14336;
      u16* QT = (u16*)sb;
      u16* KT = QT + 16 * 136;
      u16* KDT = KT + 16 * 136;
      float* DD = (float*)(KDT + 128 * 20);
      {
        float qtm[8], ktm[8];
        float bs = 0.f;
#pragma unroll
        for (int t = 0; t < 8; ++t) {
          const float f = bf2f(fr[t]);
          const float g = lower + oml * sigm(f);
          bs += __logf(g);
          const float eb = __expf(bs);
          qtm[t] = bf2f(qr[t]) * eb;
          ktm[t] = (1.f - g) * __builtin_amdgcn_rcpf(eb);
        }
        const float other = __shfl_xor(bs, 1);
        const float boff = th ? other : 0.f;
        const float bsum = bs + other;
        const float E1 = __expf(boff), E1i = __expf(-boff), EL = __expf(bsum);
        unsigned kdp[4];
        float kdprev = 0.f;
#pragma unroll
        for (int j = 0; j < 8; ++j) {
          const int t = 8 * th + j;
          const float qt = qtm[j] * E1;
          const float ktv = ktm[j] * E1i;
          const float kd = ktv * EL;
          QT[t * 136 + k] = (u16)(pk2(qt, 0.f) & 0xffffu);
          KT[t * 136 + k] = (u16)(pk2(ktv, 0.f) & 0xffffu);
          if (j & 1) kdp[j >> 1] = pk2(kdprev, kd); else kdprev = kd;
        }
        *(u32x2*)(KDT + k * 20 + 8 * th) = (u32x2){kdp[0], kdp[1]};
        *(u32x2*)(KDT + k * 20 + 8 * th + 4) = (u32x2){kdp[2], kdp[3]};
        if (th == 0) DD[k] = __expf(bsum);
      }
      if (blk + 1 < nblk) GLA_LOADRAW(blk + 1);
      __syncthreads();
      const bf16x8 vfrag = mk8u((unsigned)vr[0] | ((unsigned)vr[1] << 16), (unsigned)vr[2] | ((unsigned)vr[3] << 16),
                                (unsigned)vr[4] | ((unsigned)vr[5] << 16), (unsigned)vr[6] | ((unsigned)vr[7] << 16));
      f32x16 aacc, oacc;
#pragma unroll
      for (int i = 0; i < 16; ++i) { aacc[i] = 0.f; oacc[i] = 0.f; }
#pragma unroll
      for (int ks = 0; ks < 8; ++ks) {
        const bf16x8 ka = *(const bf16x8*)(KT + m16 * 136 + 16 * ks + 8 * hh);
        const bf16x8 qb = *(const bf16x8*)(QT + m16 * 136 + 16 * ks + 8 * hh);
        aacc = __builtin_amdgcn_mfma_f32_32x32x16_bf16(ka, qb, aacc, 0, 0, 0);
        const int kt = ks >> 1, s2 = ks & 1;
        const bf16x8 sa = mk8u(pk2(S[kt][8 * s2], S[kt][8 * s2 + 1]), pk2(S[kt][8 * s2 + 2], S[kt][8 * s2 + 3]),
                               pk2(S[kt][8 * s2 + 4], S[kt][8 * s2 + 5]), pk2(S[kt][8 * s2 + 6], S[kt][8 * s2 + 7]));
        const u32x2 lo = *(const u32x2*)(QT + m16 * 136 + 32 * kt + 16 * s2 + 4 * hh);
        const u32x2 hi = *(const u32x2*)(QT + m16 * 136 + 32 * kt + 16 * s2 + 8 + 4 * hh);
        oacc = __builtin_amdgcn_mfma_f32_32x32x16_bf16(sa, mk8(lo, hi), oacc, 0, 0, 0);
      }
      float am[8];
#pragma unroll
      for (int i = 0; i < 8; ++i) { const int m = (i & 3) + 8 * (i >> 2) + 4 * hh; am[i] = (m <= m16) ? aacc[i] : 0.f; }
      const bf16x8 afrag = mk8u(pk2(am[0], am[1]), pk2(am[2], am[3]), pk2(am[4], am[5]), pk2(am[6], am[7]));
      oacc = __builtin_amdgcn_mfma_f32_32x32x16_bf16(vfrag, afrag, oacc, 0, 0, 0);
#pragma unroll
      for (int kt = 0; kt < 4; ++kt) {
#pragma unroll
        for (int q = 0; q < 4; ++q) {
          const f32x4 d4 = *(const f32x4*)(DD + 32 * kt + 8 * q + 4 * hh);
#pragma unroll
          for (int c = 0; c < 4; ++c) S[kt][4 * q + c] *= d4[c];
        }
        const u32x2 lo = *(const u32x2*)(KDT + (32 * kt + l32) * 20 + 4 * hh);
        const u32x2 hi = *(const u32x2*)(KDT + (32 * kt + l32) * 20 + 8 + 4 * hh);
        S[kt] = __builtin_amdgcn_mfma_f32_32x32x16_bf16(mk8(lo, hi), vfrag, S[kt], 0, 0, 0);
      }
      float ss = 0.f;
#pragma unroll
      for (int i = 0; i < 16; ++i) ss += oacc[i] * oacc[i];
      ss += __shfl_xor(ss, 32);
      if (l < 16) REDB[(blk & 1) * 64 + w * 16 + l] = ss;
      __syncthreads();
      GLA_FINAL(blk);
    }
#undef GLA_LOADGS
#undef GLA_LOADV
#undef GLA_LOADRAW
#undef GLA_FINAL
    if (smp || ch == 3) {
      float* op = (smp ? p.hgrn_sample + ((size_t)(layer * 8 + (s - 16)) * 8 + h) * 16384
                       : p.hgrn_prompt + ((size_t)(layer * 16 + s) * 8 + h) * 16384) + 32 * w + l32;
#pragma unroll
      for (int kt = 0; kt < 4; ++kt)
#pragma unroll
        for (int i = 0; i < 16; ++i) op[(size_t)(32 * kt + (i & 3) + 8 * (i >> 2) + 4 * hh) * 128] = S[kt][i];
    }
  }
}

DI void kvconv_phase(const P& p) {
  const int tid = ltid();
  char* KVT = p.BIG + (size_t)ROWS * 1024 * 2;
  for (int t = lbid(); t < 4096 + 1088; t += gridDim.x) {
    const float *kb, *vb; int nvalid = 64;
    if (t < 4096) { const int kt = t & 31, sh = t >> 5, s = sh >> 3, h = sh & 7; const size_t off = ((size_t)(s * 2048 + 64 * kt)) * 1024 + h * 128; kb = p.k_prompt + off; vb = p.v_prompt + off; }
    else { const int u = t - 4096; const int kt = u % 17, sh = u / 17, b = sh >> 3, h = sh & 7;
      if (kt < 16) { const size_t off = ((size_t)(b * 1024 + 64 * kt)) * 1024 + h * 128; kb = p.cache_k + off; vb = p.cache_v + off; }
      else { const size_t off = ((size_t)(b * 32)) * 1024 + h * 128; kb = p.k_sample + off; vb = p.v_sample + off; nvalid = 32; } }
    u16* kd = (u16*)(KVT + (size_t)t * 32768);
    u16* vd = kd + 8192;
#pragma unroll
    for (int pp = 0; pp < 4; ++pp) {
      const int key = 16 * pp + (tid >> 4), d8 = (tid & 15) * 8;
      f32x4 a = {0.f, 0.f, 0.f, 0.f}, b2 = {0.f, 0.f, 0.f, 0.f};
      if (key < nvalid) { a = *(const f32x4*)(kb + (size_t)key * 1024 + d8); b2 = *(const f32x4*)(kb + (size_t)key * 1024 + d8 + 4); }
      *(u32x4*)(kd + key * 128 + d8) = (u32x4){pk2(a[0], a[1]), pk2(a[2], a[3]), pk2(b2[0], b2[1]), pk2(b2[2], b2[3])};
    }
#pragma unroll
    for (int c = 0; c < 4; ++c) {
      const int v = tid & 127, cc = 4 * (tid >> 7) + c;
      float e[8];
#pragma unroll
      for (int j = 0; j < 8; ++j) { const int key = 8 * cc + j; e[j] = key < nvalid ? vb[(size_t)key * 1024 + v] : 0.f; }
      *(u32x4*)(vd + v * 64 + 8 * cc) = (u32x4){pk2(e[0], e[1]), pk2(e[2], e[3]), pk2(e[4], e[5]), pk2(e[6], e[7])};
    }
  }
}

DI void attn_phase(const P& p, int layer, char* smem) {
  const int jl = layer - 2;
  const u16* Q = (const u16*)p.BIG;
  const char* KVT = p.BIG + (size_t)ROWS * 1024 * 2;
  const int tid = ltid(), l = tid & 63, w = tid >> 6, l16 = l & 15, g = l >> 4;
  u16* KS = (u16*)smem;
  u16* VT = KS + 64 * 136;
  float* BT = (float*)(VT + 128 * 72);
  u16* QS = (u16*)(BT + 256);
  const float lam_init = 0.8f - 0.6f * __expf(-0.3f * (float)layer);
  float lam;
  {
    const float* lp = p.lam_b + jl * 256;
    float a = 0.f, b = 0.f;
    for (int d = 0; d < 64; ++d) { a += lp[d] * lp[64 + d]; b += lp[128 + d] * lp[192 + d]; }
    lam = __expf(a) - __expf(b) + lam_init;
  }
  const int bidA = lbid(), GA = gridDim.x;
  for (int kk = 0; kk * GA < 4096 + 64; ++kk) {
    const int item = ((kk & 1) ? (GA - 1 - bidA) : bidA) + kk * GA;
    if (item >= 4096 + 64) continue;
    int b, h, nq, qrow0, qpos0, ntiles, tile0; bool smp;
    if (item < 4096) { const int jq = 31 - (item >> 7); const int bh = item & 127; b = bh >> 3; h = bh & 7; smp = false; nq = 64; qrow0 = b * 2048 + 64 * jq; qpos0 = 64 * jq; ntiles = jq + 1; tile0 = bh * 32; }
    else { const int si = item - 4096; b = si >> 3; h = si & 7; smp = true; nq = 32; qrow0 = ROWS_P + b * 32; qpos0 = 1024; ntiles = 17; tile0 = 4096 + si * 17; }
    __syncthreads();
    if (tid < 230) {
      const int rel = tid - 166;
      const int n = rel < 0 ? -rel : rel;
      int bk = n < 8 ? n : 8 + (n >= 13) + (n >= 20) + (n >= 30) + (n >= 46) + (n >= 70) + (n >= 108) + (n >= 166);
      if (rel > 0) bk += 16;
      BT[tid] = p.rel_bias[bk * 8 + h] * LOG2E;
    }
#pragma unroll
    for (int pp = 0; pp < 4; ++pp) {
      const int idx = pp * 256 + tid, r = idx >> 4, c16 = idx & 15;
      *(u32x4*)(QS + r * 136 + c16 * 8) = *(const u32x4*)(Q + (size_t)(qrow0 + min(r, nq - 1)) * 1024 + h * 128 + c16 * 8);
    }
    f32x4 oacc[2][8];
#pragma unroll
    for (int c = 0; c < 2; ++c)
#pragma unroll
      for (int vs = 0; vs < 8; ++vs) oacc[c][vs] = (f32x4){0.f, 0.f, 0.f, 0.f};
    float mrun[2] = {-1e30f, -1e30f}, lsum[2] = {0.f, 0.f};
    const int qpos = qpos0 + min(16 * w + l16, nq - 1);
    u32x4 rk[4], rv[4];
    {
      const u32x4* src = (const u32x4*)(KVT + (size_t)tile0 * 32768);
#pragma unroll
      for (int pp = 0; pp < 4; ++pp) { rk[pp] = src[pp * 256 + tid]; rv[pp] = src[1024 + pp * 256 + tid]; }
    }
    for (int kt = 0; kt < ntiles; ++kt) {
      const int nvalid = (smp && kt == 16) ? 32 : 64;
      if (kt > 0) __syncthreads();
#pragma unroll
      for (int pp = 0; pp < 4; ++pp) {
        const int idx = pp * 256 + tid;
        *(u32x4*)(KS + (idx >> 4) * 136 + (idx & 15) * 8) = rk[pp];
        *(u32x4*)(VT + (idx >> 3) * 72 + (idx & 7) * 8) = rv[pp];
      }
      if (kt + 1 < ntiles) {
        const u32x4* src = (const u32x4*)(KVT + (size_t)(tile0 + kt + 1) * 32768);
#pragma unroll
        for (int pp = 0; pp < 4; ++pp) { rk[pp] = src[pp * 256 + tid]; rv[pp] = src[1024 + pp * 256 + tid]; }
      }
      __syncthreads();
      f32x4 sacc[2][4];
#pragma unroll
      for (int c = 0; c < 2; ++c)
#pragma unroll
        for (int sub = 0; sub < 4; ++sub) {
          sacc[c][sub] = (f32x4){0.f, 0.f, 0.f, 0.f};
#pragma unroll
          for (int ks = 0; ks < 2; ++ks) {
            const bf16x8 kf = *(const bf16x8*)(KS + (16 * sub + l16) * 136 + c * 64 + 32 * ks + 8 * g);
            const bf16x8 qfr = *(const bf16x8*)(QS + (16 * w + l16) * 136 + c * 64 + 32 * ks + 8 * g);
            sacc[c][sub] = __builtin_amdgcn_mfma_f32_16x16x32_bf16(kf, qfr, sacc[c][sub], 0, 0, 0);
          }
        }
#pragma unroll
      for (int sub = 0; sub < 4; ++sub)
#pragma unroll
        for (int i = 0; i < 4; ++i) {
          const int kl = 16 * sub + 4 * g + i;
          int rel = 64 * kt + kl - qpos;
          rel = rel < -166 ? -166 : rel;
          const float bt = BT[rel + 166];
          const bool ok = kl < nvalid;
          sacc[0][sub][i] = ok ? sacc[0][sub][i] + bt : -30000.f;
          sacc[1][sub][i] = ok ? sacc[1][sub][i] + bt : -30000.f;
        }
      bf16x8 pf[2][2];
#pragma unroll
      for (int c = 0; c < 2; ++c) {
        float mx = -1e30f;
#pragma unroll
        for (int sub = 0; sub < 4; ++sub)
#pragma unroll
          for (int i = 0; i < 4; ++i) mx = fmaxf(mx, sacc[c][sub][i]);
        mx = fmaxf(mx, __shfl_xor(mx, 16));
        mx = fmaxf(mx, __shfl_xor(mx, 32));
        const float mnew = fmaxf(mrun[c], mx);
        const float alpha = __builtin_amdgcn_exp2f(mrun[c] - mnew);
        mrun[c] = mnew;
        float rs = 0.f;
#pragma unroll
        for (int sub = 0; sub < 4; ++sub)
#pragma unroll
          for (int i = 0; i < 4; ++i) { const float e = __builtin_amdgcn_exp2f(sacc[c][sub][i] - mnew); sacc[c][sub][i] = e; rs += e; }
        lsum[c] = lsum[c] * alpha + rs;
#pragma unroll
        for (int vs = 0; vs < 8; ++vs) oacc[c][vs] *= alpha;
#pragma unroll
        for (int j = 0; j < 2; ++j)
          pf[c][j] = mk8u(pk2(sacc[c][2 * j][0], sacc[c][2 * j][1]), pk2(sacc[c][2 * j][2], sacc[c][2 * j][3]),
                          pk2(sacc[c][2 * j + 1][0], sacc[c][2 * j + 1][1]), pk2(sacc[c][2 * j + 1][2], sacc[c][2 * j + 1][3]));
      }
#pragma unroll
      for (int j = 0; j < 2; ++j)
#pragma unroll
        for (int vs = 0; vs < 8; ++vs) {
          const u32x2 lo = *(const u32x2*)(VT + (16 * vs + l16) * 72 + 32 * j + 4 * g);
          const u32x2 hi = *(const u32x2*)(VT + (16 * vs + l16) * 72 + 32 * j + 16 + 4 * g);
          const bf16x8 vf = mk8(lo, hi);
          oacc[0][vs] = __builtin_amdgcn_mfma_f32_16x16x32_bf16(vf, pf[0][j], oacc[0][vs], 0, 0, 0);
          oacc[1][vs] = __builtin_amdgcn_mfma_f32_16x16x32_bf16(vf, pf[1][j], oacc[1][vs], 0, 0, 0);
        }
    }
#pragma unroll
    for (int c = 0; c < 2; ++c) { lsum[c] += __shfl_xor(lsum[c], 16); lsum[c] += __shfl_xor(lsum[c], 32); }
    const float inv0 = 1.f / lsum[0], inv1 = lam / lsum[1];
    float ss = 0.f;
#pragma unroll
    for (int vs = 0; vs < 8; ++vs)
#pragma unroll
      for (int i = 0; i < 4; ++i) { const float o = oacc[0][vs][i] * inv0 - oacc[1][vs][i] * inv1; oacc[0][vs][i] = o; ss += o * o; }
    ss += __shfl_xor(ss, 16);
    ss += __shfl_xor(ss, 32);
    const float rn = rsqrtf(ss * (1.f / 128.f) + EPS) * (1.f - lam_init);
    if (16 * w + l16 < nq) {
      const size_t row = (size_t)qrow0 + 16 * w + l16;
#pragma unroll
      for (int vs = 0; vs < 8; ++vs) {
        const int v = h * 128 + 16 * vs + 4 * g;
        const f32x4 gl = *(const f32x4*)(p.g_subln + jl * 1024 + v);
        *(u32x2*)(p.OG + row * 1024 + v) = (u32x2){pk2(oacc[0][vs][0] * rn * gl[0], oacc[0][vs][1] * rn * gl[1]),
                                                   pk2(oacc[0][vs][2] * rn * gl[2], oacc[0][vs][3] * rn * gl[3])};
      }
    }
  }
}

DI void gbar(unsigned* bar, unsigned& gen) {
  gen += 1;
  asm volatile("" : "+s"(bar));
  const unsigned tix = (unsigned)ltid();
  asm volatile("s_waitcnt vmcnt(0) lgkmcnt(0)" ::: "memory");
  __syncthreads();
  if (tix < 64) {
    const unsigned g = lbid() >> 4, ng = gridDim.x >> 4;
    bool last = false;
    if (tix == 0) {
      __builtin_amdgcn_fence(__ATOMIC_RELEASE, "agent");
      asm volatile("s_waitcnt vmcnt(0)" ::: "memory");
      const unsigned o = __hip_atomic_fetch_add(bar + 64 * g, 1u, __ATOMIC_RELAXED, __HIP_MEMORY_SCOPE_AGENT);
      if (o + 1 == 16 * gen) {
        const unsigned o2 = __hip_atomic_fetch_add(bar + 64 * 64, 1u, __ATOMIC_RELAXED, __HIP_MEMORY_SCOPE_AGENT);
        last = (o2 + 1 == ng * gen);
      }
    }
    last = __shfl(last ? 1 : 0, 0) != 0;
    if (last && tix < ng) __hip_atomic_store(bar + 64 * (65 + tix), gen, __ATOMIC_RELAXED, __HIP_MEMORY_SCOPE_AGENT);
    if (tix == 0) {
      while (__hip_atomic_load(bar + 64 * (65 + g), __ATOMIC_RELAXED, __HIP_MEMORY_SCOPE_AGENT) < gen) __builtin_amdgcn_s_sleep(2);
      __builtin_amdgcn_fence(__ATOMIC_ACQUIRE, "agent");
      asm volatile("s_waitcnt vmcnt(0)" ::: "memory");
    }
  }
  __syncthreads();
}

__global__ void __launch_bounds__(256, 2) yoco_megakernel(P p) {
  __shared__ __attribute__((aligned(16))) char smem[65536];
  cg::grid_group grid = cg::this_grid();
  if (blockIdx.x == 0 && threadIdx.x < 130) __hip_atomic_store(p.bar + 64 * threadIdx.x, 0u, __ATOMIC_RELAXED, __HIP_MEMORY_SCOPE_AGENT);
  prep_phase(p, smem);
  grid.sync();
  unsigned btarget = 0;
  u16* Mbuf = (u16*)p.BIG;
  u16* Fbuf = (u16*)(p.BIG + ((size_t)180 << 20));
  u16* PB = (u16*)p.BIG;
  u16* XRA = (u16*)p.y;
  u16* XRB = p.XB;
  for (int i = 0; i < 4; ++i) {
    const float* gn = p.g_norms + i * 4 * D;
    u16* cur = (i & 1) ? XRB : XRA;
    u16* nxt = (i == 3) ? nullptr : ((i & 1) ? XRA : XRB);
    if (i == 0) {
      rowop_phase(p, true, nullptr, nullptr, gn, p.XB, nullptr, nullptr, nullptr);
      gbar(p.bar, btarget);
    }
    if (i < 2) {
      REPG gemm_phase<0>(p, i ? cur : p.XB, 1024, p.wt_in_a + (size_t)i * 4096 * 1024, 4096, p.BIG, smem, i ? p.ss : nullptr);
      gbar(p.bar, btarget);
      gla_state_phase(p, i, smem);
      gbar(p.bar, btarget);
      for (int _r = 0; _r < REP_GLA; ++_r) gla_phase(p, i, smem);
      gbar(p.bar, btarget);
      REPG gemm_phase<2>(p, p.OG, 1024, p.wt_out_a + (size_t)i * 1024 * 1024, 1024, Mbuf, smem);
      gbar(p.bar, btarget);
    } else {
      if (i == 2) gemm_phase<3>(p, cur, 1024, p.wt_kv, 2048, nullptr, smem, p.ss);
      REPG gemm_phase<1>(p, cur, 1024, p.wt_q + (size_t)(i - 2) * 1024 * 1024, 1024, p.BIG, smem, p.ss);
      if (i == 2) gbar(p.bar, btarget);
      kvconv_phase(p);
      gbar(p.bar, btarget);
      for (int _r = 0; _r < REP_ATTN; ++_r) attn_phase(p, i, smem);
      gbar(p.bar, btarget);
      REPG gemm_phase<2>(p, p.OG, 1024, p.wt_out_b + (size_t)(i - 2) * 1024 * 1024, 1024, Mbuf, smem);
      gbar(p.bar, btarget);
    }
    rowop2_phase(p, i == 0, cur, Mbuf, gn + D, p.ss2, nullptr, nullptr, nullptr);
    gbar(p.bar, btarget);
    REPG ffn_in_phase(p, i, cur, smem);
    gbar(p.bar, btarget);
    REPG gemm_phase<2>(p, (const u16*)p.BIG, DFF, p.wt_ffn_out + (size_t)i * 1024 * DFF, 1024, Fbuf, smem);
    gbar(p.bar, btarget);
    rowop2_phase(p, false, cur, Fbuf, gn + 3 * D, nullptr, p.p_prompt + (size_t)i * ROWS_P * 256, p.p_sample + (size_t)i * 256 * 256, PB);
    gbar(p.bar, btarget);
    ple_phase(p, i, cur, nxt, smem);
    gbar(p.bar, btarget);
  }
}

extern "C" void kernel_launch(void* const* d_in, const int* in_sizes, int n_in, void* d_out, int out_size, void* d_ws,
                              size_t ws_size, hipStream_t stream) {
  static int grid_blocks = 0;
  if (!grid_blocks) {
    int dev = 0, cus = 0, per_cu = 0;
    hipGetDevice(&dev);
    hipDeviceGetAttribute(&cus, hipDeviceAttributeMultiprocessorCount, dev);
    hipOccupancyMaxActiveBlocksPerMultiprocessor(&per_cu, yoco_megakernel, 256, 0);
    if (per_cu > 2) per_cu = 2;
    grid_blocks = cus * per_cu;
    grid_blocks &= ~7;
  }
  P p{};
  const float* const* in = (const float* const*)d_in;
  p.x_prompt = in[0]; p.x_sample = in[1]; p.cache_k = in[2]; p.cache_v = in[3]; p.state_hgrn = in[4]; p.state_conv = in[5];
  p.p_prompt = in[6]; p.p_sample = in[7];
  p.g_norms = in[8]; const float* w_in_a = in[9]; p.lb_raw = in[10]; p.g_hg = in[11]; const float* w_out_a = in[12]; p.g_kv = in[13];
  const float* w_kv = in[14]; p.rel_bias = in[15]; const float* w_q_b = in[16]; p.lam_b = in[17]; p.g_subln = in[18];
  const float* w_out_b = in[19]; const float* w_ffn_in = in[20]; p.conv_w = in[21]; p.conv_b = in[22]; const float* w_ffn_out = in[23];
  const float* w_ple = in[24]; const float* w_ple_gate = in[25];
  float* o = (float*)d_out;
  p.y = o; o += (size_t)ROWS * D;
  p.k_prompt = o; o += (size_t)ROWS_P * D;
  p.v_prompt = o; o += (size_t)ROWS_P * D;
  p.k_sample = o; o += (size_t)256 * D;
  p.v_sample = o; o += (size_t)256 * D;
  p.hgrn_prompt = o; o += (size_t)2 * 16 * 8 * 16384;
  p.hgrn_sample = o; o += (size_t)2 * 8 * 8 * 16384;
  p.conv_prompt = o; o += (size_t)4 * 16 * 2 * DFF;
  p.conv_sample = o;
  u16* ws = (u16*)d_ws;
  p.wt_in_a = ws; ws += (size_t)2 * 4096 * 1024;
  p.wt_out_a = ws; ws += (size_t)2 * 1024 * 1024;
  p.wt_kv = ws; ws += (size_t)2048 * 1024;
  p.wt_q = ws; ws += (size_t)2 * 1024 * 1024;
  p.wt_out_b = ws; ws += (size_t)2 * 1024 * 1024;
  p.wt_ffn_in = ws; ws += (size_t)4 * 5632 * 1024;
  p.wt_ffn_out = ws; ws += (size_t)4 * 1024 * DFF;
  p.wt_ple = ws; ws += (size_t)4 * 1024 * 256;
  p.wt_gate = ws; ws += (size_t)4 * 1024 * 1024;
  p.XB = ws; ws += (size_t)ROWS * 1024;
  p.OG = ws; ws += (size_t)ROWS * 1024;
  p.BIG = (char*)ws;
  p.bar = (unsigned*)((char*)d_ws + ((size_t)500 << 20));
  p.ss = (float*)((char*)d_ws + ((size_t)501 << 20));
  p.ss2 = (float*)((char*)d_ws + ((size_t)504 << 20));
  int n = 0;
  for (int i = 0; i < 2; ++i) p.wd[n++] = WD{w_in_a + (size_t)i * 1024 * 4096, p.wt_in_a + (size_t)i * 4096 * 1024, i ? p.g_norms + 4 * D : nullptr, 1024, 4096, 0, 0};
  for (int i = 0; i < 2; ++i) p.wd[n++] = WD{w_out_a + (size_t)i * 1024 * 1024, p.wt_out_a + (size_t)i * 1024 * 1024, nullptr, 1024, 1024, 0, 0};
  p.wd[n++] = WD{w_kv, p.wt_kv, p.g_kv, 1024, 2048, 0, 0};
  for (int i = 0; i < 2; ++i) p.wd[n++] = WD{w_q_b + (size_t)i * 1024 * 1024, p.wt_q + (size_t)i * 1024 * 1024, p.g_norms + (size_t)(i + 2) * 4 * D, 1024, 1024, 0, 0};
  for (int i = 0; i < 2; ++i) p.wd[n++] = WD{w_out_b + (size_t)i * 1024 * 1024, p.wt_out_b + (size_t)i * 1024 * 1024, nullptr, 1024, 1024, 0, 0};
  for (int i = 0; i < 4; ++i) p.wd[n++] = WD{w_ffn_in + (size_t)i * 1024 * 5632, p.wt_ffn_in + (size_t)i * 5632 * 1024, p.g_norms + (size_t)(i * 4 + 2) * D, 1024, 5632, 1, 0};
  for (int i = 0; i < 4; ++i) p.wd[n++] = WD{w_ffn_out + (size_t)i * DFF * 1024, p.wt_ffn_out + (size_t)i * 1024 * DFF, nullptr, DFF, 1024, 0, 0};
  for (int i = 0; i < 4; ++i) p.wd[n++] = WD{w_ple + (size_t)i * 256 * 1024, p.wt_ple + (size_t)i * 1024 * 256, nullptr, 256, 1024, 0, 0};
  for (int i = 0; i < 4; ++i) p.wd[n++] = WD{w_ple_gate + (size_t)i * 1024 * 1024, p.wt_gate + (size_t)i * 1024 * 1024, nullptr, 1024, 1024, 0, 0};
  void* args[] = {&p};
  hipError_t e = hipLaunchCooperativeKernel((void*)yoco_megakernel, dim3(grid_blocks), dim3(256), args, 0, stream);
  if (e != hipSuccess) fprintf(stderr, "cooperative launch failed: %s (grid %d)\n", hipGetErrorString(e), grid_blocks);
}
```

```cpp
#include <hip/hip_runtime.h>
#include <hip/hip_cooperative_groups.h>
#include <cstdio>
namespace cg = cooperative_groups;

#define DI __device__ __forceinline__
typedef unsigned short u16;
typedef short bf16x8 __attribute__((ext_vector_type(8)));
typedef float f32x16 __attribute__((ext_vector_type(16)));
typedef float f32x4 __attribute__((ext_vector_type(4)));
typedef __bf16 bf2_t __attribute__((ext_vector_type(2)));
typedef float f2_t __attribute__((ext_vector_type(2)));
typedef unsigned u32x2 __attribute__((ext_vector_type(2)));
typedef unsigned u32x4 __attribute__((ext_vector_type(4)));

constexpr int D = 1024, ROWS_P = 32768, ROWS = 33024, DFF = 2816;
constexpr float EPS = 1e-6f;
constexpr float LOG2E = 1.4426950408889634f;
constexpr int NW = 25;
#ifndef REP_GEMM
#define REP_GEMM 1
#endif
#ifndef REP_GLA
#define REP_GLA 1
#endif
#ifndef REP_ATTN
#define REP_ATTN 1
#endif
#define REPG for (int _r = 0; _r < REP_GEMM; ++_r)

struct WD { const float* src; u16* dst; const float* gain; int K, N, mode, pad; };

struct P {
  const float *x_prompt, *x_sample, *cache_k, *cache_v, *state_hgrn, *state_conv, *p_prompt, *p_sample;
  const float *g_norms, *lb_raw, *g_hg, *g_kv, *rel_bias, *lam_b, *g_subln, *conv_w, *conv_b;
  float *y, *k_prompt, *v_prompt, *k_sample, *v_sample, *hgrn_prompt, *hgrn_sample, *conv_prompt, *conv_sample;
  u16 *wt_in_a, *wt_out_a, *wt_kv, *wt_q, *wt_out_b, *wt_ffn_in, *wt_ffn_out, *wt_ple, *wt_gate;
  u16 *XB, *OG; char* BIG; unsigned* bar; float* ss; float* ss2;
  WD wd[NW];
};

DI unsigned pk2(float a, float b) { f2_t v = {a, b}; bf2_t r = __builtin_convertvector(v, bf2_t); return __builtin_bit_cast(unsigned, r); }
DI int lbid() { int b = blockIdx.x; asm volatile("" : "+s"(b)); return b; }
DI int ltid() { int t = threadIdx.x; asm volatile("" : "+v"(t)); return t; }
DI float bf2f(u16 x) { return __uint_as_float(((unsigned)x) << 16); }
DI float bflo(unsigned x) { return __uint_as_float(x << 16); }
DI float bfhi(unsigned x) { return __uint_as_float(x & 0xffff0000u); }
DI float sigm(float x) { return 1.f / (1.f + __expf(-x)); }
DI float wave_sum(float v) {
#pragma unroll
  for (int o = 32; o; o >>= 1) v += __shfl_xor(v, o);
  return v;
}
DI bf16x8 mk8(u32x2 lo, u32x2 hi) { u32x4 t = {lo[0], lo[1], hi[0], hi[1]}; return __builtin_bit_cast(bf16x8, t); }
DI bf16x8 mk8u(unsigned a, unsigned b, unsigned c, unsigned d) { u32x4 t = {a, b, c, d}; return __builtin_bit_cast(bf16x8, t); }

DI void prep_tile_info(const P& p, int flat, int& wi, int& k0, int& n0) {
  int base = 0; wi = 0;
  for (;;) { int nt = (p.wd[wi].K >> 6) * (p.wd[wi].N >> 6); if (flat < base + nt) break; base += nt; ++wi; }
  const int tix = flat - base, ntn = p.wd[wi].N >> 6;
  k0 = (tix / ntn) << 6; n0 = (tix % ntn) << 6;
}
DI void prep_phase(const P& p, char* smem) {
  float* T = (float*)smem;
  const int tid = ltid();
  int total = 0;
  for (int i = 0; i < NW; ++i) total += (p.wd[i].K >> 6) * (p.wd[i].N >> 6);
  const int n = tid & 63, kb = tid >> 6;
  float v[16];
  int flat = lbid();
  int wi = 0, k0 = 0, n0 = 0;
  if (flat < total) {
    prep_tile_info(p, flat, wi, k0, n0);
    const WD& d = p.wd[wi];
#pragma unroll
    for (int j = 0; j < 16; ++j) { const int kk = kb + 4 * j; v[j] = d.src[(size_t)(k0 + kk) * d.N + n0 + n]; if (d.gain) v[j] *= d.gain[k0 + kk]; }
  }
  for (; flat < total; flat += gridDim.x) {
    const WD& d = p.wd[wi];
    const int ck0 = k0, cn0 = n0;
#pragma unroll
    for (int j = 0; j < 16; ++j) T[(kb + 4 * j) * 65 + n] = v[j];
    const int nf = flat + gridDim.x;
    if (nf < total) {
      prep_tile_info(p, nf, wi, k0, n0);
      const WD& d2 = p.wd[wi];
#pragma unroll
      for (int j = 0; j < 16; ++j) { const int kk = kb + 4 * j; v[j] = d2.src[(size_t)(k0 + kk) * d2.N + n0 + n]; if (d2.gain) v[j] *= d2.gain[k0 + kk]; }
    }
    __syncthreads();
    {
      const int nn = tid >> 2, ks = tid & 3;
      int nc = cn0 + nn, drow = nc;
      if (d.mode == 1) { int isu = nc >= DFF; int ch = nc - DFF * isu; drow = 256 * (ch >> 7) + 64 * ((ch >> 5) & 3) + 32 * isu + (ch & 31); }
      unsigned o[8];
#pragma unroll
      for (int j = 0; j < 8; ++j) o[j] = pk2(T[(16 * ks + 2 * j) * 65 + nn], T[(16 * ks + 2 * j + 1) * 65 + nn]);
      u16* fb = d.dst + (((size_t)(drow >> 5) * (d.K >> 4) + ((ck0 >> 4) + ks)) * 64 + (drow & 31)) * 8;
      *(u32x4*)(fb) = (u32x4){o[0], o[1], o[2], o[3]};
      *(u32x4*)(fb + 256) = (u32x4){o[4], o[5], o[6], o[7]};
    }
    __syncthreads();
  }
}

DI void rowop_phase(const P& p, bool x_from_in, const u16* __restrict__ Madd, const float* __restrict__ gpost,
                    const float* __restrict__ gnext, u16* __restrict__ outH, const float* ple_p, const float* ple_s, u16* outP) {
  const int tidr = ltid();
  const int lane = tidr & 63;
  const int wave = (lbid() * blockDim.x + tidr) >> 6;
  const int nwave = (gridDim.x * blockDim.x) >> 6;
  for (int rb = wave * 2; rb < ROWS; rb += nwave * 2) {
    f32x4 x[2][4];
    u32x2 m[2][4];
#pragma unroll
    for (int u = 0; u < 2; ++u) {
      const int r = rb + u;
      const float* xs = x_from_in ? (r < ROWS_P ? p.x_prompt + (size_t)r * D : p.x_sample + (size_t)(r - ROWS_P) * D) : p.y + (size_t)r * D;
#pragma unroll
      for (int j = 0; j < 4; ++j) x[u][j] = *(const f32x4*)(xs + 4 * lane + 256 * j);
      if (Madd) {
#pragma unroll
        for (int j = 0; j < 4; ++j) m[u][j] = *(const u32x2*)(Madd + (size_t)r * D + 4 * lane + 256 * j);
      }
    }
#pragma unroll
    for (int u = 0; u < 2; ++u) {
      const int r = rb + u;
      if (Madd) {
        f32x4 mf[4]; float ss = 0.f;
#pragma unroll
        for (int j = 0; j < 4; ++j) { mf[j] = (f32x4){bflo(m[u][j][0]), bfhi(m[u][j][0]), bflo(m[u][j][1]), bfhi(m[u][j][1])}; ss += mf[j][0] * mf[j][0] + mf[j][1] * mf[j][1] + mf[j][2] * mf[j][2] + mf[j][3] * mf[j][3]; }
        ss = wave_sum(ss);
        const float rs = rsqrtf(ss * (1.f / D) + EPS);
#pragma unroll
        for (int j = 0; j < 4; ++j) { f32x4 g = *(const f32x4*)(gpost + 4 * lane + 256 * j); x[u][j] += mf[j] * rs * g; }
#pragma unroll
        for (int j = 0; j < 4; ++j) *(f32x4*)(p.y + (size_t)r * D + 4 * lane + 256 * j) = x[u][j];
      }
      float rx = 1.f;
      if (gnext) {
        float ss = 0.f;
#pragma unroll
        for (int j = 0; j < 4; ++j) ss += x[u][j][0] * x[u][j][0] + x[u][j][1] * x[u][j][1] + x[u][j][2] * x[u][j][2] + x[u][j][3] * x[u][j][3];
        ss = wave_sum(ss);
        rx = rsqrtf(ss * (1.f / D) + EPS);
      }
#pragma unroll
      for (int j = 0; j < 4; ++j) {
        f32x4 h = x[u][j] * rx;
        if (gnext) h *= *(const f32x4*)(gnext + 4 * lane + 256 * j);
        *(u32x2*)(outH + (size_t)r * D + 4 * lane + 256 * j) = (u32x2){pk2(h[0], h[1]), pk2(h[2], h[3])};
      }
      if (outP) {
        const float* ps = r < ROWS_P ? ple_p + (size_t)r * 256 : ple_s + (size_t)(r - ROWS_P) * 256;
        f32x4 v = *(const f32x4*)(ps + 4 * lane);
        *(u32x2*)(outP + (size_t)r * 256 + 4 * lane) = (u32x2){pk2(v[0], v[1]), pk2(v[2], v[3])};
      }
    }
  }
}

DI void rowop2_phase(const P& p, bool x_from_in, u16* __restrict__ XR, const u16* __restrict__ Madd, const float* __restrict__ gpost,
                     float* __restrict__ ssout, const float* ple_p, const float* ple_s, u16* outP) {
  const int tidr = ltid();
  const int lane = tidr & 63;
  const int wave = (lbid() * blockDim.x + tidr) >> 6;
  const int nwave = (gridDim.x * blockDim.x) >> 6;
  for (int rb = wave * 2; rb < ROWS; rb += nwave * 2) {
    f32x4 x[2][4];
    u32x2 m[2][4];
#pragma unroll
    for (int u = 0; u < 2; ++u) {
      const int r = rb + u;
      if (x_from_in) {
        const float* xs = r < ROWS_P ? p.x_prompt + (size_t)r * D : p.x_sample + (size_t)(r - ROWS_P) * D;
#pragma unroll
        for (int j = 0; j < 4; ++j) x[u][j] = *(const f32x4*)(xs + 4 * lane + 256 * j);
      } else {
#pragma unroll
        for (int j = 0; j < 4; ++j) { const u32x2 t = *(const u32x2*)(XR + (size_t)r * D + 4 * lane + 256 * j); x[u][j] = (f32x4){bflo(t[0]), bfhi(t[0]), bflo(t[1]), bfhi(t[1])}; }
      }
#pragma unroll
      for (int j = 0; j < 4; ++j) m[u][j] = *(const u32x2*)(Madd + (size_t)r * D + 4 * lane + 256 * j);
    }
#pragma unroll
    for (int u = 0; u < 2; ++u) {
      const int r = rb + u;
      f32x4 mf[4]; float ss = 0.f;
#pragma unroll
      for (int j = 0; j < 4; ++j) { mf[j] = (f32x4){bflo(m[u][j][0]), bfhi(m[u][j][0]), bflo(m[u][j][1]), bfhi(m[u][j][1])}; ss += mf[j][0] * mf[j][0] + mf[j][1] * mf[j][1] + mf[j][2] * mf[j][2] + mf[j][3] * mf[j][3]; }
      ss = wave_sum(ss);
      const float rs = rsqrtf(ss * (1.f / D) + EPS);
      float sx = 0.f;
#pragma unroll
      for (int j = 0; j < 4; ++j) {
        const f32x4 g = *(const f32x4*)(gpost + 4 * lane + 256 * j);
        const f32x4 xn = x[u][j] + mf[j] * rs * g;
        const u32x2 o = (u32x2){pk2(xn[0], xn[1]), pk2(xn[2], xn[3])};
        *(u32x2*)(XR + (size_t)r * D + 4 * lane + 256 * j) = o;
        const float q0 = bflo(o[0]), q1 = bfhi(o[0]), q2 = bflo(o[1]), q3 = bfhi(o[1]);
        sx += q0 * q0 + q1 * q1 + q2 * q2 + q3 * q3;
      }
      if (ssout) { sx = wave_sum(sx); if (lane == 0) ssout[r] = sx; }
      if (outP) {
        const float* ps = r < ROWS_P ? ple_p + (size_t)r * 256 : ple_s + (size_t)(r - ROWS_P) * 256;
        f32x4 v = *(const f32x4*)(ps + 4 * lane);
        *(u32x2*)(outP + (size_t)r * 256 + 4 * lane) = (u32x2){pk2(v[0], v[1]), pk2(v[2], v[3])};
      }
    }
  }
}

template <class RowMap>
DI void gemm_core(const u16* __restrict__ A, int lda, RowMap rm, const u16* __restrict__ Bt, int n0, int K,
                  f32x16 (&acc)[4][2], char* smem, const int tid) {
  const int l = tid & 63, w = tid >> 6, l32 = l & 31, hh = l >> 5;
  const int lr = tid >> 3, lc = tid & 7;
  const u16* ap[4];
#pragma unroll
  for (int q = 0; q < 4; ++q) ap[q] = A + (size_t)rm(q * 32 + lr) * lda + lc * 8;
  const u16* bq0 = Bt + ((size_t)((n0 + w * 64) >> 5) * (K >> 4) * 64 + l) * 8;
  const u16* bq1 = bq0 + (size_t)(K >> 4) * 512;
  const unsigned woff = lr * 144 + lc * 16;
  const unsigned aoff = l32 * 144 + hh * 16;
  u32x4 ra0[4];
  bf16x8 bf0[4], bf1[4];
  const int nk = K >> 6;
#define GLOADA(RA, T) _Pragma("unroll") for (int q = 0; q < 4; ++q) { RA[q] = *(const u32x4*)(ap[q] + (T) * 64); }
#define SWRITEA(RA, BUF) { char* db_ = smem + (BUF) * 18432; _Pragma("unroll") for (int q = 0; q < 4; ++q) { *(u32x4*)(db_ + woff + q * 4608) = RA[q]; } }
#define COMPUTE(BUF, TN, MORE) { const char* sb = smem + (BUF) * 18432; _Pragma("unroll") for (int ks = 0; ks < 4; ++ks) { \
      const unsigned co = ks * 32; \
      bf16x8 a0 = *(const bf16x8*)(sb + aoff + co); \
      bf16x8 a1 = *(const bf16x8*)(sb + aoff + 4608 + co); \
      bf16x8 a2 = *(const bf16x8*)(sb + aoff + 9216 + co); \
      bf16x8 a3 = *(const bf16x8*)(sb + aoff + 13824 + co); \
      acc[0][0] = __builtin_amdgcn_mfma_f32_32x32x16_bf16(bf0[ks], a0, acc[0][0], 0, 0, 0); \
      acc[0][1] = __builtin_amdgcn_mfma_f32_32x32x16_bf16(bf1[ks], a0, acc[0][1], 0, 0, 0); \
      acc[1][0] = __builtin_amdgcn_mfma_f32_32x32x16_bf16(bf0[ks], a1, acc[1][0], 0, 0, 0); \
      acc[1][1] = __builtin_amdgcn_mfma_f32_32x32x16_bf16(bf1[ks], a1, acc[1][1], 0, 0, 0); \
      acc[2][0] = __builtin_amdgcn_mfma_f32_32x32x16_bf16(bf0[ks], a2, acc[2][0], 0, 0, 0); \
      acc[2][1] = __builtin_amdgcn_mfma_f32_32x32x16_bf16(bf1[ks], a2, acc[2][1], 0, 0, 0); \
      acc[3][0] = __builtin_amdgcn_mfma_f32_32x32x16_bf16(bf0[ks], a3, acc[3][0], 0, 0, 0); \
      acc[3][1] = __builtin_amdgcn_mfma_f32_32x32x16_bf16(bf1[ks], a3, acc[3][1], 0, 0, 0); \
      if (MORE) { bf0[ks] = *(const bf16x8*)(bq0 + ((TN) * 4 + ks) * 512); bf1[ks] = *(const bf16x8*)(bq1 + ((TN) * 4 + ks) * 512); } \
      __builtin_amdgcn_sched_barrier(0); } }
  GLOADA(ra0, 0);
#pragma unroll
  for (int ks = 0; ks < 4; ++ks) { bf0[ks] = *(const bf16x8*)(bq0 + ks * 512); bf1[ks] = *(const bf16x8*)(bq1 + ks * 512); }
  SWRITEA(ra0, 0);
  __syncthreads();
  for (int kt = 0; kt < nk; kt += 2) {
    GLOADA(ra0, kt + 1);
    __builtin_amdgcn_sched_barrier(0);
    COMPUTE(0, kt + 1, true);
    SWRITEA(ra0, 1);
    __syncthreads();
    if (kt + 2 < nk) GLOADA(ra0, kt + 2);
    __builtin_amdgcn_sched_barrier(0);
    COMPUTE(1, kt + 2, kt + 2 < nk);
    if (kt + 2 < nk) SWRITEA(ra0, 0);
    __syncthreads();
  }
#undef GLOADA
#undef SWRITEA
#undef COMPUTE
}

template <class RowMap>
DI void gemm_core_mini(const u16* __restrict__ A, int lda, RowMap rm, const u16* __restrict__ Bt, int n0, int K,
                       f32x16 (&acc)[2], char* smem, const int tid) {
  const int l = tid & 63, w = tid >> 6, l32 = l & 31, hh = l >> 5;
  const int lr = tid >> 3, lc = tid & 7;
  const u16* ap[4];
#pragma unroll
  for (int q = 0; q < 4; ++q) ap[q] = A + (size_t)rm(q * 32 + lr) * lda + lc * 8;
  const u16* bq0 = Bt + ((size_t)(n0 >> 5) * (K >> 4) * 64 + l) * 8;
  const u16* bq1 = bq0 + (size_t)(K >> 4) * 512;
  const unsigned woff = lr * 144 + lc * 16;
  const unsigned aoff = (w * 32 + l32) * 144 + hh * 16;
  u32x4 ra0[4];
  bf16x8 bf0[4], bf1[4];
  const int nk = K >> 6;
#define GLOADA(RA, T) _Pragma("unroll") for (int q = 0; q < 4; ++q) { RA[q] = *(const u32x4*)(ap[q] + (T) * 64); }
#define SWRITEA(RA, BUF) { char* db_ = smem + (BUF) * 18432; _Pragma("unroll") for (int q = 0; q < 4; ++q) { *(u32x4*)(db_ + woff + q * 4608) = RA[q]; } }
#define COMPUTE(BUF, TN, MORE) { const char* sb = smem + (BUF) * 18432; _Pragma("unroll") for (int ks = 0; ks < 4; ++ks) { \
      const unsigned co = ks * 32; \
      bf16x8 a0 = *(const bf16x8*)(sb + aoff + co); \
      acc[0] = __builtin_amdgcn_mfma_f32_32x32x16_bf16(bf0[ks], a0, acc[0], 0, 0, 0); \
      acc[1] = __builtin_amdgcn_mfma_f32_32x32x16_bf16(bf1[ks], a0, acc[1], 0, 0, 0); \
      if (MORE) { bf0[ks] = *(const bf16x8*)(bq0 + ((TN) * 4 + ks) * 512); bf1[ks] = *(const bf16x8*)(bq1 + ((TN) * 4 + ks) * 512); } \
      __builtin_amdgcn_sched_barrier(0); } }
  GLOADA(ra0, 0);
#pragma unroll
  for (int ks = 0; ks < 4; ++ks) { bf0[ks] = *(const bf16x8*)(bq0 + ks * 512); bf1[ks] = *(const bf16x8*)(bq1 + ks * 512); }
  SWRITEA(ra0, 0);
  __syncthreads();
  for (int kt = 0; kt < nk; kt += 2) {
    GLOADA(ra0, kt + 1);
    __builtin_amdgcn_sched_barrier(0);
    COMPUTE(0, kt + 1, true);
    SWRITEA(ra0, 1);
    __syncthreads();
    if (kt + 2 < nk) GLOADA(ra0, kt + 2);
    __builtin_amdgcn_sched_barrier(0);
    COMPUTE(1, kt + 2, kt + 2 < nk);
    if (kt + 2 < nk) SWRITEA(ra0, 0);
    __syncthreads();
  }
#undef GLOADA
#undef SWRITEA
#undef COMPUTE
}

DI bool next_tile(int it, int ntm, int ntn, int& tm, int& tn) {
  const int b = lbid(), x = b & 7, slot = b >> 3, S = gridDim.x >> 3;
  const int nq = (ntm - x + 7) >> 3;
  const int L = slot + it * S;
  if (L >= nq * ntn) return false;
  const int gsize = 8 * ntn;
  const int grp = L / gsize, r = L - grp * gsize;
  const int gsz = min(8, nq - 8 * grp);
  tn = r / gsz;
  tm = x + 8 * (8 * grp + r % gsz);
  return true;
}

DI void list_entry(int L, int ntm, int ntn, int& tm, int& tn) {
  const int x = lbid() & 7;
  const int nq = (ntm - x + 7) >> 3;
  const int gsize = 8 * ntn;
  const int grp = L / gsize, r = L - grp * gsize;
  const int gsz = min(8, nq - 8 * grp);
  tn = r / gsz;
  tm = x + 8 * (8 * grp + r % gsz);
}
DI void list_info(int ntm, int ntn, int& full, int& nleft) {
  const int x = lbid() & 7, S = gridDim.x >> 3;
  const int len = ((ntm - x + 7) >> 3) * ntn;
  full = (len / S) * S;
  nleft = len - full;
  if (4 * nleft > S) { full = len; nleft = 0; }
}

struct IdMap { int base; DI int operator()(int r) const { return base + r; } };
struct ClampMap { int rowbase, t0, T; DI int operator()(int r) const { int t = t0 + r; t = t < 0 ? 0 : (t > T - 1 ? T - 1 : t); return rowbase + t; } };
struct ClampMap2 { int rowbase, t0, T, srow; DI int operator()(int r) const { if (srow >= 0 && r >= 64) { int t = r - 66; t = t < 0 ? 0 : (t > 31 ? 31 : t); return srow + t; } int t = t0 + r; t = t < 0 ? 0 : (t > T - 1 ? T - 1 : t); return rowbase + t; } };

#define ZERO_ACC(a) _Pragma("unroll") for (int _i = 0; _i < 4; ++_i) _Pragma("unroll") for (int _j = 0; _j < 2; ++_j) _Pragma("unroll") for (int _e = 0; _e < 16; ++_e) a[_i][_j][_e] = 0.f;

DI float row_rs(const float* rowss, int m) {
  const f32x4* sp = (const f32x4*)(rowss + (size_t)m * 16); const f32x4 s0 = sp[0], s1 = sp[1], s2 = sp[2], s3 = sp[3];
  const float tot = ((s0[0] + s0[1]) + (s0[2] + s0[3])) + ((s1[0] + s1[1]) + (s1[2] + s1[3])) + ((s2[0] + s2[1]) + (s2[2] + s2[3])) + ((s3[0] + s3[1]) + (s3[2] + s3[3]));
  return rsqrtf(tot * (1.f / D) + EPS);
}
template <int EPI>
DI void epi4(const P& p, void* outp, int m, int n, float v0, float v1, float v2, float v3) {
  if (EPI == 0) {
    const int sec = n >> 10;
    if (sec == 0 || sec == 3) { v0 *= sigm(v0); v1 *= sigm(v1); v2 *= sigm(v2); v3 *= sigm(v3); }
    *(u32x2*)((u16*)outp + (size_t)m * 4096 + n) = (u32x2){pk2(v0, v1), pk2(v2, v3)};
  } else if (EPI == 1) {
    const float sc = 0.125f * LOG2E;
    *(u32x2*)((u16*)outp + (size_t)m * 1024 + n) = (u32x2){pk2(v0 * sc, v1 * sc), pk2(v2 * sc, v3 * sc)};
  } else if (EPI == 2) {
    *(u32x2*)((u16*)outp + (size_t)m * 1024 + n) = (u32x2){pk2(v0, v1), pk2(v2, v3)};
  } else {
    float* dst;
    if (n < 1024) dst = (m < ROWS_P ? p.k_prompt + (size_t)m * 1024 : p.k_sample + (size_t)(m - ROWS_P) * 1024) + n;
    else dst = (m < ROWS_P ? p.v_prompt + (size_t)m * 1024 : p.v_sample + (size_t)(m - ROWS_P) * 1024) + (n - 1024);
    *(f32x4*)dst = (f32x4){v0, v1, v2, v3};
  }
}
template <int EPI>
DI void gemm_phase(const P& p, const u16* A, int K, const u16* Bt, int N, void* outp, char* smem, const float* rowss = nullptr) {
  const int tid = ltid(), l = tid & 63, w = tid >> 6, l32 = l & 31, hh = l >> 5;
  const int ntm = ROWS / 128, ntn = N / 256;
  const int slot = lbid() >> 3, S = gridDim.x >> 3;
  int full, nleft, tm, tn;
  list_info(ntm, ntn, full, nleft);
  for (int L = slot; L < full; L += S) {
    list_entry(L, ntm, ntn, tm, tn);
    f32x16 acc[4][2];
    ZERO_ACC(acc);
    gemm_core(A, K, IdMap{tm * 128}, Bt, tn * 256, K, acc, smem, ltid());
#pragma unroll
    for (int mi = 0; mi < 4; ++mi) {
      const int m = tm * 128 + mi * 32 + l32;
      float rsc = 1.f;
      if (rowss) rsc = row_rs(rowss, m);
#pragma unroll
      for (int ni = 0; ni < 2; ++ni)
#pragma unroll
        for (int q = 0; q < 4; ++q)
          epi4<EPI>(p, outp, m, tn * 256 + w * 64 + ni * 32 + 8 * q + 4 * hh,
                    acc[mi][ni][4 * q] * rsc, acc[mi][ni][4 * q + 1] * rsc, acc[mi][ni][4 * q + 2] * rsc, acc[mi][ni][4 * q + 3] * rsc);
    }
  }
  if (slot < 4 * nleft) {
    list_entry(full + (slot >> 2), ntm, ntn, tm, tn);
    const int n0 = tn * 256 + (slot & 3) * 64;
    f32x16 acc[2];
#pragma unroll
    for (int e = 0; e < 16; ++e) { acc[0][e] = 0.f; acc[1][e] = 0.f; }
    gemm_core_mini(A, K, IdMap{tm * 128}, Bt, n0, K, acc, smem, ltid());
    const int m = tm * 128 + w * 32 + l32;
    float rsc = 1.f;
    if (rowss) rsc = row_rs(rowss, m);
#pragma unroll
    for (int ni = 0; ni < 2; ++ni)
#pragma unroll
      for (int q = 0; q < 4; ++q)
        epi4<EPI>(p, outp, m, n0 + ni * 32 + 8 * q + 4 * hh,
                  acc[ni][4 * q] * rsc, acc[ni][4 * q + 1] * rsc, acc[ni][4 * q + 2] * rsc, acc[ni][4 * q + 3] * rsc);
  }
}

DI void ple_epi(const P& p, const u16* PL, const u16* XIN, u16* XOUT, int m, int n, float a0, float a1, float a2, float a3, float& ssq) {
  const u32x2 xi = *(const u32x2*)(XIN + (size_t)m * D + n);
  f32x4 x = (f32x4){bflo(xi[0]), bfhi(xi[0]), bflo(xi[1]), bfhi(xi[1])};
  const u32x2 pv = *(const u32x2*)(PL + (size_t)m * D + n);
  x[0] += sigm(a0) * bflo(pv[0]);
  x[1] += sigm(a1) * bfhi(pv[0]);
  x[2] += sigm(a2) * bflo(pv[1]);
  x[3] += sigm(a3) * bfhi(pv[1]);
  if (XOUT) {
    const u32x2 o = (u32x2){pk2(x[0], x[1]), pk2(x[2], x[3])};
    *(u32x2*)(XOUT + (size_t)m * D + n) = o;
    const float q0 = bflo(o[0]), q1 = bfhi(o[0]), q2 = bflo(o[1]), q3 = bfhi(o[1]);
    ssq += q0 * q0 + q1 * q1 + q2 * q2 + q3 * q3;
  } else {
    *(f32x4*)(p.y + (size_t)m * D + n) = x;
  }
}
DI void ple_phase(const P& p, int layer, const u16* XIN, u16* XOUT, char* smem) {
  const int tid = ltid(), l = tid & 63, w = tid >> 6, l32 = l & 31, hh = l >> 5;
  const u16* XB2 = XIN;
  const u16* PB = (const u16*)p.BIG;
  u16* PL = (u16*)(p.BIG + ((size_t)32 << 20));
  const u16* Wg = p.wt_gate + (size_t)layer * 1024 * 1024;
  const u16* Wp = p.wt_ple + (size_t)layer * 1024 * 256;
  const int ntm = ROWS / 128, ntn = 4;
  const int slot = lbid() >> 3, S = gridDim.x >> 3;
  int full, nleft, tm, tn;
  list_info(ntm, ntn, full, nleft);
  for (int L = slot; L < full; L += S) {
    list_entry(L, ntm, ntn, tm, tn);
    f32x16 acc2[4][2];
    ZERO_ACC(acc2);
    gemm_core(PB, 256, IdMap{tm * 128}, Wp, tn * 256, 256, acc2, smem, ltid());
#pragma unroll
    for (int mi = 0; mi < 4; ++mi)
#pragma unroll
      for (int ni = 0; ni < 2; ++ni)
#pragma unroll
        for (int q = 0; q < 4; ++q)
          *(u32x2*)(PL + (size_t)(tm * 128 + mi * 32 + l32) * D + tn * 256 + w * 64 + ni * 32 + 8 * q + 4 * hh) =
              (u32x2){pk2(acc2[mi][ni][4 * q], acc2[mi][ni][4 * q + 1]), pk2(acc2[mi][ni][4 * q + 2], acc2[mi][ni][4 * q + 3])};
  }
  if (slot < 4 * nleft) {
    list_entry(full + (slot >> 2), ntm, ntn, tm, tn);
    const int n0 = tn * 256 + (slot & 3) * 64;
    f32x16 acc2[2];
#pragma unroll
    for (int e = 0; e < 16; ++e) { acc2[0][e] = 0.f; acc2[1][e] = 0.f; }
    gemm_core_mini(PB, 256, IdMap{tm * 128}, Wp, n0, 256, acc2, smem, ltid());
#pragma unroll
    for (int ni = 0; ni < 2; ++ni)
#pragma unroll
      for (int q = 0; q < 4; ++q)
        *(u32x2*)(PL + (size_t)(tm * 128 + w * 32 + l32) * D + n0 + ni * 32 + 8 * q + 4 * hh) =
            (u32x2){pk2(acc2[ni][4 * q], acc2[ni][4 * q + 1]), pk2(acc2[ni][4 * q + 2], acc2[ni][4 * q + 3])};
  }
  for (int L = slot; L < full; L += S) {
    list_entry(L, ntm, ntn, tm, tn);
    f32x16 acc[4][2];
    ZERO_ACC(acc);
    gemm_core(XB2, 1024, IdMap{tm * 128}, Wg, tn * 256, 1024, acc, smem, ltid());
#pragma unroll
    for (int mi = 0; mi < 4; ++mi) {
      const int m = tm * 128 + mi * 32 + l32;
      float ssq = 0.f;
#pragma unroll
      for (int ni = 0; ni < 2; ++ni)
#pragma unroll
        for (int q = 0; q < 4; ++q)
          ple_epi(p, PL, XIN, XOUT, m, tn * 256 + w * 64 + ni * 32 + 8 * q + 4 * hh, acc[mi][ni][4 * q], acc[mi][ni][4 * q + 1], acc[mi][ni][4 * q + 2], acc[mi][ni][4 * q + 3], ssq);
      ssq += __shfl_xor(ssq, 32);
      if (hh == 0) p.ss[(size_t)m * 16 + tn * 4 + w] = ssq;
    }
  }
  if (slot < 4 * nleft) {
    list_entry(full + (slot >> 2), ntm, ntn, tm, tn);
    const int ws = slot & 3, n0 = tn * 256 + ws * 64;
    f32x16 acc[2];
#pragma unroll
    for (int e = 0; e < 16; ++e) { acc[0][e] = 0.f; acc[1][e] = 0.f; }
    gemm_core_mini(XB2, 1024, IdMap{tm * 128}, Wg, n0, 1024, acc, smem, ltid());
    const int m = tm * 128 + w * 32 + l32;
    float ssq = 0.f;
#pragma unroll
    for (int ni = 0; ni < 2; ++ni)
#pragma unroll
      for (int q = 0; q < 4; ++q)
        ple_epi(p, PL, XIN, XOUT, m, n0 + ni * 32 + 8 * q + 4 * hh, acc[ni][4 * q], acc[ni][4 * q + 1], acc[ni][4 * q + 2], acc[ni][4 * q + 3], ssq);
    ssq += __shfl_xor(ssq, 32);
    if (hh == 0) p.ss[(size_t)m * 16 + tn * 4 + ws] = ssq;
  }
}

DI void ffn_in_phase(const P& p, int layer, const u16* XR, char* smem) {
  const int tid = ltid(), l = tid & 63, w = tid >> 6, l32 = l & 31, hh = l >> 5;
  const u16* Wt = p.wt_ffn_in + (size_t)layer * 5632 * 1024;
  u16* HID = (u16*)p.BIG;
  const float* cw = p.conv_w + (size_t)layer * 3 * DFF;
  const float* cb = p.conv_b + (size_t)layer * DFF;
  int tm, tn;
  for (int it = 0; next_tile(it, 272, 22, tm, tn); ++it) {
    const int seq = tm / 17, j = tm - seq * 17;
    const int T = 2048, rowbase = seq * 2048, t0 = 126 * j - 2;
    const bool last = (j == 16);
    const bool has_smp = last && seq < 8;
    const int srow = ROWS_P + seq * 32;
    f32x16 acc[4][2];
    ZERO_ACC(acc);
    const ClampMap2 rmap{rowbase, t0, T, has_smp ? srow : -1};
    gemm_core(XR, 1024, rmap, Wt, tn * 256, 1024, acc, smem, tid);
#pragma unroll
    for (int mi = 0; mi < 4; ++mi) {
      const float rsr = rsqrtf(p.ss2[rmap(mi * 32 + l32)] * (1.f / D) + EPS);
#pragma unroll
      for (int e = 0; e < 16; ++e) { acc[mi][0][e] *= rsr; acc[mi][1][e] *= rsr; }
    }
    const int chw = tn * 128 + w * 32;
    if (t0 < 0 && l32 < 2) {
#pragma unroll
      for (int q = 0; q < 4; ++q)
#pragma unroll
        for (int c = 0; c < 4; ++c) acc[0][0][4 * q + c] = 0.f;
    }
    if (has_smp && l32 < 2) {
#pragma unroll
      for (int q = 0; q < 4; ++q) {
        const f32x4 sv = *(const f32x4*)(p.state_conv + ((size_t)(layer * 8 + seq) * 2 + l32) * DFF + chw + 8 * q + 4 * hh);
#pragma unroll
        for (int c = 0; c < 4; ++c) acc[2][0][4 * q + c] = sv[c];
      }
    }
    const int lbase = l & 32;
#pragma unroll
    for (int q = 0; q < 4; ++q) {
      const int chq = chw + 8 * q + 4 * hh;
      const f32x4 b4 = *(const f32x4*)(cb + chq);
      const f32x4 w0 = *(const f32x4*)(cw + chq), w1 = *(const f32x4*)(cw + DFF + chq), w2 = *(const f32x4*)(cw + 2 * DFF + chq);
#pragma unroll
      for (int mi = 0; mi < 4; ++mi) {
        const int m = mi * 32 + l32;
        const bool seg1 = has_smp && mi >= 2;
        const int t = seg1 ? m - 66 : t0 + m;
        const int Tm = seg1 ? 32 : T;
        float hv[4];
#pragma unroll
        for (int c = 0; c < 4; ++c) {
          const float g0 = acc[mi][0][4 * q + c];
          float g1 = __shfl(g0, lbase + ((l32 + 31) & 31));
          float g2 = __shfl(g0, lbase + ((l32 + 30) & 31));
          if (mi > 0) {
            const float pg = acc[mi > 0 ? mi - 1 : 0][0][4 * q + c];
            const float p1 = __shfl(pg, lbase + 31), p2 = __shfl(pg, lbase + 30);
            if (l32 == 0) { g1 = p1; g2 = p2; }
            if (l32 == 1) { g2 = p1; }
          }
          const float cv = b4[c] + w0[c] * g2 + w1[c] * g1 + w2[c] * g0;
          hv[c] = cv * sigm(cv) * acc[mi][1][4 * q + c];
        }
        if ((seg1 ? m >= 66 : m >= 2) && t < Tm) {
          *(u32x2*)(HID + (size_t)((seg1 ? srow : rowbase) + t) * DFF + chq) = (u32x2){pk2(hv[0], hv[1]), pk2(hv[2], hv[3])};
          if (last && t >= Tm - 2) {
            float* co = seg1 ? p.conv_sample + ((size_t)(layer * 8 + seq) * 2 + (t - 30)) * DFF
                             : p.conv_prompt + ((size_t)(layer * 16 + seq) * 2 + (t - (T - 2))) * DFF;
            *(f32x4*)(co + chq) = (f32x4){acc[mi][0][4 * q], acc[mi][0][4 * q + 1], acc[mi][0][4 * q + 2], acc[mi][0][4 * q + 3]};
          }
        }
      }
    }
  }
}

DI void gla_state_phase(const P& p, int layer, char* smem) {
  const u16* PROJ = (const u16*)p.BIG;
  const int tid = ltid(), l = tid & 63, w = tid >> 6, l32 = l & 31, hh = l >> 5;
  float* SLOC = (float*)((char*)p.y + (size_t)ROWS * 1024 * 2);
  float* DTOT = SLOC + (size_t)384 * 16384;
  const int k = tid >> 1, th = tid & 1;
  for (int item = lbid(); item < 384; item += gridDim.x) {
    const int sh = item / 3, ch = item - sh * 3, s = sh >> 3, h = sh & 7;
    const int rowbase = s * 2048 + ch * 512;
    float lower = 0.f;
    if (layer == 1) lower = sigm(p.lb_raw[1024 + h * 128 + k] - p.lb_raw[h * 128 + k]);
    const float oml = 1.f - lower;
    f32x16 S[4];
#pragma unroll
    for (int kt = 0; kt < 4; ++kt)
#pragma unroll
      for (int i = 0; i < 16; ++i) S[kt][i] = 0.f;
    float btot = 0.f;
    u16 fr[8], vr[8];
#define GS_LOAD(BLK) { const size_t r0_ = (size_t)rowbase + (BLK) * 16; \
      const u16* pf_ = PROJ + (r0_ + 8 * th) * 4096 + 1024 + h * 128 + k; \
      const u16* pv_ = PROJ + r0_ * 4096 + 2048 + h * 128 + 32 * w + l32; \
      _Pragma("unroll") for (int t = 0; t < 8; ++t) fr[t] = pf_[(size_t)t * 4096]; \
      _Pragma("unroll") for (int jj = 0; jj < 8; ++jj) vr[jj] = pv_[(size_t)(8 * (jj >> 2) + 4 * hh + (jj & 3)) * 4096]; }
    GS_LOAD(0);
    for (int blk = 0; blk < 32; ++blk) {
      char* sb = smem + (blk & 1) * 8192;
      u16* KDT = (u16*)sb;
      float* DD = (float*)(KDT + 128 * 20);
      {
        float km[8], eb[8];
        float bs = 0.f;
#pragma unroll
        for (int t = 0; t < 8; ++t) {
          const float f = bf2f(fr[t]);
          const float g = lower + oml * sigm(f);
          bs += __logf(g);
          km[t] = 1.f - g; eb[t] = bs;
        }
        const float other = __shfl_xor(bs, 1);
        const float boff = th ? other : 0.f;
        const float bsum = bs + other;
        btot += bsum;
        unsigned kdp[4];
#pragma unroll
        for (int j = 0; j < 4; ++j)
          kdp[j] = pk2(km[2 * j] * __expf(bsum - boff - eb[2 * j]), km[2 * j + 1] * __expf(bsum - boff - eb[2 * j + 1]));
        *(u32x2*)(KDT + k * 20 + 8 * th) = (u32x2){kdp[0], kdp[1]};
        *(u32x2*)(KDT + k * 20 + 8 * th + 4) = (u32x2){kdp[2], kdp[3]};
        if (th == 0) DD[k] = __expf(bsum);
      }
      const bf16x8 vfrag = mk8u((unsigned)vr[0] | ((unsigned)vr[1] << 16), (unsigned)vr[2] | ((unsigned)vr[3] << 16),
                                (unsigned)vr[4] | ((unsigned)vr[5] << 16), (unsigned)vr[6] | ((unsigned)vr[7] << 16));
      if (blk + 1 < 32) GS_LOAD(blk + 1);
      __syncthreads();
#pragma unroll
      for (int kt = 0; kt < 4; ++kt) {
#pragma unroll
        for (int q = 0; q < 4; ++q) {
          const f32x4 d4 = *(const f32x4*)(DD + 32 * kt + 8 * q + 4 * hh);
#pragma unroll
          for (int c = 0; c < 4; ++c) S[kt][4 * q + c] *= d4[c];
        }
        const u32x2 lo = *(const u32x2*)(KDT + (32 * kt + l32) * 20 + 4 * hh);
        const u32x2 hi = *(const u32x2*)(KDT + (32 * kt + l32) * 20 + 8 + 4 * hh);
        S[kt] = __builtin_amdgcn_mfma_f32_32x32x16_bf16(mk8(lo, hi), vfrag, S[kt], 0, 0, 0);
      }
    }
#undef GS_LOAD
    {
      float* op = SLOC + (size_t)item * 16384 + 32 * w + l32;
#pragma unroll
      for (int kt = 0; kt < 4; ++kt)
#pragma unroll
        for (int i = 0; i < 16; ++i) op[(size_t)(32 * kt + (i & 3) + 8 * (i >> 2) + 4 * hh) * 128] = S[kt][i];
      if (th == 0) DTOT[(size_t)item * 128 + k] = __expf(btot);
    }
    __syncthreads();
  }
}

DI void gla_phase(const P& p, int layer, char* smem) {
  const u16* PROJ = (const u16*)p.BIG;
  const int tid = ltid(), l = tid & 63, w = tid >> 6, l32 = l & 31, hh = l >> 5, m16 = l & 15;
  float* REDB = (float*)(smem + 2 * 14336);
  const int k = tid >> 1, th = tid & 1;
  const float* SLOC = (const float*)((const char*)p.y + (size_t)ROWS * 1024 * 2);
  const float* DTOT = SLOC + (size_t)384 * 16384;
  for (int item = lbid(); item < 576; item += gridDim.x) {
    const bool smp = item < 64;
    const int s = smp ? 16 + (item >> 3) : (item - 64) >> 5;
    const int h = smp ? (item & 7) : ((item - 64) >> 2) & 7;
    const int ch = smp ? 0 : (item - 64) & 3;
    const int T = smp ? 32 : 512;
    const int rowbase = smp ? ROWS_P + (s - 16) * 32 : s * 2048 + ch * 512;
    float lower = 0.f;
    if (layer == 1) lower = sigm(p.lb_raw[1024 + h * 128 + k] - p.lb_raw[h * 128 + k]);
    const float oml = 1.f - lower;
    f32x16 S[4];
    if (smp) {
      const float* sp = p.state_hgrn + ((size_t)(layer * 8 + (s - 16)) * 8 + h) * 16384 + 32 * w + l32;
#pragma unroll
      for (int kt = 0; kt < 4; ++kt)
#pragma unroll
        for (int i = 0; i < 16; ++i) S[kt][i] = sp[(size_t)(32 * kt + (i & 3) + 8 * (i >> 2) + 4 * hh) * 128];
    } else {
#pragma unroll
      for (int kt = 0; kt < 4; ++kt)
#pragma unroll
        for (int i = 0; i < 16; ++i) S[kt][i] = 0.f;
#pragma unroll 1
      for (int j = 0; j < ch; ++j) {
        const int it1 = (s * 8 + h) * 3 + j;
        const float* sl = SLOC + (size_t)it1 * 16384 + 32 * w + l32 + (size_t)(4 * hh) * 128;
        const float* dl = DTOT + (size_t)it1 * 128 + 4 * hh;
#pragma unroll
        for (int kt = 0; kt < 4; ++kt) {
#pragma unroll
          for (int q = 0; q < 4; ++q) {
            const float* slq = sl + (size_t)(32 * kt + 8 * q) * 128;
            const f32x4 d4 = *(const f32x4*)(dl + 32 * kt + 8 * q);
#pragma unroll
            for (int c = 0; c < 4; ++c) S[kt][4 * q + c] = S[kt][4 * q + c] * d4[c] + slq[c * 128];
            __builtin_amdgcn_sched_barrier(0);
          }
        }
      }
    }
    const int nblk = T >> 4;
    u16 fr[8], qr[8], vr[8];
#define GLA_LOADRAW(BLK) { const size_t r0_ = (size_t)rowbase + (BLK) * 16; \
      const u16* pf_ = PROJ + (r0_ + 8 * th) * 4096 + 1024 + h * 128 + k; \
      const u16* pq_ = PROJ + (r0_ + 8 * th) * 4096 + h * 128 + k; \
      _Pragma("unroll") for (int t = 0; t < 8; ++t) fr[t] = pf_[(size_t)t * 4096]; \
      _Pragma("unroll") for (int j = 0; j < 8; ++j) qr[j] = pq_[(size_t)j * 4096]; \
 }
#define GLA_LOADV(BLK) { const u16* pv_ = PROJ + ((size_t)rowbase + (BLK) * 16) * 4096 + 2048 + h * 128 + 32 * w + l32; \
      _Pragma("unroll") for (int jj = 0; jj < 8; ++jj) vr[jj] = pv_[(size_t)(8 * (jj >> 2) + 4 * hh + (jj & 3)) * 4096]; }
#define GLA_LOADGS(BLK) { const u16* pg_ = PROJ + ((size_t)rowbase + (BLK) * 16 + m16) * 4096 + 3072 + h * 128 + 32 * w + 4 * hh; \
      _Pragma("unroll") for (int q = 0; q < 4; ++q) gsl[q] = *(const u32x2*)(pg_ + 8 * q); }
#define GLA_FINAL(BLK) { const float* RED_ = REDB + ((BLK) & 1) * 64; \
      if (l32 < 16) { \
        const float tot = RED_[l32] + RED_[16 + l32] + RED_[32 + l32] + RED_[48 + l32]; \
        const float rn = rsqrtf(tot * (1.f / 128.f) + EPS); \
        u16* op_ = p.OG + ((size_t)rowbase + (BLK) * 16 + l32) * 1024 + h * 128 + 32 * w + 4 * hh; \
        const float* gp_ = p.g_hg + layer * 1024 + h * 128 + 32 * w + 4 * hh; \
        _Pragma("unroll") for (int q = 0; q < 4; ++q) { const f32x4 gh = *(const f32x4*)(gp_ + 8 * q); \
          *(u32x2*)(op_ + 8 * q) = (u32x2){pk2(oacc[4 * q] * rn * gh[0] * bflo(gsl[q][0]), oacc[4 * q + 1] * rn * gh[1] * bfhi(gsl[q][0])), \
                                          pk2(oacc[4 * q + 2] * rn * gh[2] * bflo(gsl[q][1]), oacc[4 * q + 3] * rn * gh[3] * bfhi(gsl[q][1]))}; } \
      } }
    GLA_LOADRAW(0);
    u32x2 gsl[4];
    for (int blk = 0; blk < nblk; ++blk) {
      GLA_LOADGS(blk);
      GLA_LOADV(blk);
      char* sb = smem + (blk & 1) * 14336;
      u16* QT = (u16*)sb;
      u16* KT = QT + 16 * 136;
      u16* KDT = KT + 16 * 136;
      float* DD = (float*)(KDT + 128 * 20);
      {
        float qtm[8], ktm[8];
        float bs = 0.f;
#pragma unroll
        for (int t = 0; t < 8; ++t) {
          const float f = bf2f(fr[t]);
          const float g = lower + oml * sigm(f);
          bs += __logf(g);
          const float eb = __expf(bs);
          qtm[t] = bf2f(qr[t]) * eb;
          ktm[t] = (1.f - g) * __builtin_amdgcn_rcpf(eb);
        }
        const float other = __shfl_xor(bs, 1);
        const float boff = th ? other : 0.f;
        const float bsum = bs + other;
        const float E1 = __expf(boff), E1i = __expf(-boff), EL = __expf(bsum);
        unsigned kdp[4];
        float kdprev = 0.f;
#pragma unroll
        for (int j = 0; j < 8; ++j) {
          const int t = 8 * th + j;
          const float qt = qtm[j] * E1;
          const float ktv = ktm[j] * E1i;
          const float kd = ktv * EL;
          QT[t * 136 + k] = (u16)(pk2(qt, 0.f) & 0xffffu);
          KT[t * 136 + k] = (u16)(pk2(ktv, 0.f) & 0xffffu);
          if (j & 1) kdp[j >> 1] = pk2(kdprev, kd); else kdprev = kd;
        }
        *(u32x2*)(KDT + k * 20 + 8 * th) = (u32x2){kdp[0], kdp[1]};
        *(u32x2*)(KDT + k * 20 + 8 * th + 4) = (u32x2){kdp[2], kdp[3]};
        if (th == 0) DD[k] = __expf(bsum);
      }
      if (blk + 1 < nblk) GLA_LOADRAW(blk + 1);
      __syncthreads();
      const bf16x8 vfrag = mk8u((unsigned)vr[0] | ((unsigned)vr[1] << 16), (unsigned)vr[2] | ((unsigned)vr[3] << 16),
                                (unsigned)vr[4] | ((unsigned)vr[5] << 16), (unsigned)vr[6] | ((unsigned)vr[7] << 16));
      f32x16 aacc, oacc;
#pragma unroll
      for (int i = 0; i < 16; ++i) { aacc[i] = 0.f; oacc[i] = 0.f; }
#pragma unroll
      for (int ks = 0; ks < 8; ++ks) {
        const bf16x8 ka = *(const bf16x8*)(KT + m16 * 136 + 16 * ks + 8 * hh);
        const bf16x8 qb = *(const bf16x8*)(QT + m16 * 136 + 16 * ks + 8 * hh);
        aacc = __builtin_amdgcn_mfma_f32_32x32x16_bf16(ka, qb, aacc, 0, 0, 0);
        const int kt = ks >> 1, s2 = ks & 1;
        const bf16x8 sa = mk8u(pk2(S[kt][8 * s2], S[kt][8 * s2 + 1]), pk2(S[kt][8 * s2 + 2], S[kt][8 * s2 + 3]),
                               pk2(S[kt][8 * s2 + 4], S[kt][8 * s2 + 5]), pk2(S[kt][8 * s2 + 6], S[kt][8 * s2 + 7]));
        const u32x2 lo = *(const u32x2*)(QT + m16 * 136 + 32 * kt + 16 * s2 + 4 * hh);
        const u32x2 hi = *(const u32x2*)(QT + m16 * 136 + 32 * kt + 16 * s2 + 8 + 4 * hh);
        oacc = __builtin_amdgcn_mfma_f32_32x32x16_bf16(sa, mk8(lo, hi), oacc, 0, 0, 0);
      }
      float am[8];
#pragma unroll
      for (int i = 0; i < 8; ++i) { const int m = (i & 3) + 8 * (i >> 2) + 4 * hh; am[i] = (m <= m16) ? aacc[i] : 0.f; }
      const bf16x8 afrag = mk8u(pk2(am[0], am[1]), pk2(am[2], am[3]), pk2(am[4], am[5]), pk2(am[6], am[7]));
      oacc = __builtin_amdgcn_mfma_f32_32x32x16_bf16(vfrag, afrag, oacc, 0, 0, 0);
#pragma unroll
      for (int kt = 0; kt < 4; ++kt) {
#pragma unroll
        for (int q = 0; q < 4; ++q) {
          const f32x4 d4 = *(const f32x4*)(DD + 32 * kt + 8 * q + 4 * hh);
#pragma unroll
          for (int c = 0; c < 4; ++c) S[kt][4 * q + c] *= d4[c];
        }
        const u32x2 lo = *(const u32x2*)(KDT + (32 * kt + l32) * 20 + 4 * hh);
        const u32x2 hi = *(const u32x2*)(KDT + (32 * kt + l32) * 20 + 8 + 4 * hh);
        S[kt] = __builtin_amdgcn_mfma_f32_32x32x16_bf16(mk8(lo, hi), vfrag, S[kt], 0, 0, 0);
      }
      float ss = 0.f;
#pragma unroll
      for (int i = 0; i < 16; ++i) ss += oacc[i] * oacc[i];
      ss += __shfl_xor(ss, 32);
      if (l < 16) REDB[(blk & 1) * 64 + w * 16 + l] = ss;
      __syncthreads();
      GLA_FINAL(blk);
    }
#undef GLA_LOADGS
#undef GLA_LOADV
#undef GLA_LOADRAW
#undef GLA_FINAL
    if (smp || ch == 3) {
      float* op = (smp ? p.hgrn_sample + ((size_t)(layer * 8 + (s - 16)) * 8 + h) * 16384
                       : p.hgrn_prompt + ((size_t)(layer * 16 + s) * 8 + h) * 16384) + 32 * w + l32;
#pragma unroll
      for (int kt = 0; kt < 4; ++kt)
#pragma unroll
        for (int i = 0; i < 16; ++i) op[(size_t)(32 * kt + (i & 3) + 8 * (i >> 2) + 4 * hh) * 128] = S[kt][i];
    }
  }
}

DI void kvconv_phase(const P& p) {
  const int tid = ltid();
  char* KVT = p.BIG + (size_t)ROWS * 1024 * 2;
  for (int t = lbid(); t < 4096 + 1088; t += gridDim.x) {
    const float *kb, *vb; int nvalid = 64;
    if (t < 4096) { const int kt = t & 31, sh = t >> 5, s = sh >> 3, h = sh & 7; const size_t off = ((size_t)(s * 2048 + 64 * kt)) * 1024 + h * 128; kb = p.k_prompt + off; vb = p.v_prompt + off; }
    else { const int u = t - 4096; const int kt = u % 17, sh = u / 17, b = sh >> 3, h = sh & 7;
      if (kt < 16) { const size_t off = ((size_t)(b * 1024 + 64 * kt)) * 1024 + h * 128; kb = p.cache_k + off; vb = p.cache_v + off; }
      else { const size_t off = ((size_t)(b * 32)) * 1024 + h * 128; kb = p.k_sample + off; vb = p.v_sample + off; nvalid = 32; } }
    u16* kd = (u16*)(KVT + (size_t)t * 32768);
    u16* vd = kd + 8192;
#pragma unroll
    for (int pp = 0; pp < 4; ++pp) {
      const int key = 16 * pp + (tid >> 4), d8 = (tid & 15) * 8;
      f32x4 a = {0.f, 0.f, 0.f, 0.f}, b2 = {0.f, 0.f, 0.f, 0.f};
      if (key < nvalid) { a = *(const f32x4*)(kb + (size_t)key * 1024 + d8); b2 = *(const f32x4*)(kb + (size_t)key * 1024 + d8 + 4); }
      *(u32x4*)(kd + key * 128 + d8) = (u32x4){pk2(a[0], a[1]), pk2(a[2], a[3]), pk2(b2[0], b2[1]), pk2(b2[2], b2[3])};
    }
#pragma unroll
    for (int c = 0; c < 4; ++c) {
      const int v = tid & 127, cc = 4 * (tid >> 7) + c;
      float e[8];
#pragma unroll
      for (int j = 0; j < 8; ++j) { const int key = 8 * cc + j; e[j] = key < nvalid ? vb[(size_t)key * 1024 + v] : 0.f; }
      *(u32x4*)(vd + v * 64 + 8 * cc) = (u32x4){pk2(e[0], e[1]), pk2(e[2], e[3]), pk2(e[4], e[5]), pk2(e[6], e[7])};
    }
  }
}

DI void attn_phase(const P& p, int layer, char* smem) {
  const int jl = layer - 2;
  const u16* Q = (const u16*)p.BIG;
  const char* KVT = p.BIG + (size_t)ROWS * 1024 * 2;
  const int tid = ltid(), l = tid & 63, w = tid >> 6, l16 = l & 15, g = l >> 4;
  u16* KS = (u16*)smem;
  u16* VT = KS + 64 * 136;
  float* BT = (float*)(VT + 128 * 72);
  u16* QS = (u16*)(BT + 256);
  const float lam_init = 0.8f - 0.6f * __expf(-0.3f * (float)layer);
  float lam;
  {
    const float* lp = p.lam_b + jl * 256;
    float a = 0.f, b = 0.f;
    for (int d = 0; d < 64; ++d) { a += lp[d] * lp[64 + d]; b += lp[128 + d] * lp[192 + d]; }
    lam = __expf(a) - __expf(b) + lam_init;
  }
  const int bidA = lbid(), GA = gridDim.x;
  for (int kk = 0; kk * GA < 4096 + 64; ++kk) {
    const int item = ((kk & 1) ? (GA - 1 - bidA) : bidA) + kk * GA;
    if (item >= 4096 + 64) continue;
    int b, h, nq, qrow0, qpos0, ntiles, tile0; bool smp;
    if (item < 4096) { const int jq = 31 - (item >> 7); const int bh = item & 127; b = bh >> 3; h = bh & 7; smp = false; nq = 64; qrow0 = b * 2048 + 64 * jq; qpos0 = 64 * jq; ntiles = jq + 1; tile0 = bh * 32; }
    else { const int si = item - 4096; b = si >> 3; h = si & 7; smp = true; nq = 32; qrow0 = ROWS_P + b * 32; qpos0 = 1024; ntiles = 17; tile0 = 4096 + si * 17; }
    __syncthreads();
    if (tid < 230) {
      const int rel = tid - 166;
      const int n = rel < 0 ? -rel : rel;
      int bk = n < 8 ? n : 8 + (n >= 13) + (n >= 20) + (n >= 30) + (n >= 46) + (n >= 70) + (n >= 108) + (n >= 166);
      if (rel > 0) bk += 16;
      BT[tid] = p.rel_bias[bk * 8 + h] * LOG2E;
    }
#pragma unroll
    for (int pp = 0; pp < 4; ++pp) {
      const int idx = pp * 256 + tid, r = idx >> 4, c16 = idx & 15;
      *(u32x4*)(QS + r * 136 + c16 * 8) = *(const u32x4*)(Q + (size_t)(qrow0 + min(r, nq - 1)) * 1024 + h * 128 + c16 * 8);
    }
    f32x4 oacc[2][8];
#pragma unroll
    for (int c = 0; c < 2; ++c)
#pragma unroll
      for (int vs = 0; vs < 8; ++vs) oacc[c][vs] = (f32x4){0.f, 0.f, 0.f, 0.f};
    float mrun[2] = {-1e30f, -1e30f}, lsum[2] = {0.f, 0.f};
    const int qpos = qpos0 + min(16 * w + l16, nq - 1);
    u32x4 rk[4], rv[4];
    {
      const u32x4* src = (const u32x4*)(KVT + (size_t)tile0 * 32768);
#pragma unroll
      for (int pp = 0; pp < 4; ++pp) { rk[pp] = src[pp * 256 + tid]; rv[pp] = src[1024 + pp * 256 + tid]; }
    }
    for (int kt = 0; kt < ntiles; ++kt) {
      const int nvalid = (smp && kt == 16) ? 32 : 64;
      if (kt > 0) __syncthreads();
#pragma unroll
      for (int pp = 0; pp < 4; ++pp) {
        const int idx = pp * 256 + tid;
        *(u32x4*)(KS + (idx >> 4) * 136 + (idx & 15) * 8) = rk[pp];
        *(u32x4*)(VT + (idx >> 3) * 72 + (idx & 7) * 8) = rv[pp];
      }
      if (kt + 1 < ntiles) {
        const u32x4* src = (const u32x4*)(KVT + (size_t)(tile0 + kt + 1) * 32768);
#pragma unroll
        for (int pp = 0; pp < 4; ++pp) { rk[pp] = src[pp * 256 + tid]; rv[pp] = src[1024 + pp * 256 + tid]; }
      }
      __syncthreads();
      f32x4 sacc[2][4];
#pragma unroll
      for (int c = 0; c < 2; ++c)
#pragma unroll
        for (int sub = 0; sub < 4; ++sub) {
          sacc[c][sub] = (f32x4){0.f, 0.f, 0.f, 0.f};
#pragma unroll
          for (int ks = 0; ks < 2; ++ks) {
            const bf16x8 kf = *(const bf16x8*)(KS + (16 * sub + l16) * 136 + c * 64 + 32 * ks + 8 * g);
            const bf16x8 qfr = *(const bf16x8*)(QS + (16 * w + l16) * 136 + c * 64 + 32 * ks + 8 * g);
            sacc[c][sub] = __builtin_amdgcn_mfma_f32_16x16x32_bf16(kf, qfr, sacc[c][sub], 0, 0, 0);
          }
        }
#pragma unroll
      for (int sub = 0; sub < 4; ++sub)
#pragma unroll
        for (int i = 0; i < 4; ++i) {
          const int kl = 16 * sub + 4 * g + i;
          int rel = 64 * kt + kl - qpos;
          rel = rel < -166 ? -166 : rel;
          const float bt = BT[rel + 166];
          const bool ok = kl < nvalid;
          sacc[0][sub][i] = ok ? sacc[0][sub][i] + bt : -30000.f;
          sacc[1][sub][i] = ok ? sacc[1][sub][i] + bt : -30000.f;
        }
      bf16x8 pf[2][2];
#pragma unroll
      for (int c = 0; c < 2; ++c) {
        float mx = -1e30f;
#pragma unroll
        for (int sub = 0; sub < 4; ++sub)
#pragma unroll
          for (int i = 0; i < 4; ++i) mx = fmaxf(mx, sacc[c][sub][i]);
        mx = fmaxf(mx, __shfl_xor(mx, 16));
        mx = fmaxf(mx, __shfl_xor(mx, 32));
        const float mnew = fmaxf(mrun[c], mx);
        const float alpha = __builtin_amdgcn_exp2f(mrun[c] - mnew);
        mrun[c] = mnew;
        float rs = 0.f;
#pragma unroll
        for (int sub = 0; sub < 4; ++sub)
#pragma unroll
          for (int i = 0; i < 4; ++i) { const float e = __builtin_amdgcn_exp2f(sacc[c][sub][i] - mnew); sacc[c][sub][i] = e; rs += e; }
        lsum[c] = lsum[c] * alpha + rs;
#pragma unroll
        for (int vs = 0; vs < 8; ++vs) oacc[c][vs] *= alpha;
#pragma unroll
        for (int j = 0; j < 2; ++j)
          pf[c][j] = mk8u(pk2(sacc[c][2 * j][0], sacc[c][2 * j][1]), pk2(sacc[c][2 * j][2], sacc[c][2 * j][3]),
                          pk2(sacc[c][2 * j + 1][0], sacc[c][2 * j + 1][1]), pk2(sacc[c][2 * j + 1][2], sacc[c][2 * j + 1][3]));
      }
#pragma unroll
      for (int j = 0; j < 2; ++j)
#pragma unroll
        for (int vs = 0; vs < 8; ++vs) {
          const u32x2 lo = *(const u32x2*)(VT + (16 * vs + l16) * 72 + 32 * j + 4 * g);
          const u32x2 hi = *(const u32x2*)(VT + (16 * vs + l16) * 72 + 32 * j + 16 + 4 * g);
          const bf16x8 vf = mk8(lo, hi);
          oacc[0][vs] = __builtin_amdgcn_mfma_f32_16x16x32_bf16(vf, pf[0][j], oacc[0][vs], 0, 0, 0);
          oacc[1][vs] = __builtin_amdgcn_mfma_f32_16x16x32_bf16(vf, pf[1][j], oacc[1][vs], 0, 0, 0);
        }
    }
#pragma unroll
    for (int c = 0; c < 2; ++c) { lsum[c] += __shfl_xor(lsum[c], 16); lsum[c] += __shfl_xor(lsum[c], 32); }
    const float inv0 = 1.f / lsum[0], inv1 = lam / lsum[1];
    float ss = 0.f;
#pragma unroll
    for (int vs = 0; vs < 8; ++vs)
#pragma unroll
      for (int i = 0; i < 4; ++i) { const float o = oacc[0][vs][i] * inv0 - oacc[1][vs][i] * inv1; oacc[0][vs][i] = o; ss += o * o; }
    ss += __shfl_xor(ss, 16);
    ss += __shfl_xor(ss, 32);
    const float rn = rsqrtf(ss * (1.f / 128.f) + EPS) * (1.f - lam_init);
    if (16 * w + l16 < nq) {
      const size_t row = (size_t)qrow0 + 16 * w + l16;
#pragma unroll
      for (int vs = 0; vs < 8; ++vs) {
        const int v = h * 128 + 16 * vs + 4 * g;
        const f32x4 gl = *(const f32x4*)(p.g_subln + jl * 1024 + v);
        *(u32x2*)(p.OG + row * 1024 + v) = (u32x2){pk2(oacc[0][vs][0] * rn * gl[0], oacc[0][vs][1] * rn * gl[1]),
                                                   pk2(oacc[0][vs][2] * rn * gl[2], oacc[0][vs][3] * rn * gl[3])};
      }
    }
  }
}

#define XB_TMO      128
#define XB_XCNT(j)  (256  + 64 * (j))
#define XB_XSUB(j)  (1280 + 64 * (j))
#define XB_XGEN(j)  (2304 + 64 * (j))
#define XB_TOP      3328
#define XB_TOPGEN   3392
#define XCD_BAR_WORDS 3456
#define XB_SPIN_CAP (1u << 18)
#define LAS __attribute__((address_space(3)))
DI unsigned xb_ld(unsigned* p) { return __hip_atomic_load(p, __ATOMIC_RELAXED, __HIP_MEMORY_SCOPE_AGENT); }
DI unsigned xb_add(unsigned* p, unsigned v) { return __hip_atomic_fetch_add(p, v, __ATOMIC_RELAXED, __HIP_MEMORY_SCOPE_AGENT); }
DI unsigned xb_xcc_id() { return (unsigned)__builtin_amdgcn_s_getreg((3 << 11) | 20) & 0xFu; }
#define XB_SPIN(cond, bar) do { unsigned _sp = 0; while (cond) { __builtin_amdgcn_s_sleep(1); \
    if ((++_sp & 255u) == 0u) { if (xb_ld(&(bar)[XB_TMO])) break; if (_sp > XB_SPIN_CAP) { atomicAdd(&(bar)[XB_TMO], 1u); break; } } } } while (0)
struct XcdBarrier { unsigned* bar; unsigned x; volatile LAS unsigned* st; };
DI XcdBarrier xcd_barrier_post(unsigned* bar, volatile LAS unsigned* st) {
  XcdBarrier b; b.bar = bar; b.x = xb_xcc_id(); b.st = st;
  if (threadIdx.x == 0) (void)xb_add(&bar[XB_XCNT(b.x)], 1u);
  return b;
}
DI void xcd_barrier_complete(unsigned* bar, unsigned x, unsigned& nloc, unsigned& nx) {
  const unsigned G = gridDim.x;
  unsigned sum, cnt, mine, sp = 0u;
  for (;;) {
    sum = 0u; cnt = 0u; mine = 0u;
#pragma unroll
    for (unsigned j = 0; j < 16; ++j) { const unsigned c = xb_ld(&bar[XB_XCNT(j)]); sum += c; cnt += (c > 0u) ? 1u : 0u; mine = (j == x) ? c : mine; }
    if (sum == G) break;
    __builtin_amdgcn_s_sleep(1);
    if ((++sp & 255u) == 0u) { if (xb_ld(&bar[XB_TMO])) break; if (sp > XB_SPIN_CAP) { atomicAdd(&bar[XB_TMO], 1u); break; } }
  }
  nloc = mine > 0u ? mine : 1u; nx = cnt > 0u ? cnt : 1u;
}
DI void xcd_barrier(const XcdBarrier& b) {
  asm volatile("s_waitcnt vmcnt(0)" ::: "memory");
  __syncthreads();
  if (ltid() == 0) {
    unsigned* bar = b.bar;
    __builtin_amdgcn_s_waitcnt(0);
    unsigned nloc = b.st[0], nx = b.st[1];
    if (nloc == 0u) { xcd_barrier_complete(bar, b.x, nloc, nx); b.st[0] = nloc; b.st[1] = nx; }
    const unsigned old = xb_add(&bar[XB_XSUB(b.x)], 1u);
    const unsigned gen = old / nloc;
    if (old + 1u == (gen + 1u) * nloc) {
      __builtin_amdgcn_fence(__ATOMIC_RELEASE, "agent");
      asm volatile("s_waitcnt vmcnt(0)" ::: "memory");
      const unsigned og = xb_add(&bar[XB_TOP], 1u);
      const unsigned tg = og / nx;
      if (og + 1u == (tg + 1u) * nx) xb_add(&bar[XB_TOPGEN], 1u);
      else XB_SPIN(xb_ld(&bar[XB_TOPGEN]) == tg, bar);
      __builtin_amdgcn_fence(__ATOMIC_ACQUIRE, "agent");
      xb_add(&bar[XB_XGEN(b.x)], 1u);
      asm volatile("s_waitcnt vmcnt(0)" ::: "memory");
    } else {
      XB_SPIN(xb_ld(&bar[XB_XGEN(b.x)]) == gen, bar);
      __builtin_amdgcn_fence(__ATOMIC_ACQUIRE, "agent");
      asm volatile("s_waitcnt vmcnt(0)" ::: "memory");
    }
  }
  __syncthreads();
}

__global__ void __launch_bounds__(256, 2) yoco_megakernel(P p) {
  __shared__ __attribute__((aligned(16))) char smem[65520];
  __shared__ uint4 xb_words;
  cg::grid_group grid = cg::this_grid();
  if (threadIdx.x == 0) xb_words = make_uint4(0u, 0u, 0u, 0u);
  if (blockIdx.x == 0) { for (int i = threadIdx.x; i < XCD_BAR_WORDS; i += 256) __hip_atomic_store(p.bar + i, 0u, __ATOMIC_RELAXED, __HIP_MEMORY_SCOPE_AGENT); }
  prep_phase(p, smem);
  grid.sync();
  const XcdBarrier xb = xcd_barrier_post(p.bar, (volatile LAS unsigned*)&xb_words);
  u16* Mbuf = (u16*)p.BIG;
  u16* Fbuf = (u16*)(p.BIG + ((size_t)180 << 20));
  u16* PB = (u16*)p.BIG;
  u16* XRA = (u16*)p.y;
  u16* XRB = p.XB;
  for (int i = 0; i < 4; ++i) {
    const float* gn = p.g_norms + i * 4 * D;
    u16* cur = (i & 1) ? XRB : XRA;
    u16* nxt = (i == 3) ? nullptr : ((i & 1) ? XRA : XRB);
    if (i == 0) {
      rowop_phase(p, true, nullptr, nullptr, gn, p.XB, nullptr, nullptr, nullptr);
      xcd_barrier(xb);
    }
    if (i < 2) {
      REPG gemm_phase<0>(p, i ? cur : p.XB, 1024, p.wt_in_a + (size_t)i * 4096 * 1024, 4096, p.BIG, smem, i ? p.ss : nullptr);
      xcd_barrier(xb);
      gla_state_phase(p, i, smem);
      xcd_barrier(xb);
      for (int _r = 0; _r < REP_GLA; ++_r) gla_phase(p, i, smem);
      xcd_barrier(xb);
      REPG gemm_phase<2>(p, p.OG, 1024, p.wt_out_a + (size_t)i * 1024 * 1024, 1024, Mbuf, smem);
      xcd_barrier(xb);
    } else {
      if (i == 2) gemm_phase<3>(p, cur, 1024, p.wt_kv, 2048, nullptr, smem, p.ss);
      REPG gemm_phase<1>(p, cur, 1024, p.wt_q + (size_t)(i - 2) * 1024 * 1024, 1024, p.BIG, smem, p.ss);
      if (i == 2) xcd_barrier(xb);
      kvconv_phase(p);
      xcd_barrier(xb);
      for (int _r = 0; _r < REP_ATTN; ++_r) attn_phase(p, i, smem);
      xcd_barrier(xb);
      REPG gemm_phase<2>(p, p.OG, 1024, p.wt_out_b + (size_t)(i - 2) * 1024 * 1024, 1024, Mbuf, smem);
      xcd_barrier(xb);
    }
    rowop2_phase(p, i == 0, cur, Mbuf, gn + D, p.ss2, nullptr, nullptr, nullptr);
    xcd_barrier(xb);
    REPG ffn_in_phase(p, i, cur, smem);
    xcd_barrier(xb);
    REPG gemm_phase<2>(p, (const u16*)p.BIG, DFF, p.wt_ffn_out + (size_t)i * 1024 * DFF, 1024, Fbuf, smem);
    xcd_barrier(xb);
    rowop2_phase(p, false, cur, Fbuf, gn + 3 * D, nullptr, p.p_prompt + (size_t)i * ROWS_P * 256, p.p_sample + (size_t)i * 256 * 256, PB);
    xcd_barrier(xb);
    ple_phase(p, i, cur, nxt, smem);
    xcd_barrier(xb);
  }
}

extern "C" void kernel_launch(void* const* d_in, const int* in_sizes, int n_in, void* d_out, int out_size, void* d_ws,
                              size_t ws_size, hipStream_t stream) {
  static int grid_blocks = 0;
  if (!grid_blocks) {
    int dev = 0, cus = 0, per_cu = 0;
    hipGetDevice(&dev);
    hipDeviceGetAttribute(&cus, hipDeviceAttributeMultiprocessorCount, dev);
    hipOccupancyMaxActiveBlocksPerMultiprocessor(&per_cu, yoco_megakernel, 256, 0);
    if (per_cu > 2) per_cu = 2;
    grid_blocks = cus * per_cu;
    grid_blocks &= ~7;
  }
  P p{};
  const float* const* in = (const float* const*)d_in;
  p.x_prompt = in[0]; p.x_sample = in[1]; p.cache_k = in[2]; p.cache_v = in[3]; p.state_hgrn = in[4]; p.state_conv = in[5];
  p.p_prompt = in[6]; p.p_sample = in[7];
  p.g_norms = in[8]; const float* w_in_a = in[9]; p.lb_raw = in[10]; p.g_hg = in[11]; const float* w_out_a = in[12]; p.g_kv = in[13];
  const float* w_kv = in[14]; p.rel_bias = in[15]; const float* w_q_b = in[16]; p.lam_b = in[17]; p.g_subln = in[18];
  const float* w_out_b = in[19]; const float* w_ffn_in = in[20]; p.conv_w = in[21]; p.conv_b = in[22]; const float* w_ffn_out = in[23];
  const float* w_ple = in[24]; const float* w_ple_gate = in[25];
  float* o = (float*)d_out;
  p.y = o; o += (size_t)ROWS * D;
  p.k_prompt = o; o += (size_t)ROWS_P * D;
  p.v_prompt = o; o += (size_t)ROWS_P * D;
  p.k_sample = o; o += (size_t)256 * D;
  p.v_sample = o; o += (size_t)256 * D;
  p.hgrn_prompt = o; o += (size_t)2 * 16 * 8 * 16384;
  p.hgrn_sample = o; o += (size_t)2 * 8 * 8 * 16384;
  p.conv_prompt = o; o += (size_t)4 * 16 * 2 * DFF;
  p.conv_sample = o;
  u16* ws = (u16*)d_ws;
  p.wt_in_a = ws; ws += (size_t)2 * 4096 * 1024;
  p.wt_out_a = ws; ws += (size_t)2 * 1024 * 1024;
  p.wt_kv = ws; ws += (size_t)2048 * 1024;
  p.wt_q = ws; ws += (size_t)2 * 1024 * 1024;
  p.wt_out_b = ws; ws += (size_t)2 * 1024 * 1024;
  p.wt_ffn_in = ws; ws += (size_t)4 * 5632 * 1024;
  p.wt_ffn_out = ws; ws += (size_t)4 * 1024 * DFF;
  p.wt_ple = ws; ws += (size_t)4 * 1024 * 256;
  p.wt_gate = ws; ws += (size_t)4 * 1024 * 1024;
  p.XB = ws; ws += (size_t)ROWS * 1024;
  p.OG = ws; ws += (size_t)ROWS * 1024;
  p.BIG = (char*)ws;
  p.bar = (unsigned*)((char*)d_ws + ((size_t)500 << 20));
  p.ss = (float*)((char*)d_ws + ((size_t)501 << 20));
  p.ss2 = (float*)((char*)d_ws + ((size_t)504 << 20));
  int n = 0;
  for (int i = 0; i < 2; ++i) p.wd[n++] = WD{w_in_a + (size_t)i * 1024 * 4096, p.wt_in_a + (size_t)i * 4096 * 1024, i ? p.g_norms + 4 * D : nullptr, 1024, 4096, 0, 0};
  for (int i = 0; i < 2; ++i) p.wd[n++] = WD{w_out_a + (size_t)i * 1024 * 1024, p.wt_out_a + (size_t)i * 1024 * 1024, nullptr, 1024, 1024, 0, 0};
  p.wd[n++] = WD{w_kv, p.wt_kv, p.g_kv, 1024, 2048, 0, 0};
  for (int i = 0; i < 2; ++i) p.wd[n++] = WD{w_q_b + (size_t)i * 1024 * 1024, p.wt_q + (size_t)i * 1024 * 1024, p.g_norms + (size_t)(i + 2) * 4 * D, 1024, 1024, 0, 0};
  for (int i = 0; i < 2; ++i) p.wd[n++] = WD{w_out_b + (size_t)i * 1024 * 1024, p.wt_out_b + (size_t)i * 1024 * 1024, nullptr, 1024, 1024, 0, 0};
  for (int i = 0; i < 4; ++i) p.wd[n++] = WD{w_ffn_in + (size_t)i * 1024 * 5632, p.wt_ffn_in + (size_t)i * 5632 * 1024, p.g_norms + (size_t)(i * 4 + 2) * D, 1024, 5632, 1, 0};
  for (int i = 0; i < 4; ++i) p.wd[n++] = WD{w_ffn_out + (size_t)i * DFF * 1024, p.wt_ffn_out + (size_t)i * 1024 * DFF, nullptr, DFF, 1024, 0, 0};
  for (int i = 0; i < 4; ++i) p.wd[n++] = WD{w_ple + (size_t)i * 256 * 1024, p.wt_ple + (size_t)i * 1024 * 256, nullptr, 256, 1024, 0, 0};
  for (int i = 0; i < 4; ++i) p.wd[n++] = WD{w_ple_gate + (size_t)i * 1024 * 1024, p.wt_gate + (size_t)i * 1024 * 1024, nullptr, 1024, 1024, 0, 0};
  void* args[] = {&p};
  hipError_t e = hipLaunchCooperativeKernel((void*)yoco_megakernel, dim3(grid_blocks), dim3(256), args, 0, stream);
  if (e != hipSuccess) fprintf(stderr, "cooperative launch failed: %s (grid %d)\n", hipGetErrorString(e), grid_blocks);
}
```

```cpp
#include <hip/hip_runtime.h>
#include <hip/hip_cooperative_groups.h>
#include <cstdio>
namespace cg = cooperative_groups;

#define DI __device__ __forceinline__
typedef unsigned short u16;
typedef short bf16x8 __attribute__((ext_vector_type(8)));
typedef float f32x16 __attribute__((ext_vector_type(16)));
typedef float f32x4 __attribute__((ext_vector_type(4)));
typedef __bf16 bf2_t __attribute__((ext_vector_type(2)));
typedef float f2_t __attribute__((ext_vector_type(2)));
typedef unsigned u32x2 __attribute__((ext_vector_type(2)));
typedef unsigned u32x4 __attribute__((ext_vector_type(4)));

constexpr int D = 1024, ROWS_P = 32768, ROWS = 33024, DFF = 2816;
constexpr float EPS = 1e-6f;
constexpr float LOG2E = 1.4426950408889634f;
constexpr int NW = 25;
#ifndef REP_GEMM
#define REP_GEMM 1
#endif
#ifndef REP_GLA
#define REP_GLA 1
#endif
#ifndef REP_ATTN
#define REP_ATTN 1
#endif
#define REPG for (int _r = 0; _r < REP_GEMM; ++_r)

struct WD { const float* src; u16* dst; const float* gain; int K, N, mode, pad; };

struct P {
  const float *x_prompt, *x_sample, *cache_k, *cache_v, *state_hgrn, *state_conv, *p_prompt, *p_sample;
  const float *g_norms, *lb_raw, *g_hg, *g_kv, *rel_bias, *lam_b, *g_subln, *conv_w, *conv_b;
  float *y, *k_prompt, *v_prompt, *k_sample, *v_sample, *hgrn_prompt, *hgrn_sample, *conv_prompt, *conv_sample;
  u16 *wt_in_a, *wt_out_a, *wt_kv, *wt_q, *wt_out_b, *wt_ffn_in, *wt_ffn_out, *wt_ple, *wt_gate;
  u16 *XB, *OG; char* BIG; unsigned* bar; float* ss; float* ss2;
  WD wd[NW];
};

DI unsigned pk2(float a, float b) { f2_t v = {a, b}; bf2_t r = __builtin_convertvector(v, bf2_t); return __builtin_bit_cast(unsigned, r); }
DI int lbid() { int b = blockIdx.x; asm volatile("" : "+s"(b)); return b; }
DI int ltid() { int t = threadIdx.x; asm volatile("" : "+v"(t)); return t; }
DI float bf2f(u16 x) { return __uint_as_float(((unsigned)x) << 16); }
DI float bflo(unsigned x) { return __uint_as_float(x << 16); }
DI float bfhi(unsigned x) { return __uint_as_float(x & 0xffff0000u); }
DI float sigm(float x) { return 1.f / (1.f + __expf(-x)); }
DI float wave_sum(float v) {
#pragma unroll
  for (int o = 32; o; o >>= 1) v += __shfl_xor(v, o);
  return v;
}
DI bf16x8 mk8(u32x2 lo, u32x2 hi) { u32x4 t = {lo[0], lo[1], hi[0], hi[1]}; return __builtin_bit_cast(bf16x8, t); }
DI bf16x8 mk8u(unsigned a, unsigned b, unsigned c, unsigned d) { u32x4 t = {a, b, c, d}; return __builtin_bit_cast(bf16x8, t); }

DI void prep_tile_info(const P& p, int flat, int& wi, int& k0, int& n0) {
  int base = 0; wi = 0;
  for (;;) { int nt = (p.wd[wi].K >> 6) * (p.wd[wi].N >> 6); if (flat < base + nt) break; base += nt; ++wi; }
  const int tix = flat - base, ntn = p.wd[wi].N >> 6;
  k0 = (tix / ntn) << 6; n0 = (tix % ntn) << 6;
}
DI void prep_phase(const P& p, char* smem) {
  float* T = (float*)smem;
  const int tid = ltid();
  int total = 0;
  for (int i = 0; i < NW; ++i) total += (p.wd[i].K >> 6) * (p.wd[i].N >> 6);
  const int n = tid & 63, kb = tid >> 6;
  float v[16];
  int flat = lbid();
  int wi = 0, k0 = 0, n0 = 0;
  if (flat < total) {
    prep_tile_info(p, flat, wi, k0, n0);
    const WD& d = p.wd[wi];
#pragma unroll
    for (int j = 0; j < 16; ++j) { const int kk = kb + 4 * j; v[j] = d.src[(size_t)(k0 + kk) * d.N + n0 + n]; if (d.gain) v[j] *= d.gain[k0 + kk]; }
  }
  for (; flat < total; flat += gridDim.x) {
    const WD& d = p.wd[wi];
    const int ck0 = k0, cn0 = n0;
#pragma unroll
    for (int j = 0; j < 16; ++j) T[(kb + 4 * j) * 65 + n] = v[j];
    const int nf = flat + gridDim.x;
    if (nf < total) {
      prep_tile_info(p, nf, wi, k0, n0);
      const WD& d2 = p.wd[wi];
#pragma unroll
      for (int j = 0; j < 16; ++j) { const int kk = kb + 4 * j; v[j] = d2.src[(size_t)(k0 + kk) * d2.N + n0 + n]; if (d2.gain) v[j] *= d2.gain[k0 + kk]; }
    }
    __syncthreads();
    {
      const int nn = tid >> 2, ks = tid & 3;
      int nc = cn0 + nn, drow = nc;
      if (d.mode == 1) { int isu = nc >= DFF; int ch = nc - DFF * isu; drow = 256 * (ch >> 7) + 64 * ((ch >> 5) & 3) + 32 * isu + (ch & 31); }
      unsigned o[8];
#pragma unroll
      for (int j = 0; j < 8; ++j) o[j] = pk2(T[(16 * ks + 2 * j) * 65 + nn], T[(16 * ks + 2 * j + 1) * 65 + nn]);
      u16* fb = d.dst + (((size_t)(drow >> 5) * (d.K >> 4) + ((ck0 >> 4) + ks)) * 64 + (drow & 31)) * 8;
      *(u32x4*)(fb) = (u32x4){o[0], o[1], o[2], o[3]};
      *(u32x4*)(fb + 256) = (u32x4){o[4], o[5], o[6], o[7]};
    }
    __syncthreads();
  }
}

DI void rowop_phase(const P& p, bool x_from_in, const u16* __restrict__ Madd, const float* __restrict__ gpost,
                    const float* __restrict__ gnext, u16* __restrict__ outH, const float* ple_p, const float* ple_s, u16* outP) {
  const int tidr = ltid();
  const int lane = tidr & 63;
  const int wave = (lbid() * blockDim.x + tidr) >> 6;
  const int nwave = (gridDim.x * blockDim.x) >> 6;
  for (int rb = wave * 2; rb < ROWS; rb += nwave * 2) {
    f32x4 x[2][4];
    u32x2 m[2][4];
#pragma unroll
    for (int u = 0; u < 2; ++u) {
      const int r = rb + u;
      const float* xs = x_from_in ? (r < ROWS_P ? p.x_prompt + (size_t)r * D : p.x_sample + (size_t)(r - ROWS_P) * D) : p.y + (size_t)r * D;
#pragma unroll
      for (int j = 0; j < 4; ++j) x[u][j] = *(const f32x4*)(xs + 4 * lane + 256 * j);
      if (Madd) {
#pragma unroll
        for (int j = 0; j < 4; ++j) m[u][j] = *(const u32x2*)(Madd + (size_t)r * D + 4 * lane + 256 * j);
      }
    }
#pragma unroll
    for (int u = 0; u < 2; ++u) {
      const int r = rb + u;
      if (Madd) {
        f32x4 mf[4]; float ss = 0.f;
#pragma unroll
        for (int j = 0; j < 4; ++j) { mf[j] = (f32x4){bflo(m[u][j][0]), bfhi(m[u][j][0]), bflo(m[u][j][1]), bfhi(m[u][j][1])}; ss += mf[j][0] * mf[j][0] + mf[j][1] * mf[j][1] + mf[j][2] * mf[j][2] + mf[j][3] * mf[j][3]; }
        ss = wave_sum(ss);
        const float rs = rsqrtf(ss * (1.f / D) + EPS);
#pragma unroll
        for (int j = 0; j < 4; ++j) { f32x4 g = *(const f32x4*)(gpost + 4 * lane + 256 * j); x[u][j] += mf[j] * rs * g; }
#pragma unroll
        for (int j = 0; j < 4; ++j) *(f32x4*)(p.y + (size_t)r * D + 4 * lane + 256 * j) = x[u][j];
      }
      float rx = 1.f;
      if (gnext) {
        float ss = 0.f;
#pragma unroll
        for (int j = 0; j < 4; ++j) ss += x[u][j][0] * x[u][j][0] + x[u][j][1] * x[u][j][1] + x[u][j][2] * x[u][j][2] + x[u][j][3] * x[u][j][3];
        ss = wave_sum(ss);
        rx = rsqrtf(ss * (1.f / D) + EPS);
      }
#pragma unroll
      for (int j = 0; j < 4; ++j) {
        f32x4 h = x[u][j] * rx;
        if (gnext) h *= *(const f32x4*)(gnext + 4 * lane + 256 * j);
        *(u32x2*)(outH + (size_t)r * D + 4 * lane + 256 * j) = (u32x2){pk2(h[0], h[1]), pk2(h[2], h[3])};
      }
      if (outP) {
        const float* ps = r < ROWS_P ? ple_p + (size_t)r * 256 : ple_s + (size_t)(r - ROWS_P) * 256;
        f32x4 v = *(const f32x4*)(ps + 4 * lane);
        *(u32x2*)(outP + (size_t)r * 256 + 4 * lane) = (u32x2){pk2(v[0], v[1]), pk2(v[2], v[3])};
      }
    }
  }
}

DI void rowop2_phase(const P& p, bool x_from_in, u16* __restrict__ XR, const u16* __restrict__ Madd, const float* __restrict__ gpost,
                     float* __restrict__ ssout, const float* ple_p, const float* ple_s, u16* outP) {
  const int tidr = ltid();
  const int lane = tidr & 63;
  const int wave = (lbid() * blockDim.x + tidr) >> 6;
  const int nwave = (gridDim.x * blockDim.x) >> 6;
  for (int rb = wave * 2; rb < ROWS; rb += nwave * 2) {
    f32x4 x[2][4];
    u32x2 m[2][4];
#pragma unroll
    for (int u = 0; u < 2; ++u) {
      const int r = rb + u;
      if (x_from_in) {
        const float* xs = r < ROWS_P ? p.x_prompt + (size_t)r * D : p.x_sample + (size_t)(r - ROWS_P) * D;
#pragma unroll
        for (int j = 0; j < 4; ++j) x[u][j] = *(const f32x4*)(xs + 4 * lane + 256 * j);
      } else {
#pragma unroll
        for (int j = 0; j < 4; ++j) { const u32x2 t = *(const u32x2*)(XR + (size_t)r * D + 4 * lane + 256 * j); x[u][j] = (f32x4){bflo(t[0]), bfhi(t[0]), bflo(t[1]), bfhi(t[1])}; }
      }
#pragma unroll
      for (int j = 0; j < 4; ++j) m[u][j] = *(const u32x2*)(Madd + (size_t)r * D + 4 * lane + 256 * j);
    }
#pragma unroll
    for (int u = 0; u < 2; ++u) {
      const int r = rb + u;
      f32x4 mf[4]; float ss = 0.f;
#pragma unroll
      for (int j = 0; j < 4; ++j) { mf[j] = (f32x4){bflo(m[u][j][0]), bfhi(m[u][j][0]), bflo(m[u][j][1]), bfhi(m[u][j][1])}; ss += mf[j][0] * mf[j][0] + mf[j][1] * mf[j][1] + mf[j][2] * mf[j][2] + mf[j][3] * mf[j][3]; }
      ss = wave_sum(ss);
      const float rs = rsqrtf(ss * (1.f / D) + EPS);
      float sx = 0.f;
#pragma unroll
      for (int j = 0; j < 4; ++j) {
        const f32x4 g = *(const f32x4*)(gpost + 4 * lane + 256 * j);
        const f32x4 xn = x[u][j] + mf[j] * rs * g;
        const u32x2 o = (u32x2){pk2(xn[0], xn[1]), pk2(xn[2], xn[3])};
        *(u32x2*)(XR + (size_t)r * D + 4 * lane + 256 * j) = o;
        const float q0 = bflo(o[0]), q1 = bfhi(o[0]), q2 = bflo(o[1]), q3 = bfhi(o[1]);
        sx += q0 * q0 + q1 * q1 + q2 * q2 + q3 * q3;
      }
      if (ssout) { sx = wave_sum(sx); if (lane == 0) ssout[r] = sx; }
      if (outP) {
        const float* ps = r < ROWS_P ? ple_p + (size_t)r * 256 : ple_s + (size_t)(r - ROWS_P) * 256;
        f32x4 v = *(const f32x4*)(ps + 4 * lane);
        *(u32x2*)(outP + (size_t)r * 256 + 4 * lane) = (u32x2){pk2(v[0], v[1]), pk2(v[2], v[3])};
      }
    }
  }
}

template <class RowMap>
DI void gemm_core(const u16* __restrict__ A, int lda, RowMap rm, const u16* __restrict__ Bt, int n0, int K,
                  f32x16 (&acc)[4][2], char* smem, const int tid) {
  const int l = tid & 63, w = tid >> 6, l32 = l & 31, hh = l >> 5;
  const int lr = tid >> 3, lc = tid & 7;
  const u16* ap[4];
#pragma unroll
  for (int q = 0; q < 4; ++q) ap[q] = A + (size_t)rm(q * 32 + lr) * lda + lc * 8;
  const u16* bq0 = Bt + ((size_t)((n0 + w * 64) >> 5) * (K >> 4) * 64 + l) * 8;
  const u16* bq1 = bq0 + (size_t)(K >> 4) * 512;
  const unsigned woff = lr * 144 + lc * 16;
  const unsigned aoff = l32 * 144 + hh * 16;
  u32x4 ra0[4];
  bf16x8 bf0[4], bf1[4];
  const int nk = K >> 6;
#define GLOADA(RA, T) _Pragma("unroll") for (int q = 0; q < 4; ++q) { RA[q] = *(const u32x4*)(ap[q] + (T) * 64); }
#define SWRITEA(RA, BUF) { char* db_ = smem + (BUF) * 18432; _Pragma("unroll") for (int q = 0; q < 4; ++q) { *(u32x4*)(db_ + woff + q * 4608) = RA[q]; } }
#define COMPUTE(BUF, TN, MORE) { const char* sb = smem + (BUF) * 18432; _Pragma("unroll") for (int ks = 0; ks < 4; ++ks) { \
      const unsigned co = ks * 32; \
      bf16x8 a0 = *(const bf16x8*)(sb + aoff + co); \
      bf16x8 a1 = *(const bf16x8*)(sb + aoff + 4608 + co); \
      bf16x8 a2 = *(const bf16x8*)(sb + aoff + 9216 + co); \
      bf16x8 a3 = *(const bf16x8*)(sb + aoff + 13824 + co); \
      acc[0][0] = __builtin_amdgcn_mfma_f32_32x32x16_bf16(bf0[ks], a0, acc[0][0], 0, 0, 0); \
      acc[0][1] = __builtin_amdgcn_mfma_f32_32x32x16_bf16(bf1[ks], a0, acc[0][1], 0, 0, 0); \
      acc[1][0] = __builtin_amdgcn_mfma_f32_32x32x16_bf16(bf0[ks], a1, acc[1][0], 0, 0, 0); \
      acc[1][1] = __builtin_amdgcn_mfma_f32_32x32x16_bf16(bf1[ks], a1, acc[1][1], 0, 0, 0); \
      acc[2][0] = __builtin_amdgcn_mfma_f32_32x32x16_bf16(bf0[ks], a2, acc[2][0], 0, 0, 0); \
      acc[2][1] = __builtin_amdgcn_mfma_f32_32x32x16_bf16(bf1[ks], a2, acc[2][1], 0, 0, 0); \
      acc[3][0] = __builtin_amdgcn_mfma_f32_32x32x16_bf16(bf0[ks], a3, acc[3][0], 0, 0, 0); \
      acc[3][1] = __builtin_amdgcn_mfma_f32_32x32x16_bf16(bf1[ks], a3, acc[3][1], 0, 0, 0); \
      if (MORE) { bf0[ks] = *(const bf16x8*)(bq0 + ((TN) * 4 + ks) * 512); bf1[ks] = *(const bf16x8*)(bq1 + ((TN) * 4 + ks) * 512); } \
      __builtin_amdgcn_sched_barrier(0); } }
  GLOADA(ra0, 0);
#pragma unroll
  for (int ks = 0; ks < 4; ++ks) { bf0[ks] = *(const bf16x8*)(bq0 + ks * 512); bf1[ks] = *(const bf16x8*)(bq1 + ks * 512); }
  SWRITEA(ra0, 0);
  __syncthreads();
  for (int kt = 0; kt < nk; kt += 2) {
    GLOADA(ra0, kt + 1);
    __builtin_amdgcn_sched_barrier(0);
    COMPUTE(0, kt + 1, true);
    SWRITEA(ra0, 1);
    __syncthreads();
    if (kt + 2 < nk) GLOADA(ra0, kt + 2);
    __builtin_amdgcn_sched_barrier(0);
    COMPUTE(1, kt + 2, kt + 2 < nk);
    if (kt + 2 < nk) SWRITEA(ra0, 0);
    __syncthreads();
  }
#undef GLOADA
#undef SWRITEA
#undef COMPUTE
}

template <class RowMap>
DI void gemm_core_n1(const u16* __restrict__ A, int lda, RowMap rm, const u16* __restrict__ Bt, int n0, int K,
                     f32x16 (&acc)[4], char* smem, const int tid) {
  const int l = tid & 63, w = tid >> 6, l32 = l & 31, hh = l >> 5;
  const int lr = tid >> 3, lc = tid & 7;
  const u16* ap[4];
#pragma unroll
  for (int q = 0; q < 4; ++q) ap[q] = A + (size_t)rm(q * 32 + lr) * lda + lc * 8;
  const u16* bq0 = Bt + ((size_t)((n0 + w * 32) >> 5) * (K >> 4) * 64 + l) * 8;
  const unsigned woff = lr * 144 + lc * 16;
  const unsigned aoff = l32 * 144 + hh * 16;
  u32x4 ra0[4];
  bf16x8 bf0[4];
  const int nk = K >> 6;
#define GLOADA(RA, T) _Pragma("unroll") for (int q = 0; q < 4; ++q) { RA[q] = *(const u32x4*)(ap[q] + (T) * 64); }
#define SWRITEA(RA, BUF) { char* db_ = smem + (BUF) * 18432; _Pragma("unroll") for (int q = 0; q < 4; ++q) { *(u32x4*)(db_ + woff + q * 4608) = RA[q]; } }
#define COMPUTE(BUF, TN, MORE) { const char* sb = smem + (BUF) * 18432; _Pragma("unroll") for (int ks = 0; ks < 4; ++ks) { \
      const unsigned co = ks * 32; \
      bf16x8 a0 = *(const bf16x8*)(sb + aoff + co); \
      bf16x8 a1 = *(const bf16x8*)(sb + aoff + 4608 + co); \
      bf16x8 a2 = *(const bf16x8*)(sb + aoff + 9216 + co); \
      bf16x8 a3 = *(const bf16x8*)(sb + aoff + 13824 + co); \
      acc[0] = __builtin_amdgcn_mfma_f32_32x32x16_bf16(bf0[ks], a0, acc[0], 0, 0, 0); \
      acc[1] = __builtin_amdgcn_mfma_f32_32x32x16_bf16(bf0[ks], a1, acc[1], 0, 0, 0); \
      acc[2] = __builtin_amdgcn_mfma_f32_32x32x16_bf16(bf0[ks], a2, acc[2], 0, 0, 0); \
      acc[3] = __builtin_amdgcn_mfma_f32_32x32x16_bf16(bf0[ks], a3, acc[3], 0, 0, 0); \
      if (MORE) { bf0[ks] = *(const bf16x8*)(bq0 + ((TN) * 4 + ks) * 512); } \
      __builtin_amdgcn_sched_barrier(0); } }
  GLOADA(ra0, 0);
#pragma unroll
  for (int ks = 0; ks < 4; ++ks) bf0[ks] = *(const bf16x8*)(bq0 + ks * 512);
  SWRITEA(ra0, 0);
  __syncthreads();
  for (int kt = 0; kt < nk; kt += 2) {
    GLOADA(ra0, kt + 1);
    __builtin_amdgcn_sched_barrier(0);
    COMPUTE(0, kt + 1, true);
    SWRITEA(ra0, 1);
    __syncthreads();
    if (kt + 2 < nk) GLOADA(ra0, kt + 2);
    __builtin_amdgcn_sched_barrier(0);
    COMPUTE(1, kt + 2, kt + 2 < nk);
    if (kt + 2 < nk) SWRITEA(ra0, 0);
    __syncthreads();
  }
#undef GLOADA
#undef SWRITEA
#undef COMPUTE
}

template <class RowMap>
DI void gemm_core_mini(const u16* __restrict__ A, int lda, RowMap rm, const u16* __restrict__ Bt, int n0, int K,
                       f32x16 (&acc)[2], char* smem, const int tid) {
  const int l = tid & 63, w = tid >> 6, l32 = l & 31, hh = l >> 5;
  const int lr = tid >> 3, lc = tid & 7;
  const u16* ap[4];
#pragma unroll
  for (int q = 0; q < 4; ++q) ap[q] = A + (size_t)rm(q * 32 + lr) * lda + lc * 8;
  const u16* bq0 = Bt + ((size_t)(n0 >> 5) * (K >> 4) * 64 + l) * 8;
  const u16* bq1 = bq0 + (size_t)(K >> 4) * 512;
  const unsigned woff = lr * 144 + lc * 16;
  const unsigned aoff = (w * 32 + l32) * 144 + hh * 16;
  u32x4 ra0[4];
  bf16x8 bf0[4], bf1[4];
  const int nk = K >> 6;
#define GLOADA(RA, T) _Pragma("unroll") for (int q = 0; q < 4; ++q) { RA[q] = *(const u32x4*)(ap[q] + (T) * 64); }
#define SWRITEA(RA, BUF) { char* db_ = smem + (BUF) * 18432; _Pragma("unroll") for (int q = 0; q < 4; ++q) { *(u32x4*)(db_ + woff + q * 4608) = RA[q]; } }
#define COMPUTE(BUF, TN, MORE) { const char* sb = smem + (BUF) * 18432; _Pragma("unroll") for (int ks = 0; ks < 4; ++ks) { \
      const unsigned co = ks * 32; \
      bf16x8 a0 = *(const bf16x8*)(sb + aoff + co); \
      acc[0] = __builtin_amdgcn_mfma_f32_32x32x16_bf16(bf0[ks], a0, acc[0], 0, 0, 0); \
      acc[1] = __builtin_amdgcn_mfma_f32_32x32x16_bf16(bf1[ks], a0, acc[1], 0, 0, 0); \
      if (MORE) { bf0[ks] = *(const bf16x8*)(bq0 + ((TN) * 4 + ks) * 512); bf1[ks] = *(const bf16x8*)(bq1 + ((TN) * 4 + ks) * 512); } \
      __builtin_amdgcn_sched_barrier(0); } }
  GLOADA(ra0, 0);
#pragma unroll
  for (int ks = 0; ks < 4; ++ks) { bf0[ks] = *(const bf16x8*)(bq0 + ks * 512); bf1[ks] = *(const bf16x8*)(bq1 + ks * 512); }
  SWRITEA(ra0, 0);
  __syncthreads();
  for (int kt = 0; kt < nk; kt += 2) {
    GLOADA(ra0, kt + 1);
    __builtin_amdgcn_sched_barrier(0);
    COMPUTE(0, kt + 1, true);
    SWRITEA(ra0, 1);
    __syncthreads();
    if (kt + 2 < nk) GLOADA(ra0, kt + 2);
    __builtin_amdgcn_sched_barrier(0);
    COMPUTE(1, kt + 2, kt + 2 < nk);
    if (kt + 2 < nk) SWRITEA(ra0, 0);
    __syncthreads();
  }
#undef GLOADA
#undef SWRITEA
#undef COMPUTE
}

DI bool next_tile(int it, int ntm, int ntn, int& tm, int& tn) {
  const int b = lbid(), x = b & 7, slot = b >> 3, S = gridDim.x >> 3;
  const int nq = (ntm - x + 7) >> 3;
  const int L = slot + it * S;
  if (L >= nq * ntn) return false;
  const int gsize = 8 * ntn;
  const int grp = L / gsize, r = L - grp * gsize;
  const int gsz = min(8, nq - 8 * grp);
  tn = r / gsz;
  tm = x + 8 * (8 * grp + r % gsz);
  return true;
}

DI void list_entry(int L, int ntm, int ntn, int& tm, int& tn) {
  const int x = lbid() & 7;
  const int nq = (ntm - x + 7) >> 3;
  const int gsize = 8 * ntn;
  const int grp = L / gsize, r = L - grp * gsize;
  const int gsz = min(8, nq - 8 * grp);
  tn = r / gsz;
  tm = x + 8 * (8 * grp + r % gsz);
}
DI void list_info(int ntm, int ntn, int& full, int& nleft) {
  const int x = lbid() & 7, S = gridDim.x >> 3;
  const int len = ((ntm - x + 7) >> 3) * ntn;
  full = (len / S) * S;
  nleft = len - full;
  if (4 * nleft > S) { full = len; nleft = 0; }
}

struct IdMap { int base; DI int operator()(int r) const { return base + r; } };
struct ClampMap { int rowbase, t0, T; DI int operator()(int r) const { int t = t0 + r; t = t < 0 ? 0 : (t > T - 1 ? T - 1 : t); return rowbase + t; } };
struct ClampMap2 { int rowbase, t0, T, srow; DI int operator()(int r) const { if (srow >= 0 && r >= 64) { int t = r - 66; t = t < 0 ? 0 : (t > 31 ? 31 : t); return srow + t; } int t = t0 + r; t = t < 0 ? 0 : (t > T - 1 ? T - 1 : t); return rowbase + t; } };

#define ZERO_ACC(a) _Pragma("unroll") for (int _i = 0; _i < 4; ++_i) _Pragma("unroll") for (int _j = 0; _j < 2; ++_j) _Pragma("unroll") for (int _e = 0; _e < 16; ++_e) a[_i][_j][_e] = 0.f;

DI float row_rs(const float* rowss, int m) {
  const f32x4* sp = (const f32x4*)(rowss + (size_t)m * 32);
  float tot = 0.f;
#pragma unroll
  for (int j = 0; j < 8; ++j) { const f32x4 s = sp[j]; tot += (s[0] + s[1]) + (s[2] + s[3]); }
  return rsqrtf(tot * (1.f / D) + EPS);
}
template <int EPI>
DI void epi4(const P& p, void* outp, int m, int n, float v0, float v1, float v2, float v3) {
  if (EPI == 0) {
    const int sec = n >> 10;
    if (sec == 0 || sec == 3) { v0 *= sigm(v0); v1 *= sigm(v1); v2 *= sigm(v2); v3 *= sigm(v3); }
    *(u32x2*)((u16*)outp + (size_t)m * 4096 + n) = (u32x2){pk2(v0, v1), pk2(v2, v3)};
  } else if (EPI == 1) {
    const float sc = 0.125f * LOG2E;
    *(u32x2*)((u16*)outp + (size_t)m * 1024 + n) = (u32x2){pk2(v0 * sc, v1 * sc), pk2(v2 * sc, v3 * sc)};
  } else if (EPI == 2) {
    *(u32x2*)((u16*)outp + (size_t)m * 1024 + n) = (u32x2){pk2(v0, v1), pk2(v2, v3)};
  } else {
    float* dst;
    if (n < 1024) dst = (m < ROWS_P ? p.k_prompt + (size_t)m * 1024 : p.k_sample + (size_t)(m - ROWS_P) * 1024) + n;
    else dst = (m < ROWS_P ? p.v_prompt + (size_t)m * 1024 : p.v_sample + (size_t)(m - ROWS_P) * 1024) + (n - 1024);
    *(f32x4*)dst = (f32x4){v0, v1, v2, v3};
  }
}
template <int EPI>
DI void gemm_phase(const P& p, const u16* A, int K, const u16* Bt, int N, void* outp, char* smem, const float* rowss = nullptr) {
  const int tid = ltid(), l = tid & 63, w = tid >> 6, l32 = l & 31, hh = l >> 5;
  const int ntm = ROWS / 128, ntn = N / 256;
  const int slot = lbid() >> 3, S = gridDim.x >> 3;
  int full, nleft, tm, tn;
  list_info(ntm, ntn, full, nleft);
  for (int L = slot; L < full; L += S) {
    list_entry(L, ntm, ntn, tm, tn);
    f32x16 acc[4][2];
    ZERO_ACC(acc);
    gemm_core(A, K, IdMap{tm * 128}, Bt, tn * 256, K, acc, smem, ltid());
#pragma unroll
    for (int mi = 0; mi < 4; ++mi) {
      const int m = tm * 128 + mi * 32 + l32;
      float rsc = 1.f;
      if (rowss) rsc = row_rs(rowss, m);
#pragma unroll
      for (int ni = 0; ni < 2; ++ni)
#pragma unroll
        for (int q = 0; q < 4; ++q)
          epi4<EPI>(p, outp, m, tn * 256 + w * 64 + ni * 32 + 8 * q + 4 * hh,
                    acc[mi][ni][4 * q] * rsc, acc[mi][ni][4 * q + 1] * rsc, acc[mi][ni][4 * q + 2] * rsc, acc[mi][ni][4 * q + 3] * rsc);
    }
  }
  if (slot < 4 * nleft) {
    list_entry(full + (slot >> 2), ntm, ntn, tm, tn);
    const int n0 = tn * 256 + (slot & 3) * 64;
    f32x16 acc[2];
#pragma unroll
    for (int e = 0; e < 16; ++e) { acc[0][e] = 0.f; acc[1][e] = 0.f; }
    gemm_core_mini(A, K, IdMap{tm * 128}, Bt, n0, K, acc, smem, ltid());
    const int m = tm * 128 + w * 32 + l32;
    float rsc = 1.f;
    if (rowss) rsc = row_rs(rowss, m);
#pragma unroll
    for (int ni = 0; ni < 2; ++ni)
#pragma unroll
      for (int q = 0; q < 4; ++q)
        epi4<EPI>(p, outp, m, n0 + ni * 32 + 8 * q + 4 * hh,
                  acc[ni][4 * q] * rsc, acc[ni][4 * q + 1] * rsc, acc[ni][4 * q + 2] * rsc, acc[ni][4 * q + 3] * rsc);
  }
}

DI void ple_epi(const P& p, const u16* PL, const u16* XIN, u16* XOUT, int m, int n, float a0, float a1, float a2, float a3, float& ssq) {
  const u32x2 xi = *(const u32x2*)(XIN + (size_t)m * D + n);
  f32x4 x = (f32x4){bflo(xi[0]), bfhi(xi[0]), bflo(xi[1]), bfhi(xi[1])};
  const u32x2 pv = *(const u32x2*)(PL + (size_t)m * D + n);
  x[0] += sigm(a0) * bflo(pv[0]);
  x[1] += sigm(a1) * bfhi(pv[0]);
  x[2] += sigm(a2) * bflo(pv[1]);
  x[3] += sigm(a3) * bfhi(pv[1]);
  if (XOUT) {
    const u32x2 o = (u32x2){pk2(x[0], x[1]), pk2(x[2], x[3])};
    *(u32x2*)(XOUT + (size_t)m * D + n) = o;
    const float q0 = bflo(o[0]), q1 = bfhi(o[0]), q2 = bflo(o[1]), q3 = bfhi(o[1]);
    ssq += q0 * q0 + q1 * q1 + q2 * q2 + q3 * q3;
  } else {
    *(f32x4*)(p.y + (size_t)m * D + n) = x;
  }
}
DI void ple_phase(const P& p, int layer, const u16* XIN, u16* XOUT, char* smem) {
  const int tid = ltid(), l = tid & 63, w = tid >> 6, l32 = l & 31, hh = l >> 5;
  const u16* PB = (const u16*)p.BIG;
  const u16* Wg = p.wt_gate + (size_t)layer * 1024 * 1024;
  const u16* Wp = p.wt_ple + (size_t)layer * 1024 * 256;
  const int ntm = ROWS / 128, ntn = 8;
  const int slot = lbid() >> 3, S = gridDim.x >> 3;
  const int len = ((ntm - (lbid() & 7) + 7) >> 3) * ntn;
  int tm, tn;
  for (int L = slot; L < len; L += S) {
    list_entry(L, ntm, ntn, tm, tn);
    f32x16 accP[4], accG[4];
#pragma unroll
    for (int mi = 0; mi < 4; ++mi)
#pragma unroll
      for (int e = 0; e < 16; ++e) { accP[mi][e] = 0.f; accG[mi][e] = 0.f; }
    gemm_core_n1(PB, 256, IdMap{tm * 128}, Wp, tn * 128, 256, accP, smem, ltid());
    gemm_core_n1(XIN, 1024, IdMap{tm * 128}, Wg, tn * 128, 1024, accG, smem, ltid());
#pragma unroll
    for (int mi = 0; mi < 4; ++mi) {
      const int m = tm * 128 + mi * 32 + l32;
      float ssq = 0.f;
#pragma unroll
      for (int q = 0; q < 4; ++q) {
        const int n = tn * 128 + w * 32 + 8 * q + 4 * hh;
        const u32x2 xi = *(const u32x2*)(XIN + (size_t)m * D + n);
        f32x4 x = (f32x4){bflo(xi[0]), bfhi(xi[0]), bflo(xi[1]), bfhi(xi[1])};
#pragma unroll
        for (int c = 0; c < 4; ++c) x[c] += sigm(accG[mi][4 * q + c]) * accP[mi][4 * q + c];
        if (XOUT) {
          const u32x2 o = (u32x2){pk2(x[0], x[1]), pk2(x[2], x[3])};
          *(u32x2*)(XOUT + (size_t)m * D + n) = o;
          const float q0 = bflo(o[0]), q1 = bfhi(o[0]), q2 = bflo(o[1]), q3 = bfhi(o[1]);
          ssq += q0 * q0 + q1 * q1 + q2 * q2 + q3 * q3;
        } else {
          *(f32x4*)(p.y + (size_t)m * D + n) = x;
        }
      }
      ssq += __shfl_xor(ssq, 32);
      if (hh == 0) p.ss[(size_t)m * 32 + tn * 4 + w] = ssq;
    }
  }
}

DI void ffn_in_phase(const P& p, int layer, const u16* XR, char* smem) {
  const int tid = ltid(), l = tid & 63, w = tid >> 6, l32 = l & 31, hh = l >> 5;
  const u16* Wt = p.wt_ffn_in + (size_t)layer * 5632 * 1024;
  u16* HID = (u16*)p.BIG;
  const float* cw = p.conv_w + (size_t)layer * 3 * DFF;
  const float* cb = p.conv_b + (size_t)layer * DFF;
  int tm, tn;
  for (int it = 0; next_tile(it, 272, 22, tm, tn); ++it) {
    const int seq = tm / 17, j = tm - seq * 17;
    const int T = 2048, rowbase = seq * 2048, t0 = 126 * j - 2;
    const bool last = (j == 16);
    const bool has_smp = last && seq < 8;
    const int srow = ROWS_P + seq * 32;
    f32x16 acc[4][2];
    ZERO_ACC(acc);
    const ClampMap2 rmap{rowbase, t0, T, has_smp ? srow : -1};
    gemm_core(XR, 1024, rmap, Wt, tn * 256, 1024, acc, smem, tid);
#pragma unroll
    for (int mi = 0; mi < 4; ++mi) {
      const float rsr = rsqrtf(p.ss2[rmap(mi * 32 + l32)] * (1.f / D) + EPS);
#pragma unroll
      for (int e = 0; e < 16; ++e) { acc[mi][0][e] *= rsr; acc[mi][1][e] *= rsr; }
    }
    const int chw = tn * 128 + w * 32;
    if (t0 < 0 && l32 < 2) {
#pragma unroll
      for (int q = 0; q < 4; ++q)
#pragma unroll
        for (int c = 0; c < 4; ++c) acc[0][0][4 * q + c] = 0.f;
    }
    if (has_smp && l32 < 2) {
#pragma unroll
      for (int q = 0; q < 4; ++q) {
        const f32x4 sv = *(const f32x4*)(p.state_conv + ((size_t)(layer * 8 + seq) * 2 + l32) * DFF + chw + 8 * q + 4 * hh);
#pragma unroll
        for (int c = 0; c < 4; ++c) acc[2][0][4 * q + c] = sv[c];
      }
    }
    const int lbase = l & 32;
#pragma unroll
    for (int q = 0; q < 4; ++q) {
      const int chq = chw + 8 * q + 4 * hh;
      const f32x4 b4 = *(const f32x4*)(cb + chq);
      const f32x4 w0 = *(const f32x4*)(cw + chq), w1 = *(const f32x4*)(cw + DFF + chq), w2 = *(const f32x4*)(cw + 2 * DFF + chq);
#pragma unroll
      for (int mi = 0; mi < 4; ++mi) {
        const int m = mi * 32 + l32;
        const bool seg1 = has_smp && mi >= 2;
        const int t = seg1 ? m - 66 : t0 + m;
        const int Tm = seg1 ? 32 : T;
        float hv[4];
#pragma unroll
        for (int c = 0; c < 4; ++c) {
          const float g0 = acc[mi][0][4 * q + c];
          float g1 = __shfl(g0, lbase + ((l32 + 31) & 31));
          float g2 = __shfl(g0, lbase + ((l32 + 30) & 31));
          if (mi > 0) {
            const float pg = acc[mi > 0 ? mi - 1 : 0][0][4 * q + c];
            const float p1 = __shfl(pg, lbase + 31), p2 = __shfl(pg, lbase + 30);
            if (l32 == 0) { g1 = p1; g2 = p2; }
            if (l32 == 1) { g2 = p1; }
          }
          const float cv = b4[c] + w0[c] * g2 + w1[c] * g1 + w2[c] * g0;
          hv[c] = cv * sigm(cv) * acc[mi][1][4 * q + c];
        }
        if ((seg1 ? m >= 66 : m >= 2) && t < Tm) {
          *(u32x2*)(HID + (size_t)((seg1 ? srow : rowbase) + t) * DFF + chq) = (u32x2){pk2(hv[0], hv[1]), pk2(hv[2], hv[3])};
          if (last && t >= Tm - 2) {
            float* co = seg1 ? p.conv_sample + ((size_t)(layer * 8 + seq) * 2 + (t - 30)) * DFF
                             : p.conv_prompt + ((size_t)(layer * 16 + seq) * 2 + (t - (T - 2))) * DFF;
            *(f32x4*)(co + chq) = (f32x4){acc[mi][0][4 * q], acc[mi][0][4 * q + 1], acc[mi][0][4 * q + 2], acc[mi][0][4 * q + 3]};
          }
        }
      }
    }
  }
}

DI void gla_state_phase(const P& p, int layer, char* smem) {
  const u16* PROJ = (const u16*)p.BIG;
  const int tid = ltid(), l = tid & 63, w = tid >> 6, l32 = l & 31, hh = l >> 5;
  float* SLOC = (float*)((char*)p.y + (size_t)ROWS * 1024 * 2);
  float* DTOT = SLOC + (size_t)384 * 16384;
  const int k = tid >> 1, th = tid & 1;
  for (int item = lbid(); item < 384; item += gridDim.x) {
    const int sh = item / 3, ch = item - sh * 3, s = sh >> 3, h = sh & 7;
    const int rowbase = s * 2048 + ch * 512;
    float lower = 0.f;
    if (layer == 1) lower = sigm(p.lb_raw[1024 + h * 128 + k] - p.lb_raw[h * 128 + k]);
    const float oml = 1.f - lower;
    f32x16 S[4];
#pragma unroll
    for (int kt = 0; kt < 4; ++kt)
#pragma unroll
      for (int i = 0; i < 16; ++i) S[kt][i] = 0.f;
    float btot = 0.f;
    u16 fr[8], vr[8];
#define GS_LOAD(BLK) { const size_t r0_ = (size_t)rowbase + (BLK) * 16; \
      const u16* pf_ = PROJ + (r0_ + 8 * th) * 4096 + 1024 + h * 128 + k; \
      const u16* pv_ = PROJ + r0_ * 4096 + 2048 + h * 128 + 32 * w + l32; \
      _Pragma("unroll") for (int t = 0; t < 8; ++t) fr[t] = pf_[(size_t)t * 4096]; \
      _Pragma("unroll") for (int jj = 0; jj < 8; ++jj) vr[jj] = pv_[(size_t)(8 * (jj >> 2) + 4 * hh + (jj & 3)) * 4096]; }
    GS_LOAD(0);
    for (int blk = 0; blk < 32; ++blk) {
      char* sb = smem + (blk & 1) * 8192;
      u16* KDT = (u16*)sb;
      float* DD = (float*)(KDT + 128 * 20);
      {
        float km[8], eb[8];
        float bs = 0.f;
#pragma unroll
        for (int t = 0; t < 8; ++t) {
          const float f = bf2f(fr[t]);
          const float g = lower + oml * sigm(f);
          bs += __logf(g);
          km[t] = 1.f - g; eb[t] = bs;
        }
        const float other = __shfl_xor(bs, 1);
        const float boff = th ? other : 0.f;
        const float bsum = bs + other;
        btot += bsum;
        unsigned kdp[4];
#pragma unroll
        for (int j = 0; j < 4; ++j)
          kdp[j] = pk2(km[2 * j] * __expf(bsum - boff - eb[2 * j]), km[2 * j + 1] * __expf(bsum - boff - eb[2 * j + 1]));
        *(u32x2*)(KDT + k * 20 + 8 * th) = (u32x2){kdp[0], kdp[1]};
        *(u32x2*)(KDT + k * 20 + 8 * th + 4) = (u32x2){kdp[2], kdp[3]};
        if (th == 0) DD[k] = __expf(bsum);
      }
      const bf16x8 vfrag = mk8u((unsigned)vr[0] | ((unsigned)vr[1] << 16), (unsigned)vr[2] | ((unsigned)vr[3] << 16),
                                (unsigned)vr[4] | ((unsigned)vr[5] << 16), (unsigned)vr[6] | ((unsigned)vr[7] << 16));
      if (blk + 1 < 32) GS_LOAD(blk + 1);
      __syncthreads();
#pragma unroll
      for (int kt = 0; kt < 4; ++kt) {
#pragma unroll
        for (int q = 0; q < 4; ++q) {
          const f32x4 d4 = *(const f32x4*)(DD + 32 * kt + 8 * q + 4 * hh);
#pragma unroll
          for (int c = 0; c < 4; ++c) S[kt][4 * q + c] *= d4[c];
        }
        const u32x2 lo = *(const u32x2*)(KDT + (32 * kt + l32) * 20 + 4 * hh);
        const u32x2 hi = *(const u32x2*)(KDT + (32 * kt + l32) * 20 + 8 + 4 * hh);
        S[kt] = __builtin_amdgcn_mfma_f32_32x32x16_bf16(mk8(lo, hi), vfrag, S[kt], 0, 0, 0);
      }
    }
#undef GS_LOAD
    {
      float* op = SLOC + (size_t)item * 16384 + 32 * w + l32;
#pragma unroll
      for (int kt = 0; kt < 4; ++kt)
#pragma unroll
        for (int i = 0; i < 16; ++i) op[(size_t)(32 * kt + (i & 3) + 8 * (i >> 2) + 4 * hh) * 128] = S[kt][i];
      if (th == 0) DTOT[(size_t)item * 128 + k] = __expf(btot);
    }
    __syncthreads();
  }
}

DI void gla_phase(const P& p, int layer, char* smem) {
  const u16* PROJ = (const u16*)p.BIG;
  const int tid = ltid(), l = tid & 63, w = tid >> 6, l32 = l & 31, hh = l >> 5, m16 = l & 15;
  float* REDB = (float*)(smem + 2 * 14336);
  const int k = tid >> 1, th = tid & 1;
  const float* SLOC = (const float*)((const char*)p.y + (size_t)ROWS * 1024 * 2);
  const float* DTOT = SLOC + (size_t)384 * 16384;
  for (int item = lbid(); item < 576; item += gridDim.x) {
    const bool smp = item < 64;
    const int s = smp ? 16 + (item >> 3) : (item - 64) >> 5;
    const int h = smp ? (item & 7) : ((item - 64) >> 2) & 7;
    const int ch = smp ? 0 : (item - 64) & 3;
    const int T = smp ? 32 : 512;
    const int rowbase = smp ? ROWS_P + (s - 16) * 32 : s * 2048 + ch * 512;
    float lower = 0.f;
    if (layer == 1) lower = sigm(p.lb_raw[1024 + h * 128 + k] - p.lb_raw[h * 128 + k]);
    const float oml = 1.f - lower;
    f32x16 S[4];
    if (smp) {
      const float* sp = p.state_hgrn + ((size_t)(layer * 8 + (s - 16)) * 8 + h) * 16384 + 32 * w + l32;
#pragma unroll
      for (int kt = 0; kt < 4; ++kt)
#pragma unroll
        for (int i = 0; i < 16; ++i) S[kt][i] = sp[(size_t)(32 * kt + (i & 3) + 8 * (i >> 2) + 4 * hh) * 128];
    } else {
#pragma unroll
      for (int kt = 0; kt < 4; ++kt)
#pragma unroll
        for (int i = 0; i < 16; ++i) S[kt][i] = 0.f;
#pragma unroll 1
      for (int j = 0; j < ch; ++j) {
        const int it1 = (s * 8 + h) * 3 + j;
        const float* sl = SLOC + (size_t)it1 * 16384 + 32 * w + l32 + (size_t)(4 * hh) * 128;
        const float* dl = DTOT + (size_t)it1 * 128 + 4 * hh;
#pragma unroll
        for (int kt = 0; kt < 4; ++kt) {
#pragma unroll
          for (int q = 0; q < 4; ++q) {
            const float* slq = sl + (size_t)(32 * kt + 8 * q) * 128;
            const f32x4 d4 = *(const f32x4*)(dl + 32 * kt + 8 * q);
#pragma unroll
            for (int c = 0; c < 4; ++c) S[kt][4 * q + c] = S[kt][4 * q + c] * d4[c] + slq[c * 128];
            __builtin_amdgcn_sched_barrier(0);
          }
        }
      }
    }
    const int nblk = T >> 4;
    u16 fr[8], qr[8], vr[8];
#define GLA_LOADRAW(BLK) { const size_t r0_ = (size_t)rowbase + (BLK) * 16; \
      const u16* pf_ = PROJ + (r0_ + 8 * th) * 4096 + 1024 + h * 128 + k; \
      const u16* pq_ = PROJ + (r0_ + 8 * th) * 4096 + h * 128 + k; \
      _Pragma("unroll") for (int t = 0; t < 8; ++t) fr[t] = pf_[(size_t)t * 4096]; \
      _Pragma("unroll") for (int j = 0; j < 8; ++j) qr[j] = pq_[(size_t)j * 4096]; \
 }
#define GLA_LOADV(BLK) { const u16* pv_ = PROJ + ((size_t)rowbase + (BLK) * 16) * 4096 + 2048 + h * 128 + 32 * w + l32; \
      _Pragma("unroll") for (int jj = 0; jj < 8; ++jj) vr[jj] = pv_[(size_t)(8 * (jj >> 2) + 4 * hh + (jj & 3)) * 4096]; }
#define GLA_LOADGS(BLK) { const u16* pg_ = PROJ + ((size_t)rowbase + (BLK) * 16 + m16) * 4096 + 3072 + h * 128 + 32 * w + 4 * hh; \
      _Pragma("unroll") for (int q = 0; q < 4; ++q) gsl[q] = *(const u32x2*)(pg_ + 8 * q); }
#define GLA_FINAL(BLK) { const float* RED_ = REDB + ((BLK) & 1) * 64; \
      if (l32 < 16) { \
        const float tot = RED_[l32] + RED_[16 + l32] + RED_[32 + l32] + RED_[48 + l32]; \
        const float rn = rsqrtf(tot * (1.f / 128.f) + EPS); \
        u16* op_ = p.OG + ((size_t)rowbase + (BLK) * 16 + l32) * 1024 + h * 128 + 32 * w + 4 * hh; \
        const float* gp_ = p.g_hg + layer * 1024 + h * 128 + 32 * w + 4 * hh; \
        _Pragma("unroll") for (int q = 0; q < 4; ++q) { const f32x4 gh = *(const f32x4*)(gp_ + 8 * q); \
          *(u32x2*)(op_ + 8 * q) = (u32x2){pk2(oacc[4 * q] * rn * gh[0] * bflo(gsl[q][0]), oacc[4 * q + 1] * rn * gh[1] * bfhi(gsl[q][0])), \
                                          pk2(oacc[4 * q + 2] * rn * gh[2] * bflo(gsl[q][1]), oacc[4 * q + 3] * rn * gh[3] * bfhi(gsl[q][1]))}; } \
      } }
    GLA_LOADRAW(0);
    u32x2 gsl[4];
    for (int blk = 0; blk < nblk; ++blk) {
      GLA_LOADGS(blk);
      GLA_LOADV(blk);
      char* sb = smem + (blk & 1) * 14336;
      u16* QT = (u16*)sb;
      u16* KT = QT + 16 * 136;
      u16* KDT = KT + 16 * 136;
      float* DD = (float*)(KDT + 128 * 20);
      {
        float qtm[8], ktm[8];
        float bs = 0.f;
#pragma unroll
        for (int t = 0; t < 8; ++t) {
          const float f = bf2f(fr[t]);
          const float g = lower + oml * sigm(f);
          bs += __logf(g);
          const float eb = __expf(bs);
          qtm[t] = bf2f(qr[t]) * eb;
          ktm[t] = (1.f - g) * __builtin_amdgcn_rcpf(eb);
        }
        const float other = __shfl_xor(bs, 1);
        const float boff = th ? other : 0.f;
        const float bsum = bs + other;
        const float E1 = __expf(boff), E1i = __expf(-boff), EL = __expf(bsum);
        unsigned kdp[4];
        float kdprev = 0.f;
#pragma unroll
        for (int j = 0; j < 8; ++j) {
          const int t = 8 * th + j;
          const float qt = qtm[j] * E1;
          const float ktv = ktm[j] * E1i;
          const float kd = ktv * EL;
          QT[t * 136 + k] = (u16)(pk2(qt, 0.f) & 0xffffu);
          KT[t * 136 + k] = (u16)(pk2(ktv, 0.f) & 0xffffu);
          if (j & 1) kdp[j >> 1] = pk2(kdprev, kd); else kdprev = kd;
        }
        *(u32x2*)(KDT + k * 20 + 8 * th) = (u32x2){kdp[0], kdp[1]};
        *(u32x2*)(KDT + k * 20 + 8 * th + 4) = (u32x2){kdp[2], kdp[3]};
        if (th == 0) DD[k] = __expf(bsum);
      }
      if (blk + 1 < nblk) GLA_LOADRAW(blk + 1);
      __syncthreads();
      const bf16x8 vfrag = mk8u((unsigned)vr[0] | ((unsigned)vr[1] << 16), (unsigned)vr[2] | ((unsigned)vr[3] << 16),
                                (unsigned)vr[4] | ((unsigned)vr[5] << 16), (unsigned)vr[6] | ((unsigned)vr[7] << 16));
      f32x16 aacc, oacc;
#pragma unroll
      for (int i = 0; i < 16; ++i) { aacc[i] = 0.f; oacc[i] = 0.f; }
#pragma unroll
      for (int ks = 0; ks < 8; ++ks) {
        const bf16x8 ka = *(const bf16x8*)(KT + m16 * 136 + 16 * ks + 8 * hh);
        const bf16x8 qb = *(const bf16x8*)(QT + m16 * 136 + 16 * ks + 8 * hh);
        aacc = __builtin_amdgcn_mfma_f32_32x32x16_bf16(ka, qb, aacc, 0, 0, 0);
        const int kt = ks >> 1, s2 = ks & 1;
        const bf16x8 sa = mk8u(pk2(S[kt][8 * s2], S[kt][8 * s2 + 1]), pk2(S[kt][8 * s2 + 2], S[kt][8 * s2 + 3]),
                               pk2(S[kt][8 * s2 + 4], S[kt][8 * s2 + 5]), pk2(S[kt][8 * s2 + 6], S[kt][8 * s2 + 7]));
        const u32x2 lo = *(const u32x2*)(QT + m16 * 136 + 32 * kt + 16 * s2 + 4 * hh);
        const u32x2 hi = *(const u32x2*)(QT + m16 * 136 + 32 * kt + 16 * s2 + 8 + 4 * hh);
        oacc = __builtin_amdgcn_mfma_f32_32x32x16_bf16(sa, mk8(lo, hi), oacc, 0, 0, 0);
      }
      float am[8];
#pragma unroll
      for (int i = 0; i < 8; ++i) { const int m = (i & 3) + 8 * (i >> 2) + 4 * hh; am[i] = (m <= m16) ? aacc[i] : 0.f; }
      const bf16x8 afrag = mk8u(pk2(am[0], am[1]), pk2(am[2], am[3]), pk2(am[4], am[5]), pk2(am[6], am[7]));
      oacc = __builtin_amdgcn_mfma_f32_32x32x16_bf16(vfrag, afrag, oacc, 0, 0, 0);
#pragma unroll
      for (int kt = 0; kt < 4; ++kt) {
#pragma unroll
        for (int q = 0; q < 4; ++q) {
          const f32x4 d4 = *(const f32x4*)(DD + 32 * kt + 8 * q + 4 * hh);
#pragma unroll
          for (int c = 0; c < 4; ++c) S[kt][4 * q + c] *= d4[c];
        }
        const u32x2 lo = *(const u32x2*)(KDT + (32 * kt + l32) * 20 + 4 * hh);
        const u32x2 hi = *(const u32x2*)(KDT + (32 * kt + l32) * 20 + 8 + 4 * hh);
        S[kt] = __builtin_amdgcn_mfma_f32_32x32x16_bf16(mk8(lo, hi), vfrag, S[kt], 0, 0, 0);
      }
      float ss = 0.f;
#pragma unroll
      for (int i = 0; i < 16; ++i) ss += oacc[i] * oacc[i];
      ss += __shfl_xor(ss, 32);
      if (l < 16) REDB[(blk & 1) * 64 + w * 16 + l] = ss;
      __syncthreads();
      GLA_FINAL(blk);
    }
#undef GLA_LOADGS
#undef GLA_LOADV
#undef GLA_LOADRAW
#undef GLA_FINAL
    if (smp || ch == 3) {
      float* op = (smp ? p.hgrn_sample + ((size_t)(layer * 8 + (s - 16)) * 8 + h) * 16384
                       : p.hgrn_prompt + ((size_t)(layer * 16 + s) * 8 + h) * 16384) + 32 * w + l32;
#pragma unroll
      for (int kt = 0; kt < 4; ++kt)
#pragma unroll
        for (int i = 0; i < 16; ++i) op[(size_t)(32 * kt + (i & 3) + 8 * (i >> 2) + 4 * hh) * 128] = S[kt][i];
    }
  }
}

DI void kvconv_phase(const P& p) {
  const int tid = ltid();
  char* KVT = p.BIG + (size_t)ROWS * 1024 * 2;
  for (int t = lbid(); t < 4096 + 1088; t += gridDim.x) {
    const float *kb, *vb; int nvalid = 64;
    if (t < 4096) { const int kt = t & 31, sh = t >> 5, s = sh >> 3, h = sh & 7; const size_t off = ((size_t)(s * 2048 + 64 * kt)) * 1024 + h * 128; kb = p.k_prompt + off; vb = p.v_prompt + off; }
    else { const int u = t - 4096; const int kt = u % 17, sh = u / 17, b = sh >> 3, h = sh & 7;
      if (kt < 16) { const size_t off = ((size_t)(b * 1024 + 64 * kt)) * 1024 + h * 128; kb = p.cache_k + off; vb = p.cache_v + off; }
      else { const size_t off = ((size_t)(b * 32)) * 1024 + h * 128; kb = p.k_sample + off; vb = p.v_sample + off; nvalid = 32; } }
    u16* kd = (u16*)(KVT + (size_t)t * 32768);
    u16* vd = kd + 8192;
#pragma unroll
    for (int pp = 0; pp < 4; ++pp) {
      const int key = 16 * pp + (tid >> 4), d8 = (tid & 15) * 8;
      f32x4 a = {0.f, 0.f, 0.f, 0.f}, b2 = {0.f, 0.f, 0.f, 0.f};
      if (key < nvalid) { a = *(const f32x4*)(kb + (size_t)key * 1024 + d8); b2 = *(const f32x4*)(kb + (size_t)key * 1024 + d8 + 4); }
      *(u32x4*)(kd + key * 128 + d8) = (u32x4){pk2(a[0], a[1]), pk2(a[2], a[3]), pk2(b2[0], b2[1]), pk2(b2[2], b2[3])};
    }
#pragma unroll
    for (int c = 0; c < 4; ++c) {
      const int v = tid & 127, cc = 4 * (tid >> 7) + c;
      float e[8];
#pragma unroll
      for (int j = 0; j < 8; ++j) { const int key = 8 * cc + j; e[j] = key < nvalid ? vb[(size_t)key * 1024 + v] : 0.f; }
      *(u32x4*)(vd + v * 64 + 8 * cc) = (u32x4){pk2(e[0], e[1]), pk2(e[2], e[3]), pk2(e[4], e[5]), pk2(e[6], e[7])};
    }
  }
}

DI void attn_phase(const P& p, int layer, char* smem) {
  const int jl = layer - 2;
  const u16* Q = (const u16*)p.BIG;
  const char* KVT = p.BIG + (size_t)ROWS * 1024 * 2;
  const int tid = ltid(), l = tid & 63, w = tid >> 6, l16 = l & 15, g = l >> 4;
  u16* KS = (u16*)smem;
  u16* VT = KS + 64 * 136;
  float* BT = (float*)(VT + 128 * 72);
  u16* QS = (u16*)(BT + 256);
  const float lam_init = 0.8f - 0.6f * __expf(-0.3f * (float)layer);
  float lam;
  {
    const float* lp = p.lam_b + jl * 256;
    float a = 0.f, b = 0.f;
    for (int d = 0; d < 64; ++d) { a += lp[d] * lp[64 + d]; b += lp[128 + d] * lp[192 + d]; }
    lam = __expf(a) - __expf(b) + lam_init;
  }
  const int bidA = lbid(), GA = gridDim.x;
  for (int kk = 0; kk * GA < 4096 + 64; ++kk) {
    const int item = ((kk & 1) ? (GA - 1 - bidA) : bidA) + kk * GA;
    if (item >= 4096 + 64) continue;
    int b, h, nq, qrow0, qpos0, ntiles, tile0; bool smp;
    if (item < 4096) { const int jq = 31 - (item >> 7); const int bh = item & 127; b = bh >> 3; h = bh & 7; smp = false; nq = 64; qrow0 = b * 2048 + 64 * jq; qpos0 = 64 * jq; ntiles = jq + 1; tile0 = bh * 32; }
    else { const int si = item - 4096; b = si >> 3; h = si & 7; smp = true; nq = 32; qrow0 = ROWS_P + b * 32; qpos0 = 1024; ntiles = 17; tile0 = 4096 + si * 17; }
    __syncthreads();
    if (tid < 230) {
      const int rel = tid - 166;
      const int n = rel < 0 ? -rel : rel;
      int bk = n < 8 ? n : 8 + (n >= 13) + (n >= 20) + (n >= 30) + (n >= 46) + (n >= 70) + (n >= 108) + (n >= 166);
      if (rel > 0) bk += 16;
      BT[tid] = p.rel_bias[bk * 8 + h] * LOG2E;
    }
#pragma unroll
    for (int pp = 0; pp < 4; ++pp) {
      const int idx = pp * 256 + tid, r = idx >> 4, c16 = idx & 15;
      *(u32x4*)(QS + r * 136 + c16 * 8) = *(const u32x4*)(Q + (size_t)(qrow0 + min(r, nq - 1)) * 1024 + h * 128 + c16 * 8);
    }
    f32x4 oacc[2][8];
#pragma unroll
    for (int c = 0; c < 2; ++c)
#pragma unroll
      for (int vs = 0; vs < 8; ++vs) oacc[c][vs] = (f32x4){0.f, 0.f, 0.f, 0.f};
    float mrun[2] = {-1e30f, -1e30f}, lsum[2] = {0.f, 0.f};
    const int qpos = qpos0 + min(16 * w + l16, nq - 1);
    u32x4 rk[4], rv[4];
    {
      const u32x4* src = (const u32x4*)(KVT + (size_t)tile0 * 32768);
#pragma unroll
      for (int pp = 0; pp < 4; ++pp) { rk[pp] = src[pp * 256 + tid]; rv[pp] = src[1024 + pp * 256 + tid]; }
    }
    for (int kt = 0; kt < ntiles; ++kt) {
      const int nvalid = (smp && kt == 16) ? 32 : 64;
      if (kt > 0) __syncthreads();
#pragma unroll
      for (int pp = 0; pp < 4; ++pp) {
        const int idx = pp * 256 + tid;
        *(u32x4*)(KS + (idx >> 4) * 136 + (idx & 15) * 8) = rk[pp];
        *(u32x4*)(VT + (idx >> 3) * 72 + (idx & 7) * 8) = rv[pp];
      }
      if (kt + 1 < ntiles) {
        const u32x4* src = (const u32x4*)(KVT + (size_t)(tile0 + kt + 1) * 32768);
#pragma unroll
        for (int pp = 0; pp < 4; ++pp) { rk[pp] = src[pp * 256 + tid]; rv[pp] = src[1024 + pp * 256 + tid]; }
      }
      __syncthreads();
      f32x4 sacc[2][4];
#pragma unroll
      for (int c = 0; c < 2; ++c)
#pragma unroll
        for (int sub = 0; sub < 4; ++sub) {
          sacc[c][sub] = (f32x4){0.f, 0.f, 0.f, 0.f};
#pragma unroll
          for (int ks = 0; ks < 2; ++ks) {
            const bf16x8 kf = *(const bf16x8*)(KS + (16 * sub + l16) * 136 + c * 64 + 32 * ks + 8 * g);
            const bf16x8 qfr = *(const bf16x8*)(QS + (16 * w + l16) * 136 + c * 64 + 32 * ks + 8 * g);
            sacc[c][sub] = __builtin_amdgcn_mfma_f32_16x16x32_bf16(kf, qfr, sacc[c][sub], 0, 0, 0);
          }
        }
#pragma unroll
      for (int sub = 0; sub < 4; ++sub)
#pragma unroll
        for (int i = 0; i < 4; ++i) {
          const int kl = 16 * sub + 4 * g + i;
          int rel = 64 * kt + kl - qpos;
          rel = rel < -166 ? -166 : rel;
          const float bt = BT[rel + 166];
          const bool ok = kl < nvalid;
          sacc[0][sub][i] = ok ? sacc[0][sub][i] + bt : -30000.f;
          sacc[1][sub][i] = ok ? sacc[1][sub][i] + bt : -30000.f;
        }
      bf16x8 pf[2][2];
#pragma unroll
      for (int c = 0; c < 2; ++c) {
        float mx = -1e30f;
#pragma unroll
        for (int sub = 0; sub < 4; ++sub)
#pragma unroll
          for (int i = 0; i < 4; ++i) mx = fmaxf(mx, sacc[c][sub][i]);
        mx = fmaxf(mx, __shfl_xor(mx, 16));
        mx = fmaxf(mx, __shfl_xor(mx, 32));
        const float mnew = fmaxf(mrun[c], mx);
        const float alpha = __builtin_amdgcn_exp2f(mrun[c] - mnew);
        mrun[c] = mnew;
        float rs = 0.f;
#pragma unroll
        for (int sub = 0; sub < 4; ++sub)
#pragma unroll
          for (int i = 0; i < 4; ++i) { const float e = __builtin_amdgcn_exp2f(sacc[c][sub][i] - mnew); sacc[c][sub][i] = e; rs += e; }
        lsum[c] = lsum[c] * alpha + rs;
#pragma unroll
        for (int vs = 0; vs < 8; ++vs) oacc[c][vs] *= alpha;
#pragma unroll
        for (int j = 0; j < 2; ++j)
          pf[c][j] = mk8u(pk2(sacc[c][2 * j][0], sacc[c][2 * j][1]), pk2(sacc[c][2 * j][2], sacc[c][2 * j][3]),
                          pk2(sacc[c][2 * j + 1][0], sacc[c][2 * j + 1][1]), pk2(sacc[c][2 * j + 1][2], sacc[c][2 * j + 1][3]));
      }
#pragma unroll
      for (int j = 0; j < 2; ++j)
#pragma unroll
        for (int vs = 0; vs < 8; ++vs) {
          const u32x2 lo = *(const u32x2*)(VT + (16 * vs + l16) * 72 + 32 * j + 4 * g);
          const u32x2 hi = *(const u32x2*)(VT + (16 * vs + l16) * 72 + 32 * j + 16 + 4 * g);
          const bf16x8 vf = mk8(lo, hi);
          oacc[0][vs] = __builtin_amdgcn_mfma_f32_16x16x32_bf16(vf, pf[0][j], oacc[0][vs], 0, 0, 0);
          oacc[1][vs] = __builtin_amdgcn_mfma_f32_16x16x32_bf16(vf, pf[1][j], oacc[1][vs], 0, 0, 0);
        }
    }
#pragma unroll
    for (int c = 0; c < 2; ++c) { lsum[c] += __shfl_xor(lsum[c], 16); lsum[c] += __shfl_xor(lsum[c], 32); }
    const float inv0 = 1.f / lsum[0], inv1 = lam / lsum[1];
    float ss = 0.f;
#pragma unroll
    for (int vs = 0; vs < 8; ++vs)
#pragma unroll
      for (int i = 0; i < 4; ++i) { const float o = oacc[0][vs][i] * inv0 - oacc[1][vs][i] * inv1; oacc[0][vs][i] = o; ss += o * o; }
    ss += __shfl_xor(ss, 16);
    ss += __shfl_xor(ss, 32);
    const float rn = rsqrtf(ss * (1.f / 128.f) + EPS) * (1.f - lam_init);
    if (16 * w + l16 < nq) {
      const size_t row = (size_t)qrow0 + 16 * w + l16;
#pragma unroll
      for (int vs = 0; vs < 8; ++vs) {
        const int v = h * 128 + 16 * vs + 4 * g;
        const f32x4 gl = *(const f32x4*)(p.g_subln + jl * 1024 + v);
        *(u32x2*)(p.OG + row * 1024 + v) = (u32x2){pk2(oacc[0][vs][0] * rn * gl[0], oacc[0][vs][1] * rn * gl[1]),
                                                   pk2(oacc[0][vs][2] * rn * gl[2], oacc[0][vs][3] * rn * gl[3])};
      }
    }
  }
}

#define XB_TMO      128
#define XB_XCNT(j)  (256  + 64 * (j))
#define XB_XSUB(j)  (1280 + 64 * (j))
#define XB_XGEN(j)  (2304 + 64 * (j))
#define XB_TOP      3328
#define XB_TOPGEN   3392
#define XCD_BAR_WORDS 3456
#define XB_SPIN_CAP (1u << 18)
#define LAS __attribute__((address_space(3)))
DI unsigned xb_ld(unsigned* p) { return __hip_atomic_load(p, __ATOMIC_RELAXED, __HIP_MEMORY_SCOPE_AGENT); }
DI unsigned xb_add(unsigned* p, unsigned v) { return __hip_atomic_fetch_add(p, v, __ATOMIC_RELAXED, __HIP_MEMORY_SCOPE_AGENT); }
DI unsigned xb_xcc_id() { return (unsigned)__builtin_amdgcn_s_getreg((3 << 11) | 20) & 0xFu; }
#define XB_SPIN(cond, bar) do { unsigned _sp = 0; while (cond) { __builtin_amdgcn_s_sleep(1); \
    if ((++_sp & 255u) == 0u) { if (xb_ld(&(bar)[XB_TMO])) break; if (_sp > XB_SPIN_CAP) { atomicAdd(&(bar)[XB_TMO], 1u); break; } } } } while (0)
struct XcdBarrier { unsigned* bar; unsigned x; volatile LAS unsigned* st; };
DI XcdBarrier xcd_barrier_post(unsigned* bar, volatile LAS unsigned* st) {
  XcdBarrier b; b.bar = bar; b.x = xb_xcc_id(); b.st = st;
  if (threadIdx.x == 0) (void)xb_add(&bar[XB_XCNT(b.x)], 1u);
  return b;
}
DI void xcd_barrier_complete(unsigned* bar, unsigned x, unsigned& nloc, unsigned& nx) {
  const unsigned G = gridDim.x;
  unsigned sum, cnt, mine, sp = 0u;
  for (;;) {
    sum = 0u; cnt = 0u; mine = 0u;
#pragma unroll
    for (unsigned j = 0; j < 16; ++j) { const unsigned c = xb_ld(&bar[XB_XCNT(j)]); sum += c; cnt += (c > 0u) ? 1u : 0u; mine = (j == x) ? c : mine; }
    if (sum == G) break;
    __builtin_amdgcn_s_sleep(1);
    if ((++sp & 255u) == 0u) { if (xb_ld(&bar[XB_TMO])) break; if (sp > XB_SPIN_CAP) { atomicAdd(&bar[XB_TMO], 1u); break; } }
  }
  nloc = mine > 0u ? mine : 1u; nx = cnt > 0u ? cnt : 1u;
}
DI void xcd_barrier(const XcdBarrier& b) {
  asm volatile("s_waitcnt vmcnt(0)" ::: "memory");
  __syncthreads();
  if (ltid() == 0) {
    unsigned* bar = b.bar;
    __builtin_amdgcn_s_waitcnt(0);
    unsigned nloc = b.st[0], nx = b.st[1];
    if (nloc == 0u) { xcd_barrier_complete(bar, b.x, nloc, nx); b.st[0] = nloc; b.st[1] = nx; }
    const unsigned old = xb_add(&bar[XB_XSUB(b.x)], 1u);
    const unsigned gen = old / nloc;
    if (old + 1u == (gen + 1u) * nloc) {
      __builtin_amdgcn_fence(__ATOMIC_RELEASE, "agent");
      asm volatile("s_waitcnt vmcnt(0)" ::: "memory");
      const unsigned og = xb_add(&bar[XB_TOP], 1u);
      const unsigned tg = og / nx;
      if (og + 1u == (tg + 1u) * nx) xb_add(&bar[XB_TOPGEN], 1u);
      else XB_SPIN(xb_ld(&bar[XB_TOPGEN]) == tg, bar);
      __builtin_amdgcn_fence(__ATOMIC_ACQUIRE, "agent");
      xb_add(&bar[XB_XGEN(b.x)], 1u);
      asm volatile("s_waitcnt vmcnt(0)" ::: "memory");
    } else {
      XB_SPIN(xb_ld(&bar[XB_XGEN(b.x)]) == gen, bar);
      __builtin_amdgcn_fence(__ATOMIC_ACQUIRE, "agent");
      asm volatile("s_waitcnt vmcnt(0)" ::: "memory");
    }
  }
  __syncthreads();
}

__global__ void __launch_bounds__(256, 2) yoco_megakernel(P p) {
  __shared__ __attribute__((aligned(16))) char smem[65520];
  __shared__ uint4 xb_words;
  cg::grid_group grid = cg::this_grid();
  if (threadIdx.x == 0) xb_words = make_uint4(0u, 0u, 0u, 0u);
  if (blockIdx.x == 0) { for (int i = threadIdx.x; i < XCD_BAR_WORDS; i += 256) __hip_atomic_store(p.bar + i, 0u, __ATOMIC_RELAXED, __HIP_MEMORY_SCOPE_AGENT); }
  prep_phase(p, smem);
  grid.sync();
  const XcdBarrier xb = xcd_barrier_post(p.bar, (volatile LAS unsigned*)&xb_words);
  u16* Mbuf = (u16*)p.BIG;
  u16* Fbuf = (u16*)(p.BIG + ((size_t)180 << 20));
  u16* PB = (u16*)p.BIG;
  u16* XRA = (u16*)p.y;
  u16* XRB = p.XB;
  for (int i = 0; i < 4; ++i) {
    const float* gn = p.g_norms + i * 4 * D;
    u16* cur = (i & 1) ? XRB : XRA;
    u16* nxt = (i == 3) ? nullptr : ((i & 1) ? XRA : XRB);
    if (i == 0) {
      rowop_phase(p, true, nullptr, nullptr, gn, p.XB, nullptr, nullptr, nullptr);
      xcd_barrier(xb);
    }
    if (i < 2) {
      REPG gemm_phase<0>(p, i ? cur : p.XB, 1024, p.wt_in_a + (size_t)i * 4096 * 1024, 4096, p.BIG, smem, i ? p.ss : nullptr);
      xcd_barrier(xb);
      gla_state_phase(p, i, smem);
      xcd_barrier(xb);
      for (int _r = 0; _r < REP_GLA; ++_r) gla_phase(p, i, smem);
      xcd_barrier(xb);
      REPG gemm_phase<2>(p, p.OG, 1024, p.wt_out_a + (size_t)i * 1024 * 1024, 1024, Mbuf, smem);
      xcd_barrier(xb);
    } else {
      if (i == 2) gemm_phase<3>(p, cur, 1024, p.wt_kv, 2048, nullptr, smem, p.ss);
      REPG gemm_phase<1>(p, cur, 1024, p.wt_q + (size_t)(i - 2) * 1024 * 1024, 1024, p.BIG, smem, p.ss);
      if (i == 2) xcd_barrier(xb);
      kvconv_phase(p);
      xcd_barrier(xb);
      for (int _r = 0; _r < REP_ATTN; ++_r) attn_phase(p, i, smem);
      xcd_barrier(xb);
      REPG gemm_phase<2>(p, p.OG, 1024, p.wt_out_b + (size_t)(i - 2) * 1024 * 1024, 1024, Mbuf, smem);
      xcd_barrier(xb);
    }
    rowop2_phase(p, i == 0, cur, Mbuf, gn + D, p.ss2, nullptr, nullptr, nullptr);
    xcd_barrier(xb);
    REPG ffn_in_phase(p, i, cur, smem);
    xcd_barrier(xb);
    REPG gemm_phase<2>(p, (const u16*)p.BIG, DFF, p.wt_ffn_out + (size_t)i * 1024 * DFF, 1024, Fbuf, smem);
    xcd_barrier(xb);
    rowop2_phase(p, false, cur, Fbuf, gn + 3 * D, nullptr, p.p_prompt + (size_t)i * ROWS_P * 256, p.p_sample + (size_t)i * 256 * 256, PB);
    xcd_barrier(xb);
    ple_phase(p, i, cur, nxt, smem);
    xcd_barrier(xb);
  }
}

extern "C" void kernel_launch(void* const* d_in, const int* in_sizes, int n_in, void* d_out, int out_size, void* d_ws,
                              size_t ws_size, hipStream_t stream) {
  static int grid_blocks = 0;
  if (!grid_blocks) {
    int dev = 0, cus = 0, per_cu = 0;
    hipGetDevice(&dev);
    hipDeviceGetAttribute(&cus, hipDeviceAttributeMultiprocessorCount, dev);
    hipOccupancyMaxActiveBlocksPerMultiprocessor(&per_cu, yoco_megakernel, 256, 0);
    if (per_cu > 2) per_cu = 2;
    grid_blocks = cus * per_cu;
    grid_blocks &= ~7;
  }
  P p{};
  const float* const* in = (const float* const*)d_in;
  p.x_prompt = in[0]; p.x_sample = in[1]; p.cache_k = in[2]; p.cache_v = in[3]; p.state_hgrn = in[4]; p.state_conv = in[5];
  p.p_prompt = in[6]; p.p_sample = in[7];
  p.g_norms = in[8]; const float* w_in_a = in[9]; p.lb_raw = in[10]; p.g_hg = in[11]; const float* w_out_a = in[12]; p.g_kv = in[13];
  const float* w_kv = in[14]; p.rel_bias = in[15]; const float* w_q_b = in[16]; p.lam_b = in[17]; p.g_subln = in[18];
  const float* w_out_b = in[19]; const float* w_ffn_in = in[20]; p.conv_w = in[21]; p.conv_b = in[22]; const float* w_ffn_out = in[23];
  const float* w_ple = in[24]; const float* w_ple_gate = in[25];
  float* o = (float*)d_out;
  p.y = o; o += (size_t)ROWS * D;
  p.k_prompt = o; o += (size_t)ROWS_P * D;
  p.v_prompt = o; o += (size_t)ROWS_P * D;
  p.k_sample = o; o += (size_t)256 * D;
  p.v_sample = o; o += (size_t)256 * D;
  p.hgrn_prompt = o; o += (size_t)2 * 16 * 8 * 16384;
  p.hgrn_sample = o; o += (size_t)2 * 8 * 8 * 16384;
  p.conv_prompt = o; o += (size_t)4 * 16 * 2 * DFF;
  p.conv_sample = o;
  u16* ws = (u16*)d_ws;
  p.wt_in_a = ws; ws += (size_t)2 * 4096 * 1024;
  p.wt_out_a = ws; ws += (size_t)2 * 1024 * 1024;
  p.wt_kv = ws; ws += (size_t)2048 * 1024;
  p.wt_q = ws; ws += (size_t)2 * 1024 * 1024;
  p.wt_out_b = ws; ws += (size_t)2 * 1024 * 1024;
  p.wt_ffn_in = ws; ws += (size_t)4 * 5632 * 1024;
  p.wt_ffn_out = ws; ws += (size_t)4 * 1024 * DFF;
  p.wt_ple = ws; ws += (size_t)4 * 1024 * 256;
  p.wt_gate = ws; ws += (size_t)4 * 1024 * 1024;
  p.XB = ws; ws += (size_t)ROWS * 1024;
  p.OG = ws; ws += (size_t)ROWS * 1024;
  p.BIG = (char*)ws;
  p.bar = (unsigned*)((char*)d_ws + ((size_t)500 << 20));
  p.ss = (float*)((char*)d_ws + ((size_t)501 << 20));
  p.ss2 = (float*)((char*)d_ws + ((size_t)507 << 20));
  int n = 0;
  for (int i = 0; i < 2; ++i) p.wd[n++] = WD{w_in_a + (size_t)i * 1024 * 4096, p.wt_in_a + (size_t)i * 4096 * 1024, i ? p.g_norms + 4 * D : nullptr, 1024, 4096, 0, 0};
  for (int i = 0; i < 2; ++i) p.wd[n++] = WD{w_out_a + (size_t)i * 1024 * 1024, p.wt_out_a + (size_t)i * 1024 * 1024, nullptr, 1024, 1024, 0, 0};
  p.wd[n++] = WD{w_kv, p.wt_kv, p.g_kv, 1024, 2048, 0, 0};
  for (int i = 0; i < 2; ++i) p.wd[n++] = WD{w_q_b + (size_t)i * 1024 * 1024, p.wt_q + (size_t)i * 1024 * 1024, p.g_norms + (size_t)(i + 2) * 4 * D, 1024, 1024, 0, 0};
  for (int i = 0; i < 2; ++i) p.wd[n++] = WD{w_out_b + (size_t)i * 1024 * 1024, p.wt_out_b + (size_t)i * 1024 * 1024, nullptr, 1024, 1024, 0, 0};
  for (int i = 0; i < 4; ++i) p.wd[n++] = WD{w_ffn_in + (size_t)i * 1024 * 5632, p.wt_ffn_in + (size_t)i * 5632 * 1024, p.g_norms + (size_t)(i * 4 + 2) * D, 1024, 5632, 1, 0};
  for (int i = 0; i < 4; ++i) p.wd[n++] = WD{w_ffn_out + (size_t)i * DFF * 1024, p.wt_ffn_out + (size_t)i * 1024 * DFF, nullptr, DFF, 1024, 0, 0};
  for (int i = 0; i < 4; ++i) p.wd[n++] = WD{w_ple + (size_t)i * 256 * 1024, p.wt_ple + (size_t)i * 1024 * 256, nullptr, 256, 1024, 0, 0};
  for (int i = 0; i < 4; ++i) p.wd[n++] = WD{w_ple_gate + (size_t)i * 1024 * 1024, p.wt_gate + (size_t)i * 1024 * 1024, nullptr, 1024, 1024, 0, 0};
  void* args[] = {&p};
  hipError_t e = hipLaunchCooperativeKernel((void*)yoco_megakernel, dim3(grid_blocks), dim3(256), args, 0, stream);
  if (e != hipSuccess) fprintf(stderr, "cooperative launch failed: %s (grid %d)\n", hipGetErrorString(e), grid_blocks);
}
```

```cpp
#include <hip/hip_runtime.h>
#include <hip/hip_cooperative_groups.h>
#include <cstdio>
namespace cg = cooperative_groups;

#define DI __device__ __forceinline__
typedef unsigned short u16;
typedef short bf16x8 __attribute__((ext_vector_type(8)));
typedef float f32x16 __attribute__((ext_vector_type(16)));
typedef float f32x4 __attribute__((ext_vector_type(4)));
typedef __bf16 bf2_t __attribute__((ext_vector_type(2)));
typedef float f2_t __attribute__((ext_vector_type(2)));
typedef unsigned u32x2 __attribute__((ext_vector_type(2)));
typedef unsigned u32x4 __attribute__((ext_vector_type(4)));

constexpr int D = 1024, ROWS_P = 32768, ROWS = 33024, DFF = 2816;
constexpr float EPS = 1e-6f;
constexpr float LOG2E = 1.4426950408889634f;
constexpr int NW = 25;
#ifndef REP_GEMM
#define REP_GEMM 1
#endif
#ifndef REP_GLA
#define REP_GLA 1
#endif
#ifndef REP_ATTN
#define REP_ATTN 1
#endif
#define REPG for (int _r = 0; _r < REP_GEMM; ++_r)

struct WD { const float* src; u16* dst; const float* gain; int K, N, mode, pad; };

struct P {
  const float *x_prompt, *x_sample, *cache_k, *cache_v, *state_hgrn, *state_conv, *p_prompt, *p_sample;
  const float *g_norms, *lb_raw, *g_hg, *g_kv, *rel_bias, *lam_b, *g_subln, *conv_w, *conv_b;
  float *y, *k_prompt, *v_prompt, *k_sample, *v_sample, *hgrn_prompt, *hgrn_sample, *conv_prompt, *conv_sample;
  u16 *wt_in_a, *wt_out_a, *wt_kv, *wt_q, *wt_out_b, *wt_ffn_in, *wt_ffn_out, *wt_ple, *wt_gate;
  u16 *XB, *OG; char* BIG; unsigned* bar; float* ss; float* ss2;
  WD wd[NW];
};

DI unsigned pk2(float a, float b) { f2_t v = {a, b}; bf2_t r = __builtin_convertvector(v, bf2_t); return __builtin_bit_cast(unsigned, r); }
DI int lbid() { int b = blockIdx.x; asm volatile("" : "+s"(b)); return b; }
DI int ltid() { int t = threadIdx.x; asm volatile("" : "+v"(t)); return t; }
DI float bf2f(u16 x) { return __uint_as_float(((unsigned)x) << 16); }
DI float bflo(unsigned x) { return __uint_as_float(x << 16); }
DI float bfhi(unsigned x) { return __uint_as_float(x & 0xffff0000u); }
DI float sigm(float x) { return 1.f / (1.f + __expf(-x)); }
DI float wave_sum(float v) {
#pragma unroll
  for (int o = 32; o; o >>= 1) v += __shfl_xor(v, o);
  return v;
}
DI bf16x8 mk8(u32x2 lo, u32x2 hi) { u32x4 t = {lo[0], lo[1], hi[0], hi[1]}; return __builtin_bit_cast(bf16x8, t); }
DI bf16x8 mk8u(unsigned a, unsigned b, unsigned c, unsigned d) { u32x4 t = {a, b, c, d}; return __builtin_bit_cast(bf16x8, t); }

DI void prep_tile_info(const P& p, int flat, int& wi, int& k0, int& n0) {
  int base = 0; wi = 0;
  for (;;) { int nt = (p.wd[wi].K >> 6) * (p.wd[wi].N >> 6); if (flat < base + nt) break; base += nt; ++wi; }
  const int tix = flat - base, ntn = p.wd[wi].N >> 6;
  k0 = (tix / ntn) << 6; n0 = (tix % ntn) << 6;
}
DI void prep_phase(const P& p, char* smem) {
  float* T = (float*)smem;
  const int tid = ltid();
  int total = 0;
  for (int i = 0; i < NW; ++i) total += (p.wd[i].K >> 6) * (p.wd[i].N >> 6);
  const int n = tid & 63, kb = tid >> 6;
  float v[16];
  int flat = lbid();
  int wi = 0, k0 = 0, n0 = 0;
  if (flat < total) {
    prep_tile_info(p, flat, wi, k0, n0);
    const WD& d = p.wd[wi];
#pragma unroll
    for (int j = 0; j < 16; ++j) { const int kk = kb + 4 * j; v[j] = d.src[(size_t)(k0 + kk) * d.N + n0 + n]; if (d.gain) v[j] *= d.gain[k0 + kk]; }
  }
  for (; flat < total; flat += gridDim.x) {
    const WD& d = p.wd[wi];
    const int ck0 = k0, cn0 = n0;
#pragma unroll
    for (int j = 0; j < 16; ++j) T[(kb + 4 * j) * 65 + n] = v[j];
    const int nf = flat + gridDim.x;
    if (nf < total) {
      prep_tile_info(p, nf, wi, k0, n0);
      const WD& d2 = p.wd[wi];
#pragma unroll
      for (int j = 0; j < 16; ++j) { const int kk = kb + 4 * j; v[j] = d2.src[(size_t)(k0 + kk) * d2.N + n0 + n]; if (d2.gain) v[j] *= d2.gain[k0 + kk]; }
    }
    __syncthreads();
    {
      const int nn = tid >> 2, ks = tid & 3;
      int nc = cn0 + nn, drow = nc;
      if (d.mode == 1) { int isu = nc >= DFF; int ch = nc - DFF * isu; drow = 256 * (ch >> 7) + 64 * ((ch >> 5) & 3) + 32 * isu + (ch & 31); }
      unsigned o[8];
#pragma unroll
      for (int j = 0; j < 8; ++j) o[j] = pk2(T[(16 * ks + 2 * j) * 65 + nn], T[(16 * ks + 2 * j + 1) * 65 + nn]);
      u16* fb = d.dst + (((size_t)(drow >> 5) * (d.K >> 4) + ((ck0 >> 4) + ks)) * 64 + (drow & 31)) * 8;
      *(u32x4*)(fb) = (u32x4){o[0], o[1], o[2], o[3]};
      *(u32x4*)(fb + 256) = (u32x4){o[4], o[5], o[6], o[7]};
    }
    __syncthreads();
  }
}

DI void rowop_phase(const P& p, bool x_from_in, const u16* __restrict__ Madd, const float* __restrict__ gpost,
                    const float* __restrict__ gnext, u16* __restrict__ outH, const float* ple_p, const float* ple_s, u16* outP) {
  const int tidr = ltid();
  const int lane = tidr & 63;
  const int wave = (lbid() * blockDim.x + tidr) >> 6;
  const int nwave = (gridDim.x * blockDim.x) >> 6;
  for (int rb = wave * 2; rb < ROWS; rb += nwave * 2) {
    f32x4 x[2][4];
    u32x2 m[2][4];
#pragma unroll
    for (int u = 0; u < 2; ++u) {
      const int r = rb + u;
      const float* xs = x_from_in ? (r < ROWS_P ? p.x_prompt + (size_t)r * D : p.x_sample + (size_t)(r - ROWS_P) * D) : p.y + (size_t)r * D;
#pragma unroll
      for (int j = 0; j < 4; ++j) x[u][j] = *(const f32x4*)(xs + 4 * lane + 256 * j);
      if (Madd) {
#pragma unroll
        for (int j = 0; j < 4; ++j) m[u][j] = *(const u32x2*)(Madd + (size_t)r * D + 4 * lane + 256 * j);
      }
    }
#pragma unroll
    for (int u = 0; u < 2; ++u) {
      const int r = rb + u;
      if (Madd) {
        f32x4 mf[4]; float ss = 0.f;
#pragma unroll
        for (int j = 0; j < 4; ++j) { mf[j] = (f32x4){bflo(m[u][j][0]), bfhi(m[u][j][0]), bflo(m[u][j][1]), bfhi(m[u][j][1])}; ss += mf[j][0] * mf[j][0] + mf[j][1] * mf[j][1] + mf[j][2] * mf[j][2] + mf[j][3] * mf[j][3]; }
        ss = wave_sum(ss);
        const float rs = rsqrtf(ss * (1.f / D) + EPS);
#pragma unroll
        for (int j = 0; j < 4; ++j) { f32x4 g = *(const f32x4*)(gpost + 4 * lane + 256 * j); x[u][j] += mf[j] * rs * g; }
#pragma unroll
        for (int j = 0; j < 4; ++j) *(f32x4*)(p.y + (size_t)r * D + 4 * lane + 256 * j) = x[u][j];
      }
      float rx = 1.f;
      if (gnext) {
        float ss = 0.f;
#pragma unroll
        for (int j = 0; j < 4; ++j) ss += x[u][j][0] * x[u][j][0] + x[u][j][1] * x[u][j][1] + x[u][j][2] * x[u][j][2] + x[u][j][3] * x[u][j][3];
        ss = wave_sum(ss);
        rx = rsqrtf(ss * (1.f / D) + EPS);
      }
#pragma unroll
      for (int j = 0; j < 4; ++j) {
        f32x4 h = x[u][j] * rx;
        if (gnext) h *= *(const f32x4*)(gnext + 4 * lane + 256 * j);
        *(u32x2*)(outH + (size_t)r * D + 4 * lane + 256 * j) = (u32x2){pk2(h[0], h[1]), pk2(h[2], h[3])};
      }
      if (outP) {
        const float* ps = r < ROWS_P ? ple_p + (size_t)r * 256 : ple_s + (size_t)(r - ROWS_P) * 256;
        f32x4 v = *(const f32x4*)(ps + 4 * lane);
        *(u32x2*)(outP + (size_t)r * 256 + 4 * lane) = (u32x2){pk2(v[0], v[1]), pk2(v[2], v[3])};
      }
    }
  }
}

DI void rowop2_phase(const P& p, bool x_from_in, u16* __restrict__ XR, const u16* __restrict__ Madd, const float* __restrict__ gpost,
                     float* __restrict__ ssout, const float* ple_p, const float* ple_s, u16* outP) {
  const int tidr = ltid();
  const int lane = tidr & 63;
  const int wave = (lbid() * blockDim.x + tidr) >> 6;
  const int nwave = (gridDim.x * blockDim.x) >> 6;
  for (int rb = wave * 2; rb < ROWS; rb += nwave * 2) {
    f32x4 x[2][4];
    u32x2 m[2][4];
#pragma unroll
    for (int u = 0; u < 2; ++u) {
      const int r = rb + u;
      if (x_from_in) {
        const float* xs = r < ROWS_P ? p.x_prompt + (size_t)r * D : p.x_sample + (size_t)(r - ROWS_P) * D;
#pragma unroll
        for (int j = 0; j < 4; ++j) x[u][j] = *(const f32x4*)(xs + 4 * lane + 256 * j);
      } else {
#pragma unroll
        for (int j = 0; j < 4; ++j) { const u32x2 t = *(const u32x2*)(XR + (size_t)r * D + 4 * lane + 256 * j); x[u][j] = (f32x4){bflo(t[0]), bfhi(t[0]), bflo(t[1]), bfhi(t[1])}; }
      }
#pragma unroll
      for (int j = 0; j < 4; ++j) m[u][j] = *(const u32x2*)(Madd + (size_t)r * D + 4 * lane + 256 * j);
    }
#pragma unroll
    for (int u = 0; u < 2; ++u) {
      const int r = rb + u;
      f32x4 mf[4]; float ss = 0.f;
#pragma unroll
      for (int j = 0; j < 4; ++j) { mf[j] = (f32x4){bflo(m[u][j][0]), bfhi(m[u][j][0]), bflo(m[u][j][1]), bfhi(m[u][j][1])}; ss += mf[j][0] * mf[j][0] + mf[j][1] * mf[j][1] + mf[j][2] * mf[j][2] + mf[j][3] * mf[j][3]; }
      ss = wave_sum(ss);
      const float rs = rsqrtf(ss * (1.f / D) + EPS);
      float sx = 0.f;
#pragma unroll
      for (int j = 0; j < 4; ++j) {
        const f32x4 g = *(const f32x4*)(gpost + 4 * lane + 256 * j);
        const f32x4 xn = x[u][j] + mf[j] * rs * g;
        const u32x2 o = (u32x2){pk2(xn[0], xn[1]), pk2(xn[2], xn[3])};
        *(u32x2*)(XR + (size_t)r * D + 4 * lane + 256 * j) = o;
        const float q0 = bflo(o[0]), q1 = bfhi(o[0]), q2 = bflo(o[1]), q3 = bfhi(o[1]);
        sx += q0 * q0 + q1 * q1 + q2 * q2 + q3 * q3;
      }
      if (ssout) { sx = wave_sum(sx); if (lane == 0) ssout[r] = sx; }
      if (outP) {
        const float* ps = r < ROWS_P ? ple_p + (size_t)r * 256 : ple_s + (size_t)(r - ROWS_P) * 256;
        f32x4 v = *(const f32x4*)(ps + 4 * lane);
        *(u32x2*)(outP + (size_t)r * 256 + 4 * lane) = (u32x2){pk2(v[0], v[1]), pk2(v[2], v[3])};
      }
    }
  }
}

template <class RowMap>
DI void gemm_core(const u16* __restrict__ A, int lda, RowMap rm, const u16* __restrict__ Bt, int n0, int K,
                  f32x16 (&acc)[4][2], char* smem, const int tid) {
  const int l = tid & 63, w = tid >> 6, l32 = l & 31, hh = l >> 5;
  const int lr = tid >> 3, lc = tid & 7;
  const u16* ap[4];
#pragma unroll
  for (int q = 0; q < 4; ++q) ap[q] = A + (size_t)rm(q * 32 + lr) * lda + lc * 8;
  const u16* bq0 = Bt + ((size_t)((n0 + w * 64) >> 5) * (K >> 4) * 64 + l) * 8;
  const u16* bq1 = bq0 + (size_t)(K >> 4) * 512;
  const unsigned woff = lr * 144 + lc * 16;
  const unsigned aoff = l32 * 144 + hh * 16;
  u32x4 ra0[4];
  bf16x8 bf0[4], bf1[4];
  const int nk = K >> 6;
#define GLOADA(RA, T) _Pragma("unroll") for (int q = 0; q < 4; ++q) { RA[q] = *(const u32x4*)(ap[q] + (T) * 64); }
#define SWRITEA(RA, BUF) { char* db_ = smem + (BUF) * 18432; _Pragma("unroll") for (int q = 0; q < 4; ++q) { *(u32x4*)(db_ + woff + q * 4608) = RA[q]; } }
#define COMPUTE(BUF, TN, MORE) { const char* sb = smem + (BUF) * 18432; _Pragma("unroll") for (int ks = 0; ks < 4; ++ks) { \
      const unsigned co = ks * 32; \
      bf16x8 a0 = *(const bf16x8*)(sb + aoff + co); \
      bf16x8 a1 = *(const bf16x8*)(sb + aoff + 4608 + co); \
      bf16x8 a2 = *(const bf16x8*)(sb + aoff + 9216 + co); \
      bf16x8 a3 = *(const bf16x8*)(sb + aoff + 13824 + co); \
      acc[0][0] = __builtin_amdgcn_mfma_f32_32x32x16_bf16(bf0[ks], a0, acc[0][0], 0, 0, 0); \
      acc[0][1] = __builtin_amdgcn_mfma_f32_32x32x16_bf16(bf1[ks], a0, acc[0][1], 0, 0, 0); \
      acc[1][0] = __builtin_amdgcn_mfma_f32_32x32x16_bf16(bf0[ks], a1, acc[1][0], 0, 0, 0); \
      acc[1][1] = __builtin_amdgcn_mfma_f32_32x32x16_bf16(bf1[ks], a1, acc[1][1], 0, 0, 0); \
      acc[2][0] = __builtin_amdgcn_mfma_f32_32x32x16_bf16(bf0[ks], a2, acc[2][0], 0, 0, 0); \
      acc[2][1] = __builtin_amdgcn_mfma_f32_32x32x16_bf16(bf1[ks], a2, acc[2][1], 0, 0, 0); \
      acc[3][0] = __builtin_amdgcn_mfma_f32_32x32x16_bf16(bf0[ks], a3, acc[3][0], 0, 0, 0); \
      acc[3][1] = __builtin_amdgcn_mfma_f32_32x32x16_bf16(bf1[ks], a3, acc[3][1], 0, 0, 0); \
      if (MORE) { bf0[ks] = *(const bf16x8*)(bq0 + ((TN) * 4 + ks) * 512); bf1[ks] = *(const bf16x8*)(bq1 + ((TN) * 4 + ks) * 512); } \
      __builtin_amdgcn_sched_barrier(0); } }
  GLOADA(ra0, 0);
#pragma unroll
  for (int ks = 0; ks < 4; ++ks) { bf0[ks] = *(const bf16x8*)(bq0 + ks * 512); bf1[ks] = *(const bf16x8*)(bq1 + ks * 512); }
  SWRITEA(ra0, 0);
  __syncthreads();
  for (int kt = 0; kt < nk; kt += 2) {
    GLOADA(ra0, kt + 1);
    __builtin_amdgcn_sched_barrier(0);
    COMPUTE(0, kt + 1, true);
    SWRITEA(ra0, 1);
    __syncthreads();
    if (kt + 2 < nk) GLOADA(ra0, kt + 2);
    __builtin_amdgcn_sched_barrier(0);
    COMPUTE(1, kt + 2, kt + 2 < nk);
    if (kt + 2 < nk) SWRITEA(ra0, 0);
    __syncthreads();
  }
#undef GLOADA
#undef SWRITEA
#undef COMPUTE
}

template <class RowMap>
DI void gemm_core_n1(const u16* __restrict__ A, int lda, RowMap rm, const u16* __restrict__ Bt, int n0, int K,
                     f32x16 (&acc)[4], char* smem, const int tid) {
  const int l = tid & 63, w = tid >> 6, l32 = l & 31, hh = l >> 5;
  const int lr = tid >> 3, lc = tid & 7;
  const u16* ap[4];
#pragma unroll
  for (int q = 0; q < 4; ++q) ap[q] = A + (size_t)rm(q * 32 + lr) * lda + lc * 8;
  const u16* bq0 = Bt + ((size_t)((n0 + w * 32) >> 5) * (K >> 4) * 64 + l) * 8;
  const unsigned woff = lr * 144 + lc * 16;
  const unsigned aoff = l32 * 144 + hh * 16;
  u32x4 ra0[4];
  bf16x8 bf0[4];
  const int nk = K >> 6;
#define GLOADA(RA, T) _Pragma("unroll") for (int q = 0; q < 4; ++q) { RA[q] = *(const u32x4*)(ap[q] + (T) * 64); }
#define SWRITEA(RA, BUF) { char* db_ = smem + (BUF) * 18432; _Pragma("unroll") for (int q = 0; q < 4; ++q) { *(u32x4*)(db_ + woff + q * 4608) = RA[q]; } }
#define COMPUTE(BUF, TN, MORE) { const char* sb = smem + (BUF) * 18432; _Pragma("unroll") for (int ks = 0; ks < 4; ++ks) { \
      const unsigned co = ks * 32; \
      bf16x8 a0 = *(const bf16x8*)(sb + aoff + co); \
      bf16x8 a1 = *(const bf16x8*)(sb + aoff + 4608 + co); \
      bf16x8 a2 = *(const bf16x8*)(sb + aoff + 9216 + co); \
      bf16x8 a3 = *(const bf16x8*)(sb + aoff + 13824 + co); \
      acc[0] = __builtin_amdgcn_mfma_f32_32x32x16_bf16(bf0[ks], a0, acc[0], 0, 0, 0); \
      acc[1] = __builtin_amdgcn_mfma_f32_32x32x16_bf16(bf0[ks], a1, acc[1], 0, 0, 0); \
      acc[2] = __builtin_amdgcn_mfma_f32_32x32x16_bf16(bf0[ks], a2, acc[2], 0, 0, 0); \
      acc[3] = __builtin_amdgcn_mfma_f32_32x32x16_bf16(bf0[ks], a3, acc[3], 0, 0, 0); \
      if (MORE) { bf0[ks] = *(const bf16x8*)(bq0 + ((TN) * 4 + ks) * 512); } \
      __builtin_amdgcn_sched_barrier(0); } }
  GLOADA(ra0, 0);
#pragma unroll
  for (int ks = 0; ks < 4; ++ks) bf0[ks] = *(const bf16x8*)(bq0 + ks * 512);
  SWRITEA(ra0, 0);
  __syncthreads();
  for (int kt = 0; kt < nk; kt += 2) {
    GLOADA(ra0, kt + 1);
    __builtin_amdgcn_sched_barrier(0);
    COMPUTE(0, kt + 1, true);
    SWRITEA(ra0, 1);
    __syncthreads();
    if (kt + 2 < nk) GLOADA(ra0, kt + 2);
    __builtin_amdgcn_sched_barrier(0);
    COMPUTE(1, kt + 2, kt + 2 < nk);
    if (kt + 2 < nk) SWRITEA(ra0, 0);
    __syncthreads();
  }
#undef GLOADA
#undef SWRITEA
#undef COMPUTE
}

template <class RowMap>
DI void gemm_core_mini(const u16* __restrict__ A, int lda, RowMap rm, const u16* __restrict__ Bt, int n0, int K,
                       f32x16 (&acc)[2], char* smem, const int tid) {
  const int l = tid & 63, w = tid >> 6, l32 = l & 31, hh = l >> 5;
  const int lr = tid >> 3, lc = tid & 7;
  const u16* ap[4];
#pragma unroll
  for (int q = 0; q < 4; ++q) ap[q] = A + (size_t)rm(q * 32 + lr) * lda + lc * 8;
  const u16* bq0 = Bt + ((size_t)(n0 >> 5) * (K >> 4) * 64 + l) * 8;
  const u16* bq1 = bq0 + (size_t)(K >> 4) * 512;
  const unsigned woff = lr * 144 + lc * 16;
  const unsigned aoff = (w * 32 + l32) * 144 + hh * 16;
  u32x4 ra0[4];
  bf16x8 bf0[4], bf1[4];
  const int nk = K >> 6;
#define GLOADA(RA, T) _Pragma("unroll") for (int q = 0; q < 4; ++q) { RA[q] = *(const u32x4*)(ap[q] + (T) * 64); }
#define SWRITEA(RA, BUF) { char* db_ = smem + (BUF) * 18432; _Pragma("unroll") for (int q = 0; q < 4; ++q) { *(u32x4*)(db_ + woff + q * 4608) = RA[q]; } }
#define COMPUTE(BUF, TN, MORE) { const char* sb = smem + (BUF) * 18432; _Pragma("unroll") for (int ks = 0; ks < 4; ++ks) { \
      const unsigned co = ks * 32; \
      bf16x8 a0 = *(const bf16x8*)(sb + aoff + co); \
      acc[0] = __builtin_amdgcn_mfma_f32_32x32x16_bf16(bf0[ks], a0, acc[0], 0, 0, 0); \
      acc[1] = __builtin_amdgcn_mfma_f32_32x32x16_bf16(bf1[ks], a0, acc[1], 0, 0, 0); \
      if (MORE) { bf0[ks] = *(const bf16x8*)(bq0 + ((TN) * 4 + ks) * 512); bf1[ks] = *(const bf16x8*)(bq1 + ((TN) * 4 + ks) * 512); } \
      __builtin_amdgcn_sched_barrier(0); } }
  GLOADA(ra0, 0);
#pragma unroll
  for (int ks = 0; ks < 4; ++ks) { bf0[ks] = *(const bf16x8*)(bq0 + ks * 512); bf1[ks] = *(const bf16x8*)(bq1 + ks * 512); }
  SWRITEA(ra0, 0);
  __syncthreads();
  for (int kt = 0; kt < nk; kt += 2) {
    GLOADA(ra0, kt + 1);
    __builtin_amdgcn_sched_barrier(0);
    COMPUTE(0, kt + 1, true);
    SWRITEA(ra0, 1);
    __syncthreads();
    if (kt + 2 < nk) GLOADA(ra0, kt + 2);
    __builtin_amdgcn_sched_barrier(0);
    COMPUTE(1, kt + 2, kt + 2 < nk);
    if (kt + 2 < nk) SWRITEA(ra0, 0);
    __syncthreads();
  }
#undef GLOADA
#undef SWRITEA
#undef COMPUTE
}

DI bool next_tile(int it, int ntm, int ntn, int& tm, int& tn) {
  const int b = lbid(), x = b & 7, slot = b >> 3, S = gridDim.x >> 3;
  const int nq = (ntm - x + 7) >> 3;
  const int L = slot + it * S;
  if (L >= nq * ntn) return false;
  const int gsize = 8 * ntn;
  const int grp = L / gsize, r = L - grp * gsize;
  const int gsz = min(8, nq - 8 * grp);
  tn = r / gsz;
  tm = x + 8 * (8 * grp + r % gsz);
  return true;
}

DI void list_entry(int L, int ntm, int ntn, int& tm, int& tn) {
  const int x = lbid() & 7;
  const int nq = (ntm - x + 7) >> 3;
  const int gsize = 8 * ntn;
  const int grp = L / gsize, r = L - grp * gsize;
  const int gsz = min(8, nq - 8 * grp);
  tn = r / gsz;
  tm = x + 8 * (8 * grp + r % gsz);
}
DI void list_info(int ntm, int ntn, int& full, int& nleft) {
  const int x = lbid() & 7, S = gridDim.x >> 3;
  const int len = ((ntm - x + 7) >> 3) * ntn;
  full = (len / S) * S;
  nleft = len - full;
  if (4 * nleft > S) { full = len; nleft = 0; }
}

struct IdMap { int base; DI int operator()(int r) const { return base + r; } };
struct ClampMap { int rowbase, t0, T; DI int operator()(int r) const { int t = t0 + r; t = t < 0 ? 0 : (t > T - 1 ? T - 1 : t); return rowbase + t; } };
struct ClampMap2 { int rowbase, t0, T, srow; DI int operator()(int r) const { if (srow >= 0 && r >= 64) { int t = r - 66; t = t < 0 ? 0 : (t > 31 ? 31 : t); return srow + t; } int t = t0 + r; t = t < 0 ? 0 : (t > T - 1 ? T - 1 : t); return rowbase + t; } };

#define ZERO_ACC(a) _Pragma("unroll") for (int _i = 0; _i < 4; ++_i) _Pragma("unroll") for (int _j = 0; _j < 2; ++_j) _Pragma("unroll") for (int _e = 0; _e < 16; ++_e) a[_i][_j][_e] = 0.f;

DI float row_rs(const float* rowss, int m) {
  const f32x4* sp = (const f32x4*)(rowss + (size_t)m * 32);
  float tot = 0.f;
#pragma unroll
  for (int j = 0; j < 8; ++j) { const f32x4 s = sp[j]; tot += (s[0] + s[1]) + (s[2] + s[3]); }
  return rsqrtf(tot * (1.f / D) + EPS);
}
template <int EPI>
DI void epi4(const P& p, void* outp, int m, int n, float v0, float v1, float v2, float v3) {
  if (EPI == 0) {
    const int sec = n >> 10;
    if (sec == 0 || sec == 3) { v0 *= sigm(v0); v1 *= sigm(v1); v2 *= sigm(v2); v3 *= sigm(v3); }
    *(u32x2*)((u16*)outp + (size_t)m * 4096 + n) = (u32x2){pk2(v0, v1), pk2(v2, v3)};
  } else if (EPI == 1) {
    const float sc = 0.125f * LOG2E;
    *(u32x2*)((u16*)outp + (size_t)m * 1024 + n) = (u32x2){pk2(v0 * sc, v1 * sc), pk2(v2 * sc, v3 * sc)};
  } else if (EPI == 2) {
    *(u32x2*)((u16*)outp + (size_t)m * 1024 + n) = (u32x2){pk2(v0, v1), pk2(v2, v3)};
  } else {
    float* dst;
    if (n < 1024) dst = (m < ROWS_P ? p.k_prompt + (size_t)m * 1024 : p.k_sample + (size_t)(m - ROWS_P) * 1024) + n;
    else dst = (m < ROWS_P ? p.v_prompt + (size_t)m * 1024 : p.v_sample + (size_t)(m - ROWS_P) * 1024) + (n - 1024);
    *(f32x4*)dst = (f32x4){v0, v1, v2, v3};
    if (m < ROWS_P) {
      const int s = m >> 11, key = m & 2047, kt = key >> 6, kl = key & 63;
      const int nn = n & 1023, h = nn >> 7, d = nn & 127;
      u16* tile = (u16*)(p.BIG + (size_t)ROWS * 1024 * 2 + (size_t)((s * 8 + h) * 32 + kt) * 32768);
      if (n < 1024) {
        *(u32x2*)(tile + kl * 128 + d) = (u32x2){pk2(v0, v1), pk2(v2, v3)};
      } else {
        u16* vt = tile + 8192 + d * 64 + kl;
        const unsigned a = pk2(v0, v1), b2 = pk2(v2, v3);
        vt[0] = (u16)(a & 0xffffu); vt[64] = (u16)(a >> 16); vt[128] = (u16)(b2 & 0xffffu); vt[192] = (u16)(b2 >> 16);
      }
    }
  }
}
template <int EPI>
DI void gemm_phase(const P& p, const u16* A, int K, const u16* Bt, int N, void* outp, char* smem, const float* rowss = nullptr) {
  const int tid = ltid(), l = tid & 63, w = tid >> 6, l32 = l & 31, hh = l >> 5;
  const int ntm = ROWS / 128, ntn = N / 256;
  const int slot = lbid() >> 3, S = gridDim.x >> 3;
  int full, nleft, tm, tn;
  list_info(ntm, ntn, full, nleft);
  for (int L = slot; L < full; L += S) {
    list_entry(L, ntm, ntn, tm, tn);
    f32x16 acc[4][2];
    ZERO_ACC(acc);
    gemm_core(A, K, IdMap{tm * 128}, Bt, tn * 256, K, acc, smem, ltid());
#pragma unroll
    for (int mi = 0; mi < 4; ++mi) {
      const int m = tm * 128 + mi * 32 + l32;
      float rsc = 1.f;
      if (rowss) rsc = row_rs(rowss, m);
#pragma unroll
      for (int ni = 0; ni < 2; ++ni)
#pragma unroll
        for (int q = 0; q < 4; ++q)
          epi4<EPI>(p, outp, m, tn * 256 + w * 64 + ni * 32 + 8 * q + 4 * hh,
                    acc[mi][ni][4 * q] * rsc, acc[mi][ni][4 * q + 1] * rsc, acc[mi][ni][4 * q + 2] * rsc, acc[mi][ni][4 * q + 3] * rsc);
    }
  }
  if (slot < 4 * nleft) {
    list_entry(full + (slot >> 2), ntm, ntn, tm, tn);
    const int n0 = tn * 256 + (slot & 3) * 64;
    f32x16 acc[2];
#pragma unroll
    for (int e = 0; e < 16; ++e) { acc[0][e] = 0.f; acc[1][e] = 0.f; }
    gemm_core_mini(A, K, IdMap{tm * 128}, Bt, n0, K, acc, smem, ltid());
    const int m = tm * 128 + w * 32 + l32;
    float rsc = 1.f;
    if (rowss) rsc = row_rs(rowss, m);
#pragma unroll
    for (int ni = 0; ni < 2; ++ni)
#pragma unroll
      for (int q = 0; q < 4; ++q)
        epi4<EPI>(p, outp, m, n0 + ni * 32 + 8 * q + 4 * hh,
                  acc[ni][4 * q] * rsc, acc[ni][4 * q + 1] * rsc, acc[ni][4 * q + 2] * rsc, acc[ni][4 * q + 3] * rsc);
  }
}

DI void ple_epi(const P& p, const u16* PL, const u16* XIN, u16* XOUT, int m, int n, float a0, float a1, float a2, float a3, float& ssq) {
  const u32x2 xi = *(const u32x2*)(XIN + (size_t)m * D + n);
  f32x4 x = (f32x4){bflo(xi[0]), bfhi(xi[0]), bflo(xi[1]), bfhi(xi[1])};
  const u32x2 pv = *(const u32x2*)(PL + (size_t)m * D + n);
  x[0] += sigm(a0) * bflo(pv[0]);
  x[1] += sigm(a1) * bfhi(pv[0]);
  x[2] += sigm(a2) * bflo(pv[1]);
  x[3] += sigm(a3) * bfhi(pv[1]);
  if (XOUT) {
    const u32x2 o = (u32x2){pk2(x[0], x[1]), pk2(x[2], x[3])};
    *(u32x2*)(XOUT + (size_t)m * D + n) = o;
    const float q0 = bflo(o[0]), q1 = bfhi(o[0]), q2 = bflo(o[1]), q3 = bfhi(o[1]);
    ssq += q0 * q0 + q1 * q1 + q2 * q2 + q3 * q3;
  } else {
    *(f32x4*)(p.y + (size_t)m * D + n) = x;
  }
}
DI void ple_phase(const P& p, int layer, const u16* XIN, u16* XOUT, char* smem) {
  const int tid = ltid(), l = tid & 63, w = tid >> 6, l32 = l & 31, hh = l >> 5;
  const u16* PB = (const u16*)p.BIG;
  const u16* Wg = p.wt_gate + (size_t)layer * 1024 * 1024;
  const u16* Wp = p.wt_ple + (size_t)layer * 1024 * 256;
  const int ntm = ROWS / 128, ntn = 8;
  const int slot = lbid() >> 3, S = gridDim.x >> 3;
  const int len = ((ntm - (lbid() & 7) + 7) >> 3) * ntn;
  int tm, tn;
  for (int L = slot; L < len; L += S) {
    list_entry(L, ntm, ntn, tm, tn);
    f32x16 accP[4], accG[4];
#pragma unroll
    for (int mi = 0; mi < 4; ++mi)
#pragma unroll
      for (int e = 0; e < 16; ++e) { accP[mi][e] = 0.f; accG[mi][e] = 0.f; }
    gemm_core_n1(PB, 256, IdMap{tm * 128}, Wp, tn * 128, 256, accP, smem, ltid());
    gemm_core_n1(XIN, 1024, IdMap{tm * 128}, Wg, tn * 128, 1024, accG, smem, ltid());
#pragma unroll
    for (int mi = 0; mi < 4; ++mi) {
      const int m = tm * 128 + mi * 32 + l32;
      float ssq = 0.f;
#pragma unroll
      for (int q = 0; q < 4; ++q) {
        const int n = tn * 128 + w * 32 + 8 * q + 4 * hh;
        const u32x2 xi = *(const u32x2*)(XIN + (size_t)m * D + n);
        f32x4 x = (f32x4){bflo(xi[0]), bfhi(xi[0]), bflo(xi[1]), bfhi(xi[1])};
#pragma unroll
        for (int c = 0; c < 4; ++c) x[c] += sigm(accG[mi][4 * q + c]) * accP[mi][4 * q + c];
        if (XOUT) {
          const u32x2 o = (u32x2){pk2(x[0], x[1]), pk2(x[2], x[3])};
          *(u32x2*)(XOUT + (size_t)m * D + n) = o;
          const float q0 = bflo(o[0]), q1 = bfhi(o[0]), q2 = bflo(o[1]), q3 = bfhi(o[1]);
          ssq += q0 * q0 + q1 * q1 + q2 * q2 + q3 * q3;
        } else {
          *(f32x4*)(p.y + (size_t)m * D + n) = x;
        }
      }
      ssq += __shfl_xor(ssq, 32);
      if (hh == 0) p.ss[(size_t)m * 32 + tn * 4 + w] = ssq;
    }
  }
}

DI void ffn_in_phase(const P& p, int layer, const u16* XR, char* smem) {
  const int tid = ltid(), l = tid & 63, w = tid >> 6, l32 = l & 31, hh = l >> 5;
  const u16* Wt = p.wt_ffn_in + (size_t)layer * 5632 * 1024;
  u16* HID = (u16*)p.BIG;
  const float* cw = p.conv_w + (size_t)layer * 3 * DFF;
  const float* cb = p.conv_b + (size_t)layer * DFF;
  int tm, tn;
  for (int it = 0; next_tile(it, 272, 22, tm, tn); ++it) {
    const int seq = tm / 17, j = tm - seq * 17;
    const int T = 2048, rowbase = seq * 2048, t0 = 126 * j - 2;
    const bool last = (j == 16);
    const bool has_smp = last && seq < 8;
    const int srow = ROWS_P + seq * 32;
    f32x16 acc[4][2];
    ZERO_ACC(acc);
    const ClampMap2 rmap{rowbase, t0, T, has_smp ? srow : -1};
    gemm_core(XR, 1024, rmap, Wt, tn * 256, 1024, acc, smem, tid);
#pragma unroll
    for (int mi = 0; mi < 4; ++mi) {
      const float rsr = rsqrtf(p.ss2[rmap(mi * 32 + l32)] * (1.f / D) + EPS);
#pragma unroll
      for (int e = 0; e < 16; ++e) { acc[mi][0][e] *= rsr; acc[mi][1][e] *= rsr; }
    }
    const int chw = tn * 128 + w * 32;
    if (t0 < 0 && l32 < 2) {
#pragma unroll
      for (int q = 0; q < 4; ++q)
#pragma unroll
        for (int c = 0; c < 4; ++c) acc[0][0][4 * q + c] = 0.f;
    }
    if (has_smp && l32 < 2) {
#pragma unroll
      for (int q = 0; q < 4; ++q) {
        const f32x4 sv = *(const f32x4*)(p.state_conv + ((size_t)(layer * 8 + seq) * 2 + l32) * DFF + chw + 8 * q + 4 * hh);
#pragma unroll
        for (int c = 0; c < 4; ++c) acc[2][0][4 * q + c] = sv[c];
      }
    }
    const int lbase = l & 32;
#pragma unroll
    for (int q = 0; q < 4; ++q) {
      const int chq = chw + 8 * q + 4 * hh;
      const f32x4 b4 = *(const f32x4*)(cb + chq);
      const f32x4 w0 = *(const f32x4*)(cw + chq), w1 = *(const f32x4*)(cw + DFF + chq), w2 = *(const f32x4*)(cw + 2 * DFF + chq);
#pragma unroll
      for (int mi = 0; mi < 4; ++mi) {
        const int m = mi * 32 + l32;
        const bool seg1 = has_smp && mi >= 2;
        const int t = seg1 ? m - 66 : t0 + m;
        const int Tm = seg1 ? 32 : T;
        float hv[4];
#pragma unroll
        for (int c = 0; c < 4; ++c) {
          const float g0 = acc[mi][0][4 * q + c];
          float g1 = __shfl(g0, lbase + ((l32 + 31) & 31));
          float g2 = __shfl(g0, lbase + ((l32 + 30) & 31));
          if (mi > 0) {
            const float pg = acc[mi > 0 ? mi - 1 : 0][0][4 * q + c];
            const float p1 = __shfl(pg, lbase + 31), p2 = __shfl(pg, lbase + 30);
            if (l32 == 0) { g1 = p1; g2 = p2; }
            if (l32 == 1) { g2 = p1; }
          }
          const float cv = b4[c] + w0[c] * g2 + w1[c] * g1 + w2[c] * g0;
          hv[c] = cv * sigm(cv) * acc[mi][1][4 * q + c];
        }
        if ((seg1 ? m >= 66 : m >= 2) && t < Tm) {
          *(u32x2*)(HID + (size_t)((seg1 ? srow : rowbase) + t) * DFF + chq) = (u32x2){pk2(hv[0], hv[1]), pk2(hv[2], hv[3])};
          if (last && t >= Tm - 2) {
            float* co = seg1 ? p.conv_sample + ((size_t)(layer * 8 + seq) * 2 + (t - 30)) * DFF
                             : p.conv_prompt + ((size_t)(layer * 16 + seq) * 2 + (t - (T - 2))) * DFF;
            *(f32x4*)(co + chq) = (f32x4){acc[mi][0][4 * q], acc[mi][0][4 * q + 1], acc[mi][0][4 * q + 2], acc[mi][0][4 * q + 3]};
          }
        }
      }
    }
  }
}

DI void gla_state_phase(const P& p, int layer, char* smem) {
  const u16* PROJ = (const u16*)p.BIG;
  const int tid = ltid(), l = tid & 63, w = tid >> 6, l32 = l & 31, hh = l >> 5;
  float* SLOC = (float*)((char*)p.y + (size_t)ROWS * 1024 * 2);
  float* DTOT = SLOC + (size_t)384 * 16384;
  const int k = tid >> 1, th = tid & 1;
  for (int item = lbid(); item < 384; item += gridDim.x) {
    const int sh = item / 3, ch = item - sh * 3, s = sh >> 3, h = sh & 7;
    const int rowbase = s * 2048 + ch * 512;
    float lower = 0.f;
    if (layer == 1) lower = sigm(p.lb_raw[1024 + h * 128 + k] - p.lb_raw[h * 128 + k]);
    const float oml = 1.f - lower;
    f32x16 S[4];
#pragma unroll
    for (int kt = 0; kt < 4; ++kt)
#pragma unroll
      for (int i = 0; i < 16; ++i) S[kt][i] = 0.f;
    float btot = 0.f;
    u16 fr[8], vr[8];
#define GS_LOAD(BLK) { const size_t r0_ = (size_t)rowbase + (BLK) * 16; \
      const u16* pf_ = PROJ + (r0_ + 8 * th) * 4096 + 1024 + h * 128 + k; \
      const u16* pv_ = PROJ + r0_ * 4096 + 2048 + h * 128 + 32 * w + l32; \
      _Pragma("unroll") for (int t = 0; t < 8; ++t) fr[t] = pf_[(size_t)t * 4096]; \
      _Pragma("unroll") for (int jj = 0; jj < 8; ++jj) vr[jj] = pv_[(size_t)(8 * (jj >> 2) + 4 * hh + (jj & 3)) * 4096]; }
    GS_LOAD(0);
    for (int blk = 0; blk < 32; ++blk) {
      char* sb = smem + (blk & 1) * 8192;
      u16* KDT = (u16*)sb;
      float* DD = (float*)(KDT + 128 * 20);
      {
        float km[8], eb[8];
        float bs = 0.f;
#pragma unroll
        for (int t = 0; t < 8; ++t) {
          const float f = bf2f(fr[t]);
          const float g = lower + oml * sigm(f);
          bs += __logf(g);
          km[t] = 1.f - g; eb[t] = bs;
        }
        const float other = __shfl_xor(bs, 1);
        const float boff = th ? other : 0.f;
        const float bsum = bs + other;
        btot += bsum;
        unsigned kdp[4];
#pragma unroll
        for (int j = 0; j < 4; ++j)
          kdp[j] = pk2(km[2 * j] * __expf(bsum - boff - eb[2 * j]), km[2 * j + 1] * __expf(bsum - boff - eb[2 * j + 1]));
        *(u32x2*)(KDT + k * 20 + 8 * th) = (u32x2){kdp[0], kdp[1]};
        *(u32x2*)(KDT + k * 20 + 8 * th + 4) = (u32x2){kdp[2], kdp[3]};
        if (th == 0) DD[k] = __expf(bsum);
      }
      const bf16x8 vfrag = mk8u((unsigned)vr[0] | ((unsigned)vr[1] << 16), (unsigned)vr[2] | ((unsigned)vr[3] << 16),
                                (unsigned)vr[4] | ((unsigned)vr[5] << 16), (unsigned)vr[6] | ((unsigned)vr[7] << 16));
      if (blk + 1 < 32) GS_LOAD(blk + 1);
      __syncthreads();
#pragma unroll
      for (int kt = 0; kt < 4; ++kt) {
#pragma unroll
        for (int q = 0; q < 4; ++q) {
          const f32x4 d4 = *(const f32x4*)(DD + 32 * kt + 8 * q + 4 * hh);
#pragma unroll
          for (int c = 0; c < 4; ++c) S[kt][4 * q + c] *= d4[c];
        }
        const u32x2 lo = *(const u32x2*)(KDT + (32 * kt + l32) * 20 + 4 * hh);
        const u32x2 hi = *(const u32x2*)(KDT + (32 * kt + l32) * 20 + 8 + 4 * hh);
        S[kt] = __builtin_amdgcn_mfma_f32_32x32x16_bf16(mk8(lo, hi), vfrag, S[kt], 0, 0, 0);
      }
    }
#undef GS_LOAD
    {
      float* op = SLOC + (size_t)item * 16384 + 32 * w + l32;
#pragma unroll
      for (int kt = 0; kt < 4; ++kt)
#pragma unroll
        for (int i = 0; i < 16; ++i) op[(size_t)(32 * kt + (i & 3) + 8 * (i >> 2) + 4 * hh) * 128] = S[kt][i];
      if (th == 0) DTOT[(size_t)item * 128 + k] = __expf(btot);
    }
    __syncthreads();
  }
}

DI void gla_phase(const P& p, int layer, char* smem) {
  const u16* PROJ = (const u16*)p.BIG;
  const int tid = ltid(), l = tid & 63, w = tid >> 6, l32 = l & 31, hh = l >> 5, m16 = l & 15;
  float* REDB = (float*)(smem + 2 * 14336);
  const int k = tid >> 1, th = tid & 1;
  const float* SLOC = (const float*)((const char*)p.y + (size_t)ROWS * 1024 * 2);
  const float* DTOT = SLOC + (size_t)384 * 16384;
  for (int item = lbid(); item < 576; item += gridDim.x) {
    const bool smp = item < 64;
    const int s = smp ? 16 + (item >> 3) : (item - 64) >> 5;
    const int h = smp ? (item & 7) : ((item - 64) >> 2) & 7;
    const int ch = smp ? 0 : (item - 64) & 3;
    const int T = smp ? 32 : 512;
    const int rowbase = smp ? ROWS_P + (s - 16) * 32 : s * 2048 + ch * 512;
    float lower = 0.f;
    if (layer == 1) lower = sigm(p.lb_raw[1024 + h * 128 + k] - p.lb_raw[h * 128 + k]);
    const float oml = 1.f - lower;
    f32x16 S[4];
    if (smp) {
      const float* sp = p.state_hgrn + ((size_t)(layer * 8 + (s - 16)) * 8 + h) * 16384 + 32 * w + l32;
#pragma unroll
      for (int kt = 0; kt < 4; ++kt)
#pragma unroll
        for (int i = 0; i < 16; ++i) S[kt][i] = sp[(size_t)(32 * kt + (i & 3) + 8 * (i >> 2) + 4 * hh) * 128];
    } else {
#pragma unroll
      for (int kt = 0; kt < 4; ++kt)
#pragma unroll
        for (int i = 0; i < 16; ++i) S[kt][i] = 0.f;
#pragma unroll 1
      for (int j = 0; j < ch; ++j) {
        const int it1 = (s * 8 + h) * 3 + j;
        const float* sl = SLOC + (size_t)it1 * 16384 + 32 * w + l32 + (size_t)(4 * hh) * 128;
        const float* dl = DTOT + (size_t)it1 * 128 + 4 * hh;
#pragma unroll
        for (int kt = 0; kt < 4; ++kt) {
#pragma unroll
          for (int q = 0; q < 4; ++q) {
            const float* slq = sl + (size_t)(32 * kt + 8 * q) * 128;
            const f32x4 d4 = *(const f32x4*)(dl + 32 * kt + 8 * q);
#pragma unroll
            for (int c = 0; c < 4; ++c) S[kt][4 * q + c] = S[kt][4 * q + c] * d4[c] + slq[c * 128];
            __builtin_amdgcn_sched_barrier(0);
          }
        }
      }
    }
    const int nblk = T >> 4;
    u16 fr[8], qr[8], vr[8];
#define GLA_LOADRAW(BLK) { const size_t r0_ = (size_t)rowbase + (BLK) * 16; \
      const u16* pf_ = PROJ + (r0_ + 8 * th) * 4096 + 1024 + h * 128 + k; \
      const u16* pq_ = PROJ + (r0_ + 8 * th) * 4096 + h * 128 + k; \
      _Pragma("unroll") for (int t = 0; t < 8; ++t) fr[t] = pf_[(size_t)t * 4096]; \
      _Pragma("unroll") for (int j = 0; j < 8; ++j) qr[j] = pq_[(size_t)j * 4096]; \
 }
#define GLA_LOADV(BLK) { const u16* pv_ = PROJ + ((size_t)rowbase + (BLK) * 16) * 4096 + 2048 + h * 128 + 32 * w + l32; \
      _Pragma("unroll") for (int jj = 0; jj < 8; ++jj) vr[jj] = pv_[(size_t)(8 * (jj >> 2) + 4 * hh + (jj & 3)) * 4096]; }
#define GLA_LOADGS(BLK) { const u16* pg_ = PROJ + ((size_t)rowbase + (BLK) * 16 + m16) * 4096 + 3072 + h * 128 + 32 * w + 4 * hh; \
      _Pragma("unroll") for (int q = 0; q < 4; ++q) gsl[q] = *(const u32x2*)(pg_ + 8 * q); }
#define GLA_FINAL(BLK) { const float* RED_ = REDB + ((BLK) & 1) * 64; \
      if (l32 < 16) { \
        const float tot = RED_[l32] + RED_[16 + l32] + RED_[32 + l32] + RED_[48 + l32]; \
        const float rn = rsqrtf(tot * (1.f / 128.f) + EPS); \
        u16* op_ = p.OG + ((size_t)rowbase + (BLK) * 16 + l32) * 1024 + h * 128 + 32 * w + 4 * hh; \
        const float* gp_ = p.g_hg + layer * 1024 + h * 128 + 32 * w + 4 * hh; \
        _Pragma("unroll") for (int q = 0; q < 4; ++q) { const f32x4 gh = *(const f32x4*)(gp_ + 8 * q); \
          *(u32x2*)(op_ + 8 * q) = (u32x2){pk2(oacc[4 * q] * rn * gh[0] * bflo(gsl[q][0]), oacc[4 * q + 1] * rn * gh[1] * bfhi(gsl[q][0])), \
                                          pk2(oacc[4 * q + 2] * rn * gh[2] * bflo(gsl[q][1]), oacc[4 * q + 3] * rn * gh[3] * bfhi(gsl[q][1]))}; } \
      } }
    GLA_LOADRAW(0);
    u32x2 gsl[4];
    for (int blk = 0; blk < nblk; ++blk) {
      GLA_LOADGS(blk);
      GLA_LOADV(blk);
      char* sb = smem + (blk & 1) * 14336;
      u16* QT = (u16*)sb;
      u16* KT = QT + 16 * 136;
      u16* KDT = KT + 16 * 136;
      float* DD = (float*)(KDT + 128 * 20);
      {
        float qtm[8], ktm[8];
        float bs = 0.f;
#pragma unroll
        for (int t = 0; t < 8; ++t) {
          const float f = bf2f(fr[t]);
          const float g = lower + oml * sigm(f);
          bs += __logf(g);
          const float eb = __expf(bs);
          qtm[t] = bf2f(qr[t]) * eb;
          ktm[t] = (1.f - g) * __builtin_amdgcn_rcpf(eb);
        }
        const float other = __shfl_xor(bs, 1);
        const float boff = th ? other : 0.f;
        const float bsum = bs + other;
        const float E1 = __expf(boff), E1i = __expf(-boff), EL = __expf(bsum);
        unsigned kdp[4];
        float kdprev = 0.f;
#pragma unroll
        for (int j = 0; j < 8; ++j) {
          const int t = 8 * th + j;
          const float qt = qtm[j] * E1;
          const float ktv = ktm[j] * E1i;
          const float kd = ktv * EL;
          QT[t * 136 + k] = (u16)(pk2(qt, 0.f) & 0xffffu);
          KT[t * 136 + k] = (u16)(pk2(ktv, 0.f) & 0xffffu);
          if (j & 1) kdp[j >> 1] = pk2(kdprev, kd); else kdprev = kd;
        }
        *(u32x2*)(KDT + k * 20 + 8 * th) = (u32x2){kdp[0], kdp[1]};
        *(u32x2*)(KDT + k * 20 + 8 * th + 4) = (u32x2){kdp[2], kdp[3]};
        if (th == 0) DD[k] = __expf(bsum);
      }
      if (blk + 1 < nblk) GLA_LOADRAW(blk + 1);
      __syncthreads();
      const bf16x8 vfrag = mk8u((unsigned)vr[0] | ((unsigned)vr[1] << 16), (unsigned)vr[2] | ((unsigned)vr[3] << 16),
                                (unsigned)vr[4] | ((unsigned)vr[5] << 16), (unsigned)vr[6] | ((unsigned)vr[7] << 16));
      f32x16 aacc, oacc;
#pragma unroll
      for (int i = 0; i < 16; ++i) { aacc[i] = 0.f; oacc[i] = 0.f; }
#pragma unroll
      for (int ks = 0; ks < 8; ++ks) {
        const bf16x8 ka = *(const bf16x8*)(KT + m16 * 136 + 16 * ks + 8 * hh);
        const bf16x8 qb = *(const bf16x8*)(QT + m16 * 136 + 16 * ks + 8 * hh);
        aacc = __builtin_amdgcn_mfma_f32_32x32x16_bf16(ka, qb, aacc, 0, 0, 0);
        const int kt = ks >> 1, s2 = ks & 1;
        const bf16x8 sa = mk8u(pk2(S[kt][8 * s2], S[kt][8 * s2 + 1]), pk2(S[kt][8 * s2 + 2], S[kt][8 * s2 + 3]),
                               pk2(S[kt][8 * s2 + 4], S[kt][8 * s2 + 5]), pk2(S[kt][8 * s2 + 6], S[kt][8 * s2 + 7]));
        const u32x2 lo = *(const u32x2*)(QT + m16 * 136 + 32 * kt + 16 * s2 + 4 * hh);
        const u32x2 hi = *(const u32x2*)(QT + m16 * 136 + 32 * kt + 16 * s2 + 8 + 4 * hh);
        oacc = __builtin_amdgcn_mfma_f32_32x32x16_bf16(sa, mk8(lo, hi), oacc, 0, 0, 0);
      }
      float am[8];
#pragma unroll
      for (int i = 0; i < 8; ++i) { const int m = (i & 3) + 8 * (i >> 2) + 4 * hh; am[i] = (m <= m16) ? aacc[i] : 0.f; }
      const bf16x8 afrag = mk8u(pk2(am[0], am[1]), pk2(am[2], am[3]), pk2(am[4], am[5]), pk2(am[6], am[7]));
      oacc = __builtin_amdgcn_mfma_f32_32x32x16_bf16(vfrag, afrag, oacc, 0, 0, 0);
#pragma unroll
      for (int kt = 0; kt < 4; ++kt) {
#pragma unroll
        for (int q = 0; q < 4; ++q) {
          const f32x4 d4 = *(const f32x4*)(DD + 32 * kt + 8 * q + 4 * hh);
#pragma unroll
          for (int c = 0; c < 4; ++c) S[kt][4 * q + c] *= d4[c];
        }
        const u32x2 lo = *(const u32x2*)(KDT + (32 * kt + l32) * 20 + 4 * hh);
        const u32x2 hi = *(const u32x2*)(KDT + (32 * kt + l32) * 20 + 8 + 4 * hh);
        S[kt] = __builtin_amdgcn_mfma_f32_32x32x16_bf16(mk8(lo, hi), vfrag, S[kt], 0, 0, 0);
      }
      float ss = 0.f;
#pragma unroll
      for (int i = 0; i < 16; ++i) ss += oacc[i] * oacc[i];
      ss += __shfl_xor(ss, 32);
      if (l < 16) REDB[(blk & 1) * 64 + w * 16 + l] = ss;
      __syncthreads();
      GLA_FINAL(blk);
    }
#undef GLA_LOADGS
#undef GLA_LOADV
#undef GLA_LOADRAW
#undef GLA_FINAL
    if (smp || ch == 3) {
      float* op = (smp ? p.hgrn_sample + ((size_t)(layer * 8 + (s - 16)) * 8 + h) * 16384
                       : p.hgrn_prompt + ((size_t)(layer * 16 + s) * 8 + h) * 16384) + 32 * w + l32;
#pragma unroll
      for (int kt = 0; kt < 4; ++kt)
#pragma unroll
        for (int i = 0; i < 16; ++i) op[(size_t)(32 * kt + (i & 3) + 8 * (i >> 2) + 4 * hh) * 128] = S[kt][i];
    }
  }
}

DI void kvconv_phase(const P& p, int first) {
  const int tid = ltid();
  char* KVT = p.BIG + (size_t)ROWS * 1024 * 2;
  for (int t = first + lbid(); t < 4096 + 1088; t += gridDim.x) {
    const float *kb, *vb; int nvalid = 64;
    if (t < 4096) { const int kt = t & 31, sh = t >> 5, s = sh >> 3, h = sh & 7; const size_t off = ((size_t)(s * 2048 + 64 * kt)) * 1024 + h * 128; kb = p.k_prompt + off; vb = p.v_prompt + off; }
    else { const int u = t - 4096; const int kt = u % 17, sh = u / 17, b = sh >> 3, h = sh & 7;
      if (kt < 16) { const size_t off = ((size_t)(b * 1024 + 64 * kt)) * 1024 + h * 128; kb = p.cache_k + off; vb = p.cache_v + off; }
      else { const size_t off = ((size_t)(b * 32)) * 1024 + h * 128; kb = p.k_sample + off; vb = p.v_sample + off; nvalid = 32; } }
    u16* kd = (u16*)(KVT + (size_t)t * 32768);
    u16* vd = kd + 8192;
#pragma unroll
    for (int pp = 0; pp < 4; ++pp) {
      const int key = 16 * pp + (tid >> 4), d8 = (tid & 15) * 8;
      f32x4 a = {0.f, 0.f, 0.f, 0.f}, b2 = {0.f, 0.f, 0.f, 0.f};
      if (key < nvalid) { a = *(const f32x4*)(kb + (size_t)key * 1024 + d8); b2 = *(const f32x4*)(kb + (size_t)key * 1024 + d8 + 4); }
      *(u32x4*)(kd + key * 128 + d8) = (u32x4){pk2(a[0], a[1]), pk2(a[2], a[3]), pk2(b2[0], b2[1]), pk2(b2[2], b2[3])};
    }
#pragma unroll
    for (int c = 0; c < 4; ++c) {
      const int v = tid & 127, cc = 4 * (tid >> 7) + c;
      float e[8];
#pragma unroll
      for (int j = 0; j < 8; ++j) { const int key = 8 * cc + j; e[j] = key < nvalid ? vb[(size_t)key * 1024 + v] : 0.f; }
      *(u32x4*)(vd + v * 64 + 8 * cc) = (u32x4){pk2(e[0], e[1]), pk2(e[2], e[3]), pk2(e[4], e[5]), pk2(e[6], e[7])};
    }
  }
}

DI void attn_phase(const P& p, int layer, char* smem) {
  const int jl = layer - 2;
  const u16* Q = (const u16*)p.BIG;
  const char* KVT = p.BIG + (size_t)ROWS * 1024 * 2;
  const int tid = ltid(), l = tid & 63, w = tid >> 6, l16 = l & 15, g = l >> 4;
  u16* KS = (u16*)smem;
  u16* VT = KS + 64 * 136;
  float* BT = (float*)(VT + 128 * 72);
  u16* QS = (u16*)(BT + 256);
  const float lam_init = 0.8f - 0.6f * __expf(-0.3f * (float)layer);
  float lam;
  {
    const float* lp = p.lam_b + jl * 256;
    float a = 0.f, b = 0.f;
    for (int d = 0; d < 64; ++d) { a += lp[d] * lp[64 + d]; b += lp[128 + d] * lp[192 + d]; }
    lam = __expf(a) - __expf(b) + lam_init;
  }
  const int bidA = lbid(), GA = gridDim.x;
  for (int kk = 0; kk * GA < 4096 + 64; ++kk) {
    const int item = ((kk & 1) ? (GA - 1 - bidA) : bidA) + kk * GA;
    if (item >= 4096 + 64) continue;
    int b, h, nq, qrow0, qpos0, ntiles, tile0; bool smp;
    if (item < 4096) { const int jq = 31 - (item >> 7); const int bh = item & 127; b = bh >> 3; h = bh & 7; smp = false; nq = 64; qrow0 = b * 2048 + 64 * jq; qpos0 = 64 * jq; ntiles = jq + 1; tile0 = bh * 32; }
    else { const int si = item - 4096; b = si >> 3; h = si & 7; smp = true; nq = 32; qrow0 = ROWS_P + b * 32; qpos0 = 1024; ntiles = 17; tile0 = 4096 + si * 17; }
    __syncthreads();
    if (tid < 230) {
      const int rel = tid - 166;
      const int n = rel < 0 ? -rel : rel;
      int bk = n < 8 ? n : 8 + (n >= 13) + (n >= 20) + (n >= 30) + (n >= 46) + (n >= 70) + (n >= 108) + (n >= 166);
      if (rel > 0) bk += 16;
      BT[tid] = p.rel_bias[bk * 8 + h] * LOG2E;
    }
#pragma unroll
    for (int pp = 0; pp < 4; ++pp) {
      const int idx = pp * 256 + tid, r = idx >> 4, c16 = idx & 15;
      *(u32x4*)(QS + r * 136 + c16 * 8) = *(const u32x4*)(Q + (size_t)(qrow0 + min(r, nq - 1)) * 1024 + h * 128 + c16 * 8);
    }
    f32x4 oacc[2][8];
#pragma unroll
    for (int c = 0; c < 2; ++c)
#pragma unroll
      for (int vs = 0; vs < 8; ++vs) oacc[c][vs] = (f32x4){0.f, 0.f, 0.f, 0.f};
    float mrun[2] = {-1e30f, -1e30f}, lsum[2] = {0.f, 0.f};
    const int qpos = qpos0 + min(16 * w + l16, nq - 1);
    u32x4 rk[4], rv[4];
    {
      const u32x4* src = (const u32x4*)(KVT + (size_t)tile0 * 32768);
#pragma unroll
      for (int pp = 0; pp < 4; ++pp) { rk[pp] = src[pp * 256 + tid]; rv[pp] = src[1024 + pp * 256 + tid]; }
    }
    for (int kt = 0; kt < ntiles; ++kt) {
      const int nvalid = (smp && kt == 16) ? 32 : 64;
      if (kt > 0) __syncthreads();
#pragma unroll
      for (int pp = 0; pp < 4; ++pp) {
        const int idx = pp * 256 + tid;
        *(u32x4*)(KS + (idx >> 4) * 136 + (idx & 15) * 8) = rk[pp];
        *(u32x4*)(VT + (idx >> 3) * 72 + (idx & 7) * 8) = rv[pp];
      }
      if (kt + 1 < ntiles) {
        const u32x4* src = (const u32x4*)(KVT + (size_t)(tile0 + kt + 1) * 32768);
#pragma unroll
        for (int pp = 0; pp < 4; ++pp) { rk[pp] = src[pp * 256 + tid]; rv[pp] = src[1024 + pp * 256 + tid]; }
      }
      __syncthreads();
      f32x4 sacc[2][4];
#pragma unroll
      for (int c = 0; c < 2; ++c)
#pragma unroll
        for (int sub = 0; sub < 4; ++sub) {
          sacc[c][sub] = (f32x4){0.f, 0.f, 0.f, 0.f};
#pragma unroll
          for (int ks = 0; ks < 2; ++ks) {
            const bf16x8 kf = *(const bf16x8*)(KS + (16 * sub + l16) * 136 + c * 64 + 32 * ks + 8 * g);
            const bf16x8 qfr = *(const bf16x8*)(QS + (16 * w + l16) * 136 + c * 64 + 32 * ks + 8 * g);
            sacc[c][sub] = __builtin_amdgcn_mfma_f32_16x16x32_bf16(kf, qfr, sacc[c][sub], 0, 0, 0);
          }
        }
#pragma unroll
      for (int sub = 0; sub < 4; ++sub)
#pragma unroll
        for (int i = 0; i < 4; ++i) {
          const int kl = 16 * sub + 4 * g + i;
          int rel = 64 * kt + kl - qpos;
          rel = rel < -166 ? -166 : rel;
          const float bt = BT[rel + 166];
          const bool ok = kl < nvalid;
          sacc[0][sub][i] = ok ? sacc[0][sub][i] + bt : -30000.f;
          sacc[1][sub][i] = ok ? sacc[1][sub][i] + bt : -30000.f;
        }
      bf16x8 pf[2][2];
#pragma unroll
      for (int c = 0; c < 2; ++c) {
        float mx = -1e30f;
#pragma unroll
        for (int sub = 0; sub < 4; ++sub)
#pragma unroll
          for (int i = 0; i < 4; ++i) mx = fmaxf(mx, sacc[c][sub][i]);
        mx = fmaxf(mx, __shfl_xor(mx, 16));
        mx = fmaxf(mx, __shfl_xor(mx, 32));
        const float mnew = fmaxf(mrun[c], mx);
        const float alpha = __builtin_amdgcn_exp2f(mrun[c] - mnew);
        mrun[c] = mnew;
        float rs = 0.f;
#pragma unroll
        for (int sub = 0; sub < 4; ++sub)
#pragma unroll
          for (int i = 0; i < 4; ++i) { const float e = __builtin_amdgcn_exp2f(sacc[c][sub][i] - mnew); sacc[c][sub][i] = e; rs += e; }
        lsum[c] = lsum[c] * alpha + rs;
#pragma unroll
        for (int vs = 0; vs < 8; ++vs) oacc[c][vs] *= alpha;
#pragma unroll
        for (int j = 0; j < 2; ++j)
          pf[c][j] = mk8u(pk2(sacc[c][2 * j][0], sacc[c][2 * j][1]), pk2(sacc[c][2 * j][2], sacc[c][2 * j][3]),
                          pk2(sacc[c][2 * j + 1][0], sacc[c][2 * j + 1][1]), pk2(sacc[c][2 * j + 1][2], sacc[c][2 * j + 1][3]));
      }
#pragma unroll
      for (int j = 0; j < 2; ++j)
#pragma unroll
        for (int vs = 0; vs < 8; ++vs) {
          const u32x2 lo = *(const u32x2*)(VT + (16 * vs + l16) * 72 + 32 * j + 4 * g);
          const u32x2 hi = *(const u32x2*)(VT + (16 * vs + l16) * 72 + 32 * j + 16 + 4 * g);
          const bf16x8 vf = mk8(lo, hi);
          oacc[0][vs] = __builtin_amdgcn_mfma_f32_16x16x32_bf16(vf, pf[0][j], oacc[0][vs], 0, 0, 0);
          oacc[1][vs] = __builtin_amdgcn_mfma_f32_16x16x32_bf16(vf, pf[1][j], oacc[1][vs], 0, 0, 0);
        }
    }
#pragma unroll
    for (int c = 0; c < 2; ++c) { lsum[c] += __shfl_xor(lsum[c], 16); lsum[c] += __shfl_xor(lsum[c], 32); }
    const float inv0 = 1.f / lsum[0], inv1 = lam / lsum[1];
    float ss = 0.f;
#pragma unroll
    for (int vs = 0; vs < 8; ++vs)
#pragma unroll
      for (int i = 0; i < 4; ++i) { const float o = oacc[0][vs][i] * inv0 - oacc[1][vs][i] * inv1; oacc[0][vs][i] = o; ss += o * o; }
    ss += __shfl_xor(ss, 16);
    ss += __shfl_xor(ss, 32);
    const float rn = rsqrtf(ss * (1.f / 128.f) + EPS) * (1.f - lam_init);
    if (16 * w + l16 < nq) {
      const size_t row = (size_t)qrow0 + 16 * w + l16;
#pragma unroll
      for (int vs = 0; vs < 8; ++vs) {
        const int v = h * 128 + 16 * vs + 4 * g;
        const f32x4 gl = *(const f32x4*)(p.g_subln + jl * 1024 + v);
        *(u32x2*)(p.OG + row * 1024 + v) = (u32x2){pk2(oacc[0][vs][0] * rn * gl[0], oacc[0][vs][1] * rn * gl[1]),
                                                   pk2(oacc[0][vs][2] * rn * gl[2], oacc[0][vs][3] * rn * gl[3])};
      }
    }
  }
}

#define XB_TMO      128
#define XB_XCNT(j)  (256  + 64 * (j))
#define XB_XSUB(j)  (1280 + 64 * (j))
#define XB_XGEN(j)  (2304 + 64 * (j))
#define XB_TOP      3328
#define XB_TOPGEN   3392
#define XCD_BAR_WORDS 3456
#define XB_SPIN_CAP (1u << 18)
#define LAS __attribute__((address_space(3)))
DI unsigned xb_ld(unsigned* p) { return __hip_atomic_load(p, __ATOMIC_RELAXED, __HIP_MEMORY_SCOPE_AGENT); }
DI unsigned xb_add(unsigned* p, unsigned v) { return __hip_atomic_fetch_add(p, v, __ATOMIC_RELAXED, __HIP_MEMORY_SCOPE_AGENT); }
DI unsigned xb_xcc_id() { return (unsigned)__builtin_amdgcn_s_getreg((3 << 11) | 20) & 0xFu; }
#define XB_SPIN(cond, bar) do { unsigned _sp = 0; while (cond) { __builtin_amdgcn_s_sleep(1); \
    if ((++_sp & 255u) == 0u) { if (xb_ld(&(bar)[XB_TMO])) break; if (_sp > XB_SPIN_CAP) { atomicAdd(&(bar)[XB_TMO], 1u); break; } } } } while (0)
struct XcdBarrier { unsigned* bar; unsigned x; volatile LAS unsigned* st; };
DI XcdBarrier xcd_barrier_post(unsigned* bar, volatile LAS unsigned* st) {
  XcdBarrier b; b.bar = bar; b.x = xb_xcc_id(); b.st = st;
  if (threadIdx.x == 0) (void)xb_add(&bar[XB_XCNT(b.x)], 1u);
  return b;
}
DI void xcd_barrier_complete(unsigned* bar, unsigned x, unsigned& nloc, unsigned& nx) {
  const unsigned G = gridDim.x;
  unsigned sum, cnt, mine, sp = 0u;
  for (;;) {
    sum = 0u; cnt = 0u; mine = 0u;
#pragma unroll
    for (unsigned j = 0; j < 16; ++j) { const unsigned c = xb_ld(&bar[XB_XCNT(j)]); sum += c; cnt += (c > 0u) ? 1u : 0u; mine = (j == x) ? c : mine; }
    if (sum == G) break;
    __builtin_amdgcn_s_sleep(1);
    if ((++sp & 255u) == 0u) { if (xb_ld(&bar[XB_TMO])) break; if (sp > XB_SPIN_CAP) { atomicAdd(&bar[XB_TMO], 1u); break; } }
  }
  nloc = mine > 0u ? mine : 1u; nx = cnt > 0u ? cnt : 1u;
}
DI void xcd_barrier(const XcdBarrier& b) {
  asm volatile("s_waitcnt vmcnt(0)" ::: "memory");
  __syncthreads();
  if (ltid() == 0) {
    unsigned* bar = b.bar;
    __builtin_amdgcn_s_waitcnt(0);
    unsigned nloc = b.st[0], nx = b.st[1];
    if (nloc == 0u) { xcd_barrier_complete(bar, b.x, nloc, nx); b.st[0] = nloc; b.st[1] = nx; }
    const unsigned old = xb_add(&bar[XB_XSUB(b.x)], 1u);
    const unsigned gen = old / nloc;
    if (old + 1u == (gen + 1u) * nloc) {
      __builtin_amdgcn_fence(__ATOMIC_RELEASE, "agent");
      asm volatile("s_waitcnt vmcnt(0)" ::: "memory");
      const unsigned og = xb_add(&bar[XB_TOP], 1u);
      const unsigned tg = og / nx;
      if (og + 1u == (tg + 1u) * nx) xb_add(&bar[XB_TOPGEN], 1u);
      else XB_SPIN(xb_ld(&bar[XB_TOPGEN]) == tg, bar);
      __builtin_amdgcn_fence(__ATOMIC_ACQUIRE, "agent");
      xb_add(&bar[XB_XGEN(b.x)], 1u);
      asm volatile("s_waitcnt vmcnt(0)" ::: "memory");
    } else {
      XB_SPIN(xb_ld(&bar[XB_XGEN(b.x)]) == gen, bar);
      __builtin_amdgcn_fence(__ATOMIC_ACQUIRE, "agent");
      asm volatile("s_waitcnt vmcnt(0)" ::: "memory");
    }
  }
  __syncthreads();
}

__global__ void __launch_bounds__(256, 2) yoco_megakernel(P p) {
  __shared__ __attribute__((aligned(16))) char smem[65520];
  __shared__ uint4 xb_words;
  cg::grid_group grid = cg::this_grid();
  if (threadIdx.x == 0) xb_words = make_uint4(0u, 0u, 0u, 0u);
  if (blockIdx.x == 0) { for (int i = threadIdx.x; i < XCD_BAR_WORDS; i += 256) __hip_atomic_store(p.bar + i, 0u, __ATOMIC_RELAXED, __HIP_MEMORY_SCOPE_AGENT); }
  prep_phase(p, smem);
  grid.sync();
  const XcdBarrier xb = xcd_barrier_post(p.bar, (volatile LAS unsigned*)&xb_words);
  u16* Mbuf = (u16*)p.BIG;
  u16* Fbuf = (u16*)(p.BIG + ((size_t)180 << 20));
  u16* PB = (u16*)p.BIG;
  u16* XRA = (u16*)p.y;
  u16* XRB = p.XB;
  for (int i = 0; i < 4; ++i) {
    const float* gn = p.g_norms + i * 4 * D;
    u16* cur = (i & 1) ? XRB : XRA;
    u16* nxt = (i == 3) ? nullptr : ((i & 1) ? XRA : XRB);
    if (i == 0) {
      rowop_phase(p, true, nullptr, nullptr, gn, p.XB, nullptr, nullptr, nullptr);
      xcd_barrier(xb);
    }
    if (i < 2) {
      REPG gemm_phase<0>(p, i ? cur : p.XB, 1024, p.wt_in_a + (size_t)i * 4096 * 1024, 4096, p.BIG, smem, i ? p.ss : nullptr);
      xcd_barrier(xb);
      gla_state_phase(p, i, smem);
      xcd_barrier(xb);
      for (int _r = 0; _r < REP_GLA; ++_r) gla_phase(p, i, smem);
      xcd_barrier(xb);
      REPG gemm_phase<2>(p, p.OG, 1024, p.wt_out_a + (size_t)i * 1024 * 1024, 1024, Mbuf, smem);
      xcd_barrier(xb);
    } else {
      if (i == 2) gemm_phase<3>(p, cur, 1024, p.wt_kv, 2048, nullptr, smem, p.ss);
      REPG gemm_phase<1>(p, cur, 1024, p.wt_q + (size_t)(i - 2) * 1024 * 1024, 1024, p.BIG, smem, p.ss);
      if (i == 2) xcd_barrier(xb);
      kvconv_phase(p, i == 2 ? 4096 : 0);
      xcd_barrier(xb);
      for (int _r = 0; _r < REP_ATTN; ++_r) attn_phase(p, i, smem);
      xcd_barrier(xb);
      REPG gemm_phase<2>(p, p.OG, 1024, p.wt_out_b + (size_t)(i - 2) * 1024 * 1024, 1024, Mbuf, smem);
      xcd_barrier(xb);
    }
    rowop2_phase(p, i == 0, cur, Mbuf, gn + D, p.ss2, nullptr, nullptr, nullptr);
    xcd_barrier(xb);
    REPG ffn_in_phase(p, i, cur, smem);
    xcd_barrier(xb);
    REPG gemm_phase<2>(p, (const u16*)p.BIG, DFF, p.wt_ffn_out + (size_t)i * 1024 * DFF, 1024, Fbuf, smem);
    xcd_barrier(xb);
    rowop2_phase(p, false, cur, Fbuf, gn + 3 * D, nullptr, p.p_prompt + (size_t)i * ROWS_P * 256, p.p_sample + (size_t)i * 256 * 256, PB);
    xcd_barrier(xb);
    ple_phase(p, i, cur, nxt, smem);
    xcd_barrier(xb);
  }
}

extern "C" void kernel_launch(void* const* d_in, const int* in_sizes, int n_in, void* d_out, int out_size, void* d_ws,
                              size_t ws_size, hipStream_t stream) {
  static int grid_blocks = 0;
  if (!grid_blocks) {
    int dev = 0, cus = 0, per_cu = 0;
    hipGetDevice(&dev);
    hipDeviceGetAttribute(&cus, hipDeviceAttributeMultiprocessorCount, dev);
    hipOccupancyMaxActiveBlocksPerMultiprocessor(&per_cu, yoco_megakernel, 256, 0);
    if (per_cu > 2) per_cu = 2;
    grid_blocks = cus * per_cu;
    grid_blocks &= ~7;
  }
  P p{};
  const float* const* in = (const float* const*)d_in;
  p.x_prompt = in[0]; p.x_sample = in[1]; p.cache_k = in[2]; p.cache_v = in[3]; p.state_hgrn = in[4]; p.state_conv = in[5];
  p.p_prompt = in[6]; p.p_sample = in[7];
  p.g_norms = in[8]; const float* w_in_a = in[9]; p.lb_raw = in[10]; p.g_hg = in[11]; const float* w_out_a = in[12]; p.g_kv = in[13];
  const float* w_kv = in[14]; p.rel_bias = in[15]; const float* w_q_b = in[16]; p.lam_b = in[17]; p.g_subln = in[18];
  const float* w_out_b = in[19]; const float* w_ffn_in = in[20]; p.conv_w = in[21]; p.conv_b = in[22]; const float* w_ffn_out = in[23];
  const float* w_ple = in[24]; const float* w_ple_gate = in[25];
  float* o = (float*)d_out;
  p.y = o; o += (size_t)ROWS * D;
  p.k_prompt = o; o += (size_t)ROWS_P * D;
  p.v_prompt = o; o += (size_t)ROWS_P * D;
  p.k_sample = o; o += (size_t)256 * D;
  p.v_sample = o; o += (size_t)256 * D;
  p.hgrn_prompt = o; o += (size_t)2 * 16 * 8 * 16384;
  p.hgrn_sample = o; o += (size_t)2 * 8 * 8 * 16384;
  p.conv_prompt = o; o += (size_t)4 * 16 * 2 * DFF;
  p.conv_sample = o;
  u16* ws = (u16*)d_ws;
  p.wt_in_a = ws; ws += (size_t)2 * 4096 * 1024;
  p.wt_out_a = ws; ws += (size_t)2 * 1024 * 1024;
  p.wt_kv = ws; ws += (size_t)2048 * 1024;
  p.wt_q = ws; ws += (size_t)2 * 1024 * 1024;
  p.wt_out_b = ws; ws += (size_t)2 * 1024 * 1024;
  p.wt_ffn_in = ws; ws += (size_t)4 * 5632 * 1024;
  p.wt_ffn_out = ws; ws += (size_t)4 * 1024 * DFF;
  p.wt_ple = ws; ws += (size_t)4 * 1024 * 256;
  p.wt_gate = ws; ws += (size_t)4 * 1024 * 1024;
  p.XB = ws; ws += (size_t)ROWS * 1024;
  p.OG = ws; ws += (size_t)ROWS * 1024;
  p.BIG = (char*)ws;
  p.bar = (unsigned*)((char*)d_ws + ((size_t)500 << 20));
  p.ss = (float*)((char*)d_ws + ((size_t)501 << 20));
  p.ss2 = (float*)((char*)d_ws + ((size_t)507 << 20));
  int n = 0;
  for (int i = 0; i < 2; ++i) p.wd[n++] = WD{w_in_a + (size_t)i * 1024 * 4096, p.wt_in_a + (size_t)i * 4096 * 1024, i ? p.g_norms + 4 * D : nullptr, 1024, 4096, 0, 0};
  for (int i = 0; i < 2; ++i) p.wd[n++] = WD{w_out_a + (size_t)i * 1024 * 1024, p.wt_out_a + (size_t)i * 1024 * 1024, nullptr, 1024, 1024, 0, 0};
  p.wd[n++] = WD{w_kv, p.wt_kv, p.g_kv, 1024, 2048, 0, 0};
  for (int i = 0; i < 2; ++i) p.wd[n++] = WD{w_q_b + (size_t)i * 1024 * 1024, p.wt_q + (size_t)i * 1024 * 1024, p.g_norms + (size_t)(i + 2) * 4 * D, 1024, 1024, 0, 0};
  for (int i = 0; i < 2; ++i) p.wd[n++] = WD{w_out_b + (size_t)i * 1024 * 1024, p.wt_out_b + (size_t)i * 1024 * 1024, nullptr, 1024, 1024, 0, 0};
  for (int i = 0; i < 4; ++i) p.wd[n++] = WD{w_ffn_in + (size_t)i * 1024 * 5632, p.wt_ffn_in + (size_t)i * 5632 * 1024, p.g_norms + (size_t)(i * 4 + 2) * D, 1024, 5632, 1, 0};
  for (int i = 0; i < 4; ++i) p.wd[n++] = WD{w_ffn_out + (size_t)i * DFF * 1024, p.wt_ffn_out + (size_t)i * 1024 * DFF, nullptr, DFF, 1024, 0, 0};
  for (int i = 0; i < 4; ++i) p.wd[n++] = WD{w_ple + (size_t)i * 256 * 1024, p.wt_ple + (size_t)i * 1024 * 256, nullptr, 256, 1024, 0, 0};
  for (int i = 0; i < 4; ++i) p.wd[n++] = WD{w_ple_gate + (size_t)i * 1024 * 1024, p.wt_gate + (size_t)i * 1024 * 1024, nullptr, 1024, 1024, 0, 0};
  void* args[] = {&p};
  hipError_t e = hipLaunchCooperativeKernel((void*)yoco_megakernel, dim3(grid_blocks), dim3(256), args, 0, stream);
  if (e != hipSuccess) fprintf(stderr, "cooperative launch failed: %s (grid %d)\n", hipGetErrorString(e), grid_blocks);
}
```

```cpp
#include <hip/hip_runtime.h>
#include <hip/hip_cooperative_groups.h>
#include <cstdio>
namespace cg = cooperative_groups;

#define DI __device__ __forceinline__
typedef unsigned short u16;
typedef short bf16x8 __attribute__((ext_vector_type(8)));
typedef float f32x16 __attribute__((ext_vector_type(16)));
typedef float f32x4 __attribute__((ext_vector_type(4)));
typedef __bf16 bf2_t __attribute__((ext_vector_type(2)));
typedef float f2_t __attribute__((ext_vector_type(2)));
typedef unsigned u32x2 __attribute__((ext_vector_type(2)));
typedef unsigned u32x4 __attribute__((ext_vector_type(4)));

constexpr int D = 1024, ROWS_P = 32768, ROWS = 33024, DFF = 2816;
constexpr float EPS = 1e-6f;
constexpr float LOG2E = 1.4426950408889634f;
constexpr int NW = 25;
#ifndef REP_GEMM
#define REP_GEMM 1
#endif
#ifndef REP_GLA
#define REP_GLA 1
#endif
#ifndef REP_ATTN
#define REP_ATTN 1
#endif
#define REPG for (int _r = 0; _r < REP_GEMM; ++_r)

struct WD { const float* src; u16* dst; const float* gain; int K, N, mode, pad; };

struct P {
  const float *x_prompt, *x_sample, *cache_k, *cache_v, *state_hgrn, *state_conv, *p_prompt, *p_sample;
  const float *g_norms, *lb_raw, *g_hg, *g_kv, *rel_bias, *lam_b, *g_subln, *conv_w, *conv_b;
  float *y, *k_prompt, *v_prompt, *k_sample, *v_sample, *hgrn_prompt, *hgrn_sample, *conv_prompt, *conv_sample;
  u16 *wt_in_a, *wt_out_a, *wt_kv, *wt_q, *wt_out_b, *wt_ffn_in, *wt_ffn_out, *wt_ple, *wt_gate;
  u16 *XB, *OG; char* BIG; unsigned* bar; float* ss; float* ss2;
  WD wd[NW];
};

DI unsigned pk2(float a, float b) { f2_t v = {a, b}; bf2_t r = __builtin_convertvector(v, bf2_t); return __builtin_bit_cast(unsigned, r); }
DI int lbid() { int b = blockIdx.x; asm volatile("" : "+s"(b)); return b; }
DI int ltid() { int t = threadIdx.x; asm volatile("" : "+v"(t)); return t; }
DI float bf2f(u16 x) { return __uint_as_float(((unsigned)x) << 16); }
DI float bflo(unsigned x) { return __uint_as_float(x << 16); }
DI float bfhi(unsigned x) { return __uint_as_float(x & 0xffff0000u); }
DI float sigm(float x) { return 1.f / (1.f + __expf(-x)); }
DI float wave_sum(float v) {
#pragma unroll
  for (int o = 32; o; o >>= 1) v += __shfl_xor(v, o);
  return v;
}
DI bf16x8 mk8(u32x2 lo, u32x2 hi) { u32x4 t = {lo[0], lo[1], hi[0], hi[1]}; return __builtin_bit_cast(bf16x8, t); }
DI bf16x8 mk8u(unsigned a, unsigned b, unsigned c, unsigned d) { u32x4 t = {a, b, c, d}; return __builtin_bit_cast(bf16x8, t); }

DI void prep_tile_info(const P& p, int flat, int& wi, int& k0, int& n0) {
  int base = 0; wi = 0;
  for (;;) { int nt = (p.wd[wi].K >> 6) * (p.wd[wi].N >> 6); if (flat < base + nt) break; base += nt; ++wi; }
  const int tix = flat - base, ntn = p.wd[wi].N >> 6;
  k0 = (tix / ntn) << 6; n0 = (tix % ntn) << 6;
}
DI void prep_phase(const P& p, char* smem) {
  float* T = (float*)smem;
  const int tid = ltid();
  int total = 0;
  for (int i = 0; i < NW; ++i) total += (p.wd[i].K >> 6) * (p.wd[i].N >> 6);
  const int n4 = (tid & 15) * 4, kb = tid >> 4;
  f32x4 v[4];
  int flat = lbid();
  int wi = 0, k0 = 0, n0 = 0;
#define PREP_LOAD(DD) { _Pragma("unroll") for (int j = 0; j < 4; ++j) { const int kk = kb + 16 * j; \
      v[j] = *(const f32x4*)((DD).src + (size_t)(k0 + kk) * (DD).N + n0 + n4); if ((DD).gain) v[j] *= (DD).gain[k0 + kk]; } }
  if (flat < total) {
    prep_tile_info(p, flat, wi, k0, n0);
    const WD& d = p.wd[wi];
    PREP_LOAD(d);
  }
  for (; flat < total; flat += gridDim.x) {
    const WD& d = p.wd[wi];
    const int ck0 = k0, cn0 = n0;
#pragma unroll
    for (int j = 0; j < 4; ++j) {
      float* tr = T + (kb + 16 * j) * 65 + n4;
      tr[0] = v[j][0]; tr[1] = v[j][1]; tr[2] = v[j][2]; tr[3] = v[j][3];
    }
    const int nf = flat + gridDim.x;
    if (nf < total) {
      prep_tile_info(p, nf, wi, k0, n0);
      const WD& d2 = p.wd[wi];
      PREP_LOAD(d2);
    }
    __syncthreads();
    {
      const int nn = tid >> 2, ks = tid & 3;
      int nc = cn0 + nn, drow = nc;
      if (d.mode == 1) { int isu = nc >= DFF; int ch = nc - DFF * isu; drow = 256 * (ch >> 7) + 64 * ((ch >> 5) & 3) + 32 * isu + (ch & 31); }
      unsigned o[8];
#pragma unroll
      for (int j = 0; j < 8; ++j) o[j] = pk2(T[(16 * ks + 2 * j) * 65 + nn], T[(16 * ks + 2 * j + 1) * 65 + nn]);
      u16* fb = d.dst + (((size_t)(drow >> 5) * (d.K >> 4) + ((ck0 >> 4) + ks)) * 64 + (drow & 31)) * 8;
      *(u32x4*)(fb) = (u32x4){o[0], o[1], o[2], o[3]};
      *(u32x4*)(fb + 256) = (u32x4){o[4], o[5], o[6], o[7]};
    }
    __syncthreads();
  }
#undef PREP_LOAD
}

DI void rowop_phase(const P& p, bool x_from_in, const u16* __restrict__ Madd, const float* __restrict__ gpost,
                    const float* __restrict__ gnext, u16* __restrict__ outH, const float* ple_p, const float* ple_s, u16* outP) {
  const int tidr = ltid();
  const int lane = tidr & 63;
  const int wave = (lbid() * blockDim.x + tidr) >> 6;
  const int nwave = (gridDim.x * blockDim.x) >> 6;
  for (int rb = wave * 2; rb < ROWS; rb += nwave * 2) {
    f32x4 x[2][4];
    u32x2 m[2][4];
#pragma unroll
    for (int u = 0; u < 2; ++u) {
      const int r = rb + u;
      const float* xs = x_from_in ? (r < ROWS_P ? p.x_prompt + (size_t)r * D : p.x_sample + (size_t)(r - ROWS_P) * D) : p.y + (size_t)r * D;
#pragma unroll
      for (int j = 0; j < 4; ++j) x[u][j] = *(const f32x4*)(xs + 4 * lane + 256 * j);
      if (Madd) {
#pragma unroll
        for (int j = 0; j < 4; ++j) m[u][j] = *(const u32x2*)(Madd + (size_t)r * D + 4 * lane + 256 * j);
      }
    }
#pragma unroll
    for (int u = 0; u < 2; ++u) {
      const int r = rb + u;
      if (Madd) {
        f32x4 mf[4]; float ss = 0.f;
#pragma unroll
        for (int j = 0; j < 4; ++j) { mf[j] = (f32x4){bflo(m[u][j][0]), bfhi(m[u][j][0]), bflo(m[u][j][1]), bfhi(m[u][j][1])}; ss += mf[j][0] * mf[j][0] + mf[j][1] * mf[j][1] + mf[j][2] * mf[j][2] + mf[j][3] * mf[j][3]; }
        ss = wave_sum(ss);
        const float rs = rsqrtf(ss * (1.f / D) + EPS);
#pragma unroll
        for (int j = 0; j < 4; ++j) { f32x4 g = *(const f32x4*)(gpost + 4 * lane + 256 * j); x[u][j] += mf[j] * rs * g; }
#pragma unroll
        for (int j = 0; j < 4; ++j) *(f32x4*)(p.y + (size_t)r * D + 4 * lane + 256 * j) = x[u][j];
      }
      float rx = 1.f;
      if (gnext) {
        float ss = 0.f;
#pragma unroll
        for (int j = 0; j < 4; ++j) ss += x[u][j][0] * x[u][j][0] + x[u][j][1] * x[u][j][1] + x[u][j][2] * x[u][j][2] + x[u][j][3] * x[u][j][3];
        ss = wave_sum(ss);
        rx = rsqrtf(ss * (1.f / D) + EPS);
      }
#pragma unroll
      for (int j = 0; j < 4; ++j) {
        f32x4 h = x[u][j] * rx;
        if (gnext) h *= *(const f32x4*)(gnext + 4 * lane + 256 * j);
        *(u32x2*)(outH + (size_t)r * D + 4 * lane + 256 * j) = (u32x2){pk2(h[0], h[1]), pk2(h[2], h[3])};
      }
      if (outP) {
        const float* ps = r < ROWS_P ? ple_p + (size_t)r * 256 : ple_s + (size_t)(r - ROWS_P) * 256;
        f32x4 v = *(const f32x4*)(ps + 4 * lane);
        *(u32x2*)(outP + (size_t)r * 256 + 4 * lane) = (u32x2){pk2(v[0], v[1]), pk2(v[2], v[3])};
      }
    }
  }
}

DI void rowop2_phase(const P& p, bool x_from_in, u16* __restrict__ XR, const u16* __restrict__ Madd, const float* __restrict__ gpost,
                     float* __restrict__ ssout, const float* ple_p, const float* ple_s, u16* outP) {
  const int tidr = ltid();
  const int lane = tidr & 63;
  const int wave = (lbid() * blockDim.x + tidr) >> 6;
  const int nwave = (gridDim.x * blockDim.x) >> 6;
  for (int rb = wave * 2; rb < ROWS; rb += nwave * 2) {
    f32x4 x[2][4];
    u32x2 m[2][4];
#pragma unroll
    for (int u = 0; u < 2; ++u) {
      const int r = rb + u;
      if (x_from_in) {
        const float* xs = r < ROWS_P ? p.x_prompt + (size_t)r * D : p.x_sample + (size_t)(r - ROWS_P) * D;
#pragma unroll
        for (int j = 0; j < 4; ++j) x[u][j] = *(const f32x4*)(xs + 4 * lane + 256 * j);
      } else {
#pragma unroll
        for (int j = 0; j < 4; ++j) { const u32x2 t = *(const u32x2*)(XR + (size_t)r * D + 4 * lane + 256 * j); x[u][j] = (f32x4){bflo(t[0]), bfhi(t[0]), bflo(t[1]), bfhi(t[1])}; }
      }
#pragma unroll
      for (int j = 0; j < 4; ++j) m[u][j] = *(const u32x2*)(Madd + (size_t)r * D + 4 * lane + 256 * j);
    }
#pragma unroll
    for (int u = 0; u < 2; ++u) {
      const int r = rb + u;
      f32x4 mf[4]; float ss = 0.f;
#pragma unroll
      for (int j = 0; j < 4; ++j) { mf[j] = (f32x4){bflo(m[u][j][0]), bfhi(m[u][j][0]), bflo(m[u][j][1]), bfhi(m[u][j][1])}; ss += mf[j][0] * mf[j][0] + mf[j][1] * mf[j][1] + mf[j][2] * mf[j][2] + mf[j][3] * mf[j][3]; }
      ss = wave_sum(ss);
      const float rs = rsqrtf(ss * (1.f / D) + EPS);
      float sx = 0.f;
#pragma unroll
      for (int j = 0; j < 4; ++j) {
        const f32x4 g = *(const f32x4*)(gpost + 4 * lane + 256 * j);
        const f32x4 xn = x[u][j] + mf[j] * rs * g;
        const u32x2 o = (u32x2){pk2(xn[0], xn[1]), pk2(xn[2], xn[3])};
        *(u32x2*)(XR + (size_t)r * D + 4 * lane + 256 * j) = o;
        const float q0 = bflo(o[0]), q1 = bfhi(o[0]), q2 = bflo(o[1]), q3 = bfhi(o[1]);
        sx += q0 * q0 + q1 * q1 + q2 * q2 + q3 * q3;
      }
      if (ssout) { sx = wave_sum(sx); if (lane == 0) ssout[r] = sx; }
      if (outP) {
        const float* ps = r < ROWS_P ? ple_p + (size_t)r * 256 : ple_s + (size_t)(r - ROWS_P) * 256;
        f32x4 v = *(const f32x4*)(ps + 4 * lane);
        *(u32x2*)(outP + (size_t)r * 256 + 4 * lane) = (u32x2){pk2(v[0], v[1]), pk2(v[2], v[3])};
      }
    }
  }
}

template <class RowMap>
DI void gemm_core(const u16* __restrict__ A, int lda, RowMap rm, const u16* __restrict__ Bt, int n0, int K,
                  f32x16 (&acc)[4][2], char* smem, const int tid) {
  const int l = tid & 63, w = tid >> 6, l32 = l & 31, hh = l >> 5;
  const int lr = tid >> 3, lc = tid & 7;
  const u16* ap[4];
#pragma unroll
  for (int q = 0; q < 4; ++q) ap[q] = A + (size_t)rm(q * 32 + lr) * lda + lc * 8;
  const u16* bq0 = Bt + ((size_t)((n0 + w * 64) >> 5) * (K >> 4) * 64 + l) * 8;
  const u16* bq1 = bq0 + (size_t)(K >> 4) * 512;
  const unsigned woff = lr * 144 + lc * 16;
  const unsigned aoff = l32 * 144 + hh * 16;
  u32x4 ra0[4];
  bf16x8 bf0[4], bf1[4];
  const int nk = K >> 6;
#define GLOADA(RA, T) _Pragma("unroll") for (int q = 0; q < 4; ++q) { RA[q] = *(const u32x4*)(ap[q] + (T) * 64); }
#define SWRITEA(RA, BUF) { char* db_ = smem + (BUF) * 18432; _Pragma("unroll") for (int q = 0; q < 4; ++q) { *(u32x4*)(db_ + woff + q * 4608) = RA[q]; } }
#define COMPUTE(BUF, TN, MORE) { const char* sb = smem + (BUF) * 18432; _Pragma("unroll") for (int ks = 0; ks < 4; ++ks) { \
      const unsigned co = ks * 32; \
      bf16x8 a0 = *(const bf16x8*)(sb + aoff + co); \
      bf16x8 a1 = *(const bf16x8*)(sb + aoff + 4608 + co); \
      bf16x8 a2 = *(const bf16x8*)(sb + aoff + 9216 + co); \
      bf16x8 a3 = *(const bf16x8*)(sb + aoff + 13824 + co); \
      acc[0][0] = __builtin_amdgcn_mfma_f32_32x32x16_bf16(bf0[ks], a0, acc[0][0], 0, 0, 0); \
      acc[0][1] = __builtin_amdgcn_mfma_f32_32x32x16_bf16(bf1[ks], a0, acc[0][1], 0, 0, 0); \
      acc[1][0] = __builtin_amdgcn_mfma_f32_32x32x16_bf16(bf0[ks], a1, acc[1][0], 0, 0, 0); \
      acc[1][1] = __builtin_amdgcn_mfma_f32_32x32x16_bf16(bf1[ks], a1, acc[1][1], 0, 0, 0); \
      acc[2][0] = __builtin_amdgcn_mfma_f32_32x32x16_bf16(bf0[ks], a2, acc[2][0], 0, 0, 0); \
      acc[2][1] = __builtin_amdgcn_mfma_f32_32x32x16_bf16(bf1[ks], a2, acc[2][1], 0, 0, 0); \
      acc[3][0] = __builtin_amdgcn_mfma_f32_32x32x16_bf16(bf0[ks], a3, acc[3][0], 0, 0, 0); \
      acc[3][1] = __builtin_amdgcn_mfma_f32_32x32x16_bf16(bf1[ks], a3, acc[3][1], 0, 0, 0); \
      if (MORE) { bf0[ks] = *(const bf16x8*)(bq0 + ((TN) * 4 + ks) * 512); bf1[ks] = *(const bf16x8*)(bq1 + ((TN) * 4 + ks) * 512); } \
      __builtin_amdgcn_sched_barrier(0); } }
  GLOADA(ra0, 0);
#pragma unroll
  for (int ks = 0; ks < 4; ++ks) { bf0[ks] = *(const bf16x8*)(bq0 + ks * 512); bf1[ks] = *(const bf16x8*)(bq1 + ks * 512); }
  SWRITEA(ra0, 0);
  __syncthreads();
  for (int kt = 0; kt < nk; kt += 2) {
    GLOADA(ra0, kt + 1);
    __builtin_amdgcn_sched_barrier(0);
    COMPUTE(0, kt + 1, true);
    SWRITEA(ra0, 1);
    __syncthreads();
    if (kt + 2 < nk) GLOADA(ra0, kt + 2);
    __builtin_amdgcn_sched_barrier(0);
    COMPUTE(1, kt + 2, kt + 2 < nk);
    if (kt + 2 < nk) SWRITEA(ra0, 0);
    __syncthreads();
  }
#undef GLOADA
#undef SWRITEA
#undef COMPUTE
}

template <class RowMap>
DI void gemm_core_n1(const u16* __restrict__ A, int lda, RowMap rm, const u16* __restrict__ Bt, int n0, int K,
                     f32x16 (&acc)[4], char* smem, const int tid) {
  const int l = tid & 63, w = tid >> 6, l32 = l & 31, hh = l >> 5;
  const int lr = tid >> 3, lc = tid & 7;
  const u16* ap[4];
#pragma unroll
  for (int q = 0; q < 4; ++q) ap[q] = A + (size_t)rm(q * 32 + lr) * lda + lc * 8;
  const u16* bq0 = Bt + ((size_t)((n0 + w * 32) >> 5) * (K >> 4) * 64 + l) * 8;
  const unsigned woff = lr * 144 + lc * 16;
  const unsigned aoff = l32 * 144 + hh * 16;
  u32x4 ra0[4];
  bf16x8 bf0[4];
  const int nk = K >> 6;
#define GLOADA(RA, T) _Pragma("unroll") for (int q = 0; q < 4; ++q) { RA[q] = *(const u32x4*)(ap[q] + (T) * 64); }
#define SWRITEA(RA, BUF) { char* db_ = smem + (BUF) * 18432; _Pragma("unroll") for (int q = 0; q < 4; ++q) { *(u32x4*)(db_ + woff + q * 4608) = RA[q]; } }
#define COMPUTE(BUF, TN, MORE) { const char* sb = smem + (BUF) * 18432; _Pragma("unroll") for (int ks = 0; ks < 4; ++ks) { \
      const unsigned co = ks * 32; \
      bf16x8 a0 = *(const bf16x8*)(sb + aoff + co); \
      bf16x8 a1 = *(const bf16x8*)(sb + aoff + 4608 + co); \
      bf16x8 a2 = *(const bf16x8*)(sb + aoff + 9216 + co); \
      bf16x8 a3 = *(const bf16x8*)(sb + aoff + 13824 + co); \
      acc[0] = __builtin_amdgcn_mfma_f32_32x32x16_bf16(bf0[ks], a0, acc[0], 0, 0, 0); \
      acc[1] = __builtin_amdgcn_mfma_f32_32x32x16_bf16(bf0[ks], a1, acc[1], 0, 0, 0); \
      acc[2] = __builtin_amdgcn_mfma_f32_32x32x16_bf16(bf0[ks], a2, acc[2], 0, 0, 0); \
      acc[3] = __builtin_amdgcn_mfma_f32_32x32x16_bf16(bf0[ks], a3, acc[3], 0, 0, 0); \
      if (MORE) { bf0[ks] = *(const bf16x8*)(bq0 + ((TN) * 4 + ks) * 512); } \
      __builtin_amdgcn_sched_barrier(0); } }
  GLOADA(ra0, 0);
#pragma unroll
  for (int ks = 0; ks < 4; ++ks) bf0[ks] = *(const bf16x8*)(bq0 + ks * 512);
  SWRITEA(ra0, 0);
  __syncthreads();
  for (int kt = 0; kt < nk; kt += 2) {
    GLOADA(ra0, kt + 1);
    __builtin_amdgcn_sched_barrier(0);
    COMPUTE(0, kt + 1, true);
    SWRITEA(ra0, 1);
    __syncthreads();
    if (kt + 2 < nk) GLOADA(ra0, kt + 2);
    __builtin_amdgcn_sched_barrier(0);
    COMPUTE(1, kt + 2, kt + 2 < nk);
    if (kt + 2 < nk) SWRITEA(ra0, 0);
    __syncthreads();
  }
#undef GLOADA
#undef SWRITEA
#undef COMPUTE
}

template <class RowMap>
DI void gemm_core_mini(const u16* __restrict__ A, int lda, RowMap rm, const u16* __restrict__ Bt, int n0, int K,
                       f32x16 (&acc)[2], char* smem, const int tid) {
  const int l = tid & 63, w = tid >> 6, l32 = l & 31, hh = l >> 5;
  const int lr = tid >> 3, lc = tid & 7;
  const u16* ap[4];
#pragma unroll
  for (int q = 0; q < 4; ++q) ap[q] = A + (size_t)rm(q * 32 + lr) * lda + lc * 8;
  const u16* bq0 = Bt + ((size_t)(n0 >> 5) * (K >> 4) * 64 + l) * 8;
  const u16* bq1 = bq0 + (size_t)(K >> 4) * 512;
  const unsigned woff = lr * 144 + lc * 16;
  const unsigned aoff = (w * 32 + l32) * 144 + hh * 16;
  u32x4 ra0[4];
  bf16x8 bf0[4], bf1[4];
  const int nk = K >> 6;
#define GLOADA(RA, T) _Pragma("unroll") for (int q = 0; q < 4; ++q) { RA[q] = *(const u32x4*)(ap[q] + (T) * 64); }
#define SWRITEA(RA, BUF) { char* db_ = smem + (BUF) * 18432; _Pragma("unroll") for (int q = 0; q < 4; ++q) { *(u32x4*)(db_ + woff + q * 4608) = RA[q]; } }
#define COMPUTE(BUF, TN, MORE) { const char* sb = smem + (BUF) * 18432; _Pragma("unroll") for (int ks = 0; ks < 4; ++ks) { \
      const unsigned co = ks * 32; \
      bf16x8 a0 = *(const bf16x8*)(sb + aoff + co); \
      acc[0] = __builtin_amdgcn_mfma_f32_32x32x16_bf16(bf0[ks], a0, acc[0], 0, 0, 0); \
      acc[1] = __builtin_amdgcn_mfma_f32_32x32x16_bf16(bf1[ks], a0, acc[1], 0, 0, 0); \
      if (MORE) { bf0[ks] = *(const bf16x8*)(bq0 + ((TN) * 4 + ks) * 512); bf1[ks] = *(const bf16x8*)(bq1 + ((TN) * 4 + ks) * 512); } \
      __builtin_amdgcn_sched_barrier(0); } }
  GLOADA(ra0, 0);
#pragma unroll
  for (int ks = 0; ks < 4; ++ks) { bf0[ks] = *(const bf16x8*)(bq0 + ks * 512); bf1[ks] = *(const bf16x8*)(bq1 + ks * 512); }
  SWRITEA(ra0, 0);
  __syncthreads();
  for (int kt = 0; kt < nk; kt += 2) {
    GLOADA(ra0, kt + 1);
    __builtin_amdgcn_sched_barrier(0);
    COMPUTE(0, kt + 1, true);
    SWRITEA(ra0, 1);
    __syncthreads();
    if (kt + 2 < nk) GLOADA(ra0, kt + 2);
    __builtin_amdgcn_sched_barrier(0);
    COMPUTE(1, kt + 2, kt + 2 < nk);
    if (kt + 2 < nk) SWRITEA(ra0, 0);
    __syncthreads();
  }
#undef GLOADA
#undef SWRITEA
#undef COMPUTE
}

DI bool next_tile(int it, int ntm, int ntn, int& tm, int& tn) {
  const int b = lbid(), x = b & 7, slot = b >> 3, S = gridDim.x >> 3;
  const int nq = (ntm - x + 7) >> 3;
  const int L = slot + it * S;
  if (L >= nq * ntn) return false;
  const int gsize = 8 * ntn;
  const int grp = L / gsize, r = L - grp * gsize;
  const int gsz = min(8, nq - 8 * grp);
  tn = r / gsz;
  tm = x + 8 * (8 * grp + r % gsz);
  return true;
}

DI void list_entry(int L, int ntm, int ntn, int& tm, int& tn) {
  const int x = lbid() & 7;
  const int nq = (ntm - x + 7) >> 3;
  const int gsize = 8 * ntn;
  const int grp = L / gsize, r = L - grp * gsize;
  const int gsz = min(8, nq - 8 * grp);
  tn = r / gsz;
  tm = x + 8 * (8 * grp + r % gsz);
}
DI void list_info(int ntm, int ntn, int& full, int& nleft) {
  const int x = lbid() & 7, S = gridDim.x >> 3;
  const int len = ((ntm - x + 7) >> 3) * ntn;
  full = (len / S) * S;
  nleft = len - full;
  if (4 * nleft > S) { full = len; nleft = 0; }
}

struct IdMap { int base; DI int operator()(int r) const { return base + r; } };
struct ClampMap { int rowbase, t0, T; DI int operator()(int r) const { int t = t0 + r; t = t < 0 ? 0 : (t > T - 1 ? T - 1 : t); return rowbase + t; } };
struct ClampMap2 { int rowbase, t0, T, srow; DI int operator()(int r) const { if (srow >= 0 && r >= 64) { int t = r - 66; t = t < 0 ? 0 : (t > 31 ? 31 : t); return srow + t; } int t = t0 + r; t = t < 0 ? 0 : (t > T - 1 ? T - 1 : t); return rowbase + t; } };

#define ZERO_ACC(a) _Pragma("unroll") for (int _i = 0; _i < 4; ++_i) _Pragma("unroll") for (int _j = 0; _j < 2; ++_j) _Pragma("unroll") for (int _e = 0; _e < 16; ++_e) a[_i][_j][_e] = 0.f;

DI float row_rs(const float* rowss, int m) {
  const f32x4* sp = (const f32x4*)(rowss + (size_t)m * 32);
  float tot = 0.f;
#pragma unroll
  for (int j = 0; j < 8; ++j) { const f32x4 s = sp[j]; tot += (s[0] + s[1]) + (s[2] + s[3]); }
  return rsqrtf(tot * (1.f / D) + EPS);
}
template <int EPI>
DI void epi4(const P& p, void* outp, int m, int n, float v0, float v1, float v2, float v3) {
  if (EPI == 0) {
    const int sec = n >> 10;
    if (sec == 0 || sec == 3) { v0 *= sigm(v0); v1 *= sigm(v1); v2 *= sigm(v2); v3 *= sigm(v3); }
    *(u32x2*)((u16*)outp + (size_t)m * 4096 + n) = (u32x2){pk2(v0, v1), pk2(v2, v3)};
  } else if (EPI == 1) {
    const float sc = 0.125f * LOG2E;
    *(u32x2*)((u16*)outp + (size_t)m * 1024 + n) = (u32x2){pk2(v0 * sc, v1 * sc), pk2(v2 * sc, v3 * sc)};
  } else if (EPI == 2) {
    *(u32x2*)((u16*)outp + (size_t)m * 1024 + n) = (u32x2){pk2(v0, v1), pk2(v2, v3)};
  } else {
    float* dst;
    if (n < 1024) dst = (m < ROWS_P ? p.k_prompt + (size_t)m * 1024 : p.k_sample + (size_t)(m - ROWS_P) * 1024) + n;
    else dst = (m < ROWS_P ? p.v_prompt + (size_t)m * 1024 : p.v_sample + (size_t)(m - ROWS_P) * 1024) + (n - 1024);
    *(f32x4*)dst = (f32x4){v0, v1, v2, v3};
    if (m < ROWS_P) {
      const int s = m >> 11, key = m & 2047, kt = key >> 6, kl = key & 63;
      const int nn = n & 1023, h = nn >> 7, d = nn & 127;
      u16* tile = (u16*)(p.BIG + (size_t)ROWS * 1024 * 2 + (size_t)((s * 8 + h) * 32 + kt) * 32768);
      if (n < 1024) {
        *(u32x2*)(tile + kl * 128 + d) = (u32x2){pk2(v0, v1), pk2(v2, v3)};
      } else {
        u16* vt = tile + 8192 + d * 64 + kl;
        const unsigned a = pk2(v0, v1), b2 = pk2(v2, v3);
        vt[0] = (u16)(a & 0xffffu); vt[64] = (u16)(a >> 16); vt[128] = (u16)(b2 & 0xffffu); vt[192] = (u16)(b2 >> 16);
      }
    }
  }
}
template <int EPI>
DI void gemm_phase(const P& p, const u16* A, int K, const u16* Bt, int N, void* outp, char* smem, const float* rowss = nullptr) {
  const int tid = ltid(), l = tid & 63, w = tid >> 6, l32 = l & 31, hh = l >> 5;
  const int ntm = ROWS / 128, ntn = N / 256;
  const int slot = lbid() >> 3, S = gridDim.x >> 3;
  int full, nleft, tm, tn;
  list_info(ntm, ntn, full, nleft);
  for (int L = slot; L < full; L += S) {
    list_entry(L, ntm, ntn, tm, tn);
    f32x16 acc[4][2];
    ZERO_ACC(acc);
    gemm_core(A, K, IdMap{tm * 128}, Bt, tn * 256, K, acc, smem, ltid());
#pragma unroll
    for (int mi = 0; mi < 4; ++mi) {
      const int m = tm * 128 + mi * 32 + l32;
      float rsc = 1.f;
      if (rowss) rsc = row_rs(rowss, m);
#pragma unroll
      for (int ni = 0; ni < 2; ++ni)
#pragma unroll
        for (int q = 0; q < 4; ++q)
          epi4<EPI>(p, outp, m, tn * 256 + w * 64 + ni * 32 + 8 * q + 4 * hh,
                    acc[mi][ni][4 * q] * rsc, acc[mi][ni][4 * q + 1] * rsc, acc[mi][ni][4 * q + 2] * rsc, acc[mi][ni][4 * q + 3] * rsc);
    }
  }
  if (slot < 4 * nleft) {
    list_entry(full + (slot >> 2), ntm, ntn, tm, tn);
    const int n0 = tn * 256 + (slot & 3) * 64;
    f32x16 acc[2];
#pragma unroll
    for (int e = 0; e < 16; ++e) { acc[0][e] = 0.f; acc[1][e] = 0.f; }
    gemm_core_mini(A, K, IdMap{tm * 128}, Bt, n0, K, acc, smem, ltid());
    const int m = tm * 128 + w * 32 + l32;
    float rsc = 1.f;
    if (rowss) rsc = row_rs(rowss, m);
#pragma unroll
    for (int ni = 0; ni < 2; ++ni)
#pragma unroll
      for (int q = 0; q < 4; ++q)
        epi4<EPI>(p, outp, m, n0 + ni * 32 + 8 * q + 4 * hh,
                  acc[ni][4 * q] * rsc, acc[ni][4 * q + 1] * rsc, acc[ni][4 * q + 2] * rsc, acc[ni][4 * q + 3] * rsc);
  }
}

DI void ple_epi(const P& p, const u16* PL, const u16* XIN, u16* XOUT, int m, int n, float a0, float a1, float a2, float a3, float& ssq) {
  const u32x2 xi = *(const u32x2*)(XIN + (size_t)m * D + n);
  f32x4 x = (f32x4){bflo(xi[0]), bfhi(xi[0]), bflo(xi[1]), bfhi(xi[1])};
  const u32x2 pv = *(const u32x2*)(PL + (size_t)m * D + n);
  x[0] += sigm(a0) * bflo(pv[0]);
  x[1] += sigm(a1) * bfhi(pv[0]);
  x[2] += sigm(a2) * bflo(pv[1]);
  x[3] += sigm(a3) * bfhi(pv[1]);
  if (XOUT) {
    const u32x2 o = (u32x2){pk2(x[0], x[1]), pk2(x[2], x[3])};
    *(u32x2*)(XOUT + (size_t)m * D + n) = o;
    const float q0 = bflo(o[0]), q1 = bfhi(o[0]), q2 = bflo(o[1]), q3 = bfhi(o[1]);
    ssq += q0 * q0 + q1 * q1 + q2 * q2 + q3 * q3;
  } else {
    *(f32x4*)(p.y + (size_t)m * D + n) = x;
  }
}
DI void ple_phase(const P& p, int layer, const u16* XIN, u16* XOUT, char* smem) {
  const int tid = ltid(), l = tid & 63, w = tid >> 6, l32 = l & 31, hh = l >> 5;
  const u16* PB = (const u16*)p.BIG;
  const u16* Wg = p.wt_gate + (size_t)layer * 1024 * 1024;
  const u16* Wp = p.wt_ple + (size_t)layer * 1024 * 256;
  const int ntm = ROWS / 128, ntn = 8;
  const int slot = lbid() >> 3, S = gridDim.x >> 3;
  const int len = ((ntm - (lbid() & 7) + 7) >> 3) * ntn;
  int tm, tn;
  for (int L = slot; L < len; L += S) {
    list_entry(L, ntm, ntn, tm, tn);
    f32x16 accP[4], accG[4];
#pragma unroll
    for (int mi = 0; mi < 4; ++mi)
#pragma unroll
      for (int e = 0; e < 16; ++e) { accP[mi][e] = 0.f; accG[mi][e] = 0.f; }
    gemm_core_n1(PB, 256, IdMap{tm * 128}, Wp, tn * 128, 256, accP, smem, ltid());
    gemm_core_n1(XIN, 1024, IdMap{tm * 128}, Wg, tn * 128, 1024, accG, smem, ltid());
#pragma unroll
    for (int mi = 0; mi < 4; ++mi) {
      const int m = tm * 128 + mi * 32 + l32;
      float ssq = 0.f;
#pragma unroll
      for (int q = 0; q < 4; ++q) {
        const int n = tn * 128 + w * 32 + 8 * q + 4 * hh;
        const u32x2 xi = *(const u32x2*)(XIN + (size_t)m * D + n);
        f32x4 x = (f32x4){bflo(xi[0]), bfhi(xi[0]), bflo(xi[1]), bfhi(xi[1])};
#pragma unroll
        for (int c = 0; c < 4; ++c) x[c] += sigm(accG[mi][4 * q + c]) * accP[mi][4 * q + c];
        if (XOUT) {
          const u32x2 o = (u32x2){pk2(x[0], x[1]), pk2(x[2], x[3])};
          *(u32x2*)(XOUT + (size_t)m * D + n) = o;
          const float q0 = bflo(o[0]), q1 = bfhi(o[0]), q2 = bflo(o[1]), q3 = bfhi(o[1]);
          ssq += q0 * q0 + q1 * q1 + q2 * q2 + q3 * q3;
        } else {
          *(f32x4*)(p.y + (size_t)m * D + n) = x;
        }
      }
      ssq += __shfl_xor(ssq, 32);
      if (hh == 0) p.ss[(size_t)m * 32 + tn * 4 + w] = ssq;
    }
  }
}

DI void ffn_in_phase(const P& p, int layer, const u16* XR, char* smem) {
  const int tid = ltid(), l = tid & 63, w = tid >> 6, l32 = l & 31, hh = l >> 5;
  const u16* Wt = p.wt_ffn_in + (size_t)layer * 5632 * 1024;
  u16* HID = (u16*)p.BIG;
  const float* cw = p.conv_w + (size_t)layer * 3 * DFF;
  const float* cb = p.conv_b + (size_t)layer * DFF;
  int tm, tn;
  for (int it = 0; next_tile(it, 272, 22, tm, tn); ++it) {
    const int seq = tm / 17, j = tm - seq * 17;
    const int T = 2048, rowbase = seq * 2048, t0 = 126 * j - 2;
    const bool last = (j == 16);
    const bool has_smp = last && seq < 8;
    const int srow = ROWS_P + seq * 32;
    f32x16 acc[4][2];
    ZERO_ACC(acc);
    const ClampMap2 rmap{rowbase, t0, T, has_smp ? srow : -1};
    gemm_core(XR, 1024, rmap, Wt, tn * 256, 1024, acc, smem, tid);
#pragma unroll
    for (int mi = 0; mi < 4; ++mi) {
      const float rsr = rsqrtf(p.ss2[rmap(mi * 32 + l32)] * (1.f / D) + EPS);
#pragma unroll
      for (int e = 0; e < 16; ++e) { acc[mi][0][e] *= rsr; acc[mi][1][e] *= rsr; }
    }
    const int chw = tn * 128 + w * 32;
    if (t0 < 0 && l32 < 2) {
#pragma unroll
      for (int q = 0; q < 4; ++q)
#pragma unroll
        for (int c = 0; c < 4; ++c) acc[0][0][4 * q + c] = 0.f;
    }
    if (has_smp && l32 < 2) {
#pragma unroll
      for (int q = 0; q < 4; ++q) {
        const f32x4 sv = *(const f32x4*)(p.state_conv + ((size_t)(layer * 8 + seq) * 2 + l32) * DFF + chw + 8 * q + 4 * hh);
#pragma unroll
        for (int c = 0; c < 4; ++c) acc[2][0][4 * q + c] = sv[c];
      }
    }
    const int lbase = l & 32;
#pragma unroll
    for (int q = 0; q < 4; ++q) {
      const int chq = chw + 8 * q + 4 * hh;
      const f32x4 b4 = *(const f32x4*)(cb + chq);
      const f32x4 w0 = *(const f32x4*)(cw + chq), w1 = *(const f32x4*)(cw + DFF + chq), w2 = *(const f32x4*)(cw + 2 * DFF + chq);
#pragma unroll
      for (int mi = 0; mi < 4; ++mi) {
        const int m = mi * 32 + l32;
        const bool seg1 = has_smp && mi >= 2;
        const int t = seg1 ? m - 66 : t0 + m;
        const int Tm = seg1 ? 32 : T;
        float hv[4];
#pragma unroll
        for (int c = 0; c < 4; ++c) {
          const float g0 = acc[mi][0][4 * q + c];
          float g1 = __shfl(g0, lbase + ((l32 + 31) & 31));
          float g2 = __shfl(g0, lbase + ((l32 + 30) & 31));
          if (mi > 0) {
            const float pg = acc[mi > 0 ? mi - 1 : 0][0][4 * q + c];
            const float p1 = __shfl(pg, lbase + 31), p2 = __shfl(pg, lbase + 30);
            if (l32 == 0) { g1 = p1; g2 = p2; }
            if (l32 == 1) { g2 = p1; }
          }
          const float cv = b4[c] + w0[c] * g2 + w1[c] * g1 + w2[c] * g0;
          hv[c] = cv * sigm(cv) * acc[mi][1][4 * q + c];
        }
        if ((seg1 ? m >= 66 : m >= 2) && t < Tm) {
          *(u32x2*)(HID + (size_t)((seg1 ? srow : rowbase) + t) * DFF + chq) = (u32x2){pk2(hv[0], hv[1]), pk2(hv[2], hv[3])};
          if (last && t >= Tm - 2) {
            float* co = seg1 ? p.conv_sample + ((size_t)(layer * 8 + seq) * 2 + (t - 30)) * DFF
                             : p.conv_prompt + ((size_t)(layer * 16 + seq) * 2 + (t - (T - 2))) * DFF;
            *(f32x4*)(co + chq) = (f32x4){acc[mi][0][4 * q], acc[mi][0][4 * q + 1], acc[mi][0][4 * q + 2], acc[mi][0][4 * q + 3]};
          }
        }
      }
    }
  }
}

DI void gla_state_phase(const P& p, int layer, char* smem) {
  const u16* PROJ = (const u16*)p.BIG;
  const int tid = ltid(), l = tid & 63, w = tid >> 6, l32 = l & 31, hh = l >> 5;
  float* SLOC = (float*)((char*)p.y + (size_t)ROWS * 1024 * 2);
  float* DTOT = SLOC + (size_t)384 * 16384;
  const int k = tid >> 1, th = tid & 1;
  for (int item = lbid(); item < 384; item += gridDim.x) {
    const int sh = item / 3, ch = item - sh * 3, s = sh >> 3, h = sh & 7;
    const int rowbase = s * 2048 + ch * 512;
    float lower = 0.f;
    if (layer == 1) lower = sigm(p.lb_raw[1024 + h * 128 + k] - p.lb_raw[h * 128 + k]);
    const float oml = 1.f - lower;
    f32x16 S[4];
#pragma unroll
    for (int kt = 0; kt < 4; ++kt)
#pragma unroll
      for (int i = 0; i < 16; ++i) S[kt][i] = 0.f;
    float btot = 0.f;
    u16 fr[8], vr[8];
#define GS_LOAD(BLK) { const size_t r0_ = (size_t)rowbase + (BLK) * 16; \
      const u16* pf_ = PROJ + (r0_ + 8 * th) * 4096 + 1024 + h * 128 + k; \
      const u16* pv_ = PROJ + r0_ * 4096 + 2048 + h * 128 + 32 * w + l32; \
      _Pragma("unroll") for (int t = 0; t < 8; ++t) fr[t] = pf_[(size_t)t * 4096]; \
      _Pragma("unroll") for (int jj = 0; jj < 8; ++jj) vr[jj] = pv_[(size_t)(8 * (jj >> 2) + 4 * hh + (jj & 3)) * 4096]; }
    GS_LOAD(0);
    for (int blk = 0; blk < 32; ++blk) {
      char* sb = smem + (blk & 1) * 8192;
      u16* KDT = (u16*)sb;
      float* DD = (float*)(KDT + 128 * 20);
      {
        float km[8], eb[8];
        float bs = 0.f;
#pragma unroll
        for (int t = 0; t < 8; ++t) {
          const float f = bf2f(fr[t]);
          const float g = lower + oml * sigm(f);
          bs += __logf(g);
          km[t] = 1.f - g; eb[t] = bs;
        }
        const float other = __shfl_xor(bs, 1);
        const float boff = th ? other : 0.f;
        const float bsum = bs + other;
        btot += bsum;
        unsigned kdp[4];
#pragma unroll
        for (int j = 0; j < 4; ++j)
          kdp[j] = pk2(km[2 * j] * __expf(bsum - boff - eb[2 * j]), km[2 * j + 1] * __expf(bsum - boff - eb[2 * j + 1]));
        *(u32x2*)(KDT + k * 20 + 8 * th) = (u32x2){kdp[0], kdp[1]};
        *(u32x2*)(KDT + k * 20 + 8 * th + 4) = (u32x2){kdp[2], kdp[3]};
        if (th == 0) DD[k] = __expf(bsum);
      }
      const bf16x8 vfrag = mk8u((unsigned)vr[0] | ((unsigned)vr[1] << 16), (unsigned)vr[2] | ((unsigned)vr[3] << 16),
                                (unsigned)vr[4] | ((unsigned)vr[5] << 16), (unsigned)vr[6] | ((unsigned)vr[7] << 16));
      if (blk + 1 < 32) GS_LOAD(blk + 1);
      __syncthreads();
#pragma unroll
      for (int kt = 0; kt < 4; ++kt) {
#pragma unroll
        for (int q = 0; q < 4; ++q) {
          const f32x4 d4 = *(const f32x4*)(DD + 32 * kt + 8 * q + 4 * hh);
#pragma unroll
          for (int c = 0; c < 4; ++c) S[kt][4 * q + c] *= d4[c];
        }
        const u32x2 lo = *(const u32x2*)(KDT + (32 * kt + l32) * 20 + 4 * hh);
        const u32x2 hi = *(const u32x2*)(KDT + (32 * kt + l32) * 20 + 8 + 4 * hh);
        S[kt] = __builtin_amdgcn_mfma_f32_32x32x16_bf16(mk8(lo, hi), vfrag, S[kt], 0, 0, 0);
      }
    }
#undef GS_LOAD
    {
      float* op = SLOC + (size_t)item * 16384 + 32 * w + l32;
#pragma unroll
      for (int kt = 0; kt < 4; ++kt)
#pragma unroll
        for (int i = 0; i < 16; ++i) op[(size_t)(32 * kt + (i & 3) + 8 * (i >> 2) + 4 * hh) * 128] = S[kt][i];
      if (th == 0) DTOT[(size_t)item * 128 + k] = __expf(btot);
    }
    __syncthreads();
  }
}

DI void gla_phase(const P& p, int layer, char* smem) {
  const u16* PROJ = (const u16*)p.BIG;
  const int tid = ltid(), l = tid & 63, w = tid >> 6, l32 = l & 31, hh = l >> 5, m16 = l & 15;
  float* REDB = (float*)(smem + 2 * 14336);
  const int k = tid >> 1, th = tid & 1;
  const float* SLOC = (const float*)((const char*)p.y + (size_t)ROWS * 1024 * 2);
  const float* DTOT = SLOC + (size_t)384 * 16384;
  for (int item = lbid(); item < 576; item += gridDim.x) {
    const bool smp = item < 64;
    const int s = smp ? 16 + (item >> 3) : (item - 64) >> 5;
    const int h = smp ? (item & 7) : ((item - 64) >> 2) & 7;
    const int ch = smp ? 0 : (item - 64) & 3;
    const int T = smp ? 32 : 512;
    const int rowbase = smp ? ROWS_P + (s - 16) * 32 : s * 2048 + ch * 512;
    float lower = 0.f;
    if (layer == 1) lower = sigm(p.lb_raw[1024 + h * 128 + k] - p.lb_raw[h * 128 + k]);
    const float oml = 1.f - lower;
    f32x16 S[4];
    if (smp) {
      const float* sp = p.state_hgrn + ((size_t)(layer * 8 + (s - 16)) * 8 + h) * 16384 + 32 * w + l32;
#pragma unroll
      for (int kt = 0; kt < 4; ++kt)
#pragma unroll
        for (int i = 0; i < 16; ++i) S[kt][i] = sp[(size_t)(32 * kt + (i & 3) + 8 * (i >> 2) + 4 * hh) * 128];
    } else {
#pragma unroll
      for (int kt = 0; kt < 4; ++kt)
#pragma unroll
        for (int i = 0; i < 16; ++i) S[kt][i] = 0.f;
#pragma unroll 1
      for (int j = 0; j < ch; ++j) {
        const int it1 = (s * 8 + h) * 3 + j;
        const float* sl = SLOC + (size_t)it1 * 16384 + 32 * w + l32 + (size_t)(4 * hh) * 128;
        const float* dl = DTOT + (size_t)it1 * 128 + 4 * hh;
#pragma unroll
        for (int kt = 0; kt < 4; ++kt) {
#pragma unroll
          for (int q = 0; q < 4; ++q) {
            const float* slq = sl + (size_t)(32 * kt + 8 * q) * 128;
            const f32x4 d4 = *(const f32x4*)(dl + 32 * kt + 8 * q);
#pragma unroll
            for (int c = 0; c < 4; ++c) S[kt][4 * q + c] = S[kt][4 * q + c] * d4[c] + slq[c * 128];
            __builtin_amdgcn_sched_barrier(0);
          }
        }
      }
    }
    const int nblk = T >> 4;
    u16 fr[8], qr[8], vr[8];
#define GLA_LOADRAW(BLK) { const size_t r0_ = (size_t)rowbase + (BLK) * 16; \
      const u16* pf_ = PROJ + (r0_ + 8 * th) * 4096 + 1024 + h * 128 + k; \
      const u16* pq_ = PROJ + (r0_ + 8 * th) * 4096 + h * 128 + k; \
      _Pragma("unroll") for (int t = 0; t < 8; ++t) fr[t] = pf_[(size_t)t * 4096]; \
      _Pragma("unroll") for (int j = 0; j < 8; ++j) qr[j] = pq_[(size_t)j * 4096]; \
 }
#define GLA_LOADV(BLK) { const u16* pv_ = PROJ + ((size_t)rowbase + (BLK) * 16) * 4096 + 2048 + h * 128 + 32 * w + l32; \
      _Pragma("unroll") for (int jj = 0; jj < 8; ++jj) vr[jj] = pv_[(size_t)(8 * (jj >> 2) + 4 * hh + (jj & 3)) * 4096]; }
#define GLA_LOADGS(BLK) { const u16* pg_ = PROJ + ((size_t)rowbase + (BLK) * 16 + m16) * 4096 + 3072 + h * 128 + 32 * w + 4 * hh; \
      _Pragma("unroll") for (int q = 0; q < 4; ++q) gsl[q] = *(const u32x2*)(pg_ + 8 * q); }
#define GLA_FINAL(BLK) { const float* RED_ = REDB + ((BLK) & 1) * 64; \
      if (l32 < 16) { \
        const float tot = RED_[l32] + RED_[16 + l32] + RED_[32 + l32] + RED_[48 + l32]; \
        const float rn = rsqrtf(tot * (1.f / 128.f) + EPS); \
        u16* op_ = p.OG + ((size_t)rowbase + (BLK) * 16 + l32) * 1024 + h * 128 + 32 * w + 4 * hh; \
        const float* gp_ = p.g_hg + layer * 1024 + h * 128 + 32 * w + 4 * hh; \
        _Pragma("unroll") for (int q = 0; q < 4; ++q) { const f32x4 gh = *(const f32x4*)(gp_ + 8 * q); \
          *(u32x2*)(op_ + 8 * q) = (u32x2){pk2(oacc[4 * q] * rn * gh[0] * bflo(gsl[q][0]), oacc[4 * q + 1] * rn * gh[1] * bfhi(gsl[q][0])), \
                                          pk2(oacc[4 * q + 2] * rn * gh[2] * bflo(gsl[q][1]), oacc[4 * q + 3] * rn * gh[3] * bfhi(gsl[q][1]))}; } \
      } }
    GLA_LOADRAW(0);
    u32x2 gsl[4];
    for (int blk = 0; blk < nblk; ++blk) {
      GLA_LOADGS(blk);
      GLA_LOADV(blk);
      char* sb = smem + (blk & 1) * 14336;
      u16* QT = (u16*)sb;
      u16* KT = QT + 16 * 136;
      u16* KDT = KT + 16 * 136;
      float* DD = (float*)(KDT + 128 * 20);
      {
        float qtm[8], ktm[8];
        float bs = 0.f;
#pragma unroll
        for (int t = 0; t < 8; ++t) {
          const float f = bf2f(fr[t]);
          const float g = lower + oml * sigm(f);
          bs += __logf(g);
          const float eb = __expf(bs);
          qtm[t] = bf2f(qr[t]) * eb;
          ktm[t] = (1.f - g) * __builtin_amdgcn_rcpf(eb);
        }
        const float other = __shfl_xor(bs, 1);
        const float boff = th ? other : 0.f;
        const float bsum = bs + other;
        const float E1 = __expf(boff), E1i = __expf(-boff), EL = __expf(bsum);
        unsigned kdp[4];
        float kdprev = 0.f;
#pragma unroll
        for (int j = 0; j < 8; ++j) {
          const int t = 8 * th + j;
          const float qt = qtm[j] * E1;
          const float ktv = ktm[j] * E1i;
          const float kd = ktv * EL;
          QT[t * 136 + k] = (u16)(pk2(qt, 0.f) & 0xffffu);
          KT[t * 136 + k] = (u16)(pk2(ktv, 0.f) & 0xffffu);
          if (j & 1) kdp[j >> 1] = pk2(kdprev, kd); else kdprev = kd;
        }
        *(u32x2*)(KDT + k * 20 + 8 * th) = (u32x2){kdp[0], kdp[1]};
        *(u32x2*)(KDT + k * 20 + 8 * th + 4) = (u32x2){kdp[2], kdp[3]};
        if (th == 0) DD[k] = __expf(bsum);
      }
      if (blk + 1 < nblk) GLA_LOADRAW(blk + 1);
      __syncthreads();
      const bf16x8 vfrag = mk8u((unsigned)vr[0] | ((unsigned)vr[1] << 16), (unsigned)vr[2] | ((unsigned)vr[3] << 16),
                                (unsigned)vr[4] | ((unsigned)vr[5] << 16), (unsigned)vr[6] | ((unsigned)vr[7] << 16));
      f32x16 aacc, oacc;
#pragma unroll
      for (int i = 0; i < 16; ++i) { aacc[i] = 0.f; oacc[i] = 0.f; }
#pragma unroll
      for (int ks = 0; ks < 8; ++ks) {
        const bf16x8 ka = *(const bf16x8*)(KT + m16 * 136 + 16 * ks + 8 * hh);
        const bf16x8 qb = *(const bf16x8*)(QT + m16 * 136 + 16 * ks + 8 * hh);
        aacc = __builtin_amdgcn_mfma_f32_32x32x16_bf16(ka, qb, aacc, 0, 0, 0);
        const int kt = ks >> 1, s2 = ks & 1;
        const bf16x8 sa = mk8u(pk2(S[kt][8 * s2], S[kt][8 * s2 + 1]), pk2(S[kt][8 * s2 + 2], S[kt][8 * s2 + 3]),
                               pk2(S[kt][8 * s2 + 4], S[kt][8 * s2 + 5]), pk2(S[kt][8 * s2 + 6], S[kt][8 * s2 + 7]));
        const u32x2 lo = *(const u32x2*)(QT + m16 * 136 + 32 * kt + 16 * s2 + 4 * hh);
        const u32x2 hi = *(const u32x2*)(QT + m16 * 136 + 32 * kt + 16 * s2 + 8 + 4 * hh);
        oacc = __builtin_amdgcn_mfma_f32_32x32x16_bf16(sa, mk8(lo, hi), oacc, 0, 0, 0);
      }
      float am[8];
#pragma unroll
      for (int i = 0; i < 8; ++i) { const int m = (i & 3) + 8 * (i >> 2) + 4 * hh; am[i] = (m <= m16) ? aacc[i] : 0.f; }
      const bf16x8 afrag = mk8u(pk2(am[0], am[1]), pk2(am[2], am[3]), pk2(am[4], am[5]), pk2(am[6], am[7]));
      oacc = __builtin_amdgcn_mfma_f32_32x32x16_bf16(vfrag, afrag, oacc, 0, 0, 0);
#pragma unroll
      for (int kt = 0; kt < 4; ++kt) {
#pragma unroll
        for (int q = 0; q < 4; ++q) {
          const f32x4 d4 = *(const f32x4*)(DD + 32 * kt + 8 * q + 4 * hh);
#pragma unroll
          for (int c = 0; c < 4; ++c) S[kt][4 * q + c] *= d4[c];
        }
        const u32x2 lo = *(const u32x2*)(KDT + (32 * kt + l32) * 20 + 4 * hh);
        const u32x2 hi = *(const u32x2*)(KDT + (32 * kt + l32) * 20 + 8 + 4 * hh);
        S[kt] = __builtin_amdgcn_mfma_f32_32x32x16_bf16(mk8(lo, hi), vfrag, S[kt], 0, 0, 0);
      }
      float ss = 0.f;
#pragma unroll
      for (int i = 0; i < 16; ++i) ss += oacc[i] * oacc[i];
      ss += __shfl_xor(ss, 32);
      if (l < 16) REDB[(blk & 1) * 64 + w * 16 + l] = ss;
      __syncthreads();
      GLA_FINAL(blk);
    }
#undef GLA_LOADGS
#undef GLA_LOADV
#undef GLA_LOADRAW
#undef GLA_FINAL
    if (smp || ch == 3) {
      float* op = (smp ? p.hgrn_sample + ((size_t)(layer * 8 + (s - 16)) * 8 + h) * 16384
                       : p.hgrn_prompt + ((size_t)(layer * 16 + s) * 8 + h) * 16384) + 32 * w + l32;
#pragma unroll
      for (int kt = 0; kt < 4; ++kt)
#pragma unroll
        for (int i = 0; i < 16; ++i) op[(size_t)(32 * kt + (i & 3) + 8 * (i >> 2) + 4 * hh) * 128] = S[kt][i];
    }
  }
}

DI void kvconv_phase(const P& p, int first) {
  const int tid = ltid();
  char* KVT = p.BIG + (size_t)ROWS * 1024 * 2;
  for (int t = first + lbid(); t < 4096 + 1088; t += gridDim.x) {
    const float *kb, *vb; int nvalid = 64;
    if (t < 4096) { const int kt = t & 31, sh = t >> 5, s = sh >> 3, h = sh & 7; const size_t off = ((size_t)(s * 2048 + 64 * kt)) * 1024 + h * 128; kb = p.k_prompt + off; vb = p.v_prompt + off; }
    else { const int u = t - 4096; const int kt = u % 17, sh = u / 17, b = sh >> 3, h = sh & 7;
      if (kt < 16) { const size_t off = ((size_t)(b * 1024 + 64 * kt)) * 1024 + h * 128; kb = p.cache_k + off; vb = p.cache_v + off; }
      else { const size_t off = ((size_t)(b * 32)) * 1024 + h * 128; kb = p.k_sample + off; vb = p.v_sample + off; nvalid = 32; } }
    u16* kd = (u16*)(KVT + (size_t)t * 32768);
    u16* vd = kd + 8192;
#pragma unroll
    for (int pp = 0; pp < 4; ++pp) {
      const int key = 16 * pp + (tid >> 4), d8 = (tid & 15) * 8;
      f32x4 a = {0.f, 0.f, 0.f, 0.f}, b2 = {0.f, 0.f, 0.f, 0.f};
      if (key < nvalid) { a = *(const f32x4*)(kb + (size_t)key * 1024 + d8); b2 = *(const f32x4*)(kb + (size_t)key * 1024 + d8 + 4); }
      *(u32x4*)(kd + key * 128 + d8) = (u32x4){pk2(a[0], a[1]), pk2(a[2], a[3]), pk2(b2[0], b2[1]), pk2(b2[2], b2[3])};
    }
#pragma unroll
    for (int c = 0; c < 4; ++c) {
      const int v = tid & 127, cc = 4 * (tid >> 7) + c;
      float e[8];
#pragma unroll
      for (int j = 0; j < 8; ++j) { const int key = 8 * cc + j; e[j] = key < nvalid ? vb[(size_t)key * 1024 + v] : 0.f; }
      *(u32x4*)(vd + v * 64 + 8 * cc) = (u32x4){pk2(e[0], e[1]), pk2(e[2], e[3]), pk2(e[4], e[5]), pk2(e[6], e[7])};
    }
  }
}

DI void attn_phase(const P& p, int layer, char* smem) {
  const int jl = layer - 2;
  const u16* Q = (const u16*)p.BIG;
  const char* KVT = p.BIG + (size_t)ROWS * 1024 * 2;
  const int tid = ltid(), l = tid & 63, w = tid >> 6, l16 = l & 15, g = l >> 4;
  u16* KS = (u16*)smem;
  u16* VT = KS + 64 * 136;
  float* BT = (float*)(VT + 128 * 72);
  u16* QS = (u16*)(BT + 256);
  const float lam_init = 0.8f - 0.6f * __expf(-0.3f * (float)layer);
  float lam;
  {
    const float* lp = p.lam_b + jl * 256;
    float a = 0.f, b = 0.f;
    for (int d = 0; d < 64; ++d) { a += lp[d] * lp[64 + d]; b += lp[128 + d] * lp[192 + d]; }
    lam = __expf(a) - __expf(b) + lam_init;
  }
  const int bidA = lbid(), GA = gridDim.x;
  for (int kk = 0; kk * GA < 4096 + 64; ++kk) {
    const int item = ((kk & 1) ? (GA - 1 - bidA) : bidA) + kk * GA;
    if (item >= 4096 + 64) continue;
    int b, h, nq, qrow0, qpos0, ntiles, tile0; bool smp;
    if (item < 4096) { const int jq = 31 - (item >> 7); const int bh = item & 127; b = bh >> 3; h = bh & 7; smp = false; nq = 64; qrow0 = b * 2048 + 64 * jq; qpos0 = 64 * jq; ntiles = jq + 1; tile0 = bh * 32; }
    else { const int si = item - 4096; b = si >> 3; h = si & 7; smp = true; nq = 32; qrow0 = ROWS_P + b * 32; qpos0 = 1024; ntiles = 17; tile0 = 4096 + si * 17; }
    __syncthreads();
    if (tid < 230) {
      const int rel = tid - 166;
      const int n = rel < 0 ? -rel : rel;
      int bk = n < 8 ? n : 8 + (n >= 13) + (n >= 20) + (n >= 30) + (n >= 46) + (n >= 70) + (n >= 108) + (n >= 166);
      if (rel > 0) bk += 16;
      BT[tid] = p.rel_bias[bk * 8 + h] * LOG2E;
    }
#pragma unroll
    for (int pp = 0; pp < 4; ++pp) {
      const int idx = pp * 256 + tid, r = idx >> 4, c16 = idx & 15;
      *(u32x4*)(QS + r * 136 + c16 * 8) = *(const u32x4*)(Q + (size_t)(qrow0 + min(r, nq - 1)) * 1024 + h * 128 + c16 * 8);
    }
    f32x4 oacc[2][8];
#pragma unroll
    for (int c = 0; c < 2; ++c)
#pragma unroll
      for (int vs = 0; vs < 8; ++vs) oacc[c][vs] = (f32x4){0.f, 0.f, 0.f, 0.f};
    float mrun[2] = {-1e30f, -1e30f}, lsum[2] = {0.f, 0.f};
    const int qpos = qpos0 + min(16 * w + l16, nq - 1);
    u32x4 rk[4], rv[4];
    {
      const u32x4* src = (const u32x4*)(KVT + (size_t)tile0 * 32768);
#pragma unroll
      for (int pp = 0; pp < 4; ++pp) { rk[pp] = src[pp * 256 + tid]; rv[pp] = src[1024 + pp * 256 + tid]; }
    }
    for (int kt = 0; kt < ntiles; ++kt) {
      const int nvalid = (smp && kt == 16) ? 32 : 64;
      if (kt > 0) __syncthreads();
#pragma unroll
      for (int pp = 0; pp < 4; ++pp) {
        const int idx = pp * 256 + tid;
        *(u32x4*)(KS + (idx >> 4) * 136 + (idx & 15) * 8) = rk[pp];
        *(u32x4*)(VT + (idx >> 3) * 72 + (idx & 7) * 8) = rv[pp];
      }
      if (kt + 1 < ntiles) {
        const u32x4* src = (const u32x4*)(KVT + (size_t)(tile0 + kt + 1) * 32768);
#pragma unroll
        for (int pp = 0; pp < 4; ++pp) { rk[pp] = src[pp * 256 + tid]; rv[pp] = src[1024 + pp * 256 + tid]; }
      }
      __syncthreads();
      f32x4 sacc[2][4];
#pragma unroll
      for (int c = 0; c < 2; ++c)
#pragma unroll
        for (int sub = 0; sub < 4; ++sub) {
          sacc[c][sub] = (f32x4){0.f, 0.f, 0.f, 0.f};
#pragma unroll
          for (int ks = 0; ks < 2; ++ks) {
            const bf16x8 kf = *(const bf16x8*)(KS + (16 * sub + l16) * 136 + c * 64 + 32 * ks + 8 * g);
            const bf16x8 qfr = *(const bf16x8*)(QS + (16 * w + l16) * 136 + c * 64 + 32 * ks + 8 * g);
            sacc[c][sub] = __builtin_amdgcn_mfma_f32_16x16x32_bf16(kf, qfr, sacc[c][sub], 0, 0, 0);
          }
        }
#pragma unroll
      for (int sub = 0; sub < 4; ++sub)
#pragma unroll
        for (int i = 0; i < 4; ++i) {
          const int kl = 16 * sub + 4 * g + i;
          int rel = 64 * kt + kl - qpos;
          rel = rel < -166 ? -166 : rel;
          const float bt = BT[rel + 166];
          const bool ok = kl < nvalid;
          sacc[0][sub][i] = ok ? sacc[0][sub][i] + bt : -30000.f;
          sacc[1][sub][i] = ok ? sacc[1][sub][i] + bt : -30000.f;
        }
      bf16x8 pf[2][2];
#pragma unroll
      for (int c = 0; c < 2; ++c) {
        float mx = -1e30f;
#pragma unroll
        for (int sub = 0; sub < 4; ++sub)
#pragma unroll
          for (int i = 0; i < 4; ++i) mx = fmaxf(mx, sacc[c][sub][i]);
        mx = fmaxf(mx, __shfl_xor(mx, 16));
        mx = fmaxf(mx, __shfl_xor(mx, 32));
        const float mnew = fmaxf(mrun[c], mx);
        const float alpha = __builtin_amdgcn_exp2f(mrun[c] - mnew);
        mrun[c] = mnew;
        float rs = 0.f;
#pragma unroll
        for (int sub = 0; sub < 4; ++sub)
#pragma unroll
          for (int i = 0; i < 4; ++i) { const float e = __builtin_amdgcn_exp2f(sacc[c][sub][i] - mnew); sacc[c][sub][i] = e; rs += e; }
        lsum[c] = lsum[c] * alpha + rs;
#pragma unroll
        for (int vs = 0; vs < 8; ++vs) oacc[c][vs] *= alpha;
#pragma unroll
        for (int j = 0; j < 2; ++j)
          pf[c][j] = mk8u(pk2(sacc[c][2 * j][0], sacc[c][2 * j][1]), pk2(sacc[c][2 * j][2], sacc[c][2 * j][3]),
                          pk2(sacc[c][2 * j + 1][0], sacc[c][2 * j + 1][1]), pk2(sacc[c][2 * j + 1][2], sacc[c][2 * j + 1][3]));
      }
#pragma unroll
      for (int j = 0; j < 2; ++j)
#pragma unroll
        for (int vs = 0; vs < 8; ++vs) {
          const u32x2 lo = *(const u32x2*)(VT + (16 * vs + l16) * 72 + 32 * j + 4 * g);
          const u32x2 hi = *(const u32x2*)(VT + (16 * vs + l16) * 72 + 32 * j + 16 + 4 * g);
          const bf16x8 vf = mk8(lo, hi);
          oacc[0][vs] = __builtin_amdgcn_mfma_f32_16x16x32_bf16(vf, pf[0][j], oacc[0][vs], 0, 0, 0);
          oacc[1][vs] = __builtin_amdgcn_mfma_f32_16x16x32_bf16(vf, pf[1][j], oacc[1][vs], 0, 0, 0);
        }
    }
#pragma unroll
    for (int c = 0; c < 2; ++c) { lsum[c] += __shfl_xor(lsum[c], 16); lsum[c] += __shfl_xor(lsum[c], 32); }
    const float inv0 = 1.f / lsum[0], inv1 = lam / lsum[1];
    float ss = 0.f;
#pragma unroll
    for (int vs = 0; vs < 8; ++vs)
#pragma unroll
      for (int i = 0; i < 4; ++i) { const float o = oacc[0][vs][i] * inv0 - oacc[1][vs][i] * inv1; oacc[0][vs][i] = o; ss += o * o; }
    ss += __shfl_xor(ss, 16);
    ss += __shfl_xor(ss, 32);
    const float rn = rsqrtf(ss * (1.f / 128.f) + EPS) * (1.f - lam_init);
    if (16 * w + l16 < nq) {
      const size_t row = (size_t)qrow0 + 16 * w + l16;
#pragma unroll
      for (int vs = 0; vs < 8; ++vs) {
        const int v = h * 128 + 16 * vs + 4 * g;
        const f32x4 gl = *(const f32x4*)(p.g_subln + jl * 1024 + v);
        *(u32x2*)(p.OG + row * 1024 + v) = (u32x2){pk2(oacc[0][vs][0] * rn * gl[0], oacc[0][vs][1] * rn * gl[1]),
                                                   pk2(oacc[0][vs][2] * rn * gl[2], oacc[0][vs][3] * rn * gl[3])};
      }
    }
  }
}

#define XB_TMO      128
#define XB_XCNT(j)  (256  + 64 * (j))
#define XB_XSUB(j)  (1280 + 64 * (j))
#define XB_XGEN(j)  (2304 + 64 * (j))
#define XB_TOP      3328
#define XB_TOPGEN   3392
#define XCD_BAR_WORDS 3456
#define XB_SPIN_CAP (1u << 18)
#define LAS __attribute__((address_space(3)))
DI unsigned xb_ld(unsigned* p) { return __hip_atomic_load(p, __ATOMIC_RELAXED, __HIP_MEMORY_SCOPE_AGENT); }
DI unsigned xb_add(unsigned* p, unsigned v) { return __hip_atomic_fetch_add(p, v, __ATOMIC_RELAXED, __HIP_MEMORY_SCOPE_AGENT); }
DI unsigned xb_xcc_id() { return (unsigned)__builtin_amdgcn_s_getreg((3 << 11) | 20) & 0xFu; }
#define XB_SPIN(cond, bar) do { unsigned _sp = 0; while (cond) { __builtin_amdgcn_s_sleep(1); \
    if ((++_sp & 255u) == 0u) { if (xb_ld(&(bar)[XB_TMO])) break; if (_sp > XB_SPIN_CAP) { atomicAdd(&(bar)[XB_TMO], 1u); break; } } } } while (0)
struct XcdBarrier { unsigned* bar; unsigned x; volatile LAS unsigned* st; };
DI XcdBarrier xcd_barrier_post(unsigned* bar, volatile LAS unsigned* st) {
  XcdBarrier b; b.bar = bar; b.x = xb_xcc_id(); b.st = st;
  if (threadIdx.x == 0) (void)xb_add(&bar[XB_XCNT(b.x)], 1u);
  return b;
}
DI void xcd_barrier_complete(unsigned* bar, unsigned x, unsigned& nloc, unsigned& nx) {
  const unsigned G = gridDim.x;
  unsigned sum, cnt, mine, sp = 0u;
  for (;;) {
    sum = 0u; cnt = 0u; mine = 0u;
#pragma unroll
    for (unsigned j = 0; j < 16; ++j) { const unsigned c = xb_ld(&bar[XB_XCNT(j)]); sum += c; cnt += (c > 0u) ? 1u : 0u; mine = (j == x) ? c : mine; }
    if (sum == G) break;
    __builtin_amdgcn_s_sleep(1);
    if ((++sp & 255u) == 0u) { if (xb_ld(&bar[XB_TMO])) break; if (sp > XB_SPIN_CAP) { atomicAdd(&bar[XB_TMO], 1u); break; } }
  }
  nloc = mine > 0u ? mine : 1u; nx = cnt > 0u ? cnt : 1u;
}
DI void xcd_barrier(const XcdBarrier& b) {
  asm volatile("s_waitcnt vmcnt(0)" ::: "memory");
  __syncthreads();
  if (ltid() == 0) {
    unsigned* bar = b.bar;
    __builtin_amdgcn_s_waitcnt(0);
    unsigned nloc = b.st[0], nx = b.st[1];
    if (nloc == 0u) { xcd_barrier_complete(bar, b.x, nloc, nx); b.st[0] = nloc; b.st[1] = nx; }
    const unsigned old = xb_add(&bar[XB_XSUB(b.x)], 1u);
    const unsigned gen = old / nloc;
    if (old + 1u == (gen + 1u) * nloc) {
      __builtin_amdgcn_fence(__ATOMIC_RELEASE, "agent");
      asm volatile("s_waitcnt vmcnt(0)" ::: "memory");
      const unsigned og = xb_add(&bar[XB_TOP], 1u);
      const unsigned tg = og / nx;
      if (og + 1u == (tg + 1u) * nx) xb_add(&bar[XB_TOPGEN], 1u);
      else XB_SPIN(xb_ld(&bar[XB_TOPGEN]) == tg, bar);
      __builtin_amdgcn_fence(__ATOMIC_ACQUIRE, "agent");
      xb_add(&bar[XB_XGEN(b.x)], 1u);
      asm volatile("s_waitcnt vmcnt(0)" ::: "memory");
    } else {
      XB_SPIN(xb_ld(&bar[XB_XGEN(b.x)]) == gen, bar);
      __builtin_amdgcn_fence(__ATOMIC_ACQUIRE, "agent");
      asm volatile("s_waitcnt vmcnt(0)" ::: "memory");
    }
  }
  __syncthreads();
}

__global__ void __launch_bounds__(256, 2) yoco_megakernel(P p) {
  __shared__ __attribute__((aligned(16))) char smem[65520];
  __shared__ uint4 xb_words;
  cg::grid_group grid = cg::this_grid();
  if (threadIdx.x == 0) xb_words = make_uint4(0u, 0u, 0u, 0u);
  if (blockIdx.x == 0) { for (int i = threadIdx.x; i < XCD_BAR_WORDS; i += 256) __hip_atomic_store(p.bar + i, 0u, __ATOMIC_RELAXED, __HIP_MEMORY_SCOPE_AGENT); }
  prep_phase(p, smem);
  grid.sync();
  const XcdBarrier xb = xcd_barrier_post(p.bar, (volatile LAS unsigned*)&xb_words);
  u16* Mbuf = (u16*)p.BIG;
  u16* Fbuf = (u16*)(p.BIG + ((size_t)180 << 20));
  u16* PB = (u16*)p.BIG;
  u16* XRA = (u16*)p.y;
  u16* XRB = p.XB;
  for (int i = 0; i < 4; ++i) {
    const float* gn = p.g_norms + i * 4 * D;
    u16* cur = (i & 1) ? XRB : XRA;
    u16* nxt = (i == 3) ? nullptr : ((i & 1) ? XRA : XRB);
    if (i == 0) {
      rowop_phase(p, true, nullptr, nullptr, gn, p.XB, nullptr, nullptr, nullptr);
      xcd_barrier(xb);
    }
    if (i < 2) {
      REPG gemm_phase<0>(p, i ? cur : p.XB, 1024, p.wt_in_a + (size_t)i * 4096 * 1024, 4096, p.BIG, smem, i ? p.ss : nullptr);
      xcd_barrier(xb);
      gla_state_phase(p, i, smem);
      xcd_barrier(xb);
      for (int _r = 0; _r < REP_GLA; ++_r) gla_phase(p, i, smem);
      xcd_barrier(xb);
      REPG gemm_phase<2>(p, p.OG, 1024, p.wt_out_a + (size_t)i * 1024 * 1024, 1024, Mbuf, smem);
      xcd_barrier(xb);
    } else {
      if (i == 2) gemm_phase<3>(p, cur, 1024, p.wt_kv, 2048, nullptr, smem, p.ss);
      REPG gemm_phase<1>(p, cur, 1024, p.wt_q + (size_t)(i - 2) * 1024 * 1024, 1024, p.BIG, smem, p.ss);
      if (i == 2) xcd_barrier(xb);
      kvconv_phase(p, i == 2 ? 4096 : 0);
      xcd_barrier(xb);
      for (int _r = 0; _r < REP_ATTN; ++_r) attn_phase(p, i, smem);
      xcd_barrier(xb);
      REPG gemm_phase<2>(p, p.OG, 1024, p.wt_out_b + (size_t)(i - 2) * 1024 * 1024, 1024, Mbuf, smem);
      xcd_barrier(xb);
    }
    rowop2_phase(p, i == 0, cur, Mbuf, gn + D, p.ss2, nullptr, nullptr, nullptr);
    xcd_barrier(xb);
    REPG ffn_in_phase(p, i, cur, smem);
    xcd_barrier(xb);
    REPG gemm_phase<2>(p, (const u16*)p.BIG, DFF, p.wt_ffn_out + (size_t)i * 1024 * DFF, 1024, Fbuf, smem);
    xcd_barrier(xb);
    rowop2_phase(p, false, cur, Fbuf, gn + 3 * D, nullptr, p.p_prompt + (size_t)i * ROWS_P * 256, p.p_sample + (size_t)i * 256 * 256, PB);
    xcd_barrier(xb);
    ple_phase(p, i, cur, nxt, smem);
    xcd_barrier(xb);
  }
}

extern "C" void kernel_launch(void* const* d_in, const int* in_sizes, int n_in, void* d_out, int out_size, void* d_ws,
                              size_t ws_size, hipStream_t stream) {
  static int grid_blocks = 0;
  if (!grid_blocks) {
    int dev = 0, cus = 0, per_cu = 0;
    hipGetDevice(&dev);
    hipDeviceGetAttribute(&cus, hipDeviceAttributeMultiprocessorCount, dev);
    hipOccupancyMaxActiveBlocksPerMultiprocessor(&per_cu, yoco_megakernel, 256, 0);
    if (per_cu > 2) per_cu = 2;
    grid_blocks = cus * per_cu;
    grid_blocks &= ~7;
  }
  P p{};
  const float* const* in = (const float* const*)d_in;
  p.x_prompt = in[0]; p.x_sample = in[1]; p.cache_k = in[2]; p.cache_v = in[3]; p.state_hgrn = in[4]; p.state_conv = in[5];
  p.p_prompt = in[6]; p.p_sample = in[7];
  p.g_norms = in[8]; const float* w_in_a = in[9]; p.lb_raw = in[10]; p.g_hg = in[11]; const float* w_out_a = in[12]; p.g_kv = in[13];
  const float* w_kv = in[14]; p.rel_bias = in[15]; const float* w_q_b = in[16]; p.lam_b = in[17]; p.g_subln = in[18];
  const float* w_out_b = in[19]; const float* w_ffn_in = in[20]; p.conv_w = in[21]; p.conv_b = in[22]; const float* w_ffn_out = in[23];
  const float* w_ple = in[24]; const float* w_ple_gate = in[25];
  float* o = (float*)d_out;
  p.y = o; o += (size_t)ROWS * D;
  p.k_prompt = o; o += (size_t)ROWS_P * D;
  p.v_prompt = o; o += (size_t)ROWS_P * D;
  p.k_sample = o; o += (size_t)256 * D;
  p.v_sample = o; o += (size_t)256 * D;
  p.hgrn_prompt = o; o += (size_t)2 * 16 * 8 * 16384;
  p.hgrn_sample = o; o += (size_t)2 * 8 * 8 * 16384;
  p.conv_prompt = o; o += (size_t)4 * 16 * 2 * DFF;
  p.conv_sample = o;
  u16* ws = (u16*)d_ws;
  p.wt_in_a = ws; ws += (size_t)2 * 4096 * 1024;
  p.wt_out_a = ws; ws += (size_t)2 * 1024 * 1024;
  p.wt_kv = ws; ws += (size_t)2048 * 1024;
  p.wt_q = ws; ws += (size_t)2 * 1024 * 1024;
  p.wt_out_b = ws; ws += (size_t)2 * 1024 * 1024;
  p.wt_ffn_in = ws; ws += (size_t)4 * 5632 * 1024;
  p.wt_ffn_out = ws; ws += (size_t)4 * 1024 * DFF;
  p.wt_ple = ws; ws += (size_t)4 * 1024 * 256;
  p.wt_gate = ws; ws += (size_t)4 * 1024 * 1024;
  p.XB = ws; ws += (size_t)ROWS * 1024;
  p.OG = ws; ws += (size_t)ROWS * 1024;
  p.BIG = (char*)ws;
  p.bar = (unsigned*)((char*)d_ws + ((size_t)500 << 20));
  p.ss = (float*)((char*)d_ws + ((size_t)501 << 20));
  p.ss2 = (float*)((char*)d_ws + ((size_t)507 << 20));
  int n = 0;
  for (int i = 0; i < 2; ++i) p.wd[n++] = WD{w_in_a + (size_t)i * 1024 * 4096, p.wt_in_a + (size_t)i * 4096 * 1024, i ? p.g_norms + 4 * D : nullptr, 1024, 4096, 0, 0};
  for (int i = 0; i < 2; ++i) p.wd[n++] = WD{w_out_a + (size_t)i * 1024 * 1024, p.wt_out_a + (size_t)i * 1024 * 1024, nullptr, 1024, 1024, 0, 0};
  p.wd[n++] = WD{w_kv, p.wt_kv, p.g_kv, 1024, 2048, 0, 0};
  for (int i = 0; i < 2; ++i) p.wd[n++] = WD{w_q_b + (size_t)i * 1024 * 1024, p.wt_q + (size_t)i * 1024 * 1024, p.g_norms + (size_t)(i + 2) * 4 * D, 1024, 1024, 0, 0};
  for (int i = 0; i < 2; ++i) p.wd[n++] = WD{w_out_b + (size_t)i * 1024 * 1024, p.wt_out_b + (size_t)i * 1024 * 1024, nullptr, 1024, 1024, 0, 0};
  for (int i = 0; i < 4; ++i) p.wd[n++] = WD{w_ffn_in + (size_t)i * 1024 * 5632, p.wt_ffn_in + (size_t)i * 5632 * 1024, p.g_norms + (size_t)(i * 4 + 2) * D, 1024, 5632, 1, 0};
  for (int i = 0; i < 4; ++i) p.wd[n++] = WD{w_ffn_out + (size_t)i * DFF * 1024, p.wt_ffn_out + (size_t)i * 1024 * DFF, nullptr, DFF, 1024, 0, 0};
  for (int i = 0; i < 4; ++i) p.wd[n++] = WD{w_ple + (size_t)i * 256 * 1024, p.wt_ple + (size_t)i * 1024 * 256, nullptr, 256, 1024, 0, 0};
  for (int i = 0; i < 4; ++i) p.wd[n++] = WD{w_ple_gate + (size_t)i * 1024 * 1024, p.wt_gate + (size_t)i * 1024 * 1024, nullptr, 1024, 1024, 0, 0};
  void* args[] = {&p};
  hipError_t e = hipLaunchCooperativeKernel((void*)yoco_megakernel, dim3(grid_blocks), dim3(256), args, 0, stream);
  if (e != hipSuccess) fprintf(stderr, "cooperative launch failed: %s (grid %d)\n", hipGetErrorString(e), grid_blocks);
}
```
